# Optimizing an MI355X kernel written in HIP

```python
import math
import jax, jax.numpy as jnp
from jax import lax
import numpy as np

D_MODEL = 1024
BATCH = 4
SEQ = 4096
DEPTH = 2

RMS_EPS = 1e-6
NEG_BIG = -1e30
TINY = 1e-20
HG_HEADS = 4
HG_DK = 128
HG_DV = 128
HG_CHUNK = 64
MOBA_HEADS = 4
MOBA_DH = 128
MOBA_BLOCK = 256
MOBA_TOPK = 3
MOBA_Q_CHUNK = 32
DSA_HEADS = 4
DSA_DH = 128
DSA_KV_RANK = 256
IDX_HEADS = 8
IDX_DIM = 64
DSA_TOPK_MAX = 256
DSA_Q_BLOCK = 128
REL_BUCKETS = 32
REL_MAX_DIST = 2048
N_BRANCH = 3
D_FF = ((8 * D_MODEL // 3 + 255) // 256) * 256
HG_W = HG_HEADS * HG_DV
MOBA_W = MOBA_HEADS * MOBA_DH
DSA_W = DSA_HEADS * DSA_DH
IN_SIZES = (HG_HEADS * HG_DK, HG_HEADS * HG_DK, HG_W, HG_W,
            MOBA_W, MOBA_W, MOBA_W,
            DSA_W, DSA_KV_RANK,
            IDX_HEADS * IDX_DIM, IDX_DIM, IDX_HEADS,
            N_BRANCH * D_MODEL)
IN_WIDTH = sum(IN_SIZES)

kernel_name = 'hybrid_hgrn2_moba_dsa_gated_block'


def rms_norm(x, w):
    xf = x.astype(jnp.float32)
    y = xf * lax.rsqrt(jnp.mean(xf * xf, axis=-1, keepdims=True) + RMS_EPS)
    return (y * w.astype(jnp.float32)).astype(x.dtype)


def layer_norm(x, w, b):
    xf = x.astype(jnp.float32)
    mu = jnp.mean(xf, axis=-1, keepdims=True)
    xc = xf - mu
    y = xc * lax.rsqrt(jnp.mean(xc * xc, axis=-1, keepdims=True) + RMS_EPS)
    return (y * w.astype(jnp.float32) + b.astype(jnp.float32)).astype(x.dtype)


def rel_bucket(dist):
    n = jnp.maximum(dist, 0)
    exact = REL_BUCKETS // 2
    nf = jnp.maximum(n, exact).astype(jnp.float32)
    large = exact + (jnp.log(nf / exact) / math.log(REL_MAX_DIST / exact) * (REL_BUCKETS - exact)).astype(jnp.int32)
    large = jnp.minimum(large, REL_BUCKETS - 1)
    return jnp.where(n < exact, n, large)


def chunk_gated_recurrence(q, k, log_f, v):
    B, S, H, DK = q.shape
    DV = v.shape[-1]
    nc = S // HG_CHUNK

    def chunks(a):
        return a.reshape(B, nc, HG_CHUNK, H, a.shape[-1]).transpose(1, 0, 3, 2, 4)

    causal = jnp.tril(jnp.ones((HG_CHUNK, HG_CHUNK), dtype=bool))

    def step(state, inp):
        qc, kc, gc, vc = inp
        b = jnp.cumsum(gc, axis=2)
        o_inter = jnp.einsum('bhcd,bhde->bhce', qc * jnp.exp(b), state)
        diff = b[:, :, :, None, :] - b[:, :, None, :, :]
        decay = jnp.exp(jnp.where(causal[:, :, None], diff, NEG_BIG))
        scores = jnp.einsum('bhid,bhijd,bhjd->bhij', qc, decay, kc)
        o = o_inter + jnp.einsum('bhij,bhje->bhie', scores, vc)
        b_last = b[:, :, -1:, :]
        state = (jnp.exp(b_last[:, :, 0, :])[..., None] * state
                 + jnp.einsum('bhjd,bhje->bhde', kc * jnp.exp(b_last - b), vc))
        return state, o

    s0 = jnp.zeros((B, H, DK, DV), jnp.float32)
    _, o = lax.scan(step, s0, (chunks(q), chunks(k), chunks(log_f), chunks(v)))
    return o.transpose(1, 0, 3, 2, 4).reshape(B, S, H, DV)


def hgrn2_mixer(q, f_pre, i, g, lb, norm_w):
    B, S, _ = q.shape
    f32 = jnp.float32
    qf = q.reshape(B, S, HG_HEADS, HG_DK).astype(f32)
    fp = f_pre.reshape(B, S, HG_HEADS, HG_DK).astype(f32)
    v = i.reshape(B, S, HG_HEADS, HG_DV).astype(f32)
    lbh = lb.reshape(HG_HEADS, HG_DK).astype(f32)
    f = lbh + (1.0 - lbh) * jax.nn.sigmoid(fp)
    log_f = jnp.log(jnp.maximum(f, TINY))
    k = (1.0 - lbh) * jax.nn.sigmoid(-fp)
    o = chunk_gated_recurrence(qf, k, log_f, v)
    gate = jax.nn.silu(g.reshape(B, S, HG_HEADS, HG_DV).astype(f32))
    o = rms_norm(o, norm_w) * gate
    return o.reshape(B, S, HG_W).astype(q.dtype)


def moba_attention(q, k, v, rel_table):
    B, S, H, DH = q.shape
    f32 = jnp.float32
    nb = -(-S // MOBA_BLOCK)
    pad = nb * MOBA_BLOCK - S
    kp = jnp.pad(k, ((0, 0), (0, pad), (0, 0), (0, 0)))
    vp = jnp.pad(v, ((0, 0), (0, pad), (0, 0), (0, 0)))
    kb = kp.reshape(B, nb, MOBA_BLOCK, H, DH).transpose(0, 3, 1, 2, 4)
    vb = vp.reshape(B, nb, MOBA_BLOCK, H, DH).transpose(0, 3, 1, 2, 4)
    k_mean = jnp.mean(kb.astype(f32), axis=3).astype(q.dtype)
    n_sel = min(MOBA_TOPK, nb - 1)
    scale = DH ** -0.5
    nq = S // MOBA_Q_CHUNK
    q_chunks = q.reshape(B, nq, MOBA_Q_CHUNK, H, DH).transpose(1, 0, 2, 3, 4)
    starts = jnp.arange(nq, dtype=jnp.int32) * MOBA_Q_CHUNK
    b_ix = jnp.arange(B)[:, None, None, None]
    h_ix = jnp.arange(H)[None, None, :, None]
    h_ix5 = jnp.arange(H)[None, None, :, None, None]
    offs = jnp.arange(MOBA_BLOCK, dtype=jnp.int32)
    blk_ids = jnp.arange(nb, dtype=jnp.int32)

    def one_chunk(args):
        qc, start = args
        t = start + jnp.arange(MOBA_Q_CHUNK, dtype=jnp.int32)
        blk = start // MOBA_BLOCK
        k_own = lax.dynamic_slice_in_dim(kp, blk * MOBA_BLOCK, MOBA_BLOCK, axis=1)
        v_own = lax.dynamic_slice_in_dim(vp, blk * MOBA_BLOCK, MOBA_BLOCK, axis=1)
        dist_own = t[:, None] - (blk * MOBA_BLOCK + offs)[None, :]
        l_own = jnp.einsum('bqhd,bkhd->bqhk', qc, k_own).astype(f32) * scale
        l_own = l_own + rel_table[rel_bucket(dist_own)].astype(f32).transpose(0, 2, 1)
        l_own = jnp.where((dist_own >= 0)[:, None, :], l_own, NEG_BIG)
        if n_sel == 0:
            p = jax.nn.softmax(l_own, axis=-1).astype(v.dtype)
            return jnp.einsum('bqhk,bkhd->bqhd', p, v_own)
        gate = jnp.einsum('bqhd,bhnd->bqhn', qc, k_mean).astype(f32)
        gate = jnp.where(blk_ids < blk, gate, NEG_BIG)
        _, sel = lax.top_k(gate, n_sel)
        k_sel = kb[b_ix, h_ix, sel]
        v_sel = vb[b_ix, h_ix, sel]
        dist_sel = t[None, :, None, None, None] - (sel[..., None] * MOBA_BLOCK + offs)
        l_sel = jnp.einsum('bqhd,bqhknd->bqhkn', qc, k_sel).astype(f32) * scale
        l_sel = l_sel + rel_table[rel_bucket(dist_sel), h_ix5].astype(f32)
        l_sel = jnp.where((sel < blk)[..., None], l_sel, NEG_BIG)
        logits = jnp.concatenate([l_sel.reshape(B, MOBA_Q_CHUNK, H, n_sel * MOBA_BLOCK), l_own], axis=-1)
        p = jax.nn.softmax(logits, axis=-1).astype(v.dtype)
        p_sel = p[..., :n_sel * MOBA_BLOCK].reshape(B, MOBA_Q_CHUNK, H, n_sel, MOBA_BLOCK)
        p_own = p[..., n_sel * MOBA_BLOCK:]
        return (jnp.einsum('bqhkn,bqhknd->bqhd', p_sel, v_sel)
                + jnp.einsum('bqhk,bkhd->bqhd', p_own, v_own))

    out = lax.map(one_chunk, (q_chunks, starts))
    return out.transpose(1, 0, 2, 3, 4).reshape(B, S, H * DH)


def dsa_attention(q, c_kv, w_uk, w_uv, iq, ik, iw, rel_table, n_keep):
    B, S, H, DH = q.shape
    f32 = jnp.float32
    q_abs = jnp.einsum('bshd,rhd->bshr', q, w_uk)
    nblk = S // DSA_Q_BLOCK

    def blocks(a):
        return a.reshape((B, nblk, DSA_Q_BLOCK) + a.shape[2:]).swapaxes(0, 1)

    starts = jnp.arange(nblk, dtype=jnp.int32) * DSA_Q_BLOCK
    key_pos = jnp.arange(S, dtype=jnp.int32)
    scale = DH ** -0.5

    def one_block(args):
        qa, iqb, iwb, start = args
        t = start + jnp.arange(DSA_Q_BLOCK, dtype=jnp.int32)
        s_idx = jnp.einsum('bqhe,bse->bqhs', iqb, ik).astype(f32) * (IDX_DIM ** -0.5)
        score = jnp.einsum('bqh,bqhs->bqs', iwb.astype(f32), jax.nn.relu(s_idx))
        score = jnp.where(key_pos[None, :] <= t[:, None], score, NEG_BIG)
        _, idx = lax.top_k(score, n_keep)
        c_sel = jax.vmap(lambda cb, ib: cb[ib])(c_kv, idx)
        dist = t[None, :, None] - idx
        logits = jnp.einsum('bqhr,bqkr->bqhk', qa, c_sel).astype(f32) * scale
        logits = logits + rel_table[rel_bucket(dist)].astype(f32).transpose(0, 1, 3, 2)
        logits = jnp.where((dist >= 0)[:, :, None, :], logits, NEG_BIG)
        p = jax.nn.softmax(logits, axis=-1).astype(c_kv.dtype)
        return jnp.einsum('bqhk,bqkr->bqhr', p, c_sel)

    o_lat = lax.map(one_block, (blocks(q_abs), blocks(iq), blocks(iw), starts))
    o_lat = o_lat.swapaxes(0, 1).reshape(B, S, H, DSA_KV_RANK)
    return jnp.einsum('bshr,rhd->bshd', o_lat, w_uv).reshape(B, S, H * DH)


def setup_inputs(seed: int = 0) -> dict:
    key = jax.random.key(seed)
    ks = jax.random.split(key, 24)
    f32 = jnp.float32

    def nrm(k, shape, scale):
        return jax.random.normal(k, shape, f32) * scale

    def gain(k, shape):
        return 1.0 + 0.05 * jax.random.normal(k, shape, f32)

    return {
        'x': nrm(ks[0], (BATCH, SEQ, D_MODEL), 1.0),
        'w_in': nrm(ks[1], (DEPTH, D_MODEL, IN_WIDTH), D_MODEL ** -0.5),
        'pre_mix_norm': gain(ks[2], (DEPTH, D_MODEL)),
        'post_mix_norm': gain(ks[3], (DEPTH, D_MODEL)),
        'pre_ffn_norm': gain(ks[4], (DEPTH, D_MODEL)),
        'post_ffn_norm': gain(ks[5], (DEPTH, D_MODEL)),
        'hg_lb_logits': nrm(ks[6], (DEPTH, HG_HEADS * HG_DK), 0.5),
        'hg_norm_w': gain(ks[7], (DEPTH, HG_DV)),
        'dsa_kv_norm': gain(ks[8], (DEPTH, DSA_KV_RANK)),
        'dsa_w_uk': nrm(ks[9], (DEPTH, DSA_KV_RANK, DSA_HEADS, DSA_DH), DSA_KV_RANK ** -0.5),
        'dsa_w_uv': nrm(ks[10], (DEPTH, DSA_KV_RANK, DSA_HEADS, DSA_DH), DSA_KV_RANK ** -0.5),
        'idx_k_norm_w': gain(ks[11], (DEPTH, IDX_DIM)),
        'idx_k_norm_b': nrm(ks[12], (DEPTH, IDX_DIM), 0.02),
        'rel_bias': nrm(ks[13], (REL_BUCKETS, MOBA_HEADS + DSA_HEADS), 0.5),
        'w_branch_a': nrm(ks[14], (DEPTH, HG_W, D_MODEL), HG_W ** -0.5),
        'w_branch_b': nrm(ks[15], (DEPTH, MOBA_W, D_MODEL), MOBA_W ** -0.5),
        'w_branch_c': nrm(ks[16], (DEPTH, DSA_W, D_MODEL), DSA_W ** -0.5),
        'w_out': nrm(ks[17], (DEPTH, D_MODEL, D_MODEL), D_MODEL ** -0.5),
        'w_ffn_in': nrm(ks[18], (DEPTH, D_MODEL, 2 * D_FF), D_MODEL ** -0.5),
        'w_ffn_out': nrm(ks[19], (DEPTH, D_FF, D_MODEL), D_FF ** -0.5),
    }


def reference(x, w_in, pre_mix_norm, post_mix_norm, pre_ffn_norm, post_ffn_norm,
              hg_lb_logits, hg_norm_w, dsa_kv_norm, dsa_w_uk, dsa_w_uv,
              idx_k_norm_w, idx_k_norm_b, rel_bias, w_branch_a, w_branch_b, w_branch_c,
              w_out, w_ffn_in, w_ffn_out):
    f32 = jnp.float32
    B, S, _ = x.shape
    lbp = jax.nn.softmax(hg_lb_logits.astype(f32), axis=0)
    lower_bounds = jnp.cumsum(lbp, axis=0) - lbp[0]
    bias_b = rel_bias[:, :MOBA_HEADS]
    bias_c = rel_bias[:, MOBA_HEADS:]
    n_keep = min(DSA_TOPK_MAX, S // 4)
    splits = [int(s) for s in np.cumsum(IN_SIZES)[:-1]]
    for l in range(DEPTH):
        h = rms_norm(x, pre_mix_norm[l])
        proj = h @ w_in[l]
        (hq, hf, hi, hg, mq, mk, mv, dq, dkv, iq, ik, iw, gates) = jnp.split(proj, splits, axis=-1)
        y_a = hgrn2_mixer(hq, hf, hi, hg, lower_bounds[l], hg_norm_w[l])
        y_b = moba_attention(mq.reshape(B, S, MOBA_HEADS, MOBA_DH),
                             mk.reshape(B, S, MOBA_HEADS, MOBA_DH),
                             mv.reshape(B, S, MOBA_HEADS, MOBA_DH), bias_b)
        c_kv = rms_norm(dkv, dsa_kv_norm[l])
        ik_n = layer_norm(ik, idx_k_norm_w[l], idx_k_norm_b[l])
        y_c = dsa_attention(dq.reshape(B, S, DSA_HEADS, DSA_DH), c_kv, dsa_w_uk[l], dsa_w_uv[l],
                            iq.reshape(B, S, IDX_HEADS, IDX_DIM), ik_n, iw * (IDX_HEADS ** -0.5),
                            bias_c, n_keep)
        g = jax.nn.sigmoid(gates.reshape(B, S, N_BRANCH, D_MODEL))
        merged = (g[:, :, 0] * (y_a @ w_branch_a[l])
                  + g[:, :, 1] * (y_b @ w_branch_b[l])
                  + g[:, :, 2] * (y_c @ w_branch_c[l]))
        x = x + rms_norm(merged @ w_out[l], post_mix_norm[l])
        h2 = rms_norm(x, pre_ffn_norm[l])
        gate, up = jnp.split(h2 @ w_ffn_in[l], 2, axis=-1)
        x = x + rms_norm((jax.nn.silu(gate) * up) @ w_ffn_out[l], post_ffn_norm[l])
    return x
```

```cpp
#include <hip/hip_runtime.h>
#include <stdint.h>

#define D_MODEL 1024
#define BATCH 4
#define SEQ 4096
#define DEPTH 2
#define IN_W 8008
#define D_FF 2816
#define NEG_BIG (-1e30f)
#define C_HQ 0
#define C_HF 512
#define C_HI 1024
#define C_HG 1536
#define C_MQ 2048
#define C_MK 2560
#define C_MV 3072
#define C_DQ 3584
#define C_DKV 4096
#define C_IQ 4352
#define C_IK 4864
#define C_IW 4928
#define C_G 4936

__device__ __forceinline__ float sigmoidf_(float x) { return 1.f / (1.f + expf(-x)); }
__device__ __forceinline__ int rel_bucket(int dist) {
    int n = dist > 0 ? dist : 0;
    if (n < 16) return n;
    float nf = (float)n;
    int large = 16 + (int)(logf(nf / 16.f) / 4.852030263919617f * 16.f);
    return large < 31 ? large : 31;
}

__global__ void k_rmsnorm(const float* __restrict__ x, const float* __restrict__ w, float* __restrict__ y, int d) {
    __shared__ float red[256];
    const float* xr = x + (size_t)blockIdx.x * d; float* yr = y + (size_t)blockIdx.x * d;
    float s = 0.f;
    for (int i = threadIdx.x; i < d; i += 256) { float v = xr[i]; s += v * v; }
    red[threadIdx.x] = s; __syncthreads();
    for (int o = 128; o > 0; o >>= 1) { if (threadIdx.x < o) red[threadIdx.x] += red[threadIdx.x + o]; __syncthreads(); }
    float r = rsqrtf(red[0] / (float)d + 1e-6f);
    for (int i = threadIdx.x; i < d; i += 256) yr[i] = xr[i] * r * w[i];
}
__global__ void k_resid_norm(float* __restrict__ x, const float* __restrict__ o, const float* __restrict__ w, int d) {
    __shared__ float red[256];
    const float* orow = o + (size_t)blockIdx.x * d; float* xr = x + (size_t)blockIdx.x * d;
    float s = 0.f;
    for (int i = threadIdx.x; i < d; i += 256) { float v = orow[i]; s += v * v; }
    red[threadIdx.x] = s; __syncthreads();
    for (int k = 128; k > 0; k >>= 1) { if (threadIdx.x < k) red[threadIdx.x] += red[threadIdx.x + k]; __syncthreads(); }
    float r = rsqrtf(red[0] / (float)d + 1e-6f);
    for (int i = threadIdx.x; i < d; i += 256) xr[i] = xr[i] + orow[i] * r * w[i];
}

__global__ void __launch_bounds__(256) k_gemm(const float* __restrict__ A, int lda, const float* __restrict__ B, int ldb,
                                              float* __restrict__ C, int ldc, int M, int N, int K, int mode, const float* __restrict__ G, int ldg) {
    __shared__ float As[16][64 + 1], Bs[16][64 + 1];
    const int tx = threadIdx.x & 15, ty = threadIdx.x >> 4;
    const int m0 = blockIdx.y * 64, n0 = blockIdx.x * 64;
    float acc[4][4];
#pragma unroll
    for (int i = 0; i < 4; ++i)
#pragma unroll
        for (int j = 0; j < 4; ++j) acc[i][j] = 0.f;
    for (int k0 = 0; k0 < K; k0 += 16) {
        for (int i = threadIdx.x; i < 64 * 16; i += 256) {
            int r = i >> 4, c = i & 15;
            int gm = m0 + r; As[c][r] = (gm < M) ? A[(size_t)gm * lda + k0 + c] : 0.f;
        }
        for (int i = threadIdx.x; i < 16 * 64; i += 256) {
            int r = i >> 6, c = i & 63;
            int gn = n0 + c; Bs[r][c] = (gn < N) ? B[(size_t)(k0 + r) * ldb + gn] : 0.f;
        }
        __syncthreads();
#pragma unroll
        for (int kk = 0; kk < 16; ++kk) {
            float a[4], b[4];
#pragma unroll
            for (int i = 0; i < 4; ++i) a[i] = As[kk][ty * 4 + i];
#pragma unroll
            for (int j = 0; j < 4; ++j) b[j] = Bs[kk][tx * 4 + j];
#pragma unroll
            for (int i = 0; i < 4; ++i)
#pragma unroll
                for (int j = 0; j < 4; ++j) acc[i][j] += a[i] * b[j];
        }
        __syncthreads();
    }
#pragma unroll
    for (int i = 0; i < 4; ++i)
#pragma unroll
        for (int j = 0; j < 4; ++j) {
            int gm = m0 + ty * 4 + i, gn = n0 + tx * 4 + j;
            if (gm < M && gn < N) {
                float v = acc[i][j];
                if (mode == 0) C[(size_t)gm * ldc + gn] = v;
                else { float g = sigmoidf_(G[(size_t)gm * ldg + gn]); if (mode == 1) C[(size_t)gm * ldc + gn] = g * v; else C[(size_t)gm * ldc + gn] += g * v; }
            }
        }
}

__global__ void __launch_bounds__(128) k_hgrn2(const float* __restrict__ proj, const float* __restrict__ lbl, int layer, float* __restrict__ o) {
    const int h = blockIdx.x, e = threadIdx.x;
    __shared__ float lb[128], qs[128], fs[128], ks[128];
    {
        float l0 = lbl[h * 128 + e], l1 = lbl[512 + h * 128 + e];
        float m = fmaxf(l0, l1), e0 = expf(l0 - m), e1 = expf(l1 - m), p0 = e0 / (e0 + e1), p1 = e1 / (e0 + e1);
        float cs = (layer == 0) ? p0 : (p0 + p1);
        lb[e] = cs - p0;
    }
    float S[128];
#pragma unroll
    for (int d = 0; d < 128; ++d) S[d] = 0.f;
    __syncthreads();
    for (int t = 0; t < SEQ; ++t) {
        const float* pr = proj + (size_t)t * IN_W;
        {
            float fp = pr[C_HF + h * 128 + e]; float l = lb[e];
            float f = l + (1.f - l) * sigmoidf_(fp);
            f = fmaxf(f, 1e-20f);
            fs[e] = f; ks[e] = (1.f - l) * sigmoidf_(-fp); qs[e] = pr[C_HQ + h * 128 + e];
        }
        float v = pr[C_HI + h * 128 + e];
        __syncthreads();
        float acc = 0.f;
#pragma unroll
        for (int d = 0; d < 128; ++d) { S[d] = fs[d] * S[d] + ks[d] * v; acc += qs[d] * S[d]; }
        o[(size_t)t * 512 + h * 128 + e] = acc;
        __syncthreads();
    }
}
__global__ void __launch_bounds__(128) k_hgrn2_post(const float* __restrict__ o, const float* __restrict__ w, const float* __restrict__ proj, float* __restrict__ ya) {
    __shared__ float red[128];
    const int t = blockIdx.x >> 2, h = blockIdx.x & 3, e = threadIdx.x;
    float v = o[(size_t)t * 512 + h * 128 + e];
    red[e] = v * v; __syncthreads();
    for (int k = 64; k > 0; k >>= 1) { if (e < k) red[e] += red[e + k]; __syncthreads(); }
    float r = rsqrtf(red[0] / 128.f + 1e-6f);
    float g = proj[(size_t)t * IN_W + C_HG + h * 128 + e];
    ya[(size_t)t * 512 + h * 128 + e] = v * r * w[e] * (g * sigmoidf_(g));
}

__global__ void __launch_bounds__(128) k_kmean(const float* __restrict__ proj, float* __restrict__ kmean) {
    const int n = blockIdx.x, h = blockIdx.y, d = threadIdx.x;
    float s = 0.f;
    for (int j = 0; j < 256; ++j) s += proj[(size_t)(n * 256 + j) * IN_W + C_MK + h * 128 + d];
    kmean[(h * 16 + n) * 128 + d] = s / 256.f;
}
__global__ void __launch_bounds__(256) k_moba(const float* __restrict__ proj, const float* __restrict__ kmean, const float* __restrict__ rel, float* __restrict__ yb) {
    const int t = blockIdx.x >> 2, h = blockIdx.x & 3, tid = threadIdx.x;
    const int blk = t >> 8;
    __shared__ float q[128], gate[16], lg[1024], red[256];
    __shared__ int sel[3];
    if (tid < 128) q[tid] = proj[(size_t)t * IN_W + C_MQ + h * 128 + tid];
    __syncthreads();
    if (tid < 16) {
        float s = 0.f;
        for (int d = 0; d < 128; ++d) s += q[d] * kmean[(h * 16 + tid) * 128 + d];
        gate[tid] = (tid < blk) ? s : NEG_BIG;
    }
    __syncthreads();
    if (tid == 0) {
        unsigned used = 0u;
        for (int k = 0; k < 3; ++k) { int best = -1; float bv = 0.f;
            for (int i = 0; i < 16; ++i) if (!((used >> i) & 1u) && (best < 0 || gate[i] > bv)) { best = i; bv = gate[i]; }
            used |= 1u << best; sel[k] = best; }
    }
    __syncthreads();
    const float scale = 0.08838834764831845f;
    for (int sl = 0; sl < 4; ++sl) {
        int bn = (sl < 3) ? sel[sl] : blk;
        int s = bn * 256 + tid;
        bool valid = (sl < 3) ? (bn < blk) : (s <= t);
        float l = NEG_BIG;
        if (valid) {
            const float* kr = proj + (size_t)s * IN_W + C_MK + h * 128;
            float a = 0.f;
            for (int d = 0; d < 128; ++d) a += q[d] * kr[d];
            l = a * scale + rel[rel_bucket(t - s) * 8 + h];
        }
        lg[sl * 256 + tid] = l;
    }
    __syncthreads();
    float m = fmaxf(fmaxf(lg[tid], lg[256 + tid]), fmaxf(lg[512 + tid], lg[768 + tid]));
    red[tid] = m; __syncthreads();
    for (int k = 128; k > 0; k >>= 1) { if (tid < k) red[tid] = fmaxf(red[tid], red[tid + k]); __syncthreads(); }
    m = red[0]; __syncthreads();
    float su = 0.f;
    for (int sl = 0; sl < 4; ++sl) { float p = expf(lg[sl * 256 + tid] - m); lg[sl * 256 + tid] = p; su += p; }
    red[tid] = su; __syncthreads();
    for (int k = 128; k > 0; k >>= 1) { if (tid < k) red[tid] += red[tid + k]; __syncthreads(); }
    const float inv = 1.f / red[0];
    const int d = tid & 127, half = tid >> 7;
    float acc = 0.f;
    for (int sl = 0; sl < 4; ++sl) {
        int bn = (sl < 3) ? sel[sl] : blk;
        bool anyvalid = (sl < 3) ? (bn < blk) : true;
        if (!anyvalid) continue;
        for (int j = half * 128; j < half * 128 + 128; ++j) {
            float p = lg[sl * 256 + j];
            if (p != 0.f) acc += p * proj[(size_t)(bn * 256 + j) * IN_W + C_MV + h * 128 + d];
        }
    }
    __syncthreads();
    red[tid] = acc; __syncthreads();
    if (tid < 128) yb[(size_t)t * 512 + h * 128 + tid] = (red[tid] + red[tid + 128]) * inv;
}

__global__ void __launch_bounds__(256) k_dsa_prep(const float* __restrict__ proj, const float* __restrict__ kvw, const float* __restrict__ ikw, const float* __restrict__ ikb,
                                                  float* __restrict__ ckv, float* __restrict__ ikn) {
    __shared__ float red[256];
    const int t = blockIdx.x, tid = threadIdx.x;
    float v = proj[(size_t)t * IN_W + C_DKV + tid];
    red[tid] = v * v; __syncthreads();
    for (int k = 128; k > 0; k >>= 1) { if (tid < k) red[tid] += red[tid + k]; __syncthreads(); }
    float r = rsqrtf(red[0] / 256.f + 1e-6f);
    ckv[(size_t)t * 256 + tid] = v * r * kvw[tid];
    __syncthreads();
    float u = (tid < 64) ? proj[(size_t)t * IN_W + C_IK + tid] : 0.f;
    red[tid] = u; __syncthreads();
    for (int k = 128; k > 0; k >>= 1) { if (tid < k) red[tid] += red[tid + k]; __syncthreads(); }
    float mu = red[0] / 64.f; __syncthreads();
    float xc = (tid < 64) ? (u - mu) : 0.f;
    red[tid] = xc * xc; __syncthreads();
    for (int k = 128; k > 0; k >>= 1) { if (tid < k) red[tid] += red[tid + k]; __syncthreads(); }
    float rr = rsqrtf(red[0] / 64.f + 1e-6f);
    if (tid < 64) ikn[(size_t)t * 64 + tid] = xc * rr * ikw[tid] + ikb[tid];
}
__global__ void __launch_bounds__(256) k_qabs(const float* __restrict__ proj, const float* __restrict__ wuk, float* __restrict__ qabs) {
    const int t = blockIdx.x >> 2, h = blockIdx.x & 3, r = threadIdx.x;
    __shared__ float q[128];
    if (r < 128) q[r] = proj[(size_t)t * IN_W + C_DQ + h * 128 + r];
    __syncthreads();
    const float* w = wuk + ((size_t)r * 4 + h) * 128;
    float a = 0.f;
    for (int d = 0; d < 128; ++d) a += q[d] * w[d];
    qabs[(size_t)t * 1024 + h * 256 + r] = a;
}
__global__ void __launch_bounds__(256) k_dsa(const float* __restrict__ proj, const float* __restrict__ ckv, const float* __restrict__ ikn, const float* __restrict__ qabs,
                                             const float* __restrict__ wuv, const float* __restrict__ rel, float* __restrict__ yc) {
    const int t = blockIdx.x, tid = threadIdx.x;
    __shared__ unsigned long long keys[SEQ];
    __shared__ float iq[512], iw[8];
    __shared__ int cnt_s; __shared__ int idx[256]; __shared__ int red_i[256];
    __shared__ float pl[4][256], olat[4][256], redf[256];
    for (int i = tid; i < 512; i += 256) iq[i] = proj[(size_t)t * IN_W + C_IQ + i];
    if (tid < 8) iw[tid] = proj[(size_t)t * IN_W + C_IW + tid] * 0.35355339059327373f;
    if (tid == 0) cnt_s = 0;
    __syncthreads();
    const int nvalid = t + 1;
    for (int s = tid; s < SEQ; s += 256) {
        unsigned long long key = 0ull;
        if (s <= t) {
            const float* kr = ikn + (size_t)s * 64;
            float sc = 0.f;
            for (int hh = 0; hh < 8; ++hh) { float a = 0.f; for (int d = 0; d < 64; ++d) a += iq[hh * 64 + d] * kr[d]; a *= 0.125f; sc += iw[hh] * fmaxf(a, 0.f); }
            sc += 0.0f;
            unsigned u = __float_as_uint(sc); u = (u & 0x80000000u) ? ~u : (u | 0x80000000u);
            key = ((unsigned long long)u << 12) | (unsigned long long)(4095 - s);
            key += 1ull;
        }
        keys[s] = key;
    }
    __syncthreads();
    const int nkeep = nvalid < 256 ? nvalid : 256;
    unsigned long long thr = 0ull;
    if (nvalid > 256) {
        for (int bit = 44; bit >= 0; --bit) {
            unsigned long long cand = thr | (1ull << bit);
            int c = 0;
            for (int s = tid; s < SEQ; s += 256) c += (keys[s] >= cand) ? 1 : 0;
            red_i[tid] = c; __syncthreads();
            for (int k = 128; k > 0; k >>= 1) { if (tid < k) red_i[tid] += red_i[tid + k]; __syncthreads(); }
            int tot = red_i[0]; __syncthreads();
            if (tot >= 256) thr = cand;
        }
    } else thr = 1ull;
    for (int s = tid; s < SEQ; s += 256) if (keys[s] >= thr && keys[s] != 0ull) { int p = atomicAdd(&cnt_s, 1); if (p < 256) idx[p] = s; }
    __syncthreads();
    const float scale = 0.08838834764831845f;
    float lgt[4] = {NEG_BIG, NEG_BIG, NEG_BIG, NEG_BIG};
    if (tid < nkeep) {
        int s = idx[tid]; const float* cr = ckv + (size_t)s * 256; const float* qa = qabs + (size_t)t * 1024;
        int bk = rel_bucket(t - s);
#pragma unroll
        for (int hh = 0; hh < 4; ++hh) { float a = 0.f; for (int r = 0; r < 256; ++r) a += qa[hh * 256 + r] * cr[r]; lgt[hh] = a * scale + rel[bk * 8 + 4 + hh]; }
    }
#pragma unroll
    for (int hh = 0; hh < 4; ++hh) {
        redf[tid] = lgt[hh]; __syncthreads();
        for (int k = 128; k > 0; k >>= 1) { if (tid < k) redf[tid] = fmaxf(redf[tid], redf[tid + k]); __syncthreads(); }
        float m = redf[0]; __syncthreads();
        float p = (tid < nkeep) ? expf(lgt[hh] - m) : 0.f;
        redf[tid] = p; __syncthreads();
        for (int k = 128; k > 0; k >>= 1) { if (tid < k) redf[tid] += redf[tid + k]; __syncthreads(); }
        float su = redf[0]; __syncthreads();
        pl[hh][tid] = p / su;
    }
    __syncthreads();
    {
        float o0 = 0.f, o1 = 0.f, o2 = 0.f, o3 = 0.f;
        for (int k = 0; k < nkeep; ++k) { float c = ckv[(size_t)idx[k] * 256 + tid]; o0 += pl[0][k] * c; o1 += pl[1][k] * c; o2 += pl[2][k] * c; o3 += pl[3][k] * c; }
        olat[0][tid] = o0; olat[1][tid] = o1; olat[2][tid] = o2; olat[3][tid] = o3;
    }
    __syncthreads();
    for (int o = tid; o < 512; o += 256) {
        int hh = o >> 7, d = o & 127; float a = 0.f;
        for (int r = 0; r < 256; ++r) a += olat[hh][r] * wuv[((size_t)r * 4 + hh) * 128 + d];
        yc[(size_t)t * 512 + o] = a;
    }
}
__global__ void k_swiglu(const float* __restrict__ gu, float* __restrict__ act, int rows) {
    size_t i = (size_t)blockIdx.x * 256 + threadIdx.x; size_t n = (size_t)rows * D_FF;
    if (i < n) { size_t r = i / D_FF, c = i % D_FF; float g = gu[r * (2 * D_FF) + c], u = gu[r * (2 * D_FF) + D_FF + c]; act[i] = g * sigmoidf_(g) * u; }
}

static void gemm(hipStream_t st, const float* A, int lda, const float* B, int ldb, float* C, int ldc, int M, int N, int K, int mode = 0, const float* G = nullptr, int ldg = 0) {
    dim3 grid((N + 63) / 64, (M + 63) / 64);
    hipLaunchKernelGGL(k_gemm, grid, dim3(256), 0, st, A, lda, B, ldb, C, ldc, M, N, K, mode, G, ldg);
}

extern "C" void kernel_launch(void* const* d_in, const int* in_sizes, int n_in, void* d_out, int out_size, void* d_ws, size_t ws_size, hipStream_t stream) {
    const float* x_in = (const float*)d_in[0];
    const float* w_in = (const float*)d_in[1];
    const float* pre_mix = (const float*)d_in[2];
    const float* post_mix = (const float*)d_in[3];
    const float* pre_ffn = (const float*)d_in[4];
    const float* post_ffn = (const float*)d_in[5];
    const float* hg_lb = (const float*)d_in[6];
    const float* hg_nw = (const float*)d_in[7];
    const float* kv_norm = (const float*)d_in[8];
    const float* w_uk = (const float*)d_in[9];
    const float* w_uv = (const float*)d_in[10];
    const float* ik_w = (const float*)d_in[11];
    const float* ik_b = (const float*)d_in[12];
    const float* rel = (const float*)d_in[13];
    const float* w_a = (const float*)d_in[14];
    const float* w_b = (const float*)d_in[15];
    const float* w_c = (const float*)d_in[16];
    const float* w_out = (const float*)d_in[17];
    const float* w_f1 = (const float*)d_in[18];
    const float* w_f2 = (const float*)d_in[19];
    float* x = (float*)d_out;
    hipMemcpyAsync(x, x_in, (size_t)BATCH * SEQ * D_MODEL * 4, hipMemcpyDeviceToDevice, stream);
    float* ws = (float*)d_ws; size_t off = 0;
    auto take = [&](size_t n) { float* p = ws + off; off += (n + 63) & ~(size_t)63; return p; };
    float* h = take((size_t)SEQ * D_MODEL);
    float* proj = take((size_t)SEQ * IN_W);
    float* ya = take((size_t)SEQ * 512);
    float* yb = take((size_t)SEQ * 512);
    float* yc = take((size_t)SEQ * 512);
    float* merged = take((size_t)SEQ * D_MODEL);
    float* outb = take((size_t)SEQ * D_MODEL);
    float* act = take((size_t)SEQ * D_FF);
    float* kmean = take(4 * 16 * 128);
    float* hgo = merged;
    float* ckv = outb;
    float* ikn = outb + (size_t)SEQ * 256;
    float* qabs = act;
    for (int l = 0; l < DEPTH; ++l) {
        const float* Win = w_in + (size_t)l * D_MODEL * IN_W;
        for (int b = 0; b < BATCH; ++b) {
            float* xb = x + (size_t)b * SEQ * D_MODEL;
            hipLaunchKernelGGL(k_rmsnorm, dim3(SEQ), dim3(256), 0, stream, xb, pre_mix + l * D_MODEL, h, D_MODEL);
            gemm(stream, h, D_MODEL, Win, IN_W, proj, IN_W, SEQ, IN_W, D_MODEL);
            hipLaunchKernelGGL(k_hgrn2, dim3(4), dim3(128), 0, stream, proj, hg_lb, l, hgo);
            hipLaunchKernelGGL(k_hgrn2_post, dim3(SEQ * 4), dim3(128), 0, stream, hgo, hg_nw + l * 128, proj, ya);
            hipLaunchKernelGGL(k_kmean, dim3(16, 4), dim3(128), 0, stream, proj, kmean);
            hipLaunchKernelGGL(k_moba, dim3(SEQ * 4), dim3(256), 0, stream, proj, kmean, rel, yb);
            hipLaunchKernelGGL(k_dsa_prep, dim3(SEQ), dim3(256), 0, stream, proj, kv_norm + l * 256, ik_w + l * 64, ik_b + l * 64, ckv, ikn);
            hipLaunchKernelGGL(k_qabs, dim3(SEQ * 4), dim3(256), 0, stream, proj, w_uk + (size_t)l * 256 * 512, qabs);
            hipLaunchKernelGGL(k_dsa, dim3(SEQ), dim3(256), 0, stream, proj, ckv, ikn, qabs, w_uv + (size_t)l * 256 * 512, rel, yc);
            gemm(stream, ya, 512, w_a + (size_t)l * 512 * D_MODEL, D_MODEL, merged, D_MODEL, SEQ, D_MODEL, 512, 1, proj + C_G, IN_W);
            gemm(stream, yb, 512, w_b + (size_t)l * 512 * D_MODEL, D_MODEL, merged, D_MODEL, SEQ, D_MODEL, 512, 2, proj + C_G + 1024, IN_W);
            gemm(stream, yc, 512, w_c + (size_t)l * 512 * D_MODEL, D_MODEL, merged, D_MODEL, SEQ, D_MODEL, 512, 2, proj + C_G + 2048, IN_W);
            gemm(stream, merged, D_MODEL, w_out + (size_t)l * D_MODEL * D_MODEL, D_MODEL, outb, D_MODEL, SEQ, D_MODEL, D_MODEL);
            hipLaunchKernelGGL(k_resid_norm, dim3(SEQ), dim3(256), 0, stream, xb, outb, post_mix + l * D_MODEL, D_MODEL);
            hipLaunchKernelGGL(k_rmsnorm, dim3(SEQ), dim3(256), 0, stream, xb, pre_ffn + l * D_MODEL, h, D_MODEL);
            float* gu = proj;
            gemm(stream, h, D_MODEL, w_f1 + (size_t)l * D_MODEL * 2 * D_FF, 2 * D_FF, gu, 2 * D_FF, SEQ, 2 * D_FF, D_MODEL);
            hipLaunchKernelGGL(k_swiglu, dim3((unsigned)(((size_t)SEQ * D_FF + 255) / 256)), dim3(256), 0, stream, gu, act, SEQ);
            gemm(stream, act, D_FF, w_f2 + (size_t)l * D_FF * D_MODEL, D_MODEL, outb, D_MODEL, SEQ, D_MODEL, D_FF);
            hipLaunchKernelGGL(k_resid_norm, dim3(SEQ), dim3(256), 0, stream, xb, outb, post_ffn + l * D_MODEL, D_MODEL);
        }
    }
}
```

```cpp
#include <hip/hip_runtime.h>
#include <stdint.h>
#include <stdio.h>

#define D_MODEL 1024
#define BATCH 4
#define SEQ 4096
#define NTOK 16384
#define DEPTH 2
#define IN_W 8008
#define D_FF 2816
#define NEG_BIG (-1e30f)
#define C_HQ 0
#define C_HF 512
#define C_HI 1024
#define C_HG 1536
#define C_MQ 2048
#define C_MK 2560
#define C_MV 3072
#define C_DQ 3584
#define C_DKV 4096
#define C_IQ 4352
#define C_IK 4864
#define C_IW 4928
#define C_G 4936
#define NP1 5632

#define LAS __attribute__((address_space(3)))
typedef unsigned short bf16_t;
typedef short bf16x8 __attribute__((ext_vector_type(8)));
typedef float f32x4 __attribute__((ext_vector_type(4)));
typedef unsigned u32x4 __attribute__((ext_vector_type(4)));
typedef unsigned u32x2 __attribute__((ext_vector_type(2)));

__device__ __forceinline__ float sigmoidf_(float x) { return 1.f / (1.f + __expf(-x)); }
__device__ __forceinline__ float bf2f(bf16_t b) { return __uint_as_float(((unsigned)b) << 16); }
__device__ __forceinline__ unsigned cvt_pk_bf16(float lo, float hi) { unsigned r; asm volatile("v_cvt_pk_bf16_f32 %0, %1, %2" : "=v"(r) : "v"(lo), "v"(hi)); return r; }
__device__ __forceinline__ bf16_t f2bf(float f) { return (bf16_t)(cvt_pk_bf16(f, 0.f) & 0xffffu); }
__device__ __forceinline__ int rel_bucket(int dist) {
    int n = dist > 0 ? dist : 0;
    if (n < 16) return n;
    float nf = (float)n;
    int large = 16 + (int)(logf(nf / 16.f) / 4.852030263919617f * 16.f);
    return large < 31 ? large : 31;
}

enum { I_X = 0, I_WIN, I_PREMIX, I_POSTMIX, I_PREFFN, I_POSTFFN, I_LB, I_HGNW, I_KVN, I_WUK, I_WUV, I_IKNW, I_IKNB, I_REL, I_WA, I_WB, I_WC, I_WOUT, I_WF1, I_WF2 };
struct Params { const float* in[20]; float* x; unsigned char* ws; };
constexpr size_t MiB = 1024 * 1024;
constexpr size_t OFF_CTL = 0, OFF_Y = 65536, OFF_HF = OFF_Y + 64 * MiB, OFF_HI = OFF_HF + 16 * MiB, OFF_HG = OFF_HI + 16 * MiB, OFF_MK = OFF_HG + 16 * MiB,
                 OFF_MV = OFF_MK + 16 * MiB, OFF_IQ = OFF_MV + 16 * MiB, OFF_CKV = OFF_IQ + 16 * MiB, OFF_IKW = OFF_CKV + 8 * MiB, OFF_H = OFF_IKW + 4 * MiB,
                 OFF_WIN = OFF_H + 32 * MiB, OFF_RS = OFF_WIN + 11 * MiB;
constexpr size_t OFF_WG = OFF_RS, OFF_WBR = OFF_WG + 6 * MiB, OFF_WOUT = OFF_WBR + 4 * MiB, OFF_WF1 = OFF_WOUT + 2 * MiB, OFF_WF2 = OFF_WF1 + 11 * MiB, OFF_WEND = OFF_WF2 + 6 * MiB;
constexpr size_t OFF_TMPF = OFF_RS, OFF_KMEAN = OFF_RS + 32 * MiB, OFF_MEND = OFF_KMEAN + MiB / 4;
constexpr size_t OFF_OUT = OFF_HG, OFF_ACT = OFF_Y;
constexpr size_t WS_NEED = (OFF_WEND > OFF_MEND ? OFF_WEND : OFF_MEND);
#define BF(p, off) ((bf16_t*)((p).ws + (off)))
#define F32P(p, off) ((float*)((p).ws + (off)))
__device__ const unsigned long long kP1Off[22] = {OFF_Y, OFF_Y, OFF_HF, OFF_HF, OFF_HI, OFF_HI, OFF_HG, OFF_HG, OFF_Y, OFF_Y, OFF_MK, OFF_MK, OFF_MV, OFF_MV, OFF_Y, OFF_Y, OFF_Y, OFF_Y, OFF_CKV, OFF_IQ, OFF_IQ, OFF_IKW};
__device__ const int kP1Ld[22]  = {2048, 2048, 512, 512, 512, 512, 512, 512, 2048, 2048, 512, 512, 512, 512, 2048, 2048, 2048, 2048, 256, 512, 512, 128};
__device__ const int kP1C0[22]  = {0, 256, 0, 256, 0, 256, 0, 256, 512, 768, 0, 256, 0, 256, 1024, 1280, 1536, 1792, 0, 0, 256, 0};
__device__ const int kP1Nc[22]  = {256, 256, 256, 256, 256, 256, 256, 256, 256, 256, 256, 256, 256, 256, 256, 256, 256, 256, 256, 256, 256, 128};

namespace pg8 {
constexpr int BM = 256, BK = 64, HALF = 128, HTB = HALF * BK * 2, STAGE_BYTES = 8 * HTB, NXCD = 8, WGM = 8;
__host__ __device__ __forceinline__ int lds_byte(int r, int c) { const int st = (r >> 4) * 2 + (c >> 5), rr = r & 15, cc = c & 31, ob = rr * 64 + cc * 2; return st * 1024 + (ob ^ (((ob >> 9) & 1) << 5)); }
__host__ __device__ __forceinline__ void stage_rc(int b, int& R, int& C) { const int st = b / 1024, sb = b % 1024, swz = sb ^ (((sb >> 9) & 1) << 5); R = (st >> 1) * 16 + swz / 64; C = (st & 1) * 32 + (swz % 64) / 2; }
__host__ __device__ __forceinline__ int perm32(int rho) { const int n = rho >> 4, i = rho & 15; return 8 * (i >> 2) + 4 * n + (i & 3); }

struct Unit { int pm, pn, ka, nt, br; };
struct Gemm { const bf16_t* A; const bf16_t* Bt; int lda, ldb; };

__device__ __forceinline__ bool tile_of(long L, int nM, int nN, int& pm, int& pn) {
    const int nwg = nM * nN; if (L >= nwg) return false;
    int wgid = (int)L; { const int q = nwg / NXCD, r = nwg % NXCD, xcd = wgid % NXCD, off = wgid / NXCD; wgid = (xcd < r ? xcd * (q + 1) : r * (q + 1) + (xcd - r) * q) + off; }
    const int nig = WGM * nN, gid = wgid / nig, fm = gid * WGM, gsz = (nM - fm) < WGM ? (nM - fm) : WGM;
    pm = fm + ((wgid % nig) % gsz); pn = (wgid % nig) / gsz; return true;
}
struct StaticOrder {
    int nM, nN, G, c, nt;
    __device__ void init(int M, int N, int K, int G_, int c_) { nM = M / BM; nN = N / BM; G = G_; c = c_; nt = K / BK; }
    __device__ bool next(int i, Unit& u) const { u.ka = 0; u.nt = nt; u.br = 0; return tile_of((long)i * G + c, nM, nN, u.pm, u.pn); }
};
struct BranchOrder {
    int nM, nN, G, c;
    __device__ void init(int M, int N, int G_, int c_) { nM = M / BM; nN = N / BM; G = G_; c = c_; }
    __device__ bool next(int i, Unit& u) const { const int ti = i / 3, br = i - ti * 3; u.br = br; u.ka = br * 512; u.nt = (br == 2) ? 16 : 8; return tile_of((long)ti * G + c, nM, nN, u.pm, u.pn); }
};

template <class Epi, class Sched>
__device__ __forceinline__ void gemm_phase(LAS unsigned char* lds, const Gemm g, const Sched& S, const Epi& E) {
    const int tid = threadIdx.x, wid = __builtin_amdgcn_readfirstlane(tid >> 6), lane = tid & 63, wr = wid >> 2, wc = wid & 3, fr = lane & 15, fq = lane >> 4;
    unsigned voffA[2], voffB[2];
#pragma unroll
    for (int i = 0; i < 2; ++i) { int R, C; stage_rc(tid * 16 + i * 8192, R, C); const int Rb = Epi::PERM ? ((R & ~31) + perm32(R & 31)) : R;
        voffA[i] = (unsigned)(R * g.lda + C) * 2u; voffB[i] = (unsigned)(Rb * g.ldb + C) * 2u; }
    const size_t kstep = (size_t)(BK * 2);
    const size_t hsA = (size_t)HALF * g.lda * 2, hsB = (size_t)HALF * g.ldb * 2;
    const size_t tsA = 2 * hsA, tsB = 2 * hsB;
    const unsigned ldsw = (unsigned)wid * 1024u;
    const int aoff = lds_byte(wr * 64 + fr, fq * 8), boff = lds_byte(wc * 32 + fr, fq * 8);
#define PG8_SA(b, h) (((b) * 2 + (h)) * HTB)
#define PG8_SB(b, h) ((4 + (b) * 2 + (h)) * HTB)
#define PG8_STAGE(bufoff, gbase, voff) do { _Pragma("unroll") for (int _i = 0; _i < 2; ++_i) \
        __builtin_amdgcn_global_load_lds((const unsigned*)((const char*)(gbase) + (voff)[_i]), (LAS unsigned*)(lds + (bufoff) + ldsw + _i * 8192), 16, 0, 0); } while (0)
#define PG8_LDA(dst, b, h) do { _Pragma("unroll") for (int m = 0; m < 4; ++m) _Pragma("unroll") for (int k = 0; k < 2; ++k) dst[m][k] = *(const LAS bf16x8*)(lds + PG8_SA(b, h) + aoff + m * 2048 + k * 1024); } while (0)
#define PG8_LDB(dst, b, h) do { _Pragma("unroll") for (int n = 0; n < 2; ++n) _Pragma("unroll") for (int k = 0; k < 2; ++k) dst[n][k] = *(const LAS bf16x8*)(lds + PG8_SB(b, h) + boff + n * 2048 + k * 1024); } while (0)
#define PG8_MMA(ai, bj, At, Bt) do { __builtin_amdgcn_s_setprio(1); _Pragma("unroll") for (int m = 0; m < 4; ++m) _Pragma("unroll") for (int n = 0; n < 2; ++n) _Pragma("unroll") for (int k = 0; k < 2; ++k) \
        acc[ai][bj][m][n] = __builtin_amdgcn_mfma_f32_16x16x32_bf16(Bt[n][k], At[m][k], acc[ai][bj][m][n], 0, 0, 0); __builtin_amdgcn_s_setprio(0); } while (0)
#define PG8_WAIT_V(n) asm volatile("s_waitcnt vmcnt(" #n ")" ::: "memory")
#define PG8_WAIT_L(n) asm volatile("s_waitcnt lgkmcnt(" #n ")" ::: "memory")
#define PG8_BAR __builtin_amdgcn_s_barrier()
#define PG8_SCHED __builtin_amdgcn_sched_barrier(0)
    Unit cur, nxt; int ui = 0;
    if (!S.next(0, cur)) return;
    f32x4 acc[2][2][4][2];
#pragma unroll
    for (int a = 0; a < 2; ++a)
#pragma unroll
        for (int b = 0; b < 2; ++b)
#pragma unroll
            for (int m = 0; m < 4; ++m)
#pragma unroll
                for (int n = 0; n < 2; ++n) acc[a][b][m][n] = (f32x4){0.f, 0.f, 0.f, 0.f};
    bf16x8 At[4][2], B0[2][2], B1[2][2];
    const char* cA = (const char*)g.A + (size_t)cur.pm * tsA + (size_t)cur.ka * 2; const char* cB = (const char*)g.Bt + (size_t)cur.pn * tsB + (size_t)cur.ka * 2;
    PG8_STAGE(PG8_SB(0, 0), cB, voffB); PG8_STAGE(PG8_SA(0, 0), cA, voffA); PG8_STAGE(PG8_SB(0, 1), cB + hsB, voffB); PG8_STAGE(PG8_SA(0, 1), cA + hsA, voffA);
    if (wr == 1) PG8_BAR;
    PG8_WAIT_V(4); PG8_BAR;
    PG8_STAGE(PG8_SB(1, 0), cB + kstep, voffB); PG8_STAGE(PG8_SA(1, 0), cA + kstep, voffA); PG8_STAGE(PG8_SB(1, 1), cB + hsB + kstep, voffB);
    PG8_WAIT_V(6); PG8_BAR;
    for (;;) {
        const bool has_next = S.next(ui + 1, nxt);
        const char* nA = has_next ? (const char*)g.A + (size_t)nxt.pm * tsA + (size_t)nxt.ka * 2 : cA; const char* nB = has_next ? (const char*)g.Bt + (size_t)nxt.pn * tsB + (size_t)nxt.ka * 2 : cB;
        const int nt = cur.nt;
        for (int t = 0; t < nt; t += 2) {
            const bool last = (t == nt - 2);
            const char* a1 = cA + (size_t)(t + 1) * kstep;
            const char* a2 = last ? nA : cA + (size_t)(t + 2) * kstep; const char* b2 = last ? nB : cB + (size_t)(t + 2) * kstep;
            const char* a3 = a2 + kstep; const char* b3 = b2 + kstep;
            PG8_LDB(B0, 0, 0); PG8_SCHED; PG8_LDA(At, 0, 0); PG8_STAGE(PG8_SA(1, 1), a1 + hsA, voffA);
            PG8_WAIT_L(8); PG8_BAR; PG8_WAIT_L(0); PG8_MMA(0, 0, At, B0); PG8_BAR; PG8_SCHED;
            PG8_LDB(B1, 0, 1); PG8_STAGE(PG8_SB(0, 0), b2, voffB);
            PG8_BAR; PG8_WAIT_L(0); PG8_MMA(0, 1, At, B1); PG8_BAR;
            PG8_LDA(At, 0, 1); PG8_STAGE(PG8_SA(0, 0), a2, voffA);
            PG8_BAR; PG8_WAIT_L(0); PG8_MMA(1, 0, At, B0); PG8_BAR; PG8_SCHED;
            PG8_STAGE(PG8_SB(0, 1), b2 + hsB, voffB);
            PG8_WAIT_V(6); PG8_BAR; PG8_MMA(1, 1, At, B1); PG8_BAR;
            PG8_LDB(B0, 1, 0); PG8_SCHED; PG8_LDA(At, 1, 0); PG8_STAGE(PG8_SA(0, 1), a2 + hsA, voffA);
            PG8_WAIT_L(8); PG8_BAR; PG8_WAIT_L(0); PG8_MMA(0, 0, At, B0); PG8_BAR; PG8_SCHED;
            PG8_LDB(B1, 1, 1); PG8_STAGE(PG8_SB(1, 0), b3, voffB);
            PG8_BAR; PG8_WAIT_L(0); PG8_MMA(0, 1, At, B1); PG8_BAR;
            PG8_LDA(At, 1, 1); PG8_STAGE(PG8_SA(1, 0), a3, voffA);
            PG8_BAR; PG8_WAIT_L(0); PG8_MMA(1, 0, At, B0); PG8_BAR; PG8_SCHED;
            PG8_STAGE(PG8_SB(1, 1), b3 + hsB, voffB);
            PG8_WAIT_V(6); PG8_BAR; PG8_MMA(1, 1, At, B1); PG8_BAR;
        }
        E(acc, cur, wr, wc, fr, fq);
        if (!has_next) break;
#pragma unroll
        for (int a = 0; a < 2; ++a)
#pragma unroll
            for (int b = 0; b < 2; ++b)
#pragma unroll
                for (int m = 0; m < 4; ++m)
#pragma unroll
                    for (int n = 0; n < 2; ++n) acc[a][b][m][n] = (f32x4){0.f, 0.f, 0.f, 0.f};
        cur = nxt; cA = nA; cB = nB; ++ui;
    }
    PG8_WAIT_V(0);
    if (wr == 0) PG8_BAR;
    PG8_BAR;
#undef PG8_SA
#undef PG8_SB
#undef PG8_STAGE
#undef PG8_LDA
#undef PG8_LDB
#undef PG8_MMA
#undef PG8_WAIT_V
#undef PG8_WAIT_L
#undef PG8_BAR
#undef PG8_SCHED
}

struct EpiF32 {
    static constexpr bool PERM = false;
    float* C; int ldc;
    __device__ __forceinline__ void operator()(const f32x4 (&acc)[2][2][4][2], const Unit& u, int wr, int wc, int fr, int fq) const {
        const int row0 = u.pm * BM + wr * 64 + fr, col0 = u.pn * BM + wc * 32 + 4 * fq;
#pragma unroll
        for (int ai = 0; ai < 2; ++ai)
#pragma unroll
            for (int m = 0; m < 4; ++m) { float* rowp = C + (size_t)(row0 + ai * HALF + m * 16) * ldc + col0;
#pragma unroll
                for (int bj = 0; bj < 2; ++bj)
#pragma unroll
                    for (int n = 0; n < 2; ++n) *(f32x4*)(rowp + bj * HALF + n * 16) = acc[ai][bj][m][n]; }
    }
};
struct EpiProj {
    static constexpr bool PERM = true;
    unsigned char* ws;
    __device__ __forceinline__ void operator()(const f32x4 (&acc)[2][2][4][2], const Unit& u, int wr, int wc, int fr, int fq) const {
        bf16_t* base = (bf16_t*)(ws + kP1Off[u.pn]); const int ld = kP1Ld[u.pn], ncol = kP1Nc[u.pn];
        const int row0 = u.pm * BM + wr * 64 + fr, col0 = kP1C0[u.pn] + wc * 32 + 8 * fq;
#pragma unroll
        for (int ai = 0; ai < 2; ++ai)
#pragma unroll
            for (int m = 0; m < 4; ++m) { bf16_t* rowp = base + (size_t)(row0 + ai * HALF + m * 16) * ld + col0;
#pragma unroll
                for (int bj = 0; bj < 2; ++bj) { if (bj * HALF >= ncol) continue;
                    const f32x4 v0 = acc[ai][bj][m][0], v1 = acc[ai][bj][m][1];
                    u32x4 w; w.x = cvt_pk_bf16(v0[0], v0[1]); w.y = cvt_pk_bf16(v0[2], v0[3]); w.z = cvt_pk_bf16(v1[0], v1[1]); w.w = cvt_pk_bf16(v1[2], v1[3]);
                    *(u32x4*)(rowp + bj * HALF) = w; } }
    }
};
struct EpiGate {
    static constexpr bool PERM = true;
    bf16_t* G0;
    __device__ __forceinline__ void operator()(const f32x4 (&acc)[2][2][4][2], const Unit& u, int wr, int wc, int fr, int fq) const {
        bf16_t* base = G0 + (size_t)(u.pn >> 1) * ((size_t)NTOK * 512);
        const int row0 = u.pm * BM + wr * 64 + fr, col0 = (u.pn & 1) * 256 + wc * 32 + 8 * fq;
#pragma unroll
        for (int ai = 0; ai < 2; ++ai)
#pragma unroll
            for (int m = 0; m < 4; ++m) { bf16_t* rowp = base + (size_t)(row0 + ai * HALF + m * 16) * 512 + col0;
#pragma unroll
                for (int bj = 0; bj < 2; ++bj) {
                    f32x4 v0 = acc[ai][bj][m][0], v1 = acc[ai][bj][m][1];
#pragma unroll
                    for (int j = 0; j < 4; ++j) { v0[j] = sigmoidf_(v0[j]); v1[j] = sigmoidf_(v1[j]); }
                    u32x4 w; w.x = cvt_pk_bf16(v0[0], v0[1]); w.y = cvt_pk_bf16(v0[2], v0[3]); w.z = cvt_pk_bf16(v1[0], v1[1]); w.w = cvt_pk_bf16(v1[2], v1[3]);
                    *(u32x4*)(rowp + bj * HALF) = w; } }
    }
};
struct EpiSwiglu {
    static constexpr bool PERM = true;
    bf16_t* O; int ldc;
    __device__ __forceinline__ void operator()(const f32x4 (&acc)[2][2][4][2], const Unit& u, int wr, int wc, int fr, int fq) const {
        const int row0 = u.pm * BM + wr * 64 + fr, col0 = u.pn * HALF + wc * 32 + 8 * fq;
#pragma unroll
        for (int ai = 0; ai < 2; ++ai)
#pragma unroll
            for (int m = 0; m < 4; ++m) { bf16_t* rowp = O + (size_t)(row0 + ai * HALF + m * 16) * ldc + col0;
                float r[8];
#pragma unroll
                for (int n = 0; n < 2; ++n)
#pragma unroll
                    for (int j = 0; j < 4; ++j) { const float gv = acc[ai][0][m][n][j], uv = acc[ai][1][m][n][j]; r[n * 4 + j] = gv * sigmoidf_(gv) * uv; }
                u32x4 w; w.x = cvt_pk_bf16(r[0], r[1]); w.y = cvt_pk_bf16(r[2], r[3]); w.z = cvt_pk_bf16(r[4], r[5]); w.w = cvt_pk_bf16(r[6], r[7]);
                *(u32x4*)rowp = w; }
    }
};
struct EpiBranch {
    static constexpr bool PERM = true;
    bf16_t* Mg; const bf16_t* G0;
    __device__ __forceinline__ void operator()(const f32x4 (&acc)[2][2][4][2], const Unit& u, int wr, int wc, int fr, int fq) const {
        const bf16_t* gb = G0 + (size_t)(u.br * 2 + (u.pn >> 1)) * ((size_t)NTOK * 512);
        const int row0 = u.pm * BM + wr * 64 + fr, cl = wc * 32 + 8 * fq;
#pragma unroll
        for (int ai = 0; ai < 2; ++ai)
#pragma unroll
            for (int m = 0; m < 4; ++m) { const size_t row = (size_t)(row0 + ai * HALF + m * 16);
#pragma unroll
                for (int bj = 0; bj < 2; ++bj) {
                    const u32x4 gw = *(const u32x4*)(gb + row * 512 + (u.pn & 1) * 256 + bj * HALF + cl);
                    bf16_t* mp = Mg + row * 1024 + u.pn * 256 + bj * HALF + cl;
                    float r[8];
#pragma unroll
                    for (int q = 0; q < 4; ++q) { const unsigned g2 = gw[q]; const int n = q >> 1, j = (q & 1) * 2;
                        r[q * 2] = __uint_as_float(g2 << 16) * acc[ai][bj][m][n][j]; r[q * 2 + 1] = __uint_as_float(g2 & 0xffff0000u) * acc[ai][bj][m][n][j + 1]; }
                    if (u.br != 0) { const u32x4 ow = *(const u32x4*)mp;
#pragma unroll
                        for (int q = 0; q < 4; ++q) { r[q * 2] += __uint_as_float(ow[q] << 16); r[q * 2 + 1] += __uint_as_float(ow[q] & 0xffff0000u); } }
                    u32x4 w; w.x = cvt_pk_bf16(r[0], r[1]); w.y = cvt_pk_bf16(r[2], r[3]); w.z = cvt_pk_bf16(r[4], r[5]); w.w = cvt_pk_bf16(r[6], r[7]);
                    *(u32x4*)mp = w; } }
    }
};
}

template <int MAP> __device__ __forceinline__ int colmap(int n, int off) {
    if (MAP == 0) return n + off;
    if (MAP == 1) { if (n < 3584) return n; const int s = n - 512; return s < C_G ? s : -1; }
    const int pn = n >> 8, r = n & 255; return (r < 128) ? 128 * pn + r : D_FF + 128 * pn + (r - 128);
}
template <int MAP>
__device__ void conv_job(LAS unsigned char* lds, bf16_t* dst, int ld_dst, int koff, const float* src, int ld_src, int K, int n_lo, int n_hi, int off, int bid, int nb) {
    LAS float* tile = (LAS float*)lds;
    const int tid = threadIdx.x, nk = K / 64, nn = (n_hi - n_lo) / 64;
    for (int it = bid; it < nk * nn; it += nb) {
        const int n0 = n_lo + (it / nk) * 64, k0 = (it % nk) * 64;
        { const int kk = tid >> 3, c8 = (tid & 7) * 8;
#pragma unroll
          for (int j = 0; j < 8; ++j) { const int col = colmap<MAP>(n0 + c8 + j, off); tile[kk * 65 + c8 + j] = (col >= 0) ? src[(size_t)(k0 + kk) * ld_src + col] : 0.f; } }
        __syncthreads();
        { const int nr = tid >> 3, k8 = (tid & 7) * 8; float v[8];
#pragma unroll
          for (int j = 0; j < 8; ++j) v[j] = tile[(k8 + j) * 65 + nr];
          u32x4 w; w.x = cvt_pk_bf16(v[0], v[1]); w.y = cvt_pk_bf16(v[2], v[3]); w.z = cvt_pk_bf16(v[4], v[5]); w.w = cvt_pk_bf16(v[6], v[7]);
          *(u32x4*)(dst + (size_t)(n0 + nr) * ld_dst + koff + k0 + k8) = w; }
        __syncthreads();
    }
}
__device__ void fold_tile(LAS unsigned char* lds, bf16_t* out, long sOi, long sOj, const float* A, long sAi, long sAd, const float* B, long sBj, long sBd) {
    LAS float* As = (LAS float*)lds; LAS float* Bs = As + 64 * 129;
    const int tid = threadIdx.x;
    for (int e = tid; e < 64 * 128; e += 512) {
        int i, d; if (sAd == 1) { i = e >> 7; d = e & 127; } else { d = e >> 6; i = e & 63; }
        As[i * 129 + d] = A[i * sAi + d * sAd];
        int j, d2; if (sBd == 1) { j = e >> 7; d2 = e & 127; } else { d2 = e >> 6; j = e & 63; }
        Bs[j * 129 + d2] = B[j * sBj + d2 * sBd];
    }
    __syncthreads();
    const int i = tid & 63, jg = tid >> 6;
    float acc[8];
#pragma unroll
    for (int q = 0; q < 8; ++q) acc[q] = 0.f;
    for (int d = 0; d < 128; ++d) { const float a = As[i * 129 + d];
#pragma unroll
        for (int q = 0; q < 8; ++q) acc[q] += a * Bs[(jg * 8 + q) * 129 + d]; }
#pragma unroll
    for (int q = 0; q < 8; ++q) out[i * sOi + (jg * 8 + q) * sOj] = f2bf(acc[q]);
    __syncthreads();
}

__device__ void phase_conv_in(const Params& p, int l, LAS unsigned char* lds, int bid, int nb) {
    const float* Win = p.in[I_WIN] + (size_t)l * D_MODEL * IN_W;
    conv_job<1>(lds, BF(p, OFF_WIN), 1024, 0, Win, IN_W, 1024, 0, 3584, 0, bid, nb);
    conv_job<1>(lds, BF(p, OFF_WIN), 1024, 0, Win, IN_W, 1024, 4608, NP1, 0, bid, nb);
    const float* wuk = p.in[I_WUK] + (size_t)l * 256 * 512;
    for (int it = bid; it < 256; it += nb) { const int h = it >> 6, rb = (it >> 4) & 3, kb = it & 15;
        fold_tile(lds, BF(p, OFF_WIN) + (size_t)(3584 + h * 256 + rb * 64) * 1024 + kb * 64, 1, 1024,
                  Win + (size_t)(kb * 64) * IN_W + C_DQ + h * 128, IN_W, 1, wuk + ((size_t)(rb * 64) * 4 + h) * 128, 512, 1); }
}
__device__ void phase_conv_post(const Params& p, int l, LAS unsigned char* lds, int bid, int nb) {
    const float* Win = p.in[I_WIN] + (size_t)l * D_MODEL * IN_W;
    conv_job<0>(lds, BF(p, OFF_WG), 1024, 0, Win, IN_W, 1024, 0, 3072, C_G, bid, nb);
    conv_job<0>(lds, BF(p, OFF_WBR), 2048, 0, p.in[I_WA] + (size_t)l * 512 * 1024, 1024, 512, 0, 1024, 0, bid, nb);
    conv_job<0>(lds, BF(p, OFF_WBR), 2048, 512, p.in[I_WB] + (size_t)l * 512 * 1024, 1024, 512, 0, 1024, 0, bid, nb);
    conv_job<0>(lds, BF(p, OFF_WOUT), 1024, 0, p.in[I_WOUT] + (size_t)l * 1024 * 1024, 1024, 1024, 0, 1024, 0, bid, nb);
    conv_job<2>(lds, BF(p, OFF_WF1), 1024, 0, p.in[I_WF1] + (size_t)l * 1024 * 2 * D_FF, 2 * D_FF, 1024, 0, 2 * D_FF, 0, bid, nb);
    conv_job<0>(lds, BF(p, OFF_WF2), D_FF, 0, p.in[I_WF2] + (size_t)l * D_FF * 1024, 1024, D_FF, 0, 1024, 0, bid, nb);
    const float* wuv = p.in[I_WUV] + (size_t)l * 256 * 512; const float* wc = p.in[I_WC] + (size_t)l * 512 * 1024;
    for (int it = bid; it < 256; it += nb) { const int h = it >> 6, rb = (it >> 4) & 3, nbk = it & 15;
        fold_tile(lds, BF(p, OFF_WBR) + (size_t)(nbk * 64) * 2048 + 1024 + h * 256 + rb * 64, 1, 2048,
                  wuv + ((size_t)(rb * 64) * 4 + h) * 128, 512, 1, wc + (size_t)(h * 128) * 1024 + nbk * 64, 1, 1024); }
}

__device__ __forceinline__ float wave_sum(float v) {
#pragma unroll
    for (int o = 32; o >= 1; o >>= 1) v += __shfl_xor(v, o);
    return v;
}
template <int MODE>
__device__ void phase_norm(const float* xin, float* xout, const float* O, const float* wpost, const float* w1, bf16_t* H, int bid, int nb) {
    const int wv = threadIdx.x >> 6, lane = threadIdx.x & 63;
    for (int row = bid * 8 + wv; row < NTOK; row += nb * 8) {
        f32x4 xv[4];
#pragma unroll
        for (int j = 0; j < 4; ++j) xv[j] = *(const f32x4*)(xin + (size_t)row * 1024 + j * 256 + lane * 4);
        if (MODE >= 1) {
            f32x4 ov[4]; float ss = 0.f;
#pragma unroll
            for (int j = 0; j < 4; ++j) { ov[j] = *(const f32x4*)(O + (size_t)row * 1024 + j * 256 + lane * 4); ss += ov[j][0] * ov[j][0] + ov[j][1] * ov[j][1] + ov[j][2] * ov[j][2] + ov[j][3] * ov[j][3]; }
            ss = wave_sum(ss); const float r = rsqrtf(ss * (1.f / 1024.f) + 1e-6f);
#pragma unroll
            for (int j = 0; j < 4; ++j) { const f32x4 wv4 = *(const f32x4*)(wpost + j * 256 + lane * 4); xv[j] = xv[j] + ov[j] * r * wv4; *(f32x4*)(xout + (size_t)row * 1024 + j * 256 + lane * 4) = xv[j]; }
        }
        if (MODE <= 1) {
            float ss = 0.f;
#pragma unroll
            for (int j = 0; j < 4; ++j) ss += xv[j][0] * xv[j][0] + xv[j][1] * xv[j][1] + xv[j][2] * xv[j][2] + xv[j][3] * xv[j][3];
            ss = wave_sum(ss); const float r = rsqrtf(ss * (1.f / 1024.f) + 1e-6f);
#pragma unroll
            for (int j = 0; j < 4; ++j) { const f32x4 wv4 = *(const f32x4*)(w1 + j * 256 + lane * 4); const f32x4 y = xv[j] * r * wv4;
                u32x2 w; w.x = cvt_pk_bf16(y[0], y[1]); w.y = cvt_pk_bf16(y[2], y[3]); *(u32x2*)(H + (size_t)row * 1024 + j * 256 + lane * 4) = w; }
        }
    }
}

__device__ void phase_gemm_in(const Params& p, LAS unsigned char* lds, int bid, int nb) {
    pg8::EpiProj E{p.ws};
    pg8::Gemm g{BF(p, OFF_H), BF(p, OFF_WIN), 1024, 1024};
    pg8::StaticOrder S; S.init(NTOK, NP1, 1024, nb, bid);
    pg8::gemm_phase(lds, g, S, E);
}
__device__ void phase_gemm_gates(const Params& p, LAS unsigned char* lds, int bid, int nb) {
    pg8::EpiGate E{BF(p, OFF_HF)};
    pg8::Gemm g{BF(p, OFF_H), BF(p, OFF_WG), 1024, 1024};
    pg8::StaticOrder S; S.init(NTOK, 3072, 1024, nb, bid);
    pg8::gemm_phase(lds, g, S, E);
}
__device__ void phase_gemm_branch(const Params& p, LAS unsigned char* lds, int bid, int nb) {
    pg8::EpiBranch E; E.Mg = BF(p, OFF_H); E.G0 = BF(p, OFF_HF);
    pg8::Gemm g{BF(p, OFF_Y), BF(p, OFF_WBR), 2048, 2048};
    pg8::BranchOrder S; S.init(NTOK, 1024, nb, bid);
    pg8::gemm_phase(lds, g, S, E);
}
__device__ void phase_gemm_out(const Params& p, LAS unsigned char* lds, int bid, int nb) {
    pg8::EpiF32 E{F32P(p, OFF_OUT), 1024};
    pg8::Gemm g{BF(p, OFF_H), BF(p, OFF_WOUT), 1024, 1024};
    pg8::StaticOrder S; S.init(NTOK, 1024, 1024, nb, bid);
    pg8::gemm_phase(lds, g, S, E);
}
__device__ void phase_gemm_ffn1(const Params& p, LAS unsigned char* lds, int bid, int nb) {
    pg8::EpiSwiglu E{BF(p, OFF_ACT), D_FF};
    pg8::Gemm g{BF(p, OFF_H), BF(p, OFF_WF1), 1024, 1024};
    pg8::StaticOrder S; S.init(NTOK, 2 * D_FF, 1024, nb, bid);
    pg8::gemm_phase(lds, g, S, E);
}
__device__ void phase_gemm_ffn2(const Params& p, LAS unsigned char* lds, int bid, int nb) {
    pg8::EpiF32 E{F32P(p, OFF_OUT), 1024};
    pg8::Gemm g{BF(p, OFF_ACT), BF(p, OFF_WF2), D_FF, D_FF};
    pg8::StaticOrder S; S.init(NTOK, 1024, D_FF, nb, bid);
    pg8::gemm_phase(lds, g, S, E);
}

enum { PH_PRE = 0, PH_GEMM_IN, PH_CONV_POST, PH_GATES, PH_BRANCH, PH_OUT, PH_NORM_MID, PH_FFN1, PH_FFN2, PH_NORM_END };
template <int PH> __global__ __launch_bounds__(512, 2) void k_ph(Params p, int l) {
    extern __shared__ __attribute__((aligned(16))) unsigned char shm[];
    LAS unsigned char* lds = (LAS unsigned char*)shm;
    const int bid = blockIdx.x, nb = gridDim.x;
    if (PH == PH_PRE) { phase_norm<0>(p.in[I_X], nullptr, nullptr, nullptr, p.in[I_PREMIX], BF(p, OFF_H), bid, nb); phase_conv_in(p, 0, lds, bid, nb); }
    if (PH == PH_GEMM_IN) phase_gemm_in(p, lds, bid, nb);
    if (PH == PH_CONV_POST) phase_conv_post(p, l, lds, bid, nb);
    if (PH == PH_GATES) phase_gemm_gates(p, lds, bid, nb);
    if (PH == PH_BRANCH) phase_gemm_branch(p, lds, bid, nb);
    if (PH == PH_OUT) phase_gemm_out(p, lds, bid, nb);
    if (PH == PH_NORM_MID) phase_norm<1>(l == 0 ? p.in[I_X] : p.x, p.x, F32P(p, OFF_OUT), p.in[I_POSTMIX] + l * 1024, p.in[I_PREFFN] + l * 1024, BF(p, OFF_H), bid, nb);
    if (PH == PH_FFN1) phase_gemm_ffn1(p, lds, bid, nb);
    if (PH == PH_FFN2) phase_gemm_ffn2(p, lds, bid, nb);
    if (PH == PH_NORM_END) {
        if (l + 1 < DEPTH) { phase_norm<1>(p.x, p.x, F32P(p, OFF_OUT), p.in[I_POSTFFN] + l * 1024, p.in[I_PREMIX] + (l + 1) * 1024, BF(p, OFF_H), bid, nb); phase_conv_in(p, l + 1, lds, bid, nb); }
        else phase_norm<2>(p.x, p.x, F32P(p, OFF_OUT), p.in[I_POSTFFN] + l * 1024, nullptr, nullptr, bid, nb);
    }
}

__global__ void __launch_bounds__(128) k_hgrn2(Params p, int layer) {
    const int h = blockIdx.x, b = blockIdx.y, e = threadIdx.x;
    __shared__ float lb[128], qs[128], fs[128], ks[128];
    { float l0 = p.in[I_LB][h * 128 + e], l1 = p.in[I_LB][512 + h * 128 + e];
      float m = fmaxf(l0, l1), e0 = expf(l0 - m), e1 = expf(l1 - m), p0 = e0 / (e0 + e1), p1 = e1 / (e0 + e1);
      float cs = (layer == 0) ? p0 : (p0 + p1); lb[e] = cs - p0; }
    float S[128];
#pragma unroll
    for (int d = 0; d < 128; ++d) S[d] = 0.f;
    __syncthreads();
    for (int t = 0; t < SEQ; ++t) {
        const size_t row = (size_t)b * SEQ + t;
        { float fp = bf2f(BF(p, OFF_HF)[row * 512 + h * 128 + e]); float l = lb[e];
          float f = l + (1.f - l) * sigmoidf_(fp); f = fmaxf(f, 1e-20f);
          fs[e] = f; ks[e] = (1.f - l) * sigmoidf_(-fp); qs[e] = bf2f(BF(p, OFF_Y)[row * 2048 + h * 128 + e]); }
        float v = bf2f(BF(p, OFF_HI)[row * 512 + h * 128 + e]);
        __syncthreads();
        float acc = 0.f;
#pragma unroll
        for (int d = 0; d < 128; ++d) { S[d] = fs[d] * S[d] + ks[d] * v; acc += qs[d] * S[d]; }
        F32P(p, OFF_TMPF)[row * 512 + h * 128 + e] = acc;
        __syncthreads();
    }
}
__global__ void __launch_bounds__(128) k_hgrn2_post(Params p, int layer) {
    __shared__ float red[128];
    const int t = blockIdx.x >> 2, h = blockIdx.x & 3, e = threadIdx.x;
    float v = F32P(p, OFF_TMPF)[(size_t)t * 512 + h * 128 + e];
    red[e] = v * v; __syncthreads();
    for (int k = 64; k > 0; k >>= 1) { if (e < k) red[e] += red[e + k]; __syncthreads(); }
    float r = rsqrtf(red[0] / 128.f + 1e-6f);
    float g = bf2f(BF(p, OFF_HG)[(size_t)t * 512 + h * 128 + e]);
    BF(p, OFF_Y)[(size_t)t * 2048 + h * 128 + e] = f2bf(v * r * p.in[I_HGNW][layer * 128 + e] * (g * sigmoidf_(g)));
}
__global__ void __launch_bounds__(128) k_kmean(Params p) {
    const int n = blockIdx.x, h = blockIdx.y, b = blockIdx.z, d = threadIdx.x;
    float s = 0.f;
    for (int j = 0; j < 256; ++j) s += bf2f(BF(p, OFF_MK)[((size_t)b * SEQ + n * 256 + j) * 512 + h * 128 + d]);
    F32P(p, OFF_KMEAN)[((b * 4 + h) * 16 + n) * 128 + d] = s / 256.f;
}
__global__ void __launch_bounds__(256) k_moba(Params p) {
    const int tg = blockIdx.x >> 2, h = blockIdx.x & 3, tid = threadIdx.x;
    const int b = tg >> 12, t = tg & 4095, blk = t >> 8;
    __shared__ float q[128], gate[16], lg[1024], red[256];
    __shared__ int sel[3];
    if (tid < 128) q[tid] = bf2f(BF(p, OFF_Y)[(size_t)tg * 2048 + 512 + h * 128 + tid]);
    __syncthreads();
    if (tid < 16) { float s = 0.f; for (int d = 0; d < 128; ++d) s += q[d] * F32P(p, OFF_KMEAN)[((b * 4 + h) * 16 + tid) * 128 + d]; gate[tid] = (tid < blk) ? s : NEG_BIG; }
    __syncthreads();
    if (tid == 0) { unsigned used = 0u;
        for (int k = 0; k < 3; ++k) { int best = -1; float bv = 0.f;
            for (int i = 0; i < 16; ++i) if (!((used >> i) & 1u) && (best < 0 || gate[i] > bv)) { best = i; bv = gate[i]; }
            used |= 1u << best; sel[k] = best; } }
    __syncthreads();
    const float scale = 0.08838834764831845f;
    for (int sl = 0; sl < 4; ++sl) {
        int bn = (sl < 3) ? sel[sl] : blk; int s = bn * 256 + tid;
        bool valid = (sl < 3) ? (bn < blk) : (s <= t);
        float l = NEG_BIG;
        if (valid) { const bf16_t* kr = BF(p, OFF_MK) + ((size_t)b * SEQ + s) * 512 + h * 128; float a = 0.f; for (int d = 0; d < 128; ++d) a += q[d] * bf2f(kr[d]); l = a * scale + p.in[I_REL][rel_bucket(t - s) * 8 + h]; }
        lg[sl * 256 + tid] = l;
    }
    __syncthreads();
    float m = fmaxf(fmaxf(lg[tid], lg[256 + tid]), fmaxf(lg[512 + tid], lg[768 + tid]));
    red[tid] = m; __syncthreads();
    for (int k = 128; k > 0; k >>= 1) { if (tid < k) red[tid] = fmaxf(red[tid], red[tid + k]); __syncthreads(); }
    m = red[0]; __syncthreads();
    float su = 0.f;
    for (int sl = 0; sl < 4; ++sl) { float pp = expf(lg[sl * 256 + tid] - m); lg[sl * 256 + tid] = pp; su += pp; }
    red[tid] = su; __syncthreads();
    for (int k = 128; k > 0; k >>= 1) { if (tid < k) red[tid] += red[tid + k]; __syncthreads(); }
    const float inv = 1.f / red[0];
    const int d = tid & 127, half = tid >> 7;
    float acc = 0.f;
    for (int sl = 0; sl < 4; ++sl) {
        int bn = (sl < 3) ? sel[sl] : blk; bool anyvalid = (sl < 3) ? (bn < blk) : true;
        if (!anyvalid) continue;
        for (int j = half * 128; j < half * 128 + 128; ++j) { float pp = lg[sl * 256 + j]; if (pp != 0.f) acc += pp * bf2f(BF(p, OFF_MV)[((size_t)b * SEQ + bn * 256 + j) * 512 + h * 128 + d]); }
    }
    __syncthreads();
    red[tid] = acc; __syncthreads();
    if (tid < 128) BF(p, OFF_Y)[(size_t)tg * 2048 + 512 + h * 128 + tid] = f2bf((red[tid] + red[tid + 128]) * inv);
}
__global__ void __launch_bounds__(256) k_dsa_prep(Params p, int layer) {
    __shared__ float red[256];
    const int t = blockIdx.x, tid = threadIdx.x;
    float v = bf2f(BF(p, OFF_CKV)[(size_t)t * 256 + tid]);
    red[tid] = v * v; __syncthreads();
    for (int k = 128; k > 0; k >>= 1) { if (tid < k) red[tid] += red[tid + k]; __syncthreads(); }
    float r = rsqrtf(red[0] / 256.f + 1e-6f);
    __syncthreads();
    BF(p, OFF_CKV)[(size_t)t * 256 + tid] = f2bf(v * r * p.in[I_KVN][layer * 256 + tid]);
    float u = (tid < 64) ? bf2f(BF(p, OFF_IKW)[(size_t)t * 128 + tid]) : 0.f;
    red[tid] = u; __syncthreads();
    for (int k = 128; k > 0; k >>= 1) { if (tid < k) red[tid] += red[tid + k]; __syncthreads(); }
    float mu = red[0] / 64.f; __syncthreads();
    float xc = (tid < 64) ? (u - mu) : 0.f;
    red[tid] = xc * xc; __syncthreads();
    for (int k = 128; k > 0; k >>= 1) { if (tid < k) red[tid] += red[tid + k]; __syncthreads(); }
    float rr = rsqrtf(red[0] / 64.f + 1e-6f);
    if (tid < 64) BF(p, OFF_IKW)[(size_t)t * 128 + tid] = f2bf(xc * rr * p.in[I_IKNW][layer * 64 + tid] + p.in[I_IKNB][layer * 64 + tid]);
}
__global__ void __launch_bounds__(256) k_dsa(Params p) {
    const int tg = blockIdx.x, tid = threadIdx.x, b = tg >> 12, t = tg & 4095;
    __shared__ unsigned long long keys[SEQ];
    __shared__ float iq[512], iw[8], qa[1024];
    __shared__ int cnt_s; __shared__ int idx[256]; __shared__ int red_i[256];
    __shared__ float pl[4][256], redf[256];
    for (int i = tid; i < 512; i += 256) iq[i] = bf2f(BF(p, OFF_IQ)[(size_t)tg * 512 + i]);
    for (int i = tid; i < 1024; i += 256) qa[i] = bf2f(BF(p, OFF_Y)[(size_t)tg * 2048 + 1024 + i]);
    if (tid < 8) iw[tid] = bf2f(BF(p, OFF_IKW)[(size_t)tg * 128 + 64 + tid]) * 0.35355339059327373f;
    if (tid == 0) cnt_s = 0;
    __syncthreads();
    const int nvalid = t + 1;
    for (int s = tid; s < SEQ; s += 256) {
        unsigned long long key = 0ull;
        if (s <= t) {
            const bf16_t* kr = BF(p, OFF_IKW) + ((size_t)b * SEQ + s) * 128;
            float kv[64];
#pragma unroll
            for (int d = 0; d < 64; ++d) kv[d] = bf2f(kr[d]);
            float sc = 0.f;
#pragma unroll
            for (int hh = 0; hh < 8; ++hh) { float a = 0.f;
#pragma unroll
                for (int d = 0; d < 64; ++d) a += iq[hh * 64 + d] * kv[d];
                a *= 0.125f; sc += iw[hh] * fmaxf(a, 0.f); }
            sc += 0.0f;
            unsigned u = __float_as_uint(sc); u = (u & 0x80000000u) ? ~u : (u | 0x80000000u);
            key = (((unsigned long long)u << 12) | (unsigned long long)(4095 - s)) + 1ull;
        }
        keys[s] = key;
    }
    __syncthreads();
    const int nkeep = nvalid < 256 ? nvalid : 256;
    unsigned long long thr = 1ull;
    if (nvalid > 256) { thr = 0ull;
        for (int bit = 44; bit >= 0; --bit) {
            unsigned long long cand = thr | (1ull << bit);
            int c = 0;
            for (int s = tid; s < SEQ; s += 256) c += (keys[s] >= cand) ? 1 : 0;
            red_i[tid] = c; __syncthreads();
            for (int k = 128; k > 0; k >>= 1) { if (tid < k) red_i[tid] += red_i[tid + k]; __syncthreads(); }
            int tot = red_i[0]; __syncthreads();
            if (tot >= 256) thr = cand;
        } }
    {
        int c = 0;
        for (int j = 0; j < 16; ++j) { unsigned long long k = keys[tid * 16 + j]; c += (k >= thr && k != 0ull) ? 1 : 0; }
        red_i[tid] = c; __syncthreads();
        if (tid == 0) { int run = 0; for (int i = 0; i < 256; ++i) { int v = red_i[i]; red_i[i] = run; run += v; } cnt_s = run; }
        __syncthreads();
        int pos = red_i[tid];
        for (int j = 0; j < 16; ++j) { unsigned long long k = keys[tid * 16 + j]; if (k >= thr && k != 0ull) { if (pos < 256) idx[pos] = tid * 16 + j; ++pos; } }
    }
    __syncthreads();
    const float scale = 0.08838834764831845f;
    float lgt[4] = {NEG_BIG, NEG_BIG, NEG_BIG, NEG_BIG};
    if (tid < nkeep) {
        int s = idx[tid]; const bf16_t* cr = BF(p, OFF_CKV) + ((size_t)b * SEQ + s) * 256;
        int bk = rel_bucket(t - s);
        float a0 = 0.f, a1 = 0.f, a2 = 0.f, a3 = 0.f;
        for (int r = 0; r < 256; ++r) { float c = bf2f(cr[r]); a0 += qa[r] * c; a1 += qa[256 + r] * c; a2 += qa[512 + r] * c; a3 += qa[768 + r] * c; }
        lgt[0] = a0 * scale + p.in[I_REL][bk * 8 + 4]; lgt[1] = a1 * scale + p.in[I_REL][bk * 8 + 5]; lgt[2] = a2 * scale + p.in[I_REL][bk * 8 + 6]; lgt[3] = a3 * scale + p.in[I_REL][bk * 8 + 7];
    }
#pragma unroll
    for (int hh = 0; hh < 4; ++hh) {
        redf[tid] = lgt[hh]; __syncthreads();
        for (int k = 128; k > 0; k >>= 1) { if (tid < k) redf[tid] = fmaxf(redf[tid], redf[tid + k]); __syncthreads(); }
        float m = redf[0]; __syncthreads();
        float pp = (tid < nkeep) ? expf(lgt[hh] - m) : 0.f;
        redf[tid] = pp; __syncthreads();
        for (int k = 128; k > 0; k >>= 1) { if (tid < k) redf[tid] += redf[tid + k]; __syncthreads(); }
        float su = redf[0]; __syncthreads();
        pl[hh][tid] = pp / su;
    }
    __syncthreads();
    { float o0 = 0.f, o1 = 0.f, o2 = 0.f, o3 = 0.f;
      for (int k = 0; k < nkeep; ++k) { float c = bf2f(BF(p, OFF_CKV)[((size_t)b * SEQ + idx[k]) * 256 + tid]); o0 += pl[0][k] * c; o1 += pl[1][k] * c; o2 += pl[2][k] * c; o3 += pl[3][k] * c; }
      bf16_t* yo = BF(p, OFF_Y) + (size_t)tg * 2048 + 1024;
      yo[tid] = f2bf(o0); yo[256 + tid] = f2bf(o1); yo[512 + tid] = f2bf(o2); yo[768 + tid] = f2bf(o3); }
}

#define LDS_BYTES (128 * 1024)
template <int PH> static void launch_ph(const Params& p, int l, hipStream_t st) {
    static bool attr = false;
    if (!attr) { (void)hipFuncSetAttribute((const void*)k_ph<PH>, hipFuncAttributeMaxDynamicSharedMemorySize, LDS_BYTES); attr = true; }
    hipLaunchKernelGGL((k_ph<PH>), dim3(256), dim3(512), LDS_BYTES, st, p, l);
}

extern "C" void kernel_launch(void* const* d_in, const int* in_sizes, int n_in, void* d_out, int out_size, void* d_ws, size_t ws_size, hipStream_t stream) {
    Params p{};
    for (int i = 0; i < 20; ++i) p.in[i] = (const float*)d_in[i];
    p.x = (float*)d_out; p.ws = (unsigned char*)d_ws;
    if (WS_NEED > ws_size) { fprintf(stderr, "kernel_launch: workspace too small (%zu < %zu)\n", ws_size, (size_t)WS_NEED); return; }
    (void)hipMemsetAsync(p.ws + OFF_CTL, 0, 64 * 1024, stream);

    launch_ph<PH_PRE>(p, 0, stream);
    for (int l = 0; l < DEPTH; ++l) {
        launch_ph<PH_GEMM_IN>(p, l, stream);
        hipLaunchKernelGGL(k_hgrn2, dim3(4, 4), dim3(128), 0, stream, p, l);
        hipLaunchKernelGGL(k_hgrn2_post, dim3(NTOK * 4), dim3(128), 0, stream, p, l);
        hipLaunchKernelGGL(k_kmean, dim3(16, 4, 4), dim3(128), 0, stream, p);
        hipLaunchKernelGGL(k_moba, dim3(NTOK * 4), dim3(256), 0, stream, p);
        hipLaunchKernelGGL(k_dsa_prep, dim3(NTOK), dim3(256), 0, stream, p, l);
        hipLaunchKernelGGL(k_dsa, dim3(NTOK), dim3(256), 0, stream, p);
        launch_ph<PH_CONV_POST>(p, l, stream);
        launch_ph<PH_GATES>(p, l, stream);
        launch_ph<PH_BRANCH>(p, l, stream);
        launch_ph<PH_OUT>(p, l, stream);
        launch_ph<PH_NORM_MID>(p, l, stream);
        launch_ph<PH_FFN1>(p, l, stream);
        launch_ph<PH_FFN2>(p, l, stream);
        launch_ph<PH_NORM_END>(p, l, stream);
    }
}
```

```cpp
#include <hip/hip_runtime.h>
#include <stdint.h>
#include <stdio.h>

#define D_MODEL 1024
#define BATCH 4
#define SEQ 4096
#define NTOK 16384
#define DEPTH 2
#define IN_W 8008
#define D_FF 2816
#define NEG_BIG (-1e30f)
#define C_HQ 0
#define C_HF 512
#define C_HI 1024
#define C_HG 1536
#define C_MQ 2048
#define C_MK 2560
#define C_MV 3072
#define C_DQ 3584
#define C_DKV 4096
#define C_IQ 4352
#define C_IK 4864
#define C_IW 4928
#define C_G 4936
#define NP1 5632

#define LAS __attribute__((address_space(3)))
typedef unsigned short bf16_t;
typedef short bf16x8 __attribute__((ext_vector_type(8)));
typedef float f32x4 __attribute__((ext_vector_type(4)));
typedef unsigned u32x4 __attribute__((ext_vector_type(4)));
typedef unsigned u32x2 __attribute__((ext_vector_type(2)));

__device__ __forceinline__ float sigmoidf_(float x) { return 1.f / (1.f + __expf(-x)); }
__device__ __forceinline__ float bf2f(bf16_t b) { return __uint_as_float(((unsigned)b) << 16); }
typedef __bf16 bf16x2_t __attribute__((ext_vector_type(2)));
typedef float f32x2_t __attribute__((ext_vector_type(2)));
__device__ __forceinline__ unsigned cvt_pk_bf16(float lo, float hi) { const f32x2_t f = {lo, hi}; const bf16x2_t v = __builtin_convertvector(f, bf16x2_t); return __builtin_bit_cast(unsigned, v); }
__device__ __forceinline__ bf16_t f2bf(float f) { return (bf16_t)(cvt_pk_bf16(f, 0.f) & 0xffffu); }
__device__ __forceinline__ void mfma_fence(f32x4& a) { asm volatile("s_nop 15\n\ts_nop 3" : "+v"(a)); }
__device__ __forceinline__ void mfma_fence(f32x4& a, f32x4& b, f32x4& c, f32x4& d) { asm volatile("s_nop 15\n\ts_nop 3" : "+v"(a), "+v"(b), "+v"(c), "+v"(d)); }
__device__ __forceinline__ int rel_bucket(int dist) {
    int n = dist > 0 ? dist : 0;
    if (n < 16) return n;
    float nf = (float)n;
    int large = 16 + (int)(logf(nf / 16.f) / 4.852030263919617f * 16.f);
    return large < 31 ? large : 31;
}

enum { I_X = 0, I_WIN, I_PREMIX, I_POSTMIX, I_PREFFN, I_POSTFFN, I_LB, I_HGNW, I_KVN, I_WUK, I_WUV, I_IKNW, I_IKNB, I_REL, I_WA, I_WB, I_WC, I_WOUT, I_WF1, I_WF2 };
struct Params { const float* in[20]; float* x; unsigned char* ws; };
constexpr size_t MiB = 1024 * 1024;
constexpr size_t OFF_CTL = 0, OFF_Y = 65536, OFF_HF = OFF_Y + 64 * MiB, OFF_HI = OFF_HF + 16 * MiB, OFF_HG = OFF_HI + 16 * MiB, OFF_MK = OFF_HG + 16 * MiB,
                 OFF_MV = OFF_MK + 16 * MiB, OFF_IQ = OFF_MV + 16 * MiB, OFF_CKV = OFF_IQ + 16 * MiB, OFF_IKW = OFF_CKV + 8 * MiB, OFF_H = OFF_IKW + 4 * MiB,
                 OFF_WIN = OFF_H + 32 * MiB, OFF_RS = OFF_WIN + 11 * MiB;
constexpr size_t OFF_WG = OFF_RS, OFF_WBR = OFF_WG + 6 * MiB, OFF_WOUT = OFF_WBR + 4 * MiB, OFF_WF1 = OFF_WOUT + 2 * MiB, OFF_WF2 = OFF_WF1 + 11 * MiB, OFF_WEND = OFF_WF2 + 6 * MiB;
constexpr size_t OFF_ST = OFF_RS, OFF_TMPF = OFF_RS, OFF_DEC = OFF_ST + 32 * MiB, OFF_MASK = OFF_DEC + MiB / 2, OFF_KMEAN = OFF_MASK + 8 * MiB, OFF_MEND = OFF_KMEAN + MiB / 8;
constexpr size_t OFF_OUT = OFF_HG, OFF_ACT = OFF_Y;
constexpr size_t WS_NEED = (OFF_WEND > OFF_MEND ? OFF_WEND : OFF_MEND);
#define BF(p, off) ((bf16_t*)((p).ws + (off)))
#define F32P(p, off) ((float*)((p).ws + (off)))
__device__ const unsigned long long kP1Off[22] = {OFF_Y, OFF_Y, OFF_HF, OFF_HF, OFF_HI, OFF_HI, OFF_HG, OFF_HG, OFF_Y, OFF_Y, OFF_MK, OFF_MK, OFF_MV, OFF_MV, OFF_Y, OFF_Y, OFF_Y, OFF_Y, OFF_CKV, OFF_IQ, OFF_IQ, OFF_IKW};
__device__ const int kP1Ld[22]  = {2048, 2048, 512, 512, 512, 512, 512, 512, 2048, 2048, 512, 512, 512, 512, 2048, 2048, 2048, 2048, 256, 512, 512, 128};
__device__ const int kP1C0[22]  = {0, 256, 0, 256, 0, 256, 0, 256, 512, 768, 0, 256, 0, 256, 1024, 1280, 1536, 1792, 0, 0, 256, 0};
__device__ const int kP1Nc[22]  = {256, 256, 256, 256, 256, 256, 256, 256, 256, 256, 256, 256, 256, 256, 256, 256, 256, 256, 256, 256, 256, 128};

namespace pg8 {
constexpr int BM = 256, BK = 64, HALF = 128, HTB = HALF * BK * 2, STAGE_BYTES = 8 * HTB, NXCD = 8, WGM = 8;
__host__ __device__ __forceinline__ int lds_byte(int r, int c) { const int st = (r >> 4) * 2 + (c >> 5), rr = r & 15, cc = c & 31, ob = rr * 64 + cc * 2; return st * 1024 + (ob ^ (((ob >> 9) & 1) << 5)); }
__host__ __device__ __forceinline__ void stage_rc(int b, int& R, int& C) { const int st = b / 1024, sb = b % 1024, swz = sb ^ (((sb >> 9) & 1) << 5); R = (st >> 1) * 16 + swz / 64; C = (st & 1) * 32 + (swz % 64) / 2; }
__host__ __device__ __forceinline__ int perm32(int rho) { const int n = rho >> 4, i = rho & 15; return 8 * (i >> 2) + 4 * n + (i & 3); }

struct Unit { int pm, pn, ka, nt, br; };
struct Gemm { const bf16_t* A; const bf16_t* Bt; int lda, ldb; };

__device__ __forceinline__ bool tile_of(long L, int nM, int nN, int& pm, int& pn) {
    const int nwg = nM * nN; if (L >= nwg) return false;
    int wgid = (int)L; { const int q = nwg / NXCD, r = nwg % NXCD, xcd = wgid % NXCD, off = wgid / NXCD; wgid = (xcd < r ? xcd * (q + 1) : r * (q + 1) + (xcd - r) * q) + off; }
    const int nig = WGM * nN, gid = wgid / nig, fm = gid * WGM, gsz = (nM - fm) < WGM ? (nM - fm) : WGM;
    pm = fm + ((wgid % nig) % gsz); pn = (wgid % nig) / gsz; return true;
}
struct StaticOrder {
    int nM, nN, G, c, nt;
    __device__ void init(int M, int N, int K, int G_, int c_) { nM = M / BM; nN = N / BM; G = G_; c = c_; nt = K / BK; }
    __device__ bool next(int i, Unit& u) const { u.ka = 0; u.nt = nt; u.br = 0; return tile_of((long)i * G + c, nM, nN, u.pm, u.pn); }
};
struct BranchOrder {
    int nM, nN, G, c;
    __device__ void init(int M, int N, int G_, int c_) { nM = M / BM; nN = N / BM; G = G_; c = c_; }
    __device__ bool next(int i, Unit& u) const { const int ti = i / 3, br = i - ti * 3; u.br = br; u.ka = br * 512; u.nt = (br == 2) ? 16 : 8; return tile_of((long)ti * G + c, nM, nN, u.pm, u.pn); }
};

template <class Epi, class Sched>
__device__ __forceinline__ void gemm_phase(LAS unsigned char* lds, const Gemm g, const Sched& S, const Epi& E) {
    const int tid = threadIdx.x, wid = __builtin_amdgcn_readfirstlane(tid >> 6), lane = tid & 63, wr = wid >> 2, wc = wid & 3, fr = lane & 15, fq = lane >> 4;
    unsigned voffA[2], voffB[2];
#pragma unroll
    for (int i = 0; i < 2; ++i) { int R, C; stage_rc(tid * 16 + i * 8192, R, C); const int Rb = Epi::PERM ? ((R & ~31) + perm32(R & 31)) : R;
        voffA[i] = (unsigned)(R * g.lda + C) * 2u; voffB[i] = (unsigned)(Rb * g.ldb + C) * 2u; }
    const size_t kstep = (size_t)(BK * 2);
    const size_t hsA = (size_t)HALF * g.lda * 2, hsB = (size_t)HALF * g.ldb * 2;
    const size_t tsA = 2 * hsA, tsB = 2 * hsB;
    const unsigned ldsw = (unsigned)wid * 1024u;
    const int aoff = lds_byte(wr * 64 + fr, fq * 8), boff = lds_byte(wc * 32 + fr, fq * 8);
#define PG8_SA(b, h) (((b) * 2 + (h)) * HTB)
#define PG8_SB(b, h) ((4 + (b) * 2 + (h)) * HTB)
#define PG8_STAGE(bufoff, gbase, voff) do { _Pragma("unroll") for (int _i = 0; _i < 2; ++_i) \
        __builtin_amdgcn_global_load_lds((const unsigned*)((const char*)(gbase) + (voff)[_i]), (LAS unsigned*)(lds + (bufoff) + ldsw + _i * 8192), 16, 0, 0); } while (0)
#define PG8_LDA(dst, b, h) do { _Pragma("unroll") for (int m = 0; m < 4; ++m) _Pragma("unroll") for (int k = 0; k < 2; ++k) dst[m][k] = *(const LAS bf16x8*)(lds + PG8_SA(b, h) + aoff + m * 2048 + k * 1024); } while (0)
#define PG8_LDB(dst, b, h) do { _Pragma("unroll") for (int n = 0; n < 2; ++n) _Pragma("unroll") for (int k = 0; k < 2; ++k) dst[n][k] = *(const LAS bf16x8*)(lds + PG8_SB(b, h) + boff + n * 2048 + k * 1024); } while (0)
#define PG8_MMA(ai, bj, At, Bt) do { __builtin_amdgcn_s_setprio(1); _Pragma("unroll") for (int m = 0; m < 4; ++m) _Pragma("unroll") for (int n = 0; n < 2; ++n) _Pragma("unroll") for (int k = 0; k < 2; ++k) \
        acc[ai][bj][m][n] = __builtin_amdgcn_mfma_f32_16x16x32_bf16(Bt[n][k], At[m][k], acc[ai][bj][m][n], 0, 0, 0); __builtin_amdgcn_s_setprio(0); } while (0)
#define PG8_WAIT_V(n) asm volatile("s_waitcnt vmcnt(" #n ")" ::: "memory")
#define PG8_WAIT_L(n) asm volatile("s_waitcnt lgkmcnt(" #n ")" ::: "memory")
#define PG8_BAR __builtin_amdgcn_s_barrier()
#define PG8_SCHED __builtin_amdgcn_sched_barrier(0)
    Unit cur, nxt; int ui = 0;
    if (!S.next(0, cur)) return;
    f32x4 acc[2][2][4][2];
#pragma unroll
    for (int a = 0; a < 2; ++a)
#pragma unroll
        for (int b = 0; b < 2; ++b)
#pragma unroll
            for (int m = 0; m < 4; ++m)
#pragma unroll
                for (int n = 0; n < 2; ++n) acc[a][b][m][n] = (f32x4){0.f, 0.f, 0.f, 0.f};
    bf16x8 At[4][2], B0[2][2], B1[2][2];
    const char* cA = (const char*)g.A + (size_t)cur.pm * tsA + (size_t)cur.ka * 2; const char* cB = (const char*)g.Bt + (size_t)cur.pn * tsB + (size_t)cur.ka * 2;
    PG8_STAGE(PG8_SB(0, 0), cB, voffB); PG8_STAGE(PG8_SA(0, 0), cA, voffA); PG8_STAGE(PG8_SB(0, 1), cB + hsB, voffB); PG8_STAGE(PG8_SA(0, 1), cA + hsA, voffA);
    if (wr == 1) PG8_BAR;
    PG8_WAIT_V(4); PG8_BAR;
    PG8_STAGE(PG8_SB(1, 0), cB + kstep, voffB); PG8_STAGE(PG8_SA(1, 0), cA + kstep, voffA); PG8_STAGE(PG8_SB(1, 1), cB + hsB + kstep, voffB);
    PG8_WAIT_V(6); PG8_BAR;
    for (;;) {
        const bool has_next = S.next(ui + 1, nxt);
        const char* nA = has_next ? (const char*)g.A + (size_t)nxt.pm * tsA + (size_t)nxt.ka * 2 : cA; const char* nB = has_next ? (const char*)g.Bt + (size_t)nxt.pn * tsB + (size_t)nxt.ka * 2 : cB;
        const int nt = cur.nt;
        for (int t = 0; t < nt; t += 2) {
            const bool last = (t == nt - 2);
            const char* a1 = cA + (size_t)(t + 1) * kstep;
            const char* a2 = last ? nA : cA + (size_t)(t + 2) * kstep; const char* b2 = last ? nB : cB + (size_t)(t + 2) * kstep;
            const char* a3 = a2 + kstep; const char* b3 = b2 + kstep;
            PG8_LDB(B0, 0, 0); PG8_SCHED; PG8_LDA(At, 0, 0); PG8_STAGE(PG8_SA(1, 1), a1 + hsA, voffA);
            PG8_WAIT_L(8); PG8_BAR; PG8_WAIT_L(0); PG8_MMA(0, 0, At, B0); PG8_BAR; PG8_SCHED;
            PG8_LDB(B1, 0, 1); PG8_STAGE(PG8_SB(0, 0), b2, voffB);
            PG8_BAR; PG8_WAIT_L(0); PG8_MMA(0, 1, At, B1); PG8_BAR;
            PG8_LDA(At, 0, 1); PG8_STAGE(PG8_SA(0, 0), a2, voffA);
            PG8_BAR; PG8_WAIT_L(0); PG8_MMA(1, 0, At, B0); PG8_BAR; PG8_SCHED;
            PG8_STAGE(PG8_SB(0, 1), b2 + hsB, voffB);
            PG8_WAIT_V(6); PG8_BAR; PG8_MMA(1, 1, At, B1); PG8_BAR;
            PG8_LDB(B0, 1, 0); PG8_SCHED; PG8_LDA(At, 1, 0); PG8_STAGE(PG8_SA(0, 1), a2 + hsA, voffA);
            PG8_WAIT_L(8); PG8_BAR; PG8_WAIT_L(0); PG8_MMA(0, 0, At, B0); PG8_BAR; PG8_SCHED;
            PG8_LDB(B1, 1, 1); PG8_STAGE(PG8_SB(1, 0), b3, voffB);
            PG8_BAR; PG8_WAIT_L(0); PG8_MMA(0, 1, At, B1); PG8_BAR;
            PG8_LDA(At, 1, 1); PG8_STAGE(PG8_SA(1, 0), a3, voffA);
            PG8_BAR; PG8_WAIT_L(0); PG8_MMA(1, 0, At, B0); PG8_BAR; PG8_SCHED;
            PG8_STAGE(PG8_SB(1, 1), b3 + hsB, voffB);
            PG8_WAIT_V(6); PG8_BAR; PG8_MMA(1, 1, At, B1); PG8_BAR;
        }
        E(acc, cur, wr, wc, fr, fq);
        if (!has_next) break;
#pragma unroll
        for (int a = 0; a < 2; ++a)
#pragma unroll
            for (int b = 0; b < 2; ++b)
#pragma unroll
                for (int m = 0; m < 4; ++m)
#pragma unroll
                    for (int n = 0; n < 2; ++n) acc[a][b][m][n] = (f32x4){0.f, 0.f, 0.f, 0.f};
        cur = nxt; cA = nA; cB = nB; ++ui;
    }
    PG8_WAIT_V(0);
    if (wr == 0) PG8_BAR;
    PG8_BAR;
#undef PG8_SA
#undef PG8_SB
#undef PG8_STAGE
#undef PG8_LDA
#undef PG8_LDB
#undef PG8_MMA
#undef PG8_WAIT_V
#undef PG8_WAIT_L
#undef PG8_BAR
#undef PG8_SCHED
}

struct EpiF32 {
    static constexpr bool PERM = false;
    float* C; int ldc;
    __device__ __forceinline__ void operator()(const f32x4 (&acc)[2][2][4][2], const Unit& u, int wr, int wc, int fr, int fq) const {
        const int row0 = u.pm * BM + wr * 64 + fr, col0 = u.pn * BM + wc * 32 + 4 * fq;
#pragma unroll
        for (int ai = 0; ai < 2; ++ai)
#pragma unroll
            for (int m = 0; m < 4; ++m) { float* rowp = C + (size_t)(row0 + ai * HALF + m * 16) * ldc + col0;
#pragma unroll
                for (int bj = 0; bj < 2; ++bj)
#pragma unroll
                    for (int n = 0; n < 2; ++n) *(f32x4*)(rowp + bj * HALF + n * 16) = acc[ai][bj][m][n]; }
    }
};
struct EpiProj {
    static constexpr bool PERM = true;
    unsigned char* ws;
    __device__ __forceinline__ void operator()(const f32x4 (&acc)[2][2][4][2], const Unit& u, int wr, int wc, int fr, int fq) const {
        bf16_t* base = (bf16_t*)(ws + kP1Off[u.pn]); const int ld = kP1Ld[u.pn], ncol = kP1Nc[u.pn];
        const int row0 = u.pm * BM + wr * 64 + fr, col0 = kP1C0[u.pn] + wc * 32 + 8 * fq;
#pragma unroll
        for (int ai = 0; ai < 2; ++ai)
#pragma unroll
            for (int m = 0; m < 4; ++m) { bf16_t* rowp = base + (size_t)(row0 + ai * HALF + m * 16) * ld + col0;
#pragma unroll
                for (int bj = 0; bj < 2; ++bj) { if (bj * HALF >= ncol) continue;
                    const f32x4 v0 = acc[ai][bj][m][0], v1 = acc[ai][bj][m][1];
                    u32x4 w; w.x = cvt_pk_bf16(v0[0], v0[1]); w.y = cvt_pk_bf16(v0[2], v0[3]); w.z = cvt_pk_bf16(v1[0], v1[1]); w.w = cvt_pk_bf16(v1[2], v1[3]);
                    *(u32x4*)(rowp + bj * HALF) = w; } }
    }
};
struct EpiGate {
    static constexpr bool PERM = true;
    bf16_t* G0;
    __device__ __forceinline__ void operator()(const f32x4 (&acc)[2][2][4][2], const Unit& u, int wr, int wc, int fr, int fq) const {
        bf16_t* base = G0 + (size_t)(u.pn >> 1) * ((size_t)NTOK * 512);
        const int row0 = u.pm * BM + wr * 64 + fr, col0 = (u.pn & 1) * 256 + wc * 32 + 8 * fq;
#pragma unroll
        for (int ai = 0; ai < 2; ++ai)
#pragma unroll
            for (int m = 0; m < 4; ++m) { bf16_t* rowp = base + (size_t)(row0 + ai * HALF + m * 16) * 512 + col0;
#pragma unroll
                for (int bj = 0; bj < 2; ++bj) {
                    f32x4 v0 = acc[ai][bj][m][0], v1 = acc[ai][bj][m][1];
#pragma unroll
                    for (int j = 0; j < 4; ++j) { v0[j] = sigmoidf_(v0[j]); v1[j] = sigmoidf_(v1[j]); }
                    u32x4 w; w.x = cvt_pk_bf16(v0[0], v0[1]); w.y = cvt_pk_bf16(v0[2], v0[3]); w.z = cvt_pk_bf16(v1[0], v1[1]); w.w = cvt_pk_bf16(v1[2], v1[3]);
                    *(u32x4*)(rowp + bj * HALF) = w; } }
    }
};
struct EpiSwiglu {
    static constexpr bool PERM = true;
    bf16_t* O; int ldc;
    __device__ __forceinline__ void operator()(const f32x4 (&acc)[2][2][4][2], const Unit& u, int wr, int wc, int fr, int fq) const {
        const int row0 = u.pm * BM + wr * 64 + fr, col0 = u.pn * HALF + wc * 32 + 8 * fq;
#pragma unroll
        for (int ai = 0; ai < 2; ++ai)
#pragma unroll
            for (int m = 0; m < 4; ++m) { bf16_t* rowp = O + (size_t)(row0 + ai * HALF + m * 16) * ldc + col0;
                float r[8];
#pragma unroll
                for (int n = 0; n < 2; ++n)
#pragma unroll
                    for (int j = 0; j < 4; ++j) { const float gv = acc[ai][0][m][n][j], uv = acc[ai][1][m][n][j]; r[n * 4 + j] = gv * sigmoidf_(gv) * uv; }
                u32x4 w; w.x = cvt_pk_bf16(r[0], r[1]); w.y = cvt_pk_bf16(r[2], r[3]); w.z = cvt_pk_bf16(r[4], r[5]); w.w = cvt_pk_bf16(r[6], r[7]);
                *(u32x4*)rowp = w; }
    }
};
struct EpiBranch {
    static constexpr bool PERM = true;
    bf16_t* Mg; const bf16_t* G0;
    __device__ __forceinline__ void operator()(const f32x4 (&acc)[2][2][4][2], const Unit& u, int wr, int wc, int fr, int fq) const {
        const bf16_t* gb = G0 + (size_t)(u.br * 2 + (u.pn >> 1)) * ((size_t)NTOK * 512);
        const int row0 = u.pm * BM + wr * 64 + fr, cl = wc * 32 + 8 * fq;
#pragma unroll
        for (int ai = 0; ai < 2; ++ai)
#pragma unroll
            for (int m = 0; m < 4; ++m) { const size_t row = (size_t)(row0 + ai * HALF + m * 16);
#pragma unroll
                for (int bj = 0; bj < 2; ++bj) {
                    const u32x4 gw = *(const u32x4*)(gb + row * 512 + (u.pn & 1) * 256 + bj * HALF + cl);
                    bf16_t* mp = Mg + row * 1024 + u.pn * 256 + bj * HALF + cl;
                    float r[8];
#pragma unroll
                    for (int q = 0; q < 4; ++q) { const unsigned g2 = gw[q]; const int n = q >> 1, j = (q & 1) * 2;
                        r[q * 2] = __uint_as_float(g2 << 16) * acc[ai][bj][m][n][j]; r[q * 2 + 1] = __uint_as_float(g2 & 0xffff0000u) * acc[ai][bj][m][n][j + 1]; }
                    if (u.br != 0) { u32x4 ow;
#pragma unroll
                        for (int q = 0; q < 4; ++q) ow[q] = __hip_atomic_load((const unsigned*)mp + q, __ATOMIC_RELAXED, __HIP_MEMORY_SCOPE_AGENT);
#pragma unroll
                        for (int q = 0; q < 4; ++q) { r[q * 2] += __uint_as_float(ow[q] << 16); r[q * 2 + 1] += __uint_as_float(ow[q] & 0xffff0000u); } }
                    u32x4 w; w.x = cvt_pk_bf16(r[0], r[1]); w.y = cvt_pk_bf16(r[2], r[3]); w.z = cvt_pk_bf16(r[4], r[5]); w.w = cvt_pk_bf16(r[6], r[7]);
                    *(u32x4*)mp = w; } }
    }
};
}

template <int MAP> __device__ __forceinline__ int colmap(int n, int off) {
    if (MAP == 0) return n + off;
    if (MAP == 1) { if (n < 3584) return n; const int s = n - 512; return s < C_G ? s : -1; }
    const int pn = n >> 8, r = n & 255; return (r < 128) ? 128 * pn + r : D_FF + 128 * pn + (r - 128);
}
template <int MAP>
__device__ void conv_job(LAS unsigned char* lds, bf16_t* dst, int ld_dst, int koff, const float* src, int ld_src, int K, int n_lo, int n_hi, int off, int bid, int nb) {
    LAS float* tile = (LAS float*)lds;
    const int tid = threadIdx.x, nk = K / 64, nn = (n_hi - n_lo) / 64;
    for (int it = bid; it < nk * nn; it += nb) {
        const int n0 = n_lo + (it / nk) * 64, k0 = (it % nk) * 64;
        { const int kk = tid >> 3, c8 = (tid & 7) * 8;
#pragma unroll
          for (int j = 0; j < 8; ++j) { const int col = colmap<MAP>(n0 + c8 + j, off); tile[kk * 65 + c8 + j] = (col >= 0) ? src[(size_t)(k0 + kk) * ld_src + col] : 0.f; } }
        __syncthreads();
        { const int nr = tid >> 3, k8 = (tid & 7) * 8; float v[8];
#pragma unroll
          for (int j = 0; j < 8; ++j) v[j] = tile[(k8 + j) * 65 + nr];
          u32x4 w; w.x = cvt_pk_bf16(v[0], v[1]); w.y = cvt_pk_bf16(v[2], v[3]); w.z = cvt_pk_bf16(v[4], v[5]); w.w = cvt_pk_bf16(v[6], v[7]);
          *(u32x4*)(dst + (size_t)(n0 + nr) * ld_dst + koff + k0 + k8) = w; }
        __syncthreads();
    }
}
__device__ void fold_tile(LAS unsigned char* lds, bf16_t* out, long sOi, long sOj, const float* A, long sAi, long sAd, const float* B, long sBj, long sBd) {
    LAS float* As = (LAS float*)lds; LAS float* Bs = As + 64 * 129;
    const int tid = threadIdx.x;
    for (int e = tid; e < 64 * 128; e += 512) {
        int i, d; if (sAd == 1) { i = e >> 7; d = e & 127; } else { d = e >> 6; i = e & 63; }
        As[i * 129 + d] = A[i * sAi + d * sAd];
        int j, d2; if (sBd == 1) { j = e >> 7; d2 = e & 127; } else { d2 = e >> 6; j = e & 63; }
        Bs[j * 129 + d2] = B[j * sBj + d2 * sBd];
    }
    __syncthreads();
    const int i = tid & 63, jg = tid >> 6;
    float acc[8];
#pragma unroll
    for (int q = 0; q < 8; ++q) acc[q] = 0.f;
    for (int d = 0; d < 128; ++d) { const float a = As[i * 129 + d];
#pragma unroll
        for (int q = 0; q < 8; ++q) acc[q] += a * Bs[(jg * 8 + q) * 129 + d]; }
#pragma unroll
    for (int q = 0; q < 8; ++q) out[i * sOi + (jg * 8 + q) * sOj] = f2bf(acc[q]);
    __syncthreads();
}

__device__ void phase_conv_in(const Params& p, int l, LAS unsigned char* lds, int bid, int nb) {
    const float* Win = p.in[I_WIN] + (size_t)l * D_MODEL * IN_W;
    conv_job<1>(lds, BF(p, OFF_WIN), 1024, 0, Win, IN_W, 1024, 0, 3584, 0, bid, nb);
    conv_job<1>(lds, BF(p, OFF_WIN), 1024, 0, Win, IN_W, 1024, 4608, NP1, 0, bid, nb);
    const float* wuk = p.in[I_WUK] + (size_t)l * 256 * 512;
    for (int it = bid; it < 256; it += nb) { const int h = it >> 6, rb = (it >> 4) & 3, kb = it & 15;
        fold_tile(lds, BF(p, OFF_WIN) + (size_t)(3584 + h * 256 + rb * 64) * 1024 + kb * 64, 1, 1024,
                  Win + (size_t)(kb * 64) * IN_W + C_DQ + h * 128, IN_W, 1, wuk + ((size_t)(rb * 64) * 4 + h) * 128, 512, 1); }
}
__device__ void phase_conv_post(const Params& p, int l, LAS unsigned char* lds, int bid, int nb) {
    const float* Win = p.in[I_WIN] + (size_t)l * D_MODEL * IN_W;
    conv_job<0>(lds, BF(p, OFF_WG), 1024, 0, Win, IN_W, 1024, 0, 3072, C_G, bid, nb);
    conv_job<0>(lds, BF(p, OFF_WBR), 2048, 0, p.in[I_WA] + (size_t)l * 512 * 1024, 1024, 512, 0, 1024, 0, bid, nb);
    conv_job<0>(lds, BF(p, OFF_WBR), 2048, 512, p.in[I_WB] + (size_t)l * 512 * 1024, 1024, 512, 0, 1024, 0, bid, nb);
    conv_job<0>(lds, BF(p, OFF_WOUT), 1024, 0, p.in[I_WOUT] + (size_t)l * 1024 * 1024, 1024, 1024, 0, 1024, 0, bid, nb);
    conv_job<2>(lds, BF(p, OFF_WF1), 1024, 0, p.in[I_WF1] + (size_t)l * 1024 * 2 * D_FF, 2 * D_FF, 1024, 0, 2 * D_FF, 0, bid, nb);
    conv_job<0>(lds, BF(p, OFF_WF2), D_FF, 0, p.in[I_WF2] + (size_t)l * D_FF * 1024, 1024, D_FF, 0, 1024, 0, bid, nb);
    const float* wuv = p.in[I_WUV] + (size_t)l * 256 * 512; const float* wc = p.in[I_WC] + (size_t)l * 512 * 1024;
    for (int it = bid; it < 256; it += nb) { const int h = it >> 6, rb = (it >> 4) & 3, nbk = it & 15;
        fold_tile(lds, BF(p, OFF_WBR) + (size_t)(nbk * 64) * 2048 + 1024 + h * 256 + rb * 64, 1, 2048,
                  wuv + ((size_t)(rb * 64) * 4 + h) * 128, 512, 1, wc + (size_t)(h * 128) * 1024 + nbk * 64, 1, 1024); }
}

__device__ __forceinline__ float wave_sum(float v) {
#pragma unroll
    for (int o = 32; o >= 1; o >>= 1) v += __shfl_xor(v, o);
    return v;
}
template <int MODE>
__device__ void phase_norm(const float* xin, float* xout, const float* O, const float* wpost, const float* w1, bf16_t* H, int bid, int nb) {
    const int wv = threadIdx.x >> 6, lane = threadIdx.x & 63;
    for (int row = bid * 8 + wv; row < NTOK; row += nb * 8) {
        f32x4 xv[4];
#pragma unroll
        for (int j = 0; j < 4; ++j) xv[j] = *(const f32x4*)(xin + (size_t)row * 1024 + j * 256 + lane * 4);
        if (MODE >= 1) {
            f32x4 ov[4]; float ss = 0.f;
#pragma unroll
            for (int j = 0; j < 4; ++j) { ov[j] = *(const f32x4*)(O + (size_t)row * 1024 + j * 256 + lane * 4); ss += ov[j][0] * ov[j][0] + ov[j][1] * ov[j][1] + ov[j][2] * ov[j][2] + ov[j][3] * ov[j][3]; }
            ss = wave_sum(ss); const float r = rsqrtf(ss * (1.f / 1024.f) + 1e-6f);
#pragma unroll
            for (int j = 0; j < 4; ++j) { const f32x4 wv4 = *(const f32x4*)(wpost + j * 256 + lane * 4); xv[j] = xv[j] + ov[j] * r * wv4; *(f32x4*)(xout + (size_t)row * 1024 + j * 256 + lane * 4) = xv[j]; }
        }
        if (MODE <= 1) {
            float ss = 0.f;
#pragma unroll
            for (int j = 0; j < 4; ++j) ss += xv[j][0] * xv[j][0] + xv[j][1] * xv[j][1] + xv[j][2] * xv[j][2] + xv[j][3] * xv[j][3];
            ss = wave_sum(ss); const float r = rsqrtf(ss * (1.f / 1024.f) + 1e-6f);
#pragma unroll
            for (int j = 0; j < 4; ++j) { const f32x4 wv4 = *(const f32x4*)(w1 + j * 256 + lane * 4); const f32x4 y = xv[j] * r * wv4;
                u32x2 w; w.x = cvt_pk_bf16(y[0], y[1]); w.y = cvt_pk_bf16(y[2], y[3]); *(u32x2*)(H + (size_t)row * 1024 + j * 256 + lane * 4) = w; }
        }
    }
}

__device__ void phase_gemm_in(const Params& p, LAS unsigned char* lds, int bid, int nb) {
    pg8::EpiProj E{p.ws};
    pg8::Gemm g{BF(p, OFF_H), BF(p, OFF_WIN), 1024, 1024};
    pg8::StaticOrder S; S.init(NTOK, NP1, 1024, nb, bid);
    pg8::gemm_phase(lds, g, S, E);
}
__device__ void phase_gemm_gates(const Params& p, LAS unsigned char* lds, int bid, int nb) {
    pg8::EpiGate E{BF(p, OFF_HF)};
    pg8::Gemm g{BF(p, OFF_H), BF(p, OFF_WG), 1024, 1024};
    pg8::StaticOrder S; S.init(NTOK, 3072, 1024, nb, bid);
    pg8::gemm_phase(lds, g, S, E);
}
__device__ void phase_gemm_branch(const Params& p, LAS unsigned char* lds, int bid, int nb) {
    pg8::EpiBranch E; E.Mg = BF(p, OFF_H); E.G0 = BF(p, OFF_HF);
    pg8::Gemm g{BF(p, OFF_Y), BF(p, OFF_WBR), 2048, 2048};
    pg8::BranchOrder S; S.init(NTOK, 1024, nb, bid);
    pg8::gemm_phase(lds, g, S, E);
}
__device__ void phase_gemm_out(const Params& p, LAS unsigned char* lds, int bid, int nb) {
    pg8::EpiF32 E{F32P(p, OFF_OUT), 1024};
    pg8::Gemm g{BF(p, OFF_H), BF(p, OFF_WOUT), 1024, 1024};
    pg8::StaticOrder S; S.init(NTOK, 1024, 1024, nb, bid);
    pg8::gemm_phase(lds, g, S, E);
}
__device__ void phase_gemm_ffn1(const Params& p, LAS unsigned char* lds, int bid, int nb) {
    pg8::EpiSwiglu E{BF(p, OFF_ACT), D_FF};
    pg8::Gemm g{BF(p, OFF_H), BF(p, OFF_WF1), 1024, 1024};
    pg8::StaticOrder S; S.init(NTOK, 2 * D_FF, 1024, nb, bid);
    pg8::gemm_phase(lds, g, S, E);
}
__device__ void phase_gemm_ffn2(const Params& p, LAS unsigned char* lds, int bid, int nb) {
    pg8::EpiF32 E{F32P(p, OFF_OUT), 1024};
    pg8::Gemm g{BF(p, OFF_ACT), BF(p, OFF_WF2), D_FF, D_FF};
    pg8::StaticOrder S; S.init(NTOK, 1024, D_FF, nb, bid);
    pg8::gemm_phase(lds, g, S, E);
}


__device__ __forceinline__ float hg_lower_bound(const float* lbl, int l, int idx) {
    const float l0 = lbl[idx], l1 = lbl[512 + idx]; const float m = fmaxf(l0, l1), e0 = __expf(l0 - m), e1 = __expf(l1 - m), p0 = e0 / (e0 + e1), p1 = e1 / (e0 + e1);
    return ((l == 0) ? p0 : (p0 + p1)) - p0;
}
__device__ __forceinline__ void pack16_store(LAS unsigned char* dst, const float (&v)[16]) {
    u32x4 a, b; a.x = cvt_pk_bf16(v[0], v[1]); a.y = cvt_pk_bf16(v[2], v[3]); a.z = cvt_pk_bf16(v[4], v[5]); a.w = cvt_pk_bf16(v[6], v[7]);
    b.x = cvt_pk_bf16(v[8], v[9]); b.y = cvt_pk_bf16(v[10], v[11]); b.z = cvt_pk_bf16(v[12], v[13]); b.w = cvt_pk_bf16(v[14], v[15]);
    *(LAS u32x4*)dst = a; *(LAS u32x4*)(dst + 16) = b;
}
#define HG_FRONT()                                                                                                   \
    const int d = tid & 127, seg = tid >> 7;                                                                         \
    const float lbd = hg_lower_bound(p.in[I_LB], l, h * 128 + d);                                                    \
    float kk[16], cs[16];                                                                                            \
    { float run = 0.f;                                                                                               \
      _Pragma("unroll") for (int jj = 0; jj < 16; ++jj) {                                                            \
          const float fp = bf2f(HF[(size_t)(row0 + seg * 16 + jj) * 512 + h * 128 + d]);                            \
          const float sg = sigmoidf_(fp); const float f = fmaxf(lbd + (1.f - lbd) * sg, 1e-20f);                     \
          kk[jj] = (1.f - lbd) * (1.f - sg); run += __logf(f); cs[jj] = run; }                                       \
      SEG[seg * 128 + d] = run; }

__device__ void phase_hg1(const Params& p, int l, LAS unsigned char* lds, int bid, int nb) {
    const int tid = threadIdx.x, lane = tid & 63, w = __builtin_amdgcn_readfirstlane(tid >> 6), fr = lane & 15, g = lane >> 4;
    LAS float* SEG = (LAS float*)lds; LAS unsigned char* KT = lds + 2048; LAS unsigned char* VT = KT + 128 * 144;
    const bf16_t* HF = BF(p, OFF_HF); const bf16_t* HI = BF(p, OFF_HI); bf16_t* ST = BF(p, OFF_ST); float* DEC = F32P(p, OFF_DEC);
    for (int unit = bid; unit < 1024; unit += nb) {
        const int bh = unit >> 6, c = unit & 63, h = bh & 3, row0 = (bh >> 2) * SEQ + c * 64;
        HG_FRONT();
        float vv[16];
#pragma unroll
        for (int jj = 0; jj < 16; ++jj) vv[jj] = bf2f(HI[(size_t)(row0 + seg * 16 + jj) * 512 + h * 128 + d]);
        __syncthreads();
        float off = 0.f, bl = 0.f;
#pragma unroll
        for (int s2 = 0; s2 < 4; ++s2) { const float t = SEG[s2 * 128 + d]; off += (s2 < seg) ? t : 0.f; bl += t; }
        float kb[16];
#pragma unroll
        for (int jj = 0; jj < 16; ++jj) kb[jj] = kk[jj] * __expf(bl - (off + cs[jj]));
        pack16_store(KT + d * 144 + seg * 32, kb);
        pack16_store(VT + d * 144 + seg * 32, vv);
        if (seg == 0) DEC[(size_t)unit * 128 + d] = __expf(bl);
        __syncthreads();
        bf16x8 a[2];
#pragma unroll
        for (int ks = 0; ks < 2; ++ks) a[ks] = *(const LAS bf16x8*)(KT + (16 * w + fr) * 144 + (32 * ks + 8 * g) * 2);
#pragma unroll
        for (int et = 0; et < 8; ++et) {
            f32x4 acc = {0.f, 0.f, 0.f, 0.f};
#pragma unroll
            for (int ks = 0; ks < 2; ++ks) { const bf16x8 b = *(const LAS bf16x8*)(VT + (16 * et + fr) * 144 + (32 * ks + 8 * g) * 2); acc = __builtin_amdgcn_mfma_f32_16x16x32_bf16(a[ks], b, acc, 0, 0, 0); }
            mfma_fence(acc);
            u32x2 o; o.x = cvt_pk_bf16(acc[0], acc[1]); o.y = cvt_pk_bf16(acc[2], acc[3]);
            *(u32x2*)(ST + ((size_t)unit * 128 + 16 * et + fr) * 128 + 16 * w + 4 * g) = o;
        }
        __syncthreads();
    }
}
__device__ void phase_hg2(const Params& p, int bid, int nb) {
    bf16_t* ST = BF(p, OFF_ST); const float* DEC = F32P(p, OFF_DEC);
    for (int gid = bid * 512 + threadIdx.x; gid < 16 * 8192; gid += nb * 512) {
        const int bh = gid >> 13, within = gid & 8191, e = within >> 6, d = (within & 63) * 2;
        float s0 = 0.f, s1 = 0.f;
        for (int c0 = 0; c0 < 64; c0 += 8) {
            unsigned u[8]; float d0[8], d1[8];
#pragma unroll
            for (int k = 0; k < 8; ++k) { const size_t un = (size_t)(bh * 64 + c0 + k);
                u[k] = *(const unsigned*)(ST + (un * 128 + e) * 128 + d); d0[k] = DEC[un * 128 + d]; d1[k] = DEC[un * 128 + d + 1]; }
            asm volatile("s_waitcnt vmcnt(0)" ::: "memory");
#pragma unroll
            for (int k = 0; k < 8; ++k) { const size_t un = (size_t)(bh * 64 + c0 + k);
                *(unsigned*)(ST + (un * 128 + e) * 128 + d) = cvt_pk_bf16(s0, s1);
                s0 = d0[k] * s0 + __uint_as_float(u[k] << 16); s1 = d1[k] * s1 + __uint_as_float(u[k] & 0xffff0000u); }
        }
    }
}
__device__ void phase_hg3(const Params& p, int l, LAS unsigned char* lds, int bid, int nb) {
    const int tid = threadIdx.x, lane = tid & 63, w = __builtin_amdgcn_readfirstlane(tid >> 6), fr = lane & 15, g = lane >> 4;
    LAS float* SEG = (LAS float*)lds;
    LAS unsigned char* QH = lds + 2048; LAS unsigned char* QT = QH + 64 * 272; LAS float* OL = (LAS float*)(lds + 2048);
    LAS unsigned char* KB = lds + 36864; LAS unsigned char* VT = lds + 54272; LAS unsigned char* SP = lds + 72704; LAS unsigned char* PL = lds + 107520;
    const bf16_t* HF = BF(p, OFF_HF); const bf16_t* HI = BF(p, OFF_HI); const bf16_t* HG = BF(p, OFF_HG); const bf16_t* ST = BF(p, OFF_ST); bf16_t* Y = BF(p, OFF_Y);
    for (int unit = bid; unit < 1024; unit += nb) {
        const int bh = unit >> 6, c = unit & 63, h = bh & 3, row0 = (bh >> 2) * SEQ + c * 64;
        HG_FRONT();
        {
#pragma unroll
            for (int k = 0; k < 4; ++k) { const int ch = tid + 512 * k, e = ch >> 4, dc = ch & 15;
                *(LAS u32x4*)(SP + e * 272 + dc * 16) = *(const u32x4*)(ST + ((size_t)unit * 128 + e) * 128 + dc * 8); }
            float vv[16];
#pragma unroll
            for (int jj = 0; jj < 16; ++jj) vv[jj] = bf2f(HI[(size_t)(row0 + seg * 16 + jj) * 512 + h * 128 + d]);
            pack16_store(VT + d * 144 + seg * 32, vv);
        }
        __syncthreads();
        float beta[4]; { float run = 0.f;
#pragma unroll
            for (int s2 = 0; s2 < 4; ++s2) { beta[s2] = run; run += SEG[s2 * 128 + d]; } }
        float off = 0.f;
#pragma unroll
        for (int s2 = 0; s2 < 4; ++s2) off = (s2 == seg) ? beta[s2] : off;
#pragma unroll
        for (int jj = 0; jj < 16; ++jj) {
            const float q = bf2f(Y[(size_t)(row0 + seg * 16 + jj) * 2048 + h * 128 + d]);
            const int i = seg * 16 + jj;
            *(LAS bf16_t*)(QH + i * 272 + d * 2) = f2bf(q * __expf(off + cs[jj]));
            *(LAS bf16_t*)(QT + i * 272 + d * 2) = f2bf(q * __expf(cs[jj]));
        }
#pragma unroll
        for (int I = 0; I < 4; ++I) {
            if (seg <= I) {
                float bI = 0.f;
#pragma unroll
                for (int s2 = 0; s2 < 4; ++s2) bI = (s2 == I) ? beta[s2] : bI;
#pragma unroll
                for (int jj = 0; jj < 16; ++jj) *(LAS bf16_t*)(KB + (seg * 16 + jj) * 272 + d * 2) = f2bf(kk[jj] * __expf(fminf(bI - (off + cs[jj]), 60.f)));
            }
            __syncthreads();
            if (w < 4) {
                f32x4 acc = {0.f, 0.f, 0.f, 0.f};
                if (w <= I) {
#pragma unroll
                    for (int ks = 0; ks < 4; ++ks) {
                        const bf16x8 a = *(const LAS bf16x8*)(QT + (16 * I + fr) * 272 + (32 * ks + 8 * g) * 2);
                        const bf16x8 b = *(const LAS bf16x8*)(KB + (16 * w + fr) * 272 + (32 * ks + 8 * g) * 2);
                        acc = __builtin_amdgcn_mfma_f32_16x16x32_bf16(a, b, acc, 0, 0, 0); }
                    mfma_fence(acc);
                    const int lim = (w == I) ? (4 * g) : 1000;
#pragma unroll
                    for (int r = 0; r < 4; ++r) acc[r] = (fr <= lim + r) ? acc[r] : 0.f;
                }
#pragma unroll
                for (int r = 0; r < 4; ++r) *(LAS bf16_t*)(PL + (16 * I + 4 * g + r) * 144 + (16 * w + fr) * 2) = f2bf(acc[r]);
            }
            __syncthreads();
        }
        f32x4 oacc[4];
        { const int ib = w >> 1;
          bf16x8 aq[4], ap[2];
#pragma unroll
          for (int ks = 0; ks < 4; ++ks) aq[ks] = *(const LAS bf16x8*)(QH + (16 * ib + fr) * 272 + (32 * ks + 8 * g) * 2);
#pragma unroll
          for (int ks = 0; ks < 2; ++ks) ap[ks] = *(const LAS bf16x8*)(PL + (16 * ib + fr) * 144 + (32 * ks + 8 * g) * 2);
#pragma unroll
          for (int q4 = 0; q4 < 4; ++q4) { const int et = 4 * (w & 1) + q4; f32x4 acc = {0.f, 0.f, 0.f, 0.f};
#pragma unroll
              for (int ks = 0; ks < 4; ++ks) { const bf16x8 b = *(const LAS bf16x8*)(SP + (16 * et + fr) * 272 + (32 * ks + 8 * g) * 2); acc = __builtin_amdgcn_mfma_f32_16x16x32_bf16(aq[ks], b, acc, 0, 0, 0); }
#pragma unroll
              for (int ks = 0; ks < 2; ++ks) { const bf16x8 b = *(const LAS bf16x8*)(VT + (16 * et + fr) * 144 + (32 * ks + 8 * g) * 2); acc = __builtin_amdgcn_mfma_f32_16x16x32_bf16(ap[ks], b, acc, 0, 0, 0); }
              oacc[q4] = acc; } }
        mfma_fence(oacc[0], oacc[1], oacc[2], oacc[3]);
        __syncthreads();
#pragma unroll
        for (int q4 = 0; q4 < 4; ++q4)
#pragma unroll
            for (int r = 0; r < 4; ++r) OL[(16 * (w >> 1) + 4 * g + r) * 132 + 16 * (4 * (w & 1) + q4) + fr] = oacc[q4][r];
        __syncthreads();
        {
            const int i = tid >> 3, es = (tid & 7) * 16;
            float o[16], ss = 0.f;
#pragma unroll
            for (int k = 0; k < 16; ++k) { o[k] = OL[i * 132 + es + k]; ss += o[k] * o[k]; }
            ss += __shfl_xor(ss, 1); ss += __shfl_xor(ss, 2); ss += __shfl_xor(ss, 4);
            const float rstd = rsqrtf(ss * (1.f / 128.f) + 1e-6f);
            const u32x4 g0 = *(const u32x4*)(HG + (size_t)(row0 + i) * 512 + h * 128 + es), g1 = *(const u32x4*)(HG + (size_t)(row0 + i) * 512 + h * 128 + es + 8);
            float y[16];
#pragma unroll
            for (int k = 0; k < 16; ++k) { const unsigned gw = (k < 8) ? g0[k >> 1] : g1[(k - 8) >> 1]; const float gv = (k & 1) ? __uint_as_float(gw & 0xffff0000u) : __uint_as_float(gw << 16);
                y[k] = o[k] * rstd * p.in[I_HGNW][l * 128 + es + k] * (gv * sigmoidf_(gv)); }
            u32x4 a, b; a.x = cvt_pk_bf16(y[0], y[1]); a.y = cvt_pk_bf16(y[2], y[3]); a.z = cvt_pk_bf16(y[4], y[5]); a.w = cvt_pk_bf16(y[6], y[7]);
            b.x = cvt_pk_bf16(y[8], y[9]); b.y = cvt_pk_bf16(y[10], y[11]); b.z = cvt_pk_bf16(y[12], y[13]); b.w = cvt_pk_bf16(y[14], y[15]);
            bf16_t* yo = Y + (size_t)(row0 + i) * 2048 + h * 128 + es;
            *(u32x4*)yo = a; *(u32x4*)(yo + 8) = b;
        }
        __syncthreads();
    }
}


__device__ void phase_prep(const Params& p, int l, LAS unsigned char* lds, int bid, int nb) {
    const int tid = threadIdx.x, lane = tid & 63, wv = tid >> 6;
    {
        LAS float* red = (LAS float*)lds; const bf16_t* MK = BF(p, OFF_MK); float* KM = F32P(p, OFF_KMEAN);
        for (int it = bid; it < 256; it += nb) {
            const int bh = it >> 4, n = it & 15, h = bh & 3, d = tid & 127, part = tid >> 7; const size_t row0 = (size_t)(bh >> 2) * SEQ + n * 256 + part * 64;
            float s = 0.f;
            for (int j = 0; j < 64; ++j) s += bf2f(MK[(row0 + j) * 512 + h * 128 + d]);
            red[part * 128 + d] = s; __syncthreads();
            if (part == 0) KM[(size_t)it * 128 + d] = (red[d] + red[128 + d] + red[256 + d] + red[384 + d]) * (1.f / 256.f);
            __syncthreads();
        }
    }
    bf16_t* CKV = BF(p, OFF_CKV); bf16_t* IKW = BF(p, OFF_IKW);
    const float* kvw = p.in[I_KVN] + l * 256; const float* ikw = p.in[I_IKNW] + l * 64; const float* ikb = p.in[I_IKNB] + l * 64;
    for (int row = bid * 8 + wv; row < NTOK; row += nb * 8) {
        {   u32x2* cp = (u32x2*)(CKV + (size_t)row * 256 + lane * 4); const u32x2 v = *cp;
            const float a0 = __uint_as_float(v.x << 16), a1 = __uint_as_float(v.x & 0xffff0000u), a2 = __uint_as_float(v.y << 16), a3 = __uint_as_float(v.y & 0xffff0000u);
            const float ss = wave_sum(a0 * a0 + a1 * a1 + a2 * a2 + a3 * a3); const float r = rsqrtf(ss * (1.f / 256.f) + 1e-6f);
            const f32x4 w4 = *(const f32x4*)(kvw + lane * 4);
            u32x2 o; o.x = cvt_pk_bf16(a0 * r * w4[0], a1 * r * w4[1]); o.y = cvt_pk_bf16(a2 * r * w4[2], a3 * r * w4[3]); *cp = o; }
        {   bf16_t* ip = IKW + (size_t)row * 128; const float u = bf2f(ip[lane]);
            const float mu = wave_sum(u) * (1.f / 64.f); const float xc = u - mu; const float var = wave_sum(xc * xc) * (1.f / 64.f);
            const float y = xc * rsqrtf(var + 1e-6f) * ikw[lane] + ikb[lane];
            const float wgt = (lane < 8) ? bf2f(ip[64 + lane]) * (0.35355339059327373f * 0.125f) : 0.f;
            ip[lane] = f2bf(y); if (lane < 8) ip[64 + lane] = f2bf(wgt); }
    }
}

typedef short v4i16_t __attribute__((ext_vector_type(4)));
__device__ __forceinline__ v4i16_t lds_tr16(const LAS unsigned char* pp) { return __builtin_amdgcn_ds_read_tr16_b64_v4i16((LAS v4i16_t*)pp); }
__device__ void phase_moba(const Params& p, LAS unsigned char* lds, int bid, int nb) {
    const int tid = threadIdx.x, lane = tid & 63, w = __builtin_amdgcn_readfirstlane(tid >> 6), fr = lane & 15, g = lane >> 4;
    LAS float* BL = (LAS float*)lds; LAS float* KM = (LAS float*)(lds + 16384); LAS float* GG = (LAS float*)(lds + 24576);
    LAS unsigned* SM = (LAS unsigned*)(lds + 32768); LAS unsigned* UM = SM + 128;
    LAS unsigned char* QS = lds + 33792; LAS unsigned char* KS = lds + 68608; LAS unsigned char* VS = lds + 86016;
    bf16_t* Y = BF(p, OFF_Y); const bf16_t* MK = BF(p, OFF_MK); const bf16_t* MV = BF(p, OFF_MV);
    const float scale = 0.08838834764831845f;
    for (int j = bid; j < 512; j += nb) {
        const int bh = j & 15, qt = (j < 256) ? (j >> 4) : (31 - ((j - 256) >> 4));
        const int h = bh & 3, brow = (bh >> 2) * SEQ, t0 = qt * 128, blk = qt >> 1;
        for (int dd = tid; dd < 4096; dd += 512) BL[dd] = p.in[I_REL][rel_bucket(dd) * 8 + h];
        for (int e = tid; e < 2048; e += 512) KM[e] = F32P(p, OFF_KMEAN)[(size_t)bh * 2048 + e];
#pragma unroll
        for (int k = 0; k < 4; ++k) { const int ch = tid + 512 * k, r = ch >> 4, c = ch & 15;
            *(LAS u32x4*)(QS + r * 272 + c * 16) = *(const u32x4*)(Y + (size_t)(brow + t0 + r) * 2048 + 512 + h * 128 + c * 8); }
        if (tid == 0) *UM = 0u;
        __syncthreads();
        {
            const int q = tid >> 2, ng = tid & 3; float ga[4] = {0.f, 0.f, 0.f, 0.f};
            for (int c = 0; c < 16; ++c) { const u32x4 qv = *(const LAS u32x4*)(QS + q * 272 + c * 16);
#pragma unroll
                for (int e2 = 0; e2 < 8; ++e2) { const unsigned wq = qv[e2 >> 1]; const float qf = (e2 & 1) ? __uint_as_float(wq & 0xffff0000u) : __uint_as_float(wq << 16);
#pragma unroll
                    for (int n4 = 0; n4 < 4; ++n4) ga[n4] += qf * KM[(ng * 4 + n4) * 128 + c * 8 + e2]; } }
#pragma unroll
            for (int n4 = 0; n4 < 4; ++n4) GG[q * 16 + ng * 4 + n4] = ga[n4];
        }
        __syncthreads();
        if (tid < 128) {
            unsigned used = 0u;
            for (int k = 0; k < 3; ++k) { int best = -1; float bv = 0.f;
                for (int n = 0; n < blk; ++n) { const float v = GG[tid * 16 + n]; if (!((used >> n) & 1u) && (best < 0 || v > bv)) { best = n; bv = v; } }
                if (best >= 0) used |= 1u << best; }
            SM[tid] = used; __hip_atomic_fetch_or((unsigned*)UM, used, __ATOMIC_RELAXED, __HIP_MEMORY_SCOPE_WORKGROUP);
        }
        __syncthreads();
        const unsigned umask = *UM; const unsigned mysel = SM[16 * w + fr];
        const int tq = t0 + 16 * w + fr;
        bf16x8 qf[4];
#pragma unroll
        for (int ks = 0; ks < 4; ++ks) qf[ks] = *(const LAS bf16x8*)(QS + (16 * w + fr) * 272 + (32 * ks + 8 * g) * 2);
        f32x4 oacc[8];
#pragma unroll
        for (int dt = 0; dt < 8; ++dt) oacc[dt] = (f32x4){0.f, 0.f, 0.f, 0.f};
        float mrun = -1e30f, lsum = 0.f;
        const int own_tiles = 2 + 2 * (qt & 1);
        for (int bi = 0; bi <= blk; ++bi) {
            const int n = (bi == 0) ? blk : (bi - 1);
            if (bi > 0 && !((umask >> n) & 1u)) continue;
            const bool own = (bi == 0); const int ntile = own ? own_tiles : 4;
            const bool qsel = own || ((mysel >> n) & 1u);
            for (int kt = 0; kt < ntile; ++kt) {
                const int key0 = n * 256 + kt * 64;
                __syncthreads();
#pragma unroll
                for (int k = 0; k < 2; ++k) { const int ch = tid + 512 * k, r = ch >> 4, c = ch & 15; const size_t go = (size_t)(brow + key0 + r) * 512 + h * 128 + c * 8;
                    *(LAS u32x4*)(KS + r * 272 + c * 16) = *(const u32x4*)(MK + go); *(LAS u32x4*)(VS + r * 272 + c * 16) = *(const u32x4*)(MV + go); }
                __syncthreads();
                f32x4 s[4];
#pragma unroll
                for (int k4 = 0; k4 < 4; ++k4) { f32x4 acc = {0.f, 0.f, 0.f, 0.f};
#pragma unroll
                    for (int ks = 0; ks < 4; ++ks) { const bf16x8 a = *(const LAS bf16x8*)(KS + (16 * k4 + fr) * 272 + (32 * ks + 8 * g) * 2); acc = __builtin_amdgcn_mfma_f32_16x16x32_bf16(a, qf[ks], acc, 0, 0, 0); }
                    s[k4] = acc; }
                mfma_fence(s[0], s[1], s[2], s[3]);
                float mx = -1e30f;
#pragma unroll
                for (int k4 = 0; k4 < 4; ++k4)
#pragma unroll
                    for (int r = 0; r < 4; ++r) { const int dist = tq - (key0 + 16 * k4 + 4 * g + r); const bool ok = qsel && (dist >= 0);
                        const float lg = s[k4][r] * scale + BL[dist < 0 ? 0 : dist]; s[k4][r] = ok ? lg : -1e30f; mx = fmaxf(mx, s[k4][r]); }
                mx = fmaxf(mx, __shfl_xor(mx, 16)); mx = fmaxf(mx, __shfl_xor(mx, 32));
                const float mnew = fmaxf(mrun, mx), alpha = __expf(mrun - mnew); mrun = mnew;
                float ps = 0.f;
#pragma unroll
                for (int k4 = 0; k4 < 4; ++k4)
#pragma unroll
                    for (int r = 0; r < 4; ++r) { const float pv = (s[k4][r] > -1e29f) ? __expf(s[k4][r] - mnew) : 0.f; s[k4][r] = pv; ps += pv; }
                lsum = lsum * alpha + ps;
#pragma unroll
                for (int dt = 0; dt < 8; ++dt) oacc[dt] = oacc[dt] * alpha;
                bf16x8 pb[2];
#pragma unroll
                for (int m2 = 0; m2 < 2; ++m2) { u32x4 t; t.x = cvt_pk_bf16(s[2 * m2][0], s[2 * m2][1]); t.y = cvt_pk_bf16(s[2 * m2][2], s[2 * m2][3]);
                    t.z = cvt_pk_bf16(s[2 * m2 + 1][0], s[2 * m2 + 1][1]); t.w = cvt_pk_bf16(s[2 * m2 + 1][2], s[2 * m2 + 1][3]); pb[m2] = __builtin_bit_cast(bf16x8, t); }
#pragma unroll
                for (int dt = 0; dt < 8; ++dt)
#pragma unroll
                    for (int m2 = 0; m2 < 2; ++m2) {
                        const LAS unsigned char* va = VS + (32 * m2 + 4 * g + (fr >> 2)) * 272 + (16 * dt + 4 * (fr & 3)) * 2;
                        const v4i16_t lo = lds_tr16(va), hi = lds_tr16(va + 16 * 272);
                        const bf16x8 a = {lo[0], lo[1], lo[2], lo[3], hi[0], hi[1], hi[2], hi[3]};
                        oacc[dt] = __builtin_amdgcn_mfma_f32_16x16x32_bf16(a, pb[m2], oacc[dt], 0, 0, 0); }
            }
        }
        lsum += __shfl_xor(lsum, 16); lsum += __shfl_xor(lsum, 32);
        const float inv = 1.f / lsum;
        mfma_fence(oacc[0], oacc[1], oacc[2], oacc[3]); mfma_fence(oacc[4], oacc[5], oacc[6], oacc[7]);
        __syncthreads();
#pragma unroll
        for (int dt = 0; dt < 8; ++dt) { u32x2 o; o.x = cvt_pk_bf16(oacc[dt][0] * inv, oacc[dt][1] * inv); o.y = cvt_pk_bf16(oacc[dt][2] * inv, oacc[dt][3] * inv);
            *(u32x2*)(Y + (size_t)(brow + tq) * 2048 + 512 + h * 128 + 16 * dt + 4 * g) = o; }
        __syncthreads();
    }
}


template <int PROBE = 0> __device__ void phase_dsel(const Params& p, LAS unsigned char* lds, int bid, int nb) {
    const int tid = threadIdx.x, lane = tid & 63, w = __builtin_amdgcn_readfirstlane(tid >> 6), fr = lane & 15, g = lane >> 4, q8 = fr & 7;
    LAS unsigned char* KEYS = lds;
    LAS unsigned char* IQS = lds + 131072;
    const bf16_t* IQ = BF(p, OFF_IQ); const bf16_t* IKW = BF(p, OFF_IKW);
    unsigned* MASK = PROBE ? (unsigned*)((unsigned char*)p.x + (size_t)(PROBE - 1) * 8 * MiB) : (unsigned*)(p.ws + OFF_MASK);
    for (int u = 0; u < 2048; ++u) {
        int k;
        if (nb == 256) { if (u >= 8) break; k = (u & 1) ? (512 * (u >> 1) + 511 - bid) : (512 * (u >> 1) + bid); }
        else { k = bid + u * nb; if (k >= 2048) break; }
        const int b = k & 3, qt = k >> 2, brow = b * SEQ, t0 = qt * 8, nkt = (t0 + 7) / 16 + 1;
        __syncthreads();
        { const int r = tid >> 6, c = tid & 63;
          *(LAS u32x4*)(IQS + r * 1040 + c * 16) = *(const u32x4*)(IQ + (size_t)(brow + t0 + r) * 512 + c * 8); }
        float iw[8];
        { const u32x4 wv = *(const u32x4*)(IKW + (size_t)(brow + t0 + q8) * 128 + 64);
#pragma unroll
          for (int hh = 0; hh < 8; ++hh) iw[hh] = (hh & 1) ? __uint_as_float(wv[hh >> 1] & 0xffff0000u) : __uint_as_float(wv[hh >> 1] << 16); }
        __syncthreads();
        {
            bf16x8 bq[8][2];
#pragma unroll
            for (int hh = 0; hh < 8; ++hh) { bq[hh][0] = *(const LAS bf16x8*)(IQS + q8 * 1040 + (hh * 64 + 8 * g) * 2); bq[hh][1] = *(const LAS bf16x8*)(IQS + q8 * 1040 + (hh * 64 + 32 + 8 * g) * 2); }
            const int tq = t0 + q8;
            const bf16_t* krp = IKW + (size_t)(brow + 16 * w + fr) * 128 + 8 * g;
            for (int kt = w; kt < nkt; kt += 8, krp += 16384) {
                const bf16x8 a0 = *(const bf16x8*)krp, a1 = *(const bf16x8*)(krp + 32);
                float sc0 = 0.f, sc1 = 0.f, sc2 = 0.f, sc3 = 0.f;
#pragma unroll
                for (int hg4 = 0; hg4 < 2; ++hg4) {
                    f32x4 ah[4];
#pragma unroll
                    for (int h2 = 0; h2 < 4; ++h2) { const int hh = hg4 * 4 + h2; f32x4 acc = {0.f, 0.f, 0.f, 0.f};
                        acc = __builtin_amdgcn_mfma_f32_16x16x32_bf16(a0, bq[hh][0], acc, 0, 0, 0);
                        acc = __builtin_amdgcn_mfma_f32_16x16x32_bf16(a1, bq[hh][1], acc, 0, 0, 0);
                        ah[h2] = acc; }
                    mfma_fence(ah[0], ah[1], ah[2], ah[3]);
#pragma unroll
                    for (int h2 = 0; h2 < 4; ++h2) { const float wgt = iw[hg4 * 4 + h2];
                        sc0 += wgt * fmaxf(ah[h2][0], 0.f); sc1 += wgt * fmaxf(ah[h2][1], 0.f); sc2 += wgt * fmaxf(ah[h2][2], 0.f); sc3 += wgt * fmaxf(ah[h2][3], 0.f); }
                }
                const int sp0 = 16 * kt + 4 * g; u32x4 kv;
                { unsigned uu = __float_as_uint(sc0 + 0.0f); uu = (uu & 0x80000000u) ? ~uu : (uu | 0x80000000u); kv.x = (sp0 + 0 <= tq) ? ((uu & 0xfffff000u) | (unsigned)(4095 - sp0)) : 0u; }
                { unsigned uu = __float_as_uint(sc1 + 0.0f); uu = (uu & 0x80000000u) ? ~uu : (uu | 0x80000000u); kv.y = (sp0 + 1 <= tq) ? ((uu & 0xfffff000u) | (unsigned)(4094 - sp0)) : 0u; }
                { unsigned uu = __float_as_uint(sc2 + 0.0f); uu = (uu & 0x80000000u) ? ~uu : (uu | 0x80000000u); kv.z = (sp0 + 2 <= tq) ? ((uu & 0xfffff000u) | (unsigned)(4093 - sp0)) : 0u; }
                { unsigned uu = __float_as_uint(sc3 + 0.0f); uu = (uu & 0x80000000u) ? ~uu : (uu | 0x80000000u); kv.w = (sp0 + 3 <= tq) ? ((uu & 0xfffff000u) | (unsigned)(4092 - sp0)) : 0u; }
                if (fr < 8) *(LAS u32x4*)(KEYS + fr * 16384 + sp0 * 4) = kv;
            }
        }
        __syncthreads();
        {
            const int t = t0 + w; const int nch = 4 * nkt;
            const int mmax = (nch + 63) >> 6;
            u32x4 kr[16];
#pragma unroll
            for (int m = 0; m < 16; ++m) { const int c = lane + 64 * m; const u32x4 z = {0u, 0u, 0u, 0u};
                kr[m] = (m < mmax && c < nch) ? *(const LAS u32x4*)(KEYS + w * 16384 + c * 16) : z; }
            unsigned thr = 1u;
            if (t + 1 > 256) { thr = 0u;
                for (int it = 0; it < 32; ++it) {
                    const unsigned cand = thr | (0x80000000u >> it);
                    unsigned cn = 0u;
#pragma unroll
                    for (int m = 0; m < 16; ++m) if (m < mmax) { cn += (kr[m].x >= cand) ? 1u : 0u; cn += (kr[m].y >= cand) ? 1u : 0u; cn += (kr[m].z >= cand) ? 1u : 0u; cn += (kr[m].w >= cand) ? 1u : 0u; }
#pragma unroll
                    for (int o = 1; o < 64; o <<= 1) cn += (unsigned)__shfl_xor((int)cn, o);
                    if (cn >= 256u) thr = cand;
                    if (cn == 256u) break;
                } }
            if (PROBE >= 3) thr = 0x80000000u;
            unsigned* mrow = MASK + (size_t)(brow + t) * 128;
#pragma unroll
            for (int m = 0; m < 16; ++m) {
                unsigned nib = 0u;
                if (m < mmax) nib = ((kr[m].x >= thr) ? 1u : 0u) | ((kr[m].y >= thr) ? 2u : 0u) | ((kr[m].z >= thr) ? 4u : 0u) | ((kr[m].w >= thr) ? 8u : 0u);
                unsigned v = nib << (4 * (lane & 7));
                v |= (unsigned)__shfl_xor((int)v, 1); v |= (unsigned)__shfl_xor((int)v, 2); v |= (unsigned)__shfl_xor((int)v, 4);
                if ((lane & 7) == 0) mrow[(lane >> 3) + 8 * m] = v;
            }
        }
    }
}

__device__ void phase_datt(const Params& p, LAS unsigned char* lds, int bid, int nb) {
    const int tid = threadIdx.x, lane = tid & 63, w = __builtin_amdgcn_readfirstlane(tid >> 6), fr = lane & 15, g = lane >> 4;
    LAS unsigned char* BK = lds;
    LAS float* RL = (LAS float*)(lds + 4096);
    LAS unsigned short* IDX = (LAS unsigned short*)(lds + 5120 + w * 512);
    LAS float* PW = (LAS float*)(lds + 5120 + 8 * 512 + w * 4096);
    const bf16_t* CKV = BF(p, OFF_CKV); bf16_t* Y = BF(p, OFF_Y); const unsigned* MASK = (const unsigned*)(p.ws + OFF_MASK);
    for (int dd = tid; dd < 4096; dd += 512) BK[dd] = (unsigned char)rel_bucket(dd);
    if (tid < 256) RL[tid] = p.in[I_REL][tid];
    __syncthreads();
    const float scale = 0.08838834764831845f;
    for (int it = bid; it < NTOK / 8; it += nb) {
        const int tg = it * 8 + w, brow = (tg >> 12) * SEQ, t = tg & 4095;
        const u32x2 mw = *(const u32x2*)(MASK + (size_t)tg * 128 + 2 * lane);
        const int cnt = __popc(mw.x) + __popc(mw.y);
        int pre = cnt;
#pragma unroll
        for (int o = 1; o < 64; o <<= 1) { const int v = __shfl_up(pre, o); if (lane >= o) pre += v; }
        const int nsel = __shfl(pre, 63);
        int pos = pre - cnt;
        { unsigned m0 = mw.x; while (m0) { const int bpos = __ffs(m0) - 1; m0 &= m0 - 1; IDX[pos++] = (unsigned short)(64 * lane + bpos); }
          unsigned m1 = mw.y; while (m1) { const int bpos = __ffs(m1) - 1; m1 &= m1 - 1; IDX[pos++] = (unsigned short)(64 * lane + 32 + bpos); } }
        for (int e = nsel + lane; e < 256; e += 64) IDX[e] = 0;
        bf16x8 qb[8];
#pragma unroll
        for (int ks = 0; ks < 8; ++ks) { const u32x4 z = {0u, 0u, 0u, 0u}; const u32x4 v = (fr < 4) ? *(const u32x4*)(Y + (size_t)tg * 2048 + 1024 + fr * 256 + 32 * ks + 8 * g) : z; qb[ks] = __builtin_bit_cast(bf16x8, v); }
        f32x4 sacc[16];
#pragma unroll
        for (int kt = 0; kt < 16; ++kt) {
            const int srow = IDX[16 * kt + fr];
            const bf16_t* cr = CKV + (size_t)(brow + srow) * 256 + 8 * g;
            bf16x8 ac[8];
#pragma unroll
            for (int ks = 0; ks < 8; ++ks) ac[ks] = *(const bf16x8*)(cr + 32 * ks);
            f32x4 acc = {0.f, 0.f, 0.f, 0.f};
#pragma unroll
            for (int ks = 0; ks < 8; ++ks) acc = __builtin_amdgcn_mfma_f32_16x16x32_bf16(ac[ks], qb[ks], acc, 0, 0, 0);
            sacc[kt] = acc;
            if (kt & 1) __builtin_amdgcn_sched_barrier(0);
        }
        mfma_fence(sacc[12], sacc[13], sacc[14], sacc[15]);
        const int hd = fr & 3;
        float mx = -1e30f;
#pragma unroll
        for (int kt = 0; kt < 16; ++kt)
#pragma unroll
            for (int r = 0; r < 4; ++r) { const int slot = 16 * kt + 4 * g + r; const int sp = IDX[slot]; const int dist = t - sp;
                const float lg = sacc[kt][r] * scale + RL[BK[dist < 0 ? 0 : dist] * 8 + 4 + hd];
                sacc[kt][r] = (slot < nsel) ? lg : -1e30f; mx = fmaxf(mx, sacc[kt][r]); }
        mx = fmaxf(mx, __shfl_xor(mx, 16)); mx = fmaxf(mx, __shfl_xor(mx, 32));
        float su = 0.f;
#pragma unroll
        for (int kt = 0; kt < 16; ++kt)
#pragma unroll
            for (int r = 0; r < 4; ++r) { const float pv = (sacc[kt][r] > -1e29f) ? __expf(sacc[kt][r] - mx) : 0.f; sacc[kt][r] = pv; su += pv; }
        su += __shfl_xor(su, 16); su += __shfl_xor(su, 32);
        const float inv = 1.f / su;
        if (fr < 4) {
#pragma unroll
            for (int kt = 0; kt < 16; ++kt)
#pragma unroll
                for (int r = 0; r < 4; ++r) PW[(16 * kt + 4 * g + r) * 4 + fr] = sacc[kt][r] * inv;
        }
        float o0[4] = {0.f, 0.f, 0.f, 0.f}, o1[4] = {0.f, 0.f, 0.f, 0.f}, o2[4] = {0.f, 0.f, 0.f, 0.f}, o3[4] = {0.f, 0.f, 0.f, 0.f};
        for (int k0 = 0; k0 < nsel; k0 += 4) {
#pragma unroll
            for (int kk2 = 0; kk2 < 4; ++kk2) { const int kx = k0 + kk2; const int srow = IDX[kx];
                const u32x2 cv = *(const u32x2*)(CKV + (size_t)(brow + srow) * 256 + 4 * lane);
                const f32x4 pv = *(const LAS f32x4*)(PW + kx * 4);
                const float c0 = __uint_as_float(cv.x << 16), c1 = __uint_as_float(cv.x & 0xffff0000u), c2 = __uint_as_float(cv.y << 16), c3 = __uint_as_float(cv.y & 0xffff0000u);
                o0[0] += pv[0] * c0; o0[1] += pv[0] * c1; o0[2] += pv[0] * c2; o0[3] += pv[0] * c3;
                o1[0] += pv[1] * c0; o1[1] += pv[1] * c1; o1[2] += pv[1] * c2; o1[3] += pv[1] * c3;
                o2[0] += pv[2] * c0; o2[1] += pv[2] * c1; o2[2] += pv[2] * c2; o2[3] += pv[2] * c3;
                o3[0] += pv[3] * c0; o3[1] += pv[3] * c1; o3[2] += pv[3] * c2; o3[3] += pv[3] * c3; }
        }
        bf16_t* yo = Y + (size_t)tg * 2048 + 1024 + 4 * lane;
        { u32x2 o; o.x = cvt_pk_bf16(o0[0], o0[1]); o.y = cvt_pk_bf16(o0[2], o0[3]); *(u32x2*)(yo) = o; }
        { u32x2 o; o.x = cvt_pk_bf16(o1[0], o1[1]); o.y = cvt_pk_bf16(o1[2], o1[3]); *(u32x2*)(yo + 256) = o; }
        { u32x2 o; o.x = cvt_pk_bf16(o2[0], o2[1]); o.y = cvt_pk_bf16(o2[2], o2[3]); *(u32x2*)(yo + 512) = o; }
        { u32x2 o; o.x = cvt_pk_bf16(o3[0], o3[1]); o.y = cvt_pk_bf16(o3[2], o3[3]); *(u32x2*)(yo + 768) = o; }
    }
}

enum { PH_PRE = 0, PH_GEMM_IN, PH_CONV_POST, PH_GATES, PH_BRANCH, PH_OUT, PH_NORM_MID, PH_FFN1, PH_FFN2, PH_NORM_END, PH_HG1, PH_HG2, PH_HG3, PH_PREP, PH_MOBA, PH_DSEL, PH_DATT };
template <int PH> __global__ __launch_bounds__(512, 2) void k_ph(Params p, int l) {
    extern __shared__ __attribute__((aligned(16))) unsigned char shm[];
    LAS unsigned char* lds = (LAS unsigned char*)shm;
    const int bid = blockIdx.x, nb = gridDim.x;
    if (PH == PH_PRE) { phase_norm<0>(p.in[I_X], nullptr, nullptr, nullptr, p.in[I_PREMIX], BF(p, OFF_H), bid, nb); phase_conv_in(p, 0, lds, bid, nb); }
    if (PH == PH_GEMM_IN) phase_gemm_in(p, lds, bid, nb);
    if (PH == PH_HG1) phase_hg1(p, l, lds, bid, nb);
    if (PH == PH_HG2) phase_hg2(p, bid, nb);
    if (PH == PH_HG3) phase_hg3(p, l, lds, bid, nb);
    if (PH == PH_PREP) phase_prep(p, l, lds, bid, nb);
    if (PH == PH_MOBA) phase_moba(p, lds, bid, nb);
    if (PH == PH_DSEL) phase_dsel(p, lds, bid, nb);
    if (PH == PH_DATT) phase_datt(p, lds, bid, nb);
    if (PH == PH_CONV_POST) phase_conv_post(p, l, lds, bid, nb);
    if (PH == PH_GATES) phase_gemm_gates(p, lds, bid, nb);
    if (PH == PH_BRANCH) phase_gemm_branch(p, lds, bid, nb);
    if (PH == PH_OUT) phase_gemm_out(p, lds, bid, nb);
    if (PH == PH_NORM_MID) phase_norm<1>(l == 0 ? p.in[I_X] : p.x, p.x, F32P(p, OFF_OUT), p.in[I_POSTMIX] + l * 1024, p.in[I_PREFFN] + l * 1024, BF(p, OFF_H), bid, nb);
    if (PH == PH_FFN1) phase_gemm_ffn1(p, lds, bid, nb);
    if (PH == PH_FFN2) phase_gemm_ffn2(p, lds, bid, nb);
    if (PH == PH_NORM_END) {
        if (l + 1 < DEPTH) { phase_norm<1>(p.x, p.x, F32P(p, OFF_OUT), p.in[I_POSTFFN] + l * 1024, p.in[I_PREMIX] + (l + 1) * 1024, BF(p, OFF_H), bid, nb); phase_conv_in(p, l + 1, lds, bid, nb); }
        else phase_norm<2>(p.x, p.x, F32P(p, OFF_OUT), p.in[I_POSTFFN] + l * 1024, nullptr, nullptr, bid, nb);
    }
}

__global__ void __launch_bounds__(128) k_hgrn2(Params p, int layer) {
    const int h = blockIdx.x, b = blockIdx.y, e = threadIdx.x;
    __shared__ float lb[128], qs[128], fs[128], ks[128];
    { float l0 = p.in[I_LB][h * 128 + e], l1 = p.in[I_LB][512 + h * 128 + e];
      float m = fmaxf(l0, l1), e0 = expf(l0 - m), e1 = expf(l1 - m), p0 = e0 / (e0 + e1), p1 = e1 / (e0 + e1);
      float cs = (layer == 0) ? p0 : (p0 + p1); lb[e] = cs - p0; }
    float S[128];
#pragma unroll
    for (int d = 0; d < 128; ++d) S[d] = 0.f;
    __syncthreads();
    for (int t = 0; t < SEQ; ++t) {
        const size_t row = (size_t)b * SEQ + t;
        { float fp = bf2f(BF(p, OFF_HF)[row * 512 + h * 128 + e]); float l = lb[e];
          float f = l + (1.f - l) * sigmoidf_(fp); f = fmaxf(f, 1e-20f);
          fs[e] = f; ks[e] = (1.f - l) * sigmoidf_(-fp); qs[e] = bf2f(BF(p, OFF_Y)[row * 2048 + h * 128 + e]); }
        float v = bf2f(BF(p, OFF_HI)[row * 512 + h * 128 + e]);
        __syncthreads();
        float acc = 0.f;
#pragma unroll
        for (int d = 0; d < 128; ++d) { S[d] = fs[d] * S[d] + ks[d] * v; acc += qs[d] * S[d]; }
        F32P(p, OFF_TMPF)[row * 512 + h * 128 + e] = acc;
        __syncthreads();
    }
}
__global__ void __launch_bounds__(128) k_hgrn2_post(Params p, int layer) {
    __shared__ float red[128];
    const int t = blockIdx.x >> 2, h = blockIdx.x & 3, e = threadIdx.x;
    float v = F32P(p, OFF_TMPF)[(size_t)t * 512 + h * 128 + e];
    red[e] = v * v; __syncthreads();
    for (int k = 64; k > 0; k >>= 1) { if (e < k) red[e] += red[e + k]; __syncthreads(); }
    float r = rsqrtf(red[0] / 128.f + 1e-6f);
    float g = bf2f(BF(p, OFF_HG)[(size_t)t * 512 + h * 128 + e]);
    BF(p, OFF_Y)[(size_t)t * 2048 + h * 128 + e] = f2bf(v * r * p.in[I_HGNW][layer * 128 + e] * (g * sigmoidf_(g)));
}
__global__ void __launch_bounds__(128) k_kmean(Params p) {
    const int n = blockIdx.x, h = blockIdx.y, b = blockIdx.z, d = threadIdx.x;
    float s = 0.f;
    for (int j = 0; j < 256; ++j) s += bf2f(BF(p, OFF_MK)[((size_t)b * SEQ + n * 256 + j) * 512 + h * 128 + d]);
    F32P(p, OFF_KMEAN)[((b * 4 + h) * 16 + n) * 128 + d] = s / 256.f;
}
__global__ void __launch_bounds__(256) k_moba(Params p) {
    const int tg = blockIdx.x >> 2, h = blockIdx.x & 3, tid = threadIdx.x;
    const int b = tg >> 12, t = tg & 4095, blk = t >> 8;
    __shared__ float q[128], gate[16], lg[1024], red[256];
    __shared__ int sel[3];
    if (tid < 128) q[tid] = bf2f(BF(p, OFF_Y)[(size_t)tg * 2048 + 512 + h * 128 + tid]);
    __syncthreads();
    if (tid < 16) { float s = 0.f; for (int d = 0; d < 128; ++d) s += q[d] * F32P(p, OFF_KMEAN)[((b * 4 + h) * 16 + tid) * 128 + d]; gate[tid] = (tid < blk) ? s : NEG_BIG; }
    __syncthreads();
    if (tid == 0) { unsigned used = 0u;
        for (int k = 0; k < 3; ++k) { int best = -1; float bv = 0.f;
            for (int i = 0; i < 16; ++i) if (!((used >> i) & 1u) && (best < 0 || gate[i] > bv)) { best = i; bv = gate[i]; }
            used |= 1u << best; sel[k] = best; } }
    __syncthreads();
    const float scale = 0.08838834764831845f;
    for (int sl = 0; sl < 4; ++sl) {
        int bn = (sl < 3) ? sel[sl] : blk; int s = bn * 256 + tid;
        bool valid = (sl < 3) ? (bn < blk) : (s <= t);
        float l = NEG_BIG;
        if (valid) { const bf16_t* kr = BF(p, OFF_MK) + ((size_t)b * SEQ + s) * 512 + h * 128; float a = 0.f; for (int d = 0; d < 128; ++d) a += q[d] * bf2f(kr[d]); l = a * scale + p.in[I_REL][rel_bucket(t - s) * 8 + h]; }
        lg[sl * 256 + tid] = l;
    }
    __syncthreads();
    float m = fmaxf(fmaxf(lg[tid], lg[256 + tid]), fmaxf(lg[512 + tid], lg[768 + tid]));
    red[tid] = m; __syncthreads();
    for (int k = 128; k > 0; k >>= 1) { if (tid < k) red[tid] = fmaxf(red[tid], red[tid + k]); __syncthreads(); }
    m = red[0]; __syncthreads();
    float su = 0.f;
    for (int sl = 0; sl < 4; ++sl) { float pp = expf(lg[sl * 256 + tid] - m); lg[sl * 256 + tid] = pp; su += pp; }
    red[tid] = su; __syncthreads();
    for (int k = 128; k > 0; k >>= 1) { if (tid < k) red[tid] += red[tid + k]; __syncthreads(); }
    const float inv = 1.f / red[0];
    const int d = tid & 127, half = tid >> 7;
    float acc = 0.f;
    for (int sl = 0; sl < 4; ++sl) {
        int bn = (sl < 3) ? sel[sl] : blk; bool anyvalid = (sl < 3) ? (bn < blk) : true;
        if (!anyvalid) continue;
        for (int j = half * 128; j < half * 128 + 128; ++j) { float pp = lg[sl * 256 + j]; if (pp != 0.f) acc += pp * bf2f(BF(p, OFF_MV)[((size_t)b * SEQ + bn * 256 + j) * 512 + h * 128 + d]); }
    }
    __syncthreads();
    red[tid] = acc; __syncthreads();
    if (tid < 128) BF(p, OFF_Y)[(size_t)tg * 2048 + 512 + h * 128 + tid] = f2bf((red[tid] + red[tid + 128]) * inv);
}
__global__ void __launch_bounds__(256) k_dsa_prep(Params p, int layer) {
    __shared__ float red[256];
    const int t = blockIdx.x, tid = threadIdx.x;
    float v = bf2f(BF(p, OFF_CKV)[(size_t)t * 256 + tid]);
    red[tid] = v * v; __syncthreads();
    for (int k = 128; k > 0; k >>= 1) { if (tid < k) red[tid] += red[tid + k]; __syncthreads(); }
    float r = rsqrtf(red[0] / 256.f + 1e-6f);
    __syncthreads();
    BF(p, OFF_CKV)[(size_t)t * 256 + tid] = f2bf(v * r * p.in[I_KVN][layer * 256 + tid]);
    float u = (tid < 64) ? bf2f(BF(p, OFF_IKW)[(size_t)t * 128 + tid]) : 0.f;
    red[tid] = u; __syncthreads();
    for (int k = 128; k > 0; k >>= 1) { if (tid < k) red[tid] += red[tid + k]; __syncthreads(); }
    float mu = red[0] / 64.f; __syncthreads();
    float xc = (tid < 64) ? (u - mu) : 0.f;
    red[tid] = xc * xc; __syncthreads();
    for (int k = 128; k > 0; k >>= 1) { if (tid < k) red[tid] += red[tid + k]; __syncthreads(); }
    float rr = rsqrtf(red[0] / 64.f + 1e-6f);
    if (tid < 64) BF(p, OFF_IKW)[(size_t)t * 128 + tid] = f2bf(xc * rr * p.in[I_IKNW][layer * 64 + tid] + p.in[I_IKNB][layer * 64 + tid]);
}
__global__ void __launch_bounds__(256) k_dsa(Params p) {
    const int tg = blockIdx.x, tid = threadIdx.x, b = tg >> 12, t = tg & 4095;
    __shared__ unsigned long long keys[SEQ];
    __shared__ float iq[512], iw[8], qa[1024];
    __shared__ int cnt_s; __shared__ int idx[256]; __shared__ int red_i[256];
    __shared__ float pl[4][256], redf[256];
    for (int i = tid; i < 512; i += 256) iq[i] = bf2f(BF(p, OFF_IQ)[(size_t)tg * 512 + i]);
    for (int i = tid; i < 1024; i += 256) qa[i] = bf2f(BF(p, OFF_Y)[(size_t)tg * 2048 + 1024 + i]);
    if (tid < 8) iw[tid] = bf2f(BF(p, OFF_IKW)[(size_t)tg * 128 + 64 + tid]);
    if (tid == 0) cnt_s = 0;
    __syncthreads();
    const int nvalid = t + 1;
    for (int s = tid; s < SEQ; s += 256) {
        unsigned long long key = 0ull;
        if (s <= t) {
            const bf16_t* kr = BF(p, OFF_IKW) + ((size_t)b * SEQ + s) * 128;
            float kv[64];
#pragma unroll
            for (int d = 0; d < 64; ++d) kv[d] = bf2f(kr[d]);
            float sc = 0.f;
#pragma unroll
            for (int hh = 0; hh < 8; ++hh) { float a = 0.f;
#pragma unroll
                for (int d = 0; d < 64; ++d) a += iq[hh * 64 + d] * kv[d];
                sc += iw[hh] * fmaxf(a, 0.f); }
            sc += 0.0f;
            unsigned u = __float_as_uint(sc); u = (u & 0x80000000u) ? ~u : (u | 0x80000000u);
            key = (((unsigned long long)u << 12) | (unsigned long long)(4095 - s)) + 1ull;
        }
        keys[s] = key;
    }
    __syncthreads();
    const int nkeep = nvalid < 256 ? nvalid : 256;
    unsigned long long thr = 1ull;
    if (nvalid > 256) { thr = 0ull;
        for (int bit = 44; bit >= 0; --bit) {
            unsigned long long cand = thr | (1ull << bit);
            int c = 0;
            for (int s = tid; s < SEQ; s += 256) c += (keys[s] >= cand) ? 1 : 0;
            red_i[tid] = c; __syncthreads();
            for (int k = 128; k > 0; k >>= 1) { if (tid < k) red_i[tid] += red_i[tid + k]; __syncthreads(); }
            int tot = red_i[0]; __syncthreads();
            if (tot >= 256) thr = cand;
        } }
    {
        int c = 0;
        for (int j = 0; j < 16; ++j) { unsigned long long k = keys[tid * 16 + j]; c += (k >= thr && k != 0ull) ? 1 : 0; }
        red_i[tid] = c; __syncthreads();
        if (tid == 0) { int run = 0; for (int i = 0; i < 256; ++i) { int v = red_i[i]; red_i[i] = run; run += v; } cnt_s = run; }
        __syncthreads();
        int pos = red_i[tid];
        for (int j = 0; j < 16; ++j) { unsigned long long k = keys[tid * 16 + j]; if (k >= thr && k != 0ull) { if (pos < 256) idx[pos] = tid * 16 + j; ++pos; } }
    }
    __syncthreads();
    const float scale = 0.08838834764831845f;
    float lgt[4] = {NEG_BIG, NEG_BIG, NEG_BIG, NEG_BIG};
    if (tid < nkeep) {
        int s = idx[tid]; const bf16_t* cr = BF(p, OFF_CKV) + ((size_t)b * SEQ + s) * 256;
        int bk = rel_bucket(t - s);
        float a0 = 0.f, a1 = 0.f, a2 = 0.f, a3 = 0.f;
        for (int r = 0; r < 256; ++r) { float c = bf2f(cr[r]); a0 += qa[r] * c; a1 += qa[256 + r] * c; a2 += qa[512 + r] * c; a3 += qa[768 + r] * c; }
        lgt[0] = a0 * scale + p.in[I_REL][bk * 8 + 4]; lgt[1] = a1 * scale + p.in[I_REL][bk * 8 + 5]; lgt[2] = a2 * scale + p.in[I_REL][bk * 8 + 6]; lgt[3] = a3 * scale + p.in[I_REL][bk * 8 + 7];
    }
#pragma unroll
    for (int hh = 0; hh < 4; ++hh) {
        redf[tid] = lgt[hh]; __syncthreads();
        for (int k = 128; k > 0; k >>= 1) { if (tid < k) redf[tid] = fmaxf(redf[tid], redf[tid + k]); __syncthreads(); }
        float m = redf[0]; __syncthreads();
        float pp = (tid < nkeep) ? expf(lgt[hh] - m) : 0.f;
        redf[tid] = pp; __syncthreads();
        for (int k = 128; k > 0; k >>= 1) { if (tid < k) redf[tid] += redf[tid + k]; __syncthreads(); }
        float su = redf[0]; __syncthreads();
        pl[hh][tid] = pp / su;
    }
    __syncthreads();
    { float o0 = 0.f, o1 = 0.f, o2 = 0.f, o3 = 0.f;
      for (int k = 0; k < nkeep; ++k) { float c = bf2f(BF(p, OFF_CKV)[((size_t)b * SEQ + idx[k]) * 256 + tid]); o0 += pl[0][k] * c; o1 += pl[1][k] * c; o2 += pl[2][k] * c; o3 += pl[3][k] * c; }
      bf16_t* yo = BF(p, OFF_Y) + (size_t)tg * 2048 + 1024;
      yo[tid] = f2bf(o0); yo[256 + tid] = f2bf(o1); yo[512 + tid] = f2bf(o2); yo[768 + tid] = f2bf(o3); }
}

#define LDS_BYTES (144 * 1024)
template <int PH> static void launch_ph(const Params& p, int l, hipStream_t st) {
    static bool attr = false;
    if (!attr) { (void)hipFuncSetAttribute((const void*)k_ph<PH>, hipFuncAttributeMaxDynamicSharedMemorySize, LDS_BYTES); attr = true; }
    hipLaunchKernelGGL((k_ph<PH>), dim3(256), dim3(512), LDS_BYTES, st, p, l);
}

extern "C" void kernel_launch(void* const* d_in, const int* in_sizes, int n_in, void* d_out, int out_size, void* d_ws, size_t ws_size, hipStream_t stream) {
    Params p{};
    for (int i = 0; i < 20; ++i) p.in[i] = (const float*)d_in[i];
    p.x = (float*)d_out; p.ws = (unsigned char*)d_ws;
    if (WS_NEED > ws_size) { fprintf(stderr, "kernel_launch: workspace too small (%zu < %zu)\n", ws_size, (size_t)WS_NEED); return; }
    (void)hipMemsetAsync(p.ws + OFF_CTL, 0, 64 * 1024, stream);

    launch_ph<PH_PRE>(p, 0, stream);
    for (int l = 0; l < DEPTH; ++l) {
        launch_ph<PH_GEMM_IN>(p, l, stream);
        launch_ph<PH_HG1>(p, l, stream);
        launch_ph<PH_HG2>(p, l, stream);
        launch_ph<PH_HG3>(p, l, stream);
        launch_ph<PH_PREP>(p, l, stream);
        launch_ph<PH_MOBA>(p, l, stream);
        launch_ph<PH_DSEL>(p, l, stream);
        launch_ph<PH_DATT>(p, l, stream);
        launch_ph<PH_CONV_POST>(p, l, stream);
        launch_ph<PH_GATES>(p, l, stream);
        launch_ph<PH_BRANCH>(p, l, stream);
        launch_ph<PH_OUT>(p, l, stream);
        launch_ph<PH_NORM_MID>(p, l, stream);
        launch_ph<PH_FFN1>(p, l, stream);
        launch_ph<PH_FFN2>(p, l, stream);
        launch_ph<PH_NORM_END>(p, l, stream);
    }
}
```

```cpp
#include <hip/hip_runtime.h>
#include <stdint.h>
#include <stdio.h>

#define D_MODEL 1024
#define BATCH 4
#define SEQ 4096
#define NTOK 16384
#define DEPTH 2
#define IN_W 8008
#define D_FF 2816
#define NEG_BIG (-1e30f)
#define C_HQ 0
#define C_HF 512
#define C_HI 1024
#define C_HG 1536
#define C_MQ 2048
#define C_MK 2560
#define C_MV 3072
#define C_DQ 3584
#define C_DKV 4096
#define C_IQ 4352
#define C_IK 4864
#define C_IW 4928
#define C_G 4936
#define NP1 5632

#define LAS __attribute__((address_space(3)))
typedef unsigned short bf16_t;
typedef short bf16x8 __attribute__((ext_vector_type(8)));
typedef float f32x4 __attribute__((ext_vector_type(4)));
typedef unsigned u32x4 __attribute__((ext_vector_type(4)));
typedef unsigned u32x2 __attribute__((ext_vector_type(2)));

__device__ __forceinline__ float sigmoidf_(float x) { return 1.f / (1.f + __expf(-x)); }
__device__ __forceinline__ float bf2f(bf16_t b) { return __uint_as_float(((unsigned)b) << 16); }
typedef __bf16 bf16x2_t __attribute__((ext_vector_type(2)));
typedef float f32x2_t __attribute__((ext_vector_type(2)));
__device__ __forceinline__ unsigned cvt_pk_bf16(float lo, float hi) { const f32x2_t f = {lo, hi}; const bf16x2_t v = __builtin_convertvector(f, bf16x2_t); return __builtin_bit_cast(unsigned, v); }
__device__ __forceinline__ bf16_t f2bf(float f) { return (bf16_t)(cvt_pk_bf16(f, 0.f) & 0xffffu); }
__device__ __forceinline__ int phase_tid() { int t = threadIdx.x; asm volatile("" : "+v"(t)); return t; }
__device__ __forceinline__ void mfma_fence(f32x4& a) { asm volatile("s_nop 15\n\ts_nop 3" : "+v"(a)); }
__device__ __forceinline__ void mfma_fence(f32x4& a, f32x4& b, f32x4& c, f32x4& d) { asm volatile("s_nop 15\n\ts_nop 3" : "+v"(a), "+v"(b), "+v"(c), "+v"(d)); }
__device__ __forceinline__ int rel_bucket(int dist) {
    int n = dist > 0 ? dist : 0;
    if (n < 16) return n;
    float nf = (float)n;
    int large = 16 + (int)(logf(nf / 16.f) / 4.852030263919617f * 16.f);
    return large < 31 ? large : 31;
}

enum { I_X = 0, I_WIN, I_PREMIX, I_POSTMIX, I_PREFFN, I_POSTFFN, I_LB, I_HGNW, I_KVN, I_WUK, I_WUV, I_IKNW, I_IKNB, I_REL, I_WA, I_WB, I_WC, I_WOUT, I_WF1, I_WF2 };
struct Params { const float* in[20]; float* x; unsigned char* ws; };
constexpr size_t MiB = 1024 * 1024;
#define LDS_PHASE_BYTES (144 * 1024)
constexpr size_t OFF_CTL = 0, OFF_Y = 65536, OFF_HF = OFF_Y + 64 * MiB, OFF_HI = OFF_HF + 16 * MiB, OFF_HG = OFF_HI + 16 * MiB, OFF_MK = OFF_HG + 16 * MiB,
                 OFF_MV = OFF_MK + 16 * MiB, OFF_IQ = OFF_MV + 16 * MiB, OFF_CKV = OFF_IQ + 16 * MiB, OFF_IKW = OFF_CKV + 8 * MiB, OFF_H = OFF_IKW + 4 * MiB,
                 OFF_WIN = OFF_H + 32 * MiB, OFF_RS = OFF_WIN + 11 * MiB;
constexpr size_t OFF_WG = OFF_RS, OFF_WBR = OFF_WG + 6 * MiB, OFF_WOUT = OFF_WBR + 4 * MiB, OFF_WF1 = OFF_WOUT + 2 * MiB, OFF_WF2 = OFF_WF1 + 11 * MiB, OFF_WEND = OFF_WF2 + 6 * MiB;
constexpr size_t OFF_ST = OFF_RS, OFF_TMPF = OFF_RS, OFF_DEC = OFF_ST + 32 * MiB, OFF_MASK = OFF_DEC + MiB / 2, OFF_KMEAN = OFF_MASK + 8 * MiB, OFF_MEND = OFF_KMEAN + MiB / 8;
constexpr size_t OFF_OUT = OFF_HG, OFF_ACT = OFF_Y;
constexpr size_t WS_NEED = (OFF_WEND > OFF_MEND ? OFF_WEND : OFF_MEND);
#define BF(p, off) ((bf16_t*)((p).ws + (off)))
#define F32P(p, off) ((float*)((p).ws + (off)))
__device__ const unsigned long long kP1Off[22] = {OFF_Y, OFF_Y, OFF_HF, OFF_HF, OFF_HI, OFF_HI, OFF_HG, OFF_HG, OFF_Y, OFF_Y, OFF_MK, OFF_MK, OFF_MV, OFF_MV, OFF_Y, OFF_Y, OFF_Y, OFF_Y, OFF_CKV, OFF_IQ, OFF_IQ, OFF_IKW};
__device__ const int kP1Ld[22]  = {2048, 2048, 512, 512, 512, 512, 512, 512, 2048, 2048, 512, 512, 512, 512, 2048, 2048, 2048, 2048, 256, 512, 512, 128};
__device__ const int kP1C0[22]  = {0, 256, 0, 256, 0, 256, 0, 256, 512, 768, 0, 256, 0, 256, 1024, 1280, 1536, 1792, 0, 0, 256, 0};
__device__ const int kP1Nc[22]  = {256, 256, 256, 256, 256, 256, 256, 256, 256, 256, 256, 256, 256, 256, 256, 256, 256, 256, 256, 256, 256, 128};

#define XB_TMO      128
#define XB_XCNT(j)  (256  + 64 * (j))
#define XB_XSUB(j)  (1280 + 64 * (j))
#define XB_XGEN(j)  (2304 + 64 * (j))
#define XB_TOP      3328
#define XB_TOPGEN   3392
#define XCD_BAR_WORDS 3456
#define XB_SPIN_CAP (1u << 18)

__device__ __forceinline__ unsigned xb_ld(unsigned* p)              { return __hip_atomic_load(p, __ATOMIC_RELAXED, __HIP_MEMORY_SCOPE_AGENT); }
__device__ __forceinline__ unsigned xb_add(unsigned* p, unsigned v) { return __hip_atomic_fetch_add(p, v, __ATOMIC_RELAXED, __HIP_MEMORY_SCOPE_AGENT); }
__device__ __forceinline__ unsigned xb_xcc_id() { return (unsigned)__builtin_amdgcn_s_getreg((3 << 11) | 20) & 0xFu; }
#define XB_SPIN(cond, bar) do { unsigned _sp = 0; while (cond) { __builtin_amdgcn_s_sleep(1); \
    if ((++_sp & 255u) == 0u) { if (xb_ld(&(bar)[XB_TMO])) break; if (_sp > XB_SPIN_CAP) { atomicAdd(&(bar)[XB_TMO], 1u); break; } } } } while (0)

struct XcdBarrier {
    unsigned* bar; unsigned x;
    volatile LAS unsigned* st;
};

__device__ __forceinline__ XcdBarrier xcd_barrier_post(unsigned* bar, volatile LAS unsigned* st) {
    XcdBarrier b; b.bar = bar; b.x = xb_xcc_id(); b.st = st;
    if (threadIdx.x == 0) (void)xb_add(&bar[XB_XCNT(b.x)], 1u);
    return b;
}
__device__ __forceinline__ void xcd_barrier_complete(unsigned* bar, unsigned x, unsigned& nloc, unsigned& nx) {
    const unsigned G = gridDim.x * gridDim.y * gridDim.z;
    unsigned sum, cnt, mine, sp = 0u;
    for (;;) {
        sum = 0u; cnt = 0u; mine = 0u;
#pragma unroll
        for (unsigned j = 0; j < 16; ++j) { const unsigned c = xb_ld(&bar[XB_XCNT(j)]); sum += c; cnt += (c > 0u) ? 1u : 0u; mine = (j == x) ? c : mine; }
        if (sum == G) break;
        __builtin_amdgcn_s_sleep(1);
        if ((++sp & 255u) == 0u) { if (xb_ld(&bar[XB_TMO])) break; if (sp > XB_SPIN_CAP) { atomicAdd(&bar[XB_TMO], 1u); break; } }
    }
    nloc = mine > 0u ? mine : 1u; nx = cnt > 0u ? cnt : 1u;
}

__device__ __forceinline__ void xcd_barrier(const XcdBarrier& b) {
    asm volatile("s_waitcnt vmcnt(0)" ::: "memory");
    __syncthreads();
    if (threadIdx.x == 0) {
        unsigned* bar = b.bar;
        __builtin_amdgcn_s_waitcnt(0);
        unsigned nloc = b.st[0], nx = b.st[1];
        if (nloc == 0u) { xcd_barrier_complete(bar, b.x, nloc, nx); b.st[0] = nloc; b.st[1] = nx; }
        const unsigned old = xb_add(&bar[XB_XSUB(b.x)], 1u);
        const unsigned gen = old / nloc;
        if (old + 1u == (gen + 1u) * nloc) {
            __builtin_amdgcn_fence(__ATOMIC_RELEASE, "agent");
            asm volatile("s_waitcnt vmcnt(0)" ::: "memory");
            const unsigned og = xb_add(&bar[XB_TOP], 1u);
            const unsigned tg = og / nx;
            if (og + 1u == (tg + 1u) * nx) xb_add(&bar[XB_TOPGEN], 1u);
            else XB_SPIN(xb_ld(&bar[XB_TOPGEN]) == tg, bar);
            __builtin_amdgcn_fence(__ATOMIC_ACQUIRE, "agent");
            xb_add(&bar[XB_XGEN(b.x)], 1u);
            asm volatile("s_waitcnt vmcnt(0)" ::: "memory");
        } else {
            XB_SPIN(xb_ld(&bar[XB_XGEN(b.x)]) == gen, bar);
            __builtin_amdgcn_fence(__ATOMIC_ACQUIRE, "agent");
            asm volatile("s_waitcnt vmcnt(0)" ::: "memory");
        }
    }
    __syncthreads();
}


namespace pg8 {
constexpr int BM = 256, BK = 64, HALF = 128, HTB = HALF * BK * 2, STAGE_BYTES = 8 * HTB, NXCD = 8, WGM = 8;
__host__ __device__ __forceinline__ int lds_byte(int r, int c) { const int st = (r >> 4) * 2 + (c >> 5), rr = r & 15, cc = c & 31, ob = rr * 64 + cc * 2; return st * 1024 + (ob ^ (((ob >> 9) & 1) << 5)); }
__host__ __device__ __forceinline__ void stage_rc(int b, int& R, int& C) { const int st = b / 1024, sb = b % 1024, swz = sb ^ (((sb >> 9) & 1) << 5); R = (st >> 1) * 16 + swz / 64; C = (st & 1) * 32 + (swz % 64) / 2; }
__host__ __device__ __forceinline__ int perm32(int rho) { const int n = rho >> 4, i = rho & 15; return 8 * (i >> 2) + 4 * n + (i & 3); }

struct Unit { int pm, pn, ka, nt, br; };
struct Gemm { const bf16_t* A; const bf16_t* Bt; int lda, ldb; };

__device__ __forceinline__ bool tile_of(long L, int nM, int nN, int& pm, int& pn) {
    const int nwg = nM * nN; if (L >= nwg) return false;
    int wgid = (int)L; { const int q = nwg / NXCD, r = nwg % NXCD, xcd = wgid % NXCD, off = wgid / NXCD; wgid = (xcd < r ? xcd * (q + 1) : r * (q + 1) + (xcd - r) * q) + off; }
    const int nig = WGM * nN, gid = wgid / nig, fm = gid * WGM, gsz = (nM - fm) < WGM ? (nM - fm) : WGM;
    pm = fm + ((wgid % nig) % gsz); pn = (wgid % nig) / gsz; return true;
}
struct StaticOrder {
    int nM, nN, G, c, nt;
    __device__ void init(int M, int N, int K, int G_, int c_) { nM = M / BM; nN = N / BM; G = G_; c = c_; nt = K / BK; }
    __device__ bool next(int i, Unit& u) const { u.ka = 0; u.nt = nt; u.br = 0; return tile_of((long)i * G + c, nM, nN, u.pm, u.pn); }
};
struct BranchOrder {
    int nM, nN, G, c;
    __device__ void init(int M, int N, int G_, int c_) { nM = M / BM; nN = N / BM; G = G_; c = c_; }
    __device__ bool next(int i, Unit& u) const { const int ti = i / 3, br = i - ti * 3; u.br = br; u.ka = br * 512; u.nt = (br == 2) ? 16 : 8; return tile_of((long)ti * G + c, nM, nN, u.pm, u.pn); }
};

template <class Epi, class Sched>
__device__ __forceinline__ void gemm_phase(LAS unsigned char* lds, const Gemm g, const Sched& S, const Epi& E) {
    const int tid = phase_tid(), wid = __builtin_amdgcn_readfirstlane(tid >> 6), lane = tid & 63, wr = wid >> 2, wc = wid & 3, fr = lane & 15, fq = lane >> 4;
    unsigned voffA[2], voffB[2];
#pragma unroll
    for (int i = 0; i < 2; ++i) { int R, C; stage_rc(tid * 16 + i * 8192, R, C); const int Rb = Epi::PERM ? ((R & ~31) + perm32(R & 31)) : R;
        voffA[i] = (unsigned)(R * g.lda + C) * 2u; voffB[i] = (unsigned)(Rb * g.ldb + C) * 2u; }
    const size_t kstep = (size_t)(BK * 2);
    const size_t hsA = (size_t)HALF * g.lda * 2, hsB = (size_t)HALF * g.ldb * 2;
    const size_t tsA = 2 * hsA, tsB = 2 * hsB;
    const unsigned ldsw = (unsigned)wid * 1024u;
    const int aoff = lds_byte(wr * 64 + fr, fq * 8), boff = lds_byte(wc * 32 + fr, fq * 8);
#define PG8_SA(b, h) (((b) * 2 + (h)) * HTB)
#define PG8_SB(b, h) ((4 + (b) * 2 + (h)) * HTB)
#define PG8_STAGE(bufoff, gbase, voff) do { _Pragma("unroll") for (int _i = 0; _i < 2; ++_i) \
        __builtin_amdgcn_global_load_lds((const unsigned*)((const char*)(gbase) + (voff)[_i]), (LAS unsigned*)(lds + (bufoff) + ldsw + _i * 8192), 16, 0, 0); } while (0)
#define PG8_LDA(dst, b, h) do { _Pragma("unroll") for (int m = 0; m < 4; ++m) _Pragma("unroll") for (int k = 0; k < 2; ++k) dst[m][k] = *(const LAS bf16x8*)(lds + PG8_SA(b, h) + aoff + m * 2048 + k * 1024); } while (0)
#define PG8_LDB(dst, b, h) do { _Pragma("unroll") for (int n = 0; n < 2; ++n) _Pragma("unroll") for (int k = 0; k < 2; ++k) dst[n][k] = *(const LAS bf16x8*)(lds + PG8_SB(b, h) + boff + n * 2048 + k * 1024); } while (0)
#define PG8_MMA(ai, bj, At, Bt) do { __builtin_amdgcn_s_setprio(1); _Pragma("unroll") for (int m = 0; m < 4; ++m) _Pragma("unroll") for (int n = 0; n < 2; ++n) _Pragma("unroll") for (int k = 0; k < 2; ++k) \
        acc[ai][bj][m][n] = __builtin_amdgcn_mfma_f32_16x16x32_bf16(Bt[n][k], At[m][k], acc[ai][bj][m][n], 0, 0, 0); __builtin_amdgcn_s_setprio(0); } while (0)
#define PG8_WAIT_V(n) asm volatile("s_waitcnt vmcnt(" #n ")" ::: "memory")
#define PG8_WAIT_L(n) asm volatile("s_waitcnt lgkmcnt(" #n ")" ::: "memory")
#define PG8_BAR __builtin_amdgcn_s_barrier()
#define PG8_SCHED __builtin_amdgcn_sched_barrier(0)
    Unit cur, nxt; int ui = 0;
    if (!S.next(0, cur)) return;
    f32x4 acc[2][2][4][2];
#pragma unroll
    for (int a = 0; a < 2; ++a)
#pragma unroll
        for (int b = 0; b < 2; ++b)
#pragma unroll
            for (int m = 0; m < 4; ++m)
#pragma unroll
                for (int n = 0; n < 2; ++n) acc[a][b][m][n] = (f32x4){0.f, 0.f, 0.f, 0.f};
    bf16x8 At[4][2], B0[2][2], B1[2][2];
    const char* cA = (const char*)g.A + (size_t)cur.pm * tsA + (size_t)cur.ka * 2; const char* cB = (const char*)g.Bt + (size_t)cur.pn * tsB + (size_t)cur.ka * 2;
    PG8_STAGE(PG8_SB(0, 0), cB, voffB); PG8_STAGE(PG8_SA(0, 0), cA, voffA); PG8_STAGE(PG8_SB(0, 1), cB + hsB, voffB); PG8_STAGE(PG8_SA(0, 1), cA + hsA, voffA);
    if (wr == 1) PG8_BAR;
    PG8_WAIT_V(4); PG8_BAR;
    PG8_STAGE(PG8_SB(1, 0), cB + kstep, voffB); PG8_STAGE(PG8_SA(1, 0), cA + kstep, voffA); PG8_STAGE(PG8_SB(1, 1), cB + hsB + kstep, voffB);
    PG8_WAIT_V(6); PG8_BAR;
    for (;;) {
        const bool has_next = S.next(ui + 1, nxt);
        const char* nA = has_next ? (const char*)g.A + (size_t)nxt.pm * tsA + (size_t)nxt.ka * 2 : cA; const char* nB = has_next ? (const char*)g.Bt + (size_t)nxt.pn * tsB + (size_t)nxt.ka * 2 : cB;
        const int nt = cur.nt;
        for (int t = 0; t < nt; t += 2) {
            const bool last = (t == nt - 2);
            const char* a1 = cA + (size_t)(t + 1) * kstep;
            const char* a2 = last ? nA : cA + (size_t)(t + 2) * kstep; const char* b2 = last ? nB : cB + (size_t)(t + 2) * kstep;
            const char* a3 = a2 + kstep; const char* b3 = b2 + kstep;
            PG8_LDB(B0, 0, 0); PG8_SCHED; PG8_LDA(At, 0, 0); PG8_STAGE(PG8_SA(1, 1), a1 + hsA, voffA);
            PG8_WAIT_L(8); PG8_BAR; PG8_WAIT_L(0); PG8_MMA(0, 0, At, B0); PG8_BAR; PG8_SCHED;
            PG8_LDB(B1, 0, 1); PG8_STAGE(PG8_SB(0, 0), b2, voffB);
            PG8_BAR; PG8_WAIT_L(0); PG8_MMA(0, 1, At, B1); PG8_BAR;
            PG8_LDA(At, 0, 1); PG8_STAGE(PG8_SA(0, 0), a2, voffA);
            PG8_BAR; PG8_WAIT_L(0); PG8_MMA(1, 0, At, B0); PG8_BAR; PG8_SCHED;
            PG8_STAGE(PG8_SB(0, 1), b2 + hsB, voffB);
            PG8_WAIT_V(6); PG8_BAR; PG8_MMA(1, 1, At, B1); PG8_BAR;
            PG8_LDB(B0, 1, 0); PG8_SCHED; PG8_LDA(At, 1, 0); PG8_STAGE(PG8_SA(0, 1), a2 + hsA, voffA);
            PG8_WAIT_L(8); PG8_BAR; PG8_WAIT_L(0); PG8_MMA(0, 0, At, B0); PG8_BAR; PG8_SCHED;
            PG8_LDB(B1, 1, 1); PG8_STAGE(PG8_SB(1, 0), b3, voffB);
            PG8_BAR; PG8_WAIT_L(0); PG8_MMA(0, 1, At, B1); PG8_BAR;
            PG8_LDA(At, 1, 1); PG8_STAGE(PG8_SA(1, 0), a3, voffA);
            PG8_BAR; PG8_WAIT_L(0); PG8_MMA(1, 0, At, B0); PG8_BAR; PG8_SCHED;
            PG8_STAGE(PG8_SB(1, 1), b3 + hsB, voffB);
            PG8_WAIT_V(6); PG8_BAR; PG8_MMA(1, 1, At, B1); PG8_BAR;
        }
        E(acc, cur, wr, wc, fr, fq);
        if (!has_next) break;
#pragma unroll
        for (int a = 0; a < 2; ++a)
#pragma unroll
            for (int b = 0; b < 2; ++b)
#pragma unroll
                for (int m = 0; m < 4; ++m)
#pragma unroll
                    for (int n = 0; n < 2; ++n) acc[a][b][m][n] = (f32x4){0.f, 0.f, 0.f, 0.f};
        cur = nxt; cA = nA; cB = nB; ++ui;
    }
    PG8_WAIT_V(0);
    if (wr == 0) PG8_BAR;
    PG8_BAR;
#undef PG8_SA
#undef PG8_SB
#undef PG8_STAGE
#undef PG8_LDA
#undef PG8_LDB
#undef PG8_MMA
#undef PG8_WAIT_V
#undef PG8_WAIT_L
#undef PG8_BAR
#undef PG8_SCHED
}

struct EpiF32 {
    static constexpr bool PERM = false;
    float* C; int ldc;
    __device__ __forceinline__ void operator()(const f32x4 (&acc)[2][2][4][2], const Unit& u, int wr, int wc, int fr, int fq) const {
        const int row0 = u.pm * BM + wr * 64 + fr, col0 = u.pn * BM + wc * 32 + 4 * fq;
#pragma unroll
        for (int ai = 0; ai < 2; ++ai)
#pragma unroll
            for (int m = 0; m < 4; ++m) { float* rowp = C + (size_t)(row0 + ai * HALF + m * 16) * ldc + col0;
#pragma unroll
                for (int bj = 0; bj < 2; ++bj)
#pragma unroll
                    for (int n = 0; n < 2; ++n) *(f32x4*)(rowp + bj * HALF + n * 16) = acc[ai][bj][m][n]; }
    }
};
struct EpiProj {
    static constexpr bool PERM = true;
    unsigned char* ws;
    __device__ __forceinline__ void operator()(const f32x4 (&acc)[2][2][4][2], const Unit& u, int wr, int wc, int fr, int fq) const {
        bf16_t* base = (bf16_t*)(ws + kP1Off[u.pn]); const int ld = kP1Ld[u.pn], ncol = kP1Nc[u.pn];
        const int row0 = u.pm * BM + wr * 64 + fr, col0 = kP1C0[u.pn] + wc * 32 + 8 * fq;
#pragma unroll
        for (int ai = 0; ai < 2; ++ai)
#pragma unroll
            for (int m = 0; m < 4; ++m) { bf16_t* rowp = base + (size_t)(row0 + ai * HALF + m * 16) * ld + col0;
#pragma unroll
                for (int bj = 0; bj < 2; ++bj) { if (bj * HALF >= ncol) continue;
                    const f32x4 v0 = acc[ai][bj][m][0], v1 = acc[ai][bj][m][1];
                    u32x4 w; w.x = cvt_pk_bf16(v0[0], v0[1]); w.y = cvt_pk_bf16(v0[2], v0[3]); w.z = cvt_pk_bf16(v1[0], v1[1]); w.w = cvt_pk_bf16(v1[2], v1[3]);
                    *(u32x4*)(rowp + bj * HALF) = w; } }
    }
};
struct EpiGate {
    static constexpr bool PERM = true;
    bf16_t* G0;
    __device__ __forceinline__ void operator()(const f32x4 (&acc)[2][2][4][2], const Unit& u, int wr, int wc, int fr, int fq) const {
        bf16_t* base = G0 + (size_t)(u.pn >> 1) * ((size_t)NTOK * 512);
        const int row0 = u.pm * BM + wr * 64 + fr, col0 = (u.pn & 1) * 256 + wc * 32 + 8 * fq;
#pragma unroll
        for (int ai = 0; ai < 2; ++ai)
#pragma unroll
            for (int m = 0; m < 4; ++m) { bf16_t* rowp = base + (size_t)(row0 + ai * HALF + m * 16) * 512 + col0;
#pragma unroll
                for (int bj = 0; bj < 2; ++bj) {
                    f32x4 v0 = acc[ai][bj][m][0], v1 = acc[ai][bj][m][1];
#pragma unroll
                    for (int j = 0; j < 4; ++j) { v0[j] = sigmoidf_(v0[j]); v1[j] = sigmoidf_(v1[j]); }
                    u32x4 w; w.x = cvt_pk_bf16(v0[0], v0[1]); w.y = cvt_pk_bf16(v0[2], v0[3]); w.z = cvt_pk_bf16(v1[0], v1[1]); w.w = cvt_pk_bf16(v1[2], v1[3]);
                    *(u32x4*)(rowp + bj * HALF) = w; } }
    }
};
struct EpiSwiglu {
    static constexpr bool PERM = true;
    bf16_t* O; int ldc;
    __device__ __forceinline__ void operator()(const f32x4 (&acc)[2][2][4][2], const Unit& u, int wr, int wc, int fr, int fq) const {
        const int row0 = u.pm * BM + wr * 64 + fr, col0 = u.pn * HALF + wc * 32 + 8 * fq;
#pragma unroll
        for (int ai = 0; ai < 2; ++ai)
#pragma unroll
            for (int m = 0; m < 4; ++m) { bf16_t* rowp = O + (size_t)(row0 + ai * HALF + m * 16) * ldc + col0;
                float r[8];
#pragma unroll
                for (int n = 0; n < 2; ++n)
#pragma unroll
                    for (int j = 0; j < 4; ++j) { const float gv = acc[ai][0][m][n][j], uv = acc[ai][1][m][n][j]; r[n * 4 + j] = gv * sigmoidf_(gv) * uv; }
                u32x4 w; w.x = cvt_pk_bf16(r[0], r[1]); w.y = cvt_pk_bf16(r[2], r[3]); w.z = cvt_pk_bf16(r[4], r[5]); w.w = cvt_pk_bf16(r[6], r[7]);
                *(u32x4*)rowp = w; }
    }
};
struct EpiBranch {
    static constexpr bool PERM = true;
    bf16_t* Mg; const bf16_t* G0;
    __device__ __forceinline__ void operator()(const f32x4 (&acc)[2][2][4][2], const Unit& u, int wr, int wc, int fr, int fq) const {
        const bf16_t* gb = G0 + (size_t)(u.br * 2 + (u.pn >> 1)) * ((size_t)NTOK * 512);
        const int row0 = u.pm * BM + wr * 64 + fr, cl = wc * 32 + 8 * fq;
#pragma unroll
        for (int ai = 0; ai < 2; ++ai)
#pragma unroll
            for (int m = 0; m < 4; ++m) { const size_t row = (size_t)(row0 + ai * HALF + m * 16);
#pragma unroll
                for (int bj = 0; bj < 2; ++bj) {
                    const u32x4 gw = *(const u32x4*)(gb + row * 512 + (u.pn & 1) * 256 + bj * HALF + cl);
                    bf16_t* mp = Mg + row * 1024 + u.pn * 256 + bj * HALF + cl;
                    float r[8];
#pragma unroll
                    for (int q = 0; q < 4; ++q) { const unsigned g2 = gw[q]; const int n = q >> 1, j = (q & 1) * 2;
                        r[q * 2] = __uint_as_float(g2 << 16) * acc[ai][bj][m][n][j]; r[q * 2 + 1] = __uint_as_float(g2 & 0xffff0000u) * acc[ai][bj][m][n][j + 1]; }
                    if (u.br != 0) { u32x4 ow;
#pragma unroll
                        for (int q = 0; q < 4; ++q) ow[q] = __hip_atomic_load((const unsigned*)mp + q, __ATOMIC_RELAXED, __HIP_MEMORY_SCOPE_AGENT);
#pragma unroll
                        for (int q = 0; q < 4; ++q) { r[q * 2] += __uint_as_float(ow[q] << 16); r[q * 2 + 1] += __uint_as_float(ow[q] & 0xffff0000u); } }
                    u32x4 w; w.x = cvt_pk_bf16(r[0], r[1]); w.y = cvt_pk_bf16(r[2], r[3]); w.z = cvt_pk_bf16(r[4], r[5]); w.w = cvt_pk_bf16(r[6], r[7]);
                    *(u32x4*)mp = w; } }
    }
};
}

template <int MAP> __device__ __forceinline__ int colmap(int n, int off) {
    if (MAP == 0) return n + off;
    if (MAP == 1) { if (n < 3584) return n; const int s = n - 512; return s < C_G ? s : -1; }
    const int pn = n >> 8, r = n & 255; return (r < 128) ? 128 * pn + r : D_FF + 128 * pn + (r - 128);
}
template <int MAP>
__device__ void conv_job(LAS unsigned char* lds, bf16_t* dst, int ld_dst, int koff, const float* src, int ld_src, int K, int n_lo, int n_hi, int off, int bid, int nb) {
    LAS float* tile = (LAS float*)lds;
    const int tid = phase_tid(), nk = K / 64, nn = (n_hi - n_lo) / 64;
    for (int it = bid; it < nk * nn; it += nb) {
        const int n0 = n_lo + (it / nk) * 64, k0 = (it % nk) * 64;
        { const int kk = tid >> 3, c8 = (tid & 7) * 8;
#pragma unroll
          for (int j = 0; j < 8; ++j) { const int col = colmap<MAP>(n0 + c8 + j, off); tile[kk * 65 + c8 + j] = (col >= 0) ? src[(size_t)(k0 + kk) * ld_src + col] : 0.f; } }
        __syncthreads();
        { const int nr = tid >> 3, k8 = (tid & 7) * 8; float v[8];
#pragma unroll
          for (int j = 0; j < 8; ++j) v[j] = tile[(k8 + j) * 65 + nr];
          u32x4 w; w.x = cvt_pk_bf16(v[0], v[1]); w.y = cvt_pk_bf16(v[2], v[3]); w.z = cvt_pk_bf16(v[4], v[5]); w.w = cvt_pk_bf16(v[6], v[7]);
          *(u32x4*)(dst + (size_t)(n0 + nr) * ld_dst + koff + k0 + k8) = w; }
        __syncthreads();
    }
}
__device__ void fold_tile(LAS unsigned char* lds, bf16_t* out, long sOi, long sOj, const float* A, long sAi, long sAd, const float* B, long sBj, long sBd) {
    LAS float* As = (LAS float*)lds; LAS float* Bs = As + 64 * 129;
    const int tid = phase_tid();
    for (int e = tid; e < 64 * 128; e += 512) {
        int i, d; if (sAd == 1) { i = e >> 7; d = e & 127; } else { d = e >> 6; i = e & 63; }
        As[i * 129 + d] = A[i * sAi + d * sAd];
        int j, d2; if (sBd == 1) { j = e >> 7; d2 = e & 127; } else { d2 = e >> 6; j = e & 63; }
        Bs[j * 129 + d2] = B[j * sBj + d2 * sBd];
    }
    __syncthreads();
    const int i = tid & 63, jg = tid >> 6;
    float acc[8];
#pragma unroll
    for (int q = 0; q < 8; ++q) acc[q] = 0.f;
    for (int d = 0; d < 128; ++d) { const float a = As[i * 129 + d];
#pragma unroll
        for (int q = 0; q < 8; ++q) acc[q] += a * Bs[(jg * 8 + q) * 129 + d]; }
#pragma unroll
    for (int q = 0; q < 8; ++q) out[i * sOi + (jg * 8 + q) * sOj] = f2bf(acc[q]);
    __syncthreads();
}

__device__ void phase_conv_in(const Params& p, int l, LAS unsigned char* lds, int bid, int nb) {
    const float* Win = p.in[I_WIN] + (size_t)l * D_MODEL * IN_W;
    conv_job<1>(lds, BF(p, OFF_WIN), 1024, 0, Win, IN_W, 1024, 0, 3584, 0, bid, nb);
    conv_job<1>(lds, BF(p, OFF_WIN), 1024, 0, Win, IN_W, 1024, 4608, NP1, 0, bid, nb);
    const float* wuk = p.in[I_WUK] + (size_t)l * 256 * 512;
    for (int it = bid; it < 256; it += nb) { const int h = it >> 6, rb = (it >> 4) & 3, kb = it & 15;
        fold_tile(lds, BF(p, OFF_WIN) + (size_t)(3584 + h * 256 + rb * 64) * 1024 + kb * 64, 1, 1024,
                  Win + (size_t)(kb * 64) * IN_W + C_DQ + h * 128, IN_W, 1, wuk + ((size_t)(rb * 64) * 4 + h) * 128, 512, 1); }
}
__device__ void phase_conv_post(const Params& p, int l, LAS unsigned char* lds, int bid, int nb) {
    const float* Win = p.in[I_WIN] + (size_t)l * D_MODEL * IN_W;
    conv_job<0>(lds, BF(p, OFF_WG), 1024, 0, Win, IN_W, 1024, 0, 3072, C_G, bid, nb);
    conv_job<0>(lds, BF(p, OFF_WBR), 2048, 0, p.in[I_WA] + (size_t)l * 512 * 1024, 1024, 512, 0, 1024, 0, bid, nb);
    conv_job<0>(lds, BF(p, OFF_WBR), 2048, 512, p.in[I_WB] + (size_t)l * 512 * 1024, 1024, 512, 0, 1024, 0, bid, nb);
    conv_job<0>(lds, BF(p, OFF_WOUT), 1024, 0, p.in[I_WOUT] + (size_t)l * 1024 * 1024, 1024, 1024, 0, 1024, 0, bid, nb);
    conv_job<2>(lds, BF(p, OFF_WF1), 1024, 0, p.in[I_WF1] + (size_t)l * 1024 * 2 * D_FF, 2 * D_FF, 1024, 0, 2 * D_FF, 0, bid, nb);
    conv_job<0>(lds, BF(p, OFF_WF2), D_FF, 0, p.in[I_WF2] + (size_t)l * D_FF * 1024, 1024, D_FF, 0, 1024, 0, bid, nb);
    const float* wuv = p.in[I_WUV] + (size_t)l * 256 * 512; const float* wc = p.in[I_WC] + (size_t)l * 512 * 1024;
    for (int it = bid; it < 256; it += nb) { const int h = it >> 6, rb = (it >> 4) & 3, nbk = it & 15;
        fold_tile(lds, BF(p, OFF_WBR) + (size_t)(nbk * 64) * 2048 + 1024 + h * 256 + rb * 64, 1, 2048,
                  wuv + ((size_t)(rb * 64) * 4 + h) * 128, 512, 1, wc + (size_t)(h * 128) * 1024 + nbk * 64, 1, 1024); }
}

__device__ __forceinline__ float wave_sum(float v) {
#pragma unroll
    for (int o = 32; o >= 1; o >>= 1) v += __shfl_xor(v, o);
    return v;
}
template <int MODE>
__device__ void phase_norm(const float* xin, float* xout, const float* O, const float* wpost, const float* w1, bf16_t* H, int bid, int nb) {
    const int tidn = phase_tid(); const int wv = tidn >> 6, lane = tidn & 63;
    for (int row = bid * 8 + wv; row < NTOK; row += nb * 8) {
        f32x4 xv[4];
#pragma unroll
        for (int j = 0; j < 4; ++j) xv[j] = *(const f32x4*)(xin + (size_t)row * 1024 + j * 256 + lane * 4);
        if (MODE >= 1) {
            f32x4 ov[4]; float ss = 0.f;
#pragma unroll
            for (int j = 0; j < 4; ++j) { ov[j] = *(const f32x4*)(O + (size_t)row * 1024 + j * 256 + lane * 4); ss += ov[j][0] * ov[j][0] + ov[j][1] * ov[j][1] + ov[j][2] * ov[j][2] + ov[j][3] * ov[j][3]; }
            ss = wave_sum(ss); const float r = rsqrtf(ss * (1.f / 1024.f) + 1e-6f);
#pragma unroll
            for (int j = 0; j < 4; ++j) { const f32x4 wv4 = *(const f32x4*)(wpost + j * 256 + lane * 4); xv[j] = xv[j] + ov[j] * r * wv4; *(f32x4*)(xout + (size_t)row * 1024 + j * 256 + lane * 4) = xv[j]; }
        }
        if (MODE <= 1) {
            float ss = 0.f;
#pragma unroll
            for (int j = 0; j < 4; ++j) ss += xv[j][0] * xv[j][0] + xv[j][1] * xv[j][1] + xv[j][2] * xv[j][2] + xv[j][3] * xv[j][3];
            ss = wave_sum(ss); const float r = rsqrtf(ss * (1.f / 1024.f) + 1e-6f);
#pragma unroll
            for (int j = 0; j < 4; ++j) { const f32x4 wv4 = *(const f32x4*)(w1 + j * 256 + lane * 4); const f32x4 y = xv[j] * r * wv4;
                u32x2 w; w.x = cvt_pk_bf16(y[0], y[1]); w.y = cvt_pk_bf16(y[2], y[3]); *(u32x2*)(H + (size_t)row * 1024 + j * 256 + lane * 4) = w; }
        }
    }
}

__device__ void phase_gemm_in(const Params& p, LAS unsigned char* lds, int bid, int nb) {
    pg8::EpiProj E{p.ws};
    pg8::Gemm g{BF(p, OFF_H), BF(p, OFF_WIN), 1024, 1024};
    pg8::StaticOrder S; S.init(NTOK, NP1, 1024, nb, bid);
    pg8::gemm_phase(lds, g, S, E);
}
__device__ void phase_gemm_gates(const Params& p, LAS unsigned char* lds, int bid, int nb) {
    pg8::EpiGate E{BF(p, OFF_HF)};
    pg8::Gemm g{BF(p, OFF_H), BF(p, OFF_WG), 1024, 1024};
    pg8::StaticOrder S; S.init(NTOK, 3072, 1024, nb, bid);
    pg8::gemm_phase(lds, g, S, E);
}
__device__ void phase_gemm_branch(const Params& p, LAS unsigned char* lds, int bid, int nb) {
    pg8::EpiBranch E; E.Mg = BF(p, OFF_H); E.G0 = BF(p, OFF_HF);
    pg8::Gemm g{BF(p, OFF_Y), BF(p, OFF_WBR), 2048, 2048};
    pg8::BranchOrder S; S.init(NTOK, 1024, nb, bid);
    pg8::gemm_phase(lds, g, S, E);
}
__device__ void phase_gemm_out(const Params& p, LAS unsigned char* lds, int bid, int nb) {
    pg8::EpiF32 E{F32P(p, OFF_OUT), 1024};
    pg8::Gemm g{BF(p, OFF_H), BF(p, OFF_WOUT), 1024, 1024};
    pg8::StaticOrder S; S.init(NTOK, 1024, 1024, nb, bid);
    pg8::gemm_phase(lds, g, S, E);
}
__device__ void phase_gemm_ffn1(const Params& p, LAS unsigned char* lds, int bid, int nb) {
    pg8::EpiSwiglu E{BF(p, OFF_ACT), D_FF};
    pg8::Gemm g{BF(p, OFF_H), BF(p, OFF_WF1), 1024, 1024};
    pg8::StaticOrder S; S.init(NTOK, 2 * D_FF, 1024, nb, bid);
    pg8::gemm_phase(lds, g, S, E);
}
__device__ void phase_gemm_ffn2(const Params& p, LAS unsigned char* lds, int bid, int nb) {
    pg8::EpiF32 E{F32P(p, OFF_OUT), 1024};
    pg8::Gemm g{BF(p, OFF_ACT), BF(p, OFF_WF2), D_FF, D_FF};
    pg8::StaticOrder S; S.init(NTOK, 1024, D_FF, nb, bid);
    pg8::gemm_phase(lds, g, S, E);
}


__device__ __forceinline__ float hg_lower_bound(const float* lbl, int l, int idx) {
    const float l0 = lbl[idx], l1 = lbl[512 + idx]; const float m = fmaxf(l0, l1), e0 = __expf(l0 - m), e1 = __expf(l1 - m), p0 = e0 / (e0 + e1), p1 = e1 / (e0 + e1);
    return ((l == 0) ? p0 : (p0 + p1)) - p0;
}
__device__ __forceinline__ void pack16_store(LAS unsigned char* dst, const float (&v)[16]) {
    u32x4 a, b; a.x = cvt_pk_bf16(v[0], v[1]); a.y = cvt_pk_bf16(v[2], v[3]); a.z = cvt_pk_bf16(v[4], v[5]); a.w = cvt_pk_bf16(v[6], v[7]);
    b.x = cvt_pk_bf16(v[8], v[9]); b.y = cvt_pk_bf16(v[10], v[11]); b.z = cvt_pk_bf16(v[12], v[13]); b.w = cvt_pk_bf16(v[14], v[15]);
    *(LAS u32x4*)dst = a; *(LAS u32x4*)(dst + 16) = b;
}
#define HG_FRONT()                                                                                                   \
    const int d = tid & 127, seg = tid >> 7;                                                                         \
    const float lbd = hg_lower_bound(p.in[I_LB], l, h * 128 + d);                                                    \
    float kk[16], cs[16];                                                                                            \
    { float run = 0.f;                                                                                               \
      _Pragma("unroll") for (int jj = 0; jj < 16; ++jj) {                                                            \
          const float fp = bf2f(HF[(size_t)(row0 + seg * 16 + jj) * 512 + h * 128 + d]);                            \
          const float sg = sigmoidf_(fp); const float f = fmaxf(lbd + (1.f - lbd) * sg, 1e-20f);                     \
          kk[jj] = (1.f - lbd) * (1.f - sg); run += __logf(f); cs[jj] = run; }                                       \
      SEG[seg * 128 + d] = run; }

__device__ void phase_hg1(const Params& p, int l, LAS unsigned char* lds, int bid, int nb) {
    const int tid = phase_tid(), lane = tid & 63, w = __builtin_amdgcn_readfirstlane(tid >> 6), fr = lane & 15, g = lane >> 4;
    LAS float* SEG = (LAS float*)lds; LAS unsigned char* KT = lds + 2048; LAS unsigned char* VT = KT + 128 * 144;
    const bf16_t* HF = BF(p, OFF_HF); const bf16_t* HI = BF(p, OFF_HI); bf16_t* ST = BF(p, OFF_ST); float* DEC = F32P(p, OFF_DEC);
    for (int unit = bid; unit < 1024; unit += nb) {
        const int bh = unit >> 6, c = unit & 63, h = bh & 3, row0 = (bh >> 2) * SEQ + c * 64;
        HG_FRONT();
        float vv[16];
#pragma unroll
        for (int jj = 0; jj < 16; ++jj) vv[jj] = bf2f(HI[(size_t)(row0 + seg * 16 + jj) * 512 + h * 128 + d]);
        __syncthreads();
        float off = 0.f, bl = 0.f;
#pragma unroll
        for (int s2 = 0; s2 < 4; ++s2) { const float t = SEG[s2 * 128 + d]; off += (s2 < seg) ? t : 0.f; bl += t; }
        float kb[16];
#pragma unroll
        for (int jj = 0; jj < 16; ++jj) kb[jj] = kk[jj] * __expf(bl - (off + cs[jj]));
        pack16_store(KT + d * 144 + seg * 32, kb);
        pack16_store(VT + d * 144 + seg * 32, vv);
        if (seg == 0) DEC[(size_t)unit * 128 + d] = __expf(bl);
        __syncthreads();
        bf16x8 a[2];
#pragma unroll
        for (int ks = 0; ks < 2; ++ks) a[ks] = *(const LAS bf16x8*)(KT + (16 * w + fr) * 144 + (32 * ks + 8 * g) * 2);
#pragma unroll
        for (int et = 0; et < 8; ++et) {
            f32x4 acc = {0.f, 0.f, 0.f, 0.f};
#pragma unroll
            for (int ks = 0; ks < 2; ++ks) { const bf16x8 b = *(const LAS bf16x8*)(VT + (16 * et + fr) * 144 + (32 * ks + 8 * g) * 2); acc = __builtin_amdgcn_mfma_f32_16x16x32_bf16(a[ks], b, acc, 0, 0, 0); }
            mfma_fence(acc);
            u32x2 o; o.x = cvt_pk_bf16(acc[0], acc[1]); o.y = cvt_pk_bf16(acc[2], acc[3]);
            *(u32x2*)(ST + ((size_t)unit * 128 + 16 * et + fr) * 128 + 16 * w + 4 * g) = o;
        }
        __syncthreads();
    }
}
__device__ void phase_hg2(const Params& p, int bid, int nb) {
    bf16_t* ST = BF(p, OFF_ST); const float* DEC = F32P(p, OFF_DEC);
    for (int gid = bid * 512 + phase_tid(); gid < 16 * 8192; gid += nb * 512) {
        const int bh = gid >> 13, within = gid & 8191, e = within >> 6, d = (within & 63) * 2;
        float s0 = 0.f, s1 = 0.f;
        for (int c0 = 0; c0 < 64; c0 += 8) {
            unsigned u[8]; float d0[8], d1[8];
#pragma unroll
            for (int k = 0; k < 8; ++k) { const size_t un = (size_t)(bh * 64 + c0 + k);
                u[k] = *(const unsigned*)(ST + (un * 128 + e) * 128 + d); d0[k] = DEC[un * 128 + d]; d1[k] = DEC[un * 128 + d + 1]; }
            asm volatile("s_waitcnt vmcnt(0)" ::: "memory");
#pragma unroll
            for (int k = 0; k < 8; ++k) { const size_t un = (size_t)(bh * 64 + c0 + k);
                *(unsigned*)(ST + (un * 128 + e) * 128 + d) = cvt_pk_bf16(s0, s1);
                s0 = d0[k] * s0 + __uint_as_float(u[k] << 16); s1 = d1[k] * s1 + __uint_as_float(u[k] & 0xffff0000u); }
        }
    }
}
__device__ void phase_hg3(const Params& p, int l, LAS unsigned char* lds, int bid, int nb) {
    const int tid = phase_tid(), lane = tid & 63, w = __builtin_amdgcn_readfirstlane(tid >> 6), fr = lane & 15, g = lane >> 4;
    LAS float* SEG = (LAS float*)lds;
    LAS unsigned char* QH = lds + 2048; LAS unsigned char* QT = QH + 64 * 272; LAS float* OL = (LAS float*)(lds + 2048);
    LAS unsigned char* KB = lds + 36864; LAS unsigned char* VT = lds + 54272; LAS unsigned char* SP = lds + 72704; LAS unsigned char* PL = lds + 107520;
    const bf16_t* HF = BF(p, OFF_HF); const bf16_t* HI = BF(p, OFF_HI); const bf16_t* HG = BF(p, OFF_HG); const bf16_t* ST = BF(p, OFF_ST); bf16_t* Y = BF(p, OFF_Y);
    for (int unit = bid; unit < 1024; unit += nb) {
        const int bh = unit >> 6, c = unit & 63, h = bh & 3, row0 = (bh >> 2) * SEQ + c * 64;
        HG_FRONT();
        {
#pragma unroll
            for (int k = 0; k < 4; ++k) { const int ch = tid + 512 * k, e = ch >> 4, dc = ch & 15;
                *(LAS u32x4*)(SP + e * 272 + dc * 16) = *(const u32x4*)(ST + ((size_t)unit * 128 + e) * 128 + dc * 8); }
            float vv[16];
#pragma unroll
            for (int jj = 0; jj < 16; ++jj) vv[jj] = bf2f(HI[(size_t)(row0 + seg * 16 + jj) * 512 + h * 128 + d]);
            pack16_store(VT + d * 144 + seg * 32, vv);
        }
        __syncthreads();
        float beta[4]; { float run = 0.f;
#pragma unroll
            for (int s2 = 0; s2 < 4; ++s2) { beta[s2] = run; run += SEG[s2 * 128 + d]; } }
        float off = 0.f;
#pragma unroll
        for (int s2 = 0; s2 < 4; ++s2) off = (s2 == seg) ? beta[s2] : off;
#pragma unroll
        for (int jj = 0; jj < 16; ++jj) {
            const float q = bf2f(Y[(size_t)(row0 + seg * 16 + jj) * 2048 + h * 128 + d]);
            const int i = seg * 16 + jj;
            *(LAS bf16_t*)(QH + i * 272 + d * 2) = f2bf(q * __expf(off + cs[jj]));
            *(LAS bf16_t*)(QT + i * 272 + d * 2) = f2bf(q * __expf(cs[jj]));
        }
#pragma unroll
        for (int I = 0; I < 4; ++I) {
            if (seg <= I) {
                float bI = 0.f;
#pragma unroll
                for (int s2 = 0; s2 < 4; ++s2) bI = (s2 == I) ? beta[s2] : bI;
#pragma unroll
                for (int jj = 0; jj < 16; ++jj) *(LAS bf16_t*)(KB + (seg * 16 + jj) * 272 + d * 2) = f2bf(kk[jj] * __expf(fminf(bI - (off + cs[jj]), 60.f)));
            }
            __syncthreads();
            if (w < 4) {
                f32x4 acc = {0.f, 0.f, 0.f, 0.f};
                if (w <= I) {
#pragma unroll
                    for (int ks = 0; ks < 4; ++ks) {
                        const bf16x8 a = *(const LAS bf16x8*)(QT + (16 * I + fr) * 272 + (32 * ks + 8 * g) * 2);
                        const bf16x8 b = *(const LAS bf16x8*)(KB + (16 * w + fr) * 272 + (32 * ks + 8 * g) * 2);
                        acc = __builtin_amdgcn_mfma_f32_16x16x32_bf16(a, b, acc, 0, 0, 0); }
                    mfma_fence(acc);
                    const int lim = (w == I) ? (4 * g) : 1000;
#pragma unroll
                    for (int r = 0; r < 4; ++r) acc[r] = (fr <= lim + r) ? acc[r] : 0.f;
                }
#pragma unroll
                for (int r = 0; r < 4; ++r) *(LAS bf16_t*)(PL + (16 * I + 4 * g + r) * 144 + (16 * w + fr) * 2) = f2bf(acc[r]);
            }
            __syncthreads();
        }
        f32x4 oacc[4];
        { const int ib = w >> 1;
          bf16x8 aq[4], ap[2];
#pragma unroll
          for (int ks = 0; ks < 4; ++ks) aq[ks] = *(const LAS bf16x8*)(QH + (16 * ib + fr) * 272 + (32 * ks + 8 * g) * 2);
#pragma unroll
          for (int ks = 0; ks < 2; ++ks) ap[ks] = *(const LAS bf16x8*)(PL + (16 * ib + fr) * 144 + (32 * ks + 8 * g) * 2);
#pragma unroll
          for (int q4 = 0; q4 < 4; ++q4) { const int et = 4 * (w & 1) + q4; f32x4 acc = {0.f, 0.f, 0.f, 0.f};
#pragma unroll
              for (int ks = 0; ks < 4; ++ks) { const bf16x8 b = *(const LAS bf16x8*)(SP + (16 * et + fr) * 272 + (32 * ks + 8 * g) * 2); acc = __builtin_amdgcn_mfma_f32_16x16x32_bf16(aq[ks], b, acc, 0, 0, 0); }
#pragma unroll
              for (int ks = 0; ks < 2; ++ks) { const bf16x8 b = *(const LAS bf16x8*)(VT + (16 * et + fr) * 144 + (32 * ks + 8 * g) * 2); acc = __builtin_amdgcn_mfma_f32_16x16x32_bf16(ap[ks], b, acc, 0, 0, 0); }
              oacc[q4] = acc; } }
        mfma_fence(oacc[0], oacc[1], oacc[2], oacc[3]);
        __syncthreads();
#pragma unroll
        for (int q4 = 0; q4 < 4; ++q4)
#pragma unroll
            for (int r = 0; r < 4; ++r) OL[(16 * (w >> 1) + 4 * g + r) * 132 + 16 * (4 * (w & 1) + q4) + fr] = oacc[q4][r];
        __syncthreads();
        {
            const int i = tid >> 3, es = (tid & 7) * 16;
            float o[16], ss = 0.f;
#pragma unroll
            for (int k = 0; k < 16; ++k) { o[k] = OL[i * 132 + es + k]; ss += o[k] * o[k]; }
            ss += __shfl_xor(ss, 1); ss += __shfl_xor(ss, 2); ss += __shfl_xor(ss, 4);
            const float rstd = rsqrtf(ss * (1.f / 128.f) + 1e-6f);
            const u32x4 g0 = *(const u32x4*)(HG + (size_t)(row0 + i) * 512 + h * 128 + es), g1 = *(const u32x4*)(HG + (size_t)(row0 + i) * 512 + h * 128 + es + 8);
            float y[16];
#pragma unroll
            for (int k = 0; k < 16; ++k) { const unsigned gw = (k < 8) ? g0[k >> 1] : g1[(k - 8) >> 1]; const float gv = (k & 1) ? __uint_as_float(gw & 0xffff0000u) : __uint_as_float(gw << 16);
                y[k] = o[k] * rstd * p.in[I_HGNW][l * 128 + es + k] * (gv * sigmoidf_(gv)); }
            u32x4 a, b; a.x = cvt_pk_bf16(y[0], y[1]); a.y = cvt_pk_bf16(y[2], y[3]); a.z = cvt_pk_bf16(y[4], y[5]); a.w = cvt_pk_bf16(y[6], y[7]);
            b.x = cvt_pk_bf16(y[8], y[9]); b.y = cvt_pk_bf16(y[10], y[11]); b.z = cvt_pk_bf16(y[12], y[13]); b.w = cvt_pk_bf16(y[14], y[15]);
            bf16_t* yo = Y + (size_t)(row0 + i) * 2048 + h * 128 + es;
            *(u32x4*)yo = a; *(u32x4*)(yo + 8) = b;
        }
        __syncthreads();
    }
}


__device__ void phase_prep(const Params& p, int l, LAS unsigned char* lds, int bid, int nb) {
    const int tid = phase_tid(), lane = tid & 63, wv = tid >> 6;
    {
        LAS float* red = (LAS float*)lds; const bf16_t* MK = BF(p, OFF_MK); float* KM = F32P(p, OFF_KMEAN);
        for (int it = bid; it < 256; it += nb) {
            const int bh = it >> 4, n = it & 15, h = bh & 3, d = tid & 127, part = tid >> 7; const size_t row0 = (size_t)(bh >> 2) * SEQ + n * 256 + part * 64;
            float s = 0.f;
            for (int j = 0; j < 64; ++j) s += bf2f(MK[(row0 + j) * 512 + h * 128 + d]);
            red[part * 128 + d] = s; __syncthreads();
            if (part == 0) KM[(size_t)it * 128 + d] = (red[d] + red[128 + d] + red[256 + d] + red[384 + d]) * (1.f / 256.f);
            __syncthreads();
        }
    }
    bf16_t* CKV = BF(p, OFF_CKV); bf16_t* IKW = BF(p, OFF_IKW);
    const float* kvw = p.in[I_KVN] + l * 256; const float* ikw = p.in[I_IKNW] + l * 64; const float* ikb = p.in[I_IKNB] + l * 64;
    for (int row = bid * 8 + wv; row < NTOK; row += nb * 8) {
        {   u32x2* cp = (u32x2*)(CKV + (size_t)row * 256 + lane * 4); const u32x2 v = *cp;
            const float a0 = __uint_as_float(v.x << 16), a1 = __uint_as_float(v.x & 0xffff0000u), a2 = __uint_as_float(v.y << 16), a3 = __uint_as_float(v.y & 0xffff0000u);
            const float ss = wave_sum(a0 * a0 + a1 * a1 + a2 * a2 + a3 * a3); const float r = rsqrtf(ss * (1.f / 256.f) + 1e-6f);
            const f32x4 w4 = *(const f32x4*)(kvw + lane * 4);
            u32x2 o; o.x = cvt_pk_bf16(a0 * r * w4[0], a1 * r * w4[1]); o.y = cvt_pk_bf16(a2 * r * w4[2], a3 * r * w4[3]); *cp = o; }
        {   bf16_t* ip = IKW + (size_t)row * 128; const float u = bf2f(ip[lane]);
            const float mu = wave_sum(u) * (1.f / 64.f); const float xc = u - mu; const float var = wave_sum(xc * xc) * (1.f / 64.f);
            const float y = xc * rsqrtf(var + 1e-6f) * ikw[lane] + ikb[lane];
            const float wgt = (lane < 8) ? bf2f(ip[64 + lane]) * (0.35355339059327373f * 0.125f) : 0.f;
            ip[lane] = f2bf(y); if (lane < 8) ip[64 + lane] = f2bf(wgt); }
    }
}

typedef short v4i16_t __attribute__((ext_vector_type(4)));
__device__ __forceinline__ v4i16_t lds_tr16(const LAS unsigned char* pp) { return __builtin_amdgcn_ds_read_tr16_b64_v4i16((LAS v4i16_t*)pp); }
__device__ void phase_moba(const Params& p, LAS unsigned char* lds, int bid, int nb) {
    const int tid = phase_tid(), lane = tid & 63, w = __builtin_amdgcn_readfirstlane(tid >> 6), fr = lane & 15, g = lane >> 4;
    LAS float* BL = (LAS float*)lds; LAS float* KM = (LAS float*)(lds + 16384); LAS float* GG = (LAS float*)(lds + 24576);
    LAS unsigned* SM = (LAS unsigned*)(lds + 32768); LAS unsigned* UM = SM + 128;
    LAS unsigned char* QS = lds + 33792; LAS unsigned char* KS = lds + 68608; LAS unsigned char* VS = lds + 86016;
    bf16_t* Y = BF(p, OFF_Y); const bf16_t* MK = BF(p, OFF_MK); const bf16_t* MV = BF(p, OFF_MV);
    const float scale = 0.08838834764831845f;
    for (int j = bid; j < 512; j += nb) {
        const int bh = j & 15, qt = (j < 256) ? (j >> 4) : (31 - ((j - 256) >> 4));
        const int h = bh & 3, brow = (bh >> 2) * SEQ, t0 = qt * 128, blk = qt >> 1;
        for (int dd = tid; dd < 4096; dd += 512) BL[dd] = p.in[I_REL][rel_bucket(dd) * 8 + h];
        for (int e = tid; e < 2048; e += 512) KM[e] = F32P(p, OFF_KMEAN)[(size_t)bh * 2048 + e];
#pragma unroll
        for (int k = 0; k < 4; ++k) { const int ch = tid + 512 * k, r = ch >> 4, c = ch & 15;
            *(LAS u32x4*)(QS + r * 272 + c * 16) = *(const u32x4*)(Y + (size_t)(brow + t0 + r) * 2048 + 512 + h * 128 + c * 8); }
        if (tid == 0) *UM = 0u;
        __syncthreads();
        {
            const int q = tid >> 2, ng = tid & 3; float ga[4] = {0.f, 0.f, 0.f, 0.f};
            for (int c = 0; c < 16; ++c) { const u32x4 qv = *(const LAS u32x4*)(QS + q * 272 + c * 16);
#pragma unroll
                for (int e2 = 0; e2 < 8; ++e2) { const unsigned wq = qv[e2 >> 1]; const float qf = (e2 & 1) ? __uint_as_float(wq & 0xffff0000u) : __uint_as_float(wq << 16);
#pragma unroll
                    for (int n4 = 0; n4 < 4; ++n4) ga[n4] += qf * KM[(ng * 4 + n4) * 128 + c * 8 + e2]; } }
#pragma unroll
            for (int n4 = 0; n4 < 4; ++n4) GG[q * 16 + ng * 4 + n4] = ga[n4];
        }
        __syncthreads();
        if (tid < 128) {
            unsigned used = 0u;
            for (int k = 0; k < 3; ++k) { int best = -1; float bv = 0.f;
                for (int n = 0; n < blk; ++n) { const float v = GG[tid * 16 + n]; if (!((used >> n) & 1u) && (best < 0 || v > bv)) { best = n; bv = v; } }
                if (best >= 0) used |= 1u << best; }
            SM[tid] = used; __hip_atomic_fetch_or((unsigned*)UM, used, __ATOMIC_RELAXED, __HIP_MEMORY_SCOPE_WORKGROUP);
        }
        __syncthreads();
        const unsigned umask = *UM; const unsigned mysel = SM[16 * w + fr];
        const int tq = t0 + 16 * w + fr;
        bf16x8 qf[4];
#pragma unroll
        for (int ks = 0; ks < 4; ++ks) qf[ks] = *(const LAS bf16x8*)(QS + (16 * w + fr) * 272 + (32 * ks + 8 * g) * 2);
        f32x4 oacc[8];
#pragma unroll
        for (int dt = 0; dt < 8; ++dt) oacc[dt] = (f32x4){0.f, 0.f, 0.f, 0.f};
        float mrun = -1e30f, lsum = 0.f;
        const int own_tiles = 2 + 2 * (qt & 1);
        for (int bi = 0; bi <= blk; ++bi) {
            const int n = (bi == 0) ? blk : (bi - 1);
            if (bi > 0 && !((umask >> n) & 1u)) continue;
            const bool own = (bi == 0); const int ntile = own ? own_tiles : 4;
            const bool qsel = own || ((mysel >> n) & 1u);
            for (int kt = 0; kt < ntile; ++kt) {
                const int key0 = n * 256 + kt * 64;
                __syncthreads();
#pragma unroll
                for (int k = 0; k < 2; ++k) { const int ch = tid + 512 * k, r = ch >> 4, c = ch & 15; const size_t go = (size_t)(brow + key0 + r) * 512 + h * 128 + c * 8;
                    *(LAS u32x4*)(KS + r * 272 + c * 16) = *(const u32x4*)(MK + go); *(LAS u32x4*)(VS + r * 272 + c * 16) = *(const u32x4*)(MV + go); }
                __syncthreads();
                f32x4 s[4];
#pragma unroll
                for (int k4 = 0; k4 < 4; ++k4) { f32x4 acc = {0.f, 0.f, 0.f, 0.f};
#pragma unroll
                    for (int ks = 0; ks < 4; ++ks) { const bf16x8 a = *(const LAS bf16x8*)(KS + (16 * k4 + fr) * 272 + (32 * ks + 8 * g) * 2); acc = __builtin_amdgcn_mfma_f32_16x16x32_bf16(a, qf[ks], acc, 0, 0, 0); }
                    s[k4] = acc; }
                mfma_fence(s[0], s[1], s[2], s[3]);
                float mx = -1e30f;
#pragma unroll
                for (int k4 = 0; k4 < 4; ++k4)
#pragma unroll
                    for (int r = 0; r < 4; ++r) { const int dist = tq - (key0 + 16 * k4 + 4 * g + r); const bool ok = qsel && (dist >= 0);
                        const float lg = s[k4][r] * scale + BL[dist < 0 ? 0 : dist]; s[k4][r] = ok ? lg : -1e30f; mx = fmaxf(mx, s[k4][r]); }
                mx = fmaxf(mx, __shfl_xor(mx, 16)); mx = fmaxf(mx, __shfl_xor(mx, 32));
                const float mnew = fmaxf(mrun, mx), alpha = __expf(mrun - mnew); mrun = mnew;
                float ps = 0.f;
#pragma unroll
                for (int k4 = 0; k4 < 4; ++k4)
#pragma unroll
                    for (int r = 0; r < 4; ++r) { const float pv = (s[k4][r] > -1e29f) ? __expf(s[k4][r] - mnew) : 0.f; s[k4][r] = pv; ps += pv; }
                lsum = lsum * alpha + ps;
#pragma unroll
                for (int dt = 0; dt < 8; ++dt) oacc[dt] = oacc[dt] * alpha;
                bf16x8 pb[2];
#pragma unroll
                for (int m2 = 0; m2 < 2; ++m2) { u32x4 t; t.x = cvt_pk_bf16(s[2 * m2][0], s[2 * m2][1]); t.y = cvt_pk_bf16(s[2 * m2][2], s[2 * m2][3]);
                    t.z = cvt_pk_bf16(s[2 * m2 + 1][0], s[2 * m2 + 1][1]); t.w = cvt_pk_bf16(s[2 * m2 + 1][2], s[2 * m2 + 1][3]); pb[m2] = __builtin_bit_cast(bf16x8, t); }
#pragma unroll
                for (int dt = 0; dt < 8; ++dt)
#pragma unroll
                    for (int m2 = 0; m2 < 2; ++m2) {
                        const LAS unsigned char* va = VS + (32 * m2 + 4 * g + (fr >> 2)) * 272 + (16 * dt + 4 * (fr & 3)) * 2;
                        const v4i16_t lo = lds_tr16(va), hi = lds_tr16(va + 16 * 272);
                        const bf16x8 a = {lo[0], lo[1], lo[2], lo[3], hi[0], hi[1], hi[2], hi[3]};
                        oacc[dt] = __builtin_amdgcn_mfma_f32_16x16x32_bf16(a, pb[m2], oacc[dt], 0, 0, 0); }
            }
        }
        lsum += __shfl_xor(lsum, 16); lsum += __shfl_xor(lsum, 32);
        const float inv = 1.f / lsum;
        mfma_fence(oacc[0], oacc[1], oacc[2], oacc[3]); mfma_fence(oacc[4], oacc[5], oacc[6], oacc[7]);
        __syncthreads();
#pragma unroll
        for (int dt = 0; dt < 8; ++dt) { u32x2 o; o.x = cvt_pk_bf16(oacc[dt][0] * inv, oacc[dt][1] * inv); o.y = cvt_pk_bf16(oacc[dt][2] * inv, oacc[dt][3] * inv);
            *(u32x2*)(Y + (size_t)(brow + tq) * 2048 + 512 + h * 128 + 16 * dt + 4 * g) = o; }
        __syncthreads();
    }
}


template <int PROBE = 0> __device__ void phase_dsel(const Params& p, LAS unsigned char* lds, int bid, int nb) {
    const int tid = phase_tid(), lane = tid & 63, w = __builtin_amdgcn_readfirstlane(tid >> 6), fr = lane & 15, g = lane >> 4, q8 = fr & 7;
    LAS unsigned char* KEYS = lds;
    LAS unsigned char* IQS = lds + 131072;
    const bf16_t* IQ = BF(p, OFF_IQ); const bf16_t* IKW = BF(p, OFF_IKW);
    unsigned* MASK = PROBE ? (unsigned*)((unsigned char*)p.x + (size_t)(PROBE - 1) * 8 * MiB) : (unsigned*)(p.ws + OFF_MASK);
    for (int u = 0; u < 2048; ++u) {
        int k;
        if (nb == 256) { if (u >= 8) break; k = (u & 1) ? (512 * (u >> 1) + 511 - bid) : (512 * (u >> 1) + bid); }
        else { k = bid + u * nb; if (k >= 2048) break; }
        const int b = k & 3, qt = k >> 2, brow = b * SEQ, t0 = qt * 8, nkt = (t0 + 7) / 16 + 1;
        __syncthreads();
        { const int r = tid >> 6, c = tid & 63;
          *(LAS u32x4*)(IQS + r * 1040 + c * 16) = *(const u32x4*)(IQ + (size_t)(brow + t0 + r) * 512 + c * 8); }
        float iw[8];
        { const u32x4 wv = *(const u32x4*)(IKW + (size_t)(brow + t0 + q8) * 128 + 64);
#pragma unroll
          for (int hh = 0; hh < 8; ++hh) iw[hh] = (hh & 1) ? __uint_as_float(wv[hh >> 1] & 0xffff0000u) : __uint_as_float(wv[hh >> 1] << 16); }
        __syncthreads();
        {
            bf16x8 bq[8][2];
#pragma unroll
            for (int hh = 0; hh < 8; ++hh) { bq[hh][0] = *(const LAS bf16x8*)(IQS + q8 * 1040 + (hh * 64 + 8 * g) * 2); bq[hh][1] = *(const LAS bf16x8*)(IQS + q8 * 1040 + (hh * 64 + 32 + 8 * g) * 2); }
            const int tq = t0 + q8;
            const bf16_t* krp = IKW + (size_t)(brow + 16 * w + fr) * 128 + 8 * g;
            for (int kt = w; kt < nkt; kt += 8, krp += 16384) {
                const bf16x8 a0 = *(const bf16x8*)krp, a1 = *(const bf16x8*)(krp + 32);
                float sc0 = 0.f, sc1 = 0.f, sc2 = 0.f, sc3 = 0.f;
#pragma unroll
                for (int hg4 = 0; hg4 < 2; ++hg4) {
                    f32x4 ah[4];
#pragma unroll
                    for (int h2 = 0; h2 < 4; ++h2) { const int hh = hg4 * 4 + h2; f32x4 acc = {0.f, 0.f, 0.f, 0.f};
                        acc = __builtin_amdgcn_mfma_f32_16x16x32_bf16(a0, bq[hh][0], acc, 0, 0, 0);
                        acc = __builtin_amdgcn_mfma_f32_16x16x32_bf16(a1, bq[hh][1], acc, 0, 0, 0);
                        ah[h2] = acc; }
                    mfma_fence(ah[0], ah[1], ah[2], ah[3]);
#pragma unroll
                    for (int h2 = 0; h2 < 4; ++h2) { const float wgt = iw[hg4 * 4 + h2];
                        sc0 += wgt * fmaxf(ah[h2][0], 0.f); sc1 += wgt * fmaxf(ah[h2][1], 0.f); sc2 += wgt * fmaxf(ah[h2][2], 0.f); sc3 += wgt * fmaxf(ah[h2][3], 0.f); }
                }
                const int sp0 = 16 * kt + 4 * g; u32x4 kv;
                { unsigned uu = __float_as_uint(sc0 + 0.0f); uu = (uu & 0x80000000u) ? ~uu : (uu | 0x80000000u); kv.x = (sp0 + 0 <= tq) ? ((uu & 0xfffff000u) | (unsigned)(4095 - sp0)) : 0u; }
                { unsigned uu = __float_as_uint(sc1 + 0.0f); uu = (uu & 0x80000000u) ? ~uu : (uu | 0x80000000u); kv.y = (sp0 + 1 <= tq) ? ((uu & 0xfffff000u) | (unsigned)(4094 - sp0)) : 0u; }
                { unsigned uu = __float_as_uint(sc2 + 0.0f); uu = (uu & 0x80000000u) ? ~uu : (uu | 0x80000000u); kv.z = (sp0 + 2 <= tq) ? ((uu & 0xfffff000u) | (unsigned)(4093 - sp0)) : 0u; }
                { unsigned uu = __float_as_uint(sc3 + 0.0f); uu = (uu & 0x80000000u) ? ~uu : (uu | 0x80000000u); kv.w = (sp0 + 3 <= tq) ? ((uu & 0xfffff000u) | (unsigned)(4092 - sp0)) : 0u; }
                if (fr < 8) *(LAS u32x4*)(KEYS + fr * 16384 + sp0 * 4) = kv;
            }
        }
        __syncthreads();
        {
            const int t = t0 + w; const int nch = 4 * nkt;
            const int mmax = (nch + 63) >> 6;
            u32x4 kr[16];
#pragma unroll
            for (int m = 0; m < 16; ++m) { const int c = lane + 64 * m; const u32x4 z = {0u, 0u, 0u, 0u};
                kr[m] = (m < mmax && c < nch) ? *(const LAS u32x4*)(KEYS + w * 16384 + c * 16) : z; }
            unsigned thr = 1u;
            if (t + 1 > 256) { thr = 0u;
                for (int it = 0; it < 32; ++it) {
                    const unsigned cand = thr | (0x80000000u >> it);
                    unsigned cn = 0u;
#pragma unroll
                    for (int m = 0; m < 16; ++m) if (m < mmax) { cn += (kr[m].x >= cand) ? 1u : 0u; cn += (kr[m].y >= cand) ? 1u : 0u; cn += (kr[m].z >= cand) ? 1u : 0u; cn += (kr[m].w >= cand) ? 1u : 0u; }
#pragma unroll
                    for (int o = 1; o < 64; o <<= 1) cn += (unsigned)__shfl_xor((int)cn, o);
                    if (cn >= 256u) thr = cand;
                    if (cn == 256u) break;
                } }
            if (PROBE >= 3) thr = 0x80000000u;
            unsigned* mrow = MASK + (size_t)(brow + t) * 128;
#pragma unroll
            for (int m = 0; m < 16; ++m) {
                unsigned nib = 0u;
                if (m < mmax) nib = ((kr[m].x >= thr) ? 1u : 0u) | ((kr[m].y >= thr) ? 2u : 0u) | ((kr[m].z >= thr) ? 4u : 0u) | ((kr[m].w >= thr) ? 8u : 0u);
                unsigned v = nib << (4 * (lane & 7));
                v |= (unsigned)__shfl_xor((int)v, 1); v |= (unsigned)__shfl_xor((int)v, 2); v |= (unsigned)__shfl_xor((int)v, 4);
                if ((lane & 7) == 0) mrow[(lane >> 3) + 8 * m] = v;
            }
        }
    }
}

__device__ void phase_datt(const Params& p, LAS unsigned char* lds, int bid, int nb) {
    const int tid = phase_tid(), lane = tid & 63, w = __builtin_amdgcn_readfirstlane(tid >> 6), fr = lane & 15, g = lane >> 4;
    LAS unsigned char* BK = lds;
    LAS float* RL = (LAS float*)(lds + 4096);
    LAS unsigned short* IDX = (LAS unsigned short*)(lds + 5120 + w * 512);
    LAS float* PW = (LAS float*)(lds + 5120 + 8 * 512 + w * 4096);
    const bf16_t* CKV = BF(p, OFF_CKV); bf16_t* Y = BF(p, OFF_Y); const unsigned* MASK = (const unsigned*)(p.ws + OFF_MASK);
    for (int dd = tid; dd < 4096; dd += 512) BK[dd] = (unsigned char)rel_bucket(dd);
    if (tid < 256) RL[tid] = p.in[I_REL][tid];
    __syncthreads();
    const float scale = 0.08838834764831845f;
    for (int it = bid; it < NTOK / 8; it += nb) {
        const int tg = it * 8 + w, brow = (tg >> 12) * SEQ, t = tg & 4095;
        const u32x2 mw = *(const u32x2*)(MASK + (size_t)tg * 128 + 2 * lane);
        const int cnt = __popc(mw.x) + __popc(mw.y);
        int pre = cnt;
#pragma unroll
        for (int o = 1; o < 64; o <<= 1) { const int v = __shfl_up(pre, o); if (lane >= o) pre += v; }
        const int nsel = __shfl(pre, 63);
        int pos = pre - cnt;
        { unsigned m0 = mw.x; while (m0) { const int bpos = __ffs(m0) - 1; m0 &= m0 - 1; IDX[pos++] = (unsigned short)(64 * lane + bpos); }
          unsigned m1 = mw.y; while (m1) { const int bpos = __ffs(m1) - 1; m1 &= m1 - 1; IDX[pos++] = (unsigned short)(64 * lane + 32 + bpos); } }
        for (int e = nsel + lane; e < 256; e += 64) IDX[e] = 0;
        bf16x8 qb[8];
#pragma unroll
        for (int ks = 0; ks < 8; ++ks) { const u32x4 z = {0u, 0u, 0u, 0u}; const u32x4 v = (fr < 4) ? *(const u32x4*)(Y + (size_t)tg * 2048 + 1024 + fr * 256 + 32 * ks + 8 * g) : z; qb[ks] = __builtin_bit_cast(bf16x8, v); }
        const int hd = fr & 3;
        for (int kt = 0; kt < 16; ++kt) {
            const int srow = IDX[16 * kt + fr];
            const bf16_t* cr = CKV + (size_t)(brow + srow) * 256 + 8 * g;
            bf16x8 ac[8];
#pragma unroll
            for (int ks = 0; ks < 8; ++ks) ac[ks] = *(const bf16x8*)(cr + 32 * ks);
            f32x4 acc = {0.f, 0.f, 0.f, 0.f};
#pragma unroll
            for (int ks = 0; ks < 8; ++ks) acc = __builtin_amdgcn_mfma_f32_16x16x32_bf16(ac[ks], qb[ks], acc, 0, 0, 0);
            mfma_fence(acc);
#pragma unroll
            for (int r = 0; r < 4; ++r) { const int slot = 16 * kt + 4 * g + r; const int sp = IDX[slot]; const int dist = t - sp;
                const float lg = acc[r] * scale + RL[BK[dist < 0 ? 0 : dist] * 8 + 4 + hd];
                if (fr < 4) PW[slot * 4 + fr] = (slot < nsel) ? lg : -1e30f; }
        }
        {
            f32x4 v[4]; f32x4 mx = {-1e30f, -1e30f, -1e30f, -1e30f};
#pragma unroll
            for (int j = 0; j < 4; ++j) { v[j] = *(const LAS f32x4*)(PW + (lane + 64 * j) * 4);
#pragma unroll
                for (int hh = 0; hh < 4; ++hh) mx[hh] = fmaxf(mx[hh], v[j][hh]); }
#pragma unroll
            for (int o = 1; o < 64; o <<= 1)
#pragma unroll
                for (int hh = 0; hh < 4; ++hh) mx[hh] = fmaxf(mx[hh], __shfl_xor(mx[hh], o));
            f32x4 su = {0.f, 0.f, 0.f, 0.f};
#pragma unroll
            for (int j = 0; j < 4; ++j)
#pragma unroll
                for (int hh = 0; hh < 4; ++hh) { const float pv = (v[j][hh] > -1e29f) ? __expf(v[j][hh] - mx[hh]) : 0.f; v[j][hh] = pv; su[hh] += pv; }
#pragma unroll
            for (int o = 1; o < 64; o <<= 1)
#pragma unroll
                for (int hh = 0; hh < 4; ++hh) su[hh] += __shfl_xor(su[hh], o);
#pragma unroll
            for (int j = 0; j < 4; ++j) { f32x4 pn;
#pragma unroll
                for (int hh = 0; hh < 4; ++hh) pn[hh] = v[j][hh] / su[hh];
                *(LAS f32x4*)(PW + (lane + 64 * j) * 4) = pn; }
        }
        float o0[4] = {0.f, 0.f, 0.f, 0.f}, o1[4] = {0.f, 0.f, 0.f, 0.f}, o2[4] = {0.f, 0.f, 0.f, 0.f}, o3[4] = {0.f, 0.f, 0.f, 0.f};
        for (int k0 = 0; k0 < nsel; k0 += 4) {
#pragma unroll
            for (int kk2 = 0; kk2 < 4; ++kk2) { const int kx = k0 + kk2; const int srow = IDX[kx];
                const u32x2 cv = *(const u32x2*)(CKV + (size_t)(brow + srow) * 256 + 4 * lane);
                const f32x4 pv = *(const LAS f32x4*)(PW + kx * 4);
                const float c0 = __uint_as_float(cv.x << 16), c1 = __uint_as_float(cv.x & 0xffff0000u), c2 = __uint_as_float(cv.y << 16), c3 = __uint_as_float(cv.y & 0xffff0000u);
                o0[0] += pv[0] * c0; o0[1] += pv[0] * c1; o0[2] += pv[0] * c2; o0[3] += pv[0] * c3;
                o1[0] += pv[1] * c0; o1[1] += pv[1] * c1; o1[2] += pv[1] * c2; o1[3] += pv[1] * c3;
                o2[0] += pv[2] * c0; o2[1] += pv[2] * c1; o2[2] += pv[2] * c2; o2[3] += pv[2] * c3;
                o3[0] += pv[3] * c0; o3[1] += pv[3] * c1; o3[2] += pv[3] * c2; o3[3] += pv[3] * c3; }
        }
        bf16_t* yo = Y + (size_t)tg * 2048 + 1024 + 4 * lane;
        { u32x2 o; o.x = cvt_pk_bf16(o0[0], o0[1]); o.y = cvt_pk_bf16(o0[2], o0[3]); *(u32x2*)(yo) = o; }
        { u32x2 o; o.x = cvt_pk_bf16(o1[0], o1[1]); o.y = cvt_pk_bf16(o1[2], o1[3]); *(u32x2*)(yo + 256) = o; }
        { u32x2 o; o.x = cvt_pk_bf16(o2[0], o2[1]); o.y = cvt_pk_bf16(o2[2], o2[3]); *(u32x2*)(yo + 512) = o; }
        { u32x2 o; o.x = cvt_pk_bf16(o3[0], o3[1]); o.y = cvt_pk_bf16(o3[2], o3[3]); *(u32x2*)(yo + 768) = o; }
    }
}

__device__ __forceinline__ Params opq(const Params& p) { Params q = p; asm volatile("" : "+s"(q.ws), "+s"(q.x)); return q; }
__device__ __forceinline__ int opqi(int v) { asm volatile("" : "+s"(v)); return v; }
#define GRID_BARRIER() do { XcdBarrier _b; _b.bar = (unsigned*)(opq(p).ws + OFF_CTL); _b.x = xb_xcc_id(); _b.st = (volatile LAS unsigned*)(lds + LDS_PHASE_BYTES); xcd_barrier(_b); } while (0)
#define PP opq(p)
#define BB opqi(bid)
__device__ __forceinline__ void layer_body(const Params& p, LAS unsigned char* lds, const int bid, const int nb, const int l) {
        phase_gemm_in(PP, lds, BB, nb);
        GRID_BARRIER();
        phase_prep(PP, l, lds, BB, nb);
        phase_hg1(PP, l, lds, BB, nb);
        GRID_BARRIER();
        phase_hg2(PP, BB, nb);
        phase_moba(PP, lds, BB, nb);
        phase_dsel(PP, lds, BB, nb);
        GRID_BARRIER();
        phase_hg3(PP, l, lds, BB, nb);
        phase_datt(PP, lds, BB, nb);
        GRID_BARRIER();
        phase_conv_post(PP, l, lds, BB, nb);
        GRID_BARRIER();
        phase_gemm_gates(PP, lds, BB, nb);
        GRID_BARRIER();
        phase_gemm_branch(PP, lds, BB, nb);
        GRID_BARRIER();
        phase_gemm_out(PP, lds, BB, nb);
        GRID_BARRIER();
        { const Params q = PP; phase_norm<1>(l == 0 ? q.in[I_X] : q.x, q.x, F32P(q, OFF_OUT), q.in[I_POSTMIX] + l * 1024, q.in[I_PREFFN] + l * 1024, BF(q, OFF_H), BB, nb); }
        GRID_BARRIER();
        phase_gemm_ffn1(PP, lds, BB, nb);
        GRID_BARRIER();
        phase_gemm_ffn2(PP, lds, BB, nb);
        GRID_BARRIER();
        if (l + 1 < DEPTH) { { const Params q = PP; phase_norm<1>(q.x, q.x, F32P(q, OFF_OUT), q.in[I_POSTFFN] + l * 1024, q.in[I_PREMIX] + (l + 1) * 1024, BF(q, OFF_H), BB, nb); } phase_conv_in(PP, l + 1, lds, BB, nb); GRID_BARRIER(); }
        else { const Params q = PP; phase_norm<2>(q.x, q.x, F32P(q, OFF_OUT), q.in[I_POSTFFN] + l * 1024, nullptr, nullptr, BB, nb); }
}
__global__ __launch_bounds__(512, 2) void mega_fwd(Params p) {
    extern __shared__ __attribute__((aligned(16))) unsigned char shm[];
    LAS unsigned char* lds = (LAS unsigned char*)shm;
    const int bid = blockIdx.x, nb = gridDim.x;
    volatile LAS unsigned* xbw = (volatile LAS unsigned*)(lds + LDS_PHASE_BYTES);
    if (threadIdx.x < 4) xbw[threadIdx.x] = 0u;
    __syncthreads();
    (void)xcd_barrier_post((unsigned*)(p.ws + OFF_CTL), xbw);
    { const Params q = PP; phase_norm<0>(q.in[I_X], nullptr, nullptr, nullptr, q.in[I_PREMIX], BF(q, OFF_H), BB, nb); }
    phase_conv_in(PP, 0, lds, BB, nb);
    GRID_BARRIER();
    for (int l = 0; l < DEPTH; ++l) layer_body(p, lds, bid, nb, l);
}

#define LDS_BYTES (LDS_PHASE_BYTES + 16)
extern "C" void kernel_launch(void* const* d_in, const int* in_sizes, int n_in, void* d_out, int out_size, void* d_ws, size_t ws_size, hipStream_t stream) {
    static int grid = 0;
    if (grid == 0) {
        int dev = 0, cus = 0;
        if (hipGetDevice(&dev) != hipSuccess || hipDeviceGetAttribute(&cus, hipDeviceAttributeMultiprocessorCount, dev) != hipSuccess || cus < 1) { fprintf(stderr, "kernel_launch: no device info\n"); grid = -1; return; }
        if (hipFuncSetAttribute((const void*)mega_fwd, hipFuncAttributeMaxDynamicSharedMemorySize, LDS_BYTES) != hipSuccess) { fprintf(stderr, "kernel_launch: hipFuncSetAttribute failed\n"); grid = -1; return; }
        int per_cu = 0;
        if (hipOccupancyMaxActiveBlocksPerMultiprocessor(&per_cu, (const void*)mega_fwd, 512, LDS_BYTES) != hipSuccess || per_cu < 1) { fprintf(stderr, "kernel_launch: occupancy query says %d blocks per CU\n", per_cu); }
        (void)hipGetLastError();
        grid = cus;
    }
    if (grid < 0) return;
    Params p{};
    for (int i = 0; i < 20; ++i) p.in[i] = (const float*)d_in[i];
    p.x = (float*)d_out; p.ws = (unsigned char*)d_ws;
    if (WS_NEED > ws_size) { fprintf(stderr, "kernel_launch: workspace too small (%zu < %zu)\n", ws_size, (size_t)WS_NEED); return; }
    (void)hipMemsetAsync(p.ws + OFF_CTL, 0, 16384, stream);
    hipLaunchKernelGGL(mega_fwd, dim3(grid), dim3(512), LDS_BYTES, stream, p);
}
```

```cpp
#include <hip/hip_runtime.h>
#include <stdint.h>
#include <stdio.h>

#define D_MODEL 1024
#define BATCH 4
#define SEQ 4096
#define NTOK 16384
#define DEPTH 2
#define IN_W 8008
#define D_FF 2816
#define NEG_BIG (-1e30f)
#define C_HQ 0
#define C_HF 512
#define C_HI 1024
#define C_HG 1536
#define C_MQ 2048
#define C_MK 2560
#define C_MV 3072
#define C_DQ 3584
#define C_DKV 4096
#define C_IQ 4352
#define C_IK 4864
#define C_IW 4928
#define C_G 4936
#define NP1 5632

#define LAS __attribute__((address_space(3)))
typedef unsigned short bf16_t;
typedef short bf16x8 __attribute__((ext_vector_type(8)));
typedef float f32x4 __attribute__((ext_vector_type(4)));
typedef unsigned u32x4 __attribute__((ext_vector_type(4)));
typedef unsigned u32x2 __attribute__((ext_vector_type(2)));

__device__ __forceinline__ float sigmoidf_(float x) { return 1.f / (1.f + __expf(-x)); }
__device__ __forceinline__ float bf2f(bf16_t b) { return __uint_as_float(((unsigned)b) << 16); }
typedef __bf16 bf16x2_t __attribute__((ext_vector_type(2)));
typedef float f32x2_t __attribute__((ext_vector_type(2)));
__device__ __forceinline__ unsigned cvt_pk_bf16(float lo, float hi) { const f32x2_t f = {lo, hi}; const bf16x2_t v = __builtin_convertvector(f, bf16x2_t); return __builtin_bit_cast(unsigned, v); }
__device__ __forceinline__ bf16_t f2bf(float f) { return (bf16_t)(cvt_pk_bf16(f, 0.f) & 0xffffu); }
__device__ __forceinline__ int phase_tid() { int t = threadIdx.x; asm volatile("" : "+v"(t)); return t; }
__device__ __forceinline__ void mfma_fence(f32x4& a) { asm volatile("s_nop 15\n\ts_nop 3" : "+v"(a)); }
__device__ __forceinline__ void mfma_fence(f32x4& a, f32x4& b, f32x4& c, f32x4& d) { asm volatile("s_nop 15\n\ts_nop 3" : "+v"(a), "+v"(b), "+v"(c), "+v"(d)); }
__device__ __forceinline__ int rel_bucket(int dist) {
    int n = dist > 0 ? dist : 0;
    if (n < 16) return n;
    float nf = (float)n;
    int large = 16 + (int)(logf(nf / 16.f) / 4.852030263919617f * 16.f);
    return large < 31 ? large : 31;
}

enum { I_X = 0, I_WIN, I_PREMIX, I_POSTMIX, I_PREFFN, I_POSTFFN, I_LB, I_HGNW, I_KVN, I_WUK, I_WUV, I_IKNW, I_IKNB, I_REL, I_WA, I_WB, I_WC, I_WOUT, I_WF1, I_WF2 };
struct Params { const float* in[20]; float* x; unsigned char* ws; };
constexpr size_t MiB = 1024 * 1024;
#define LDS_PHASE_BYTES (144 * 1024)
#ifndef MK_PROBE
#define MK_PROBE 0
#endif
constexpr size_t OFF_CTL = 0, OFF_Y = 65536, OFF_HF = OFF_Y + 64 * MiB, OFF_HI = OFF_HF + 16 * MiB, OFF_HG = OFF_HI + 16 * MiB, OFF_MK = OFF_HG + 16 * MiB,
                 OFF_MV = OFF_MK + 16 * MiB, OFF_IQ = OFF_MV + 16 * MiB, OFF_CKV = OFF_IQ + 16 * MiB, OFF_IKW = OFF_CKV + 8 * MiB, OFF_H = OFF_IKW + 4 * MiB,
                 OFF_WIN = OFF_H + 32 * MiB, OFF_RS = OFF_WIN + 11 * MiB;
constexpr size_t OFF_WG = OFF_RS, OFF_WBR = OFF_WG + 6 * MiB, OFF_WOUT = OFF_WBR + 4 * MiB, OFF_WF1 = OFF_WOUT + 2 * MiB, OFF_WF2 = OFF_WF1 + 11 * MiB, OFF_WEND = OFF_WF2 + 6 * MiB;
constexpr size_t OFF_ST = OFF_RS, OFF_TMPF = OFF_RS, OFF_DEC = OFF_ST + 32 * MiB, OFF_MASK = OFF_DEC + MiB / 2, OFF_KMEAN = OFF_MASK + 8 * MiB, OFF_MEND = OFF_KMEAN + MiB / 8;
constexpr size_t OFF_OUT = OFF_HG, OFF_ACT = OFF_Y;
constexpr size_t WS_NEED = (OFF_WEND > OFF_MEND ? OFF_WEND : OFF_MEND);
#define BF(p, off) ((bf16_t*)((p).ws + (off)))
#define F32P(p, off) ((float*)((p).ws + (off)))
__device__ const unsigned long long kP1Off[22] = {OFF_Y, OFF_Y, OFF_HF, OFF_HF, OFF_HI, OFF_HI, OFF_HG, OFF_HG, OFF_Y, OFF_Y, OFF_MK, OFF_MK, OFF_MV, OFF_MV, OFF_Y, OFF_Y, OFF_Y, OFF_Y, OFF_CKV, OFF_IQ, OFF_IQ, OFF_IKW};
__device__ const int kP1Ld[22]  = {2048, 2048, 512, 512, 512, 512, 512, 512, 2048, 2048, 512, 512, 512, 512, 2048, 2048, 2048, 2048, 256, 512, 512, 128};
__device__ const int kP1C0[22]  = {0, 256, 0, 256, 0, 256, 0, 256, 512, 768, 0, 256, 0, 256, 1024, 1280, 1536, 1792, 0, 0, 256, 0};
__device__ const int kP1Nc[22]  = {256, 256, 256, 256, 256, 256, 256, 256, 256, 256, 256, 256, 256, 256, 256, 256, 256, 256, 256, 256, 256, 128};

#define XB_TMO      128
#define XB_XCNT(j)  (256  + 64 * (j))
#define XB_XSUB(j)  (1280 + 64 * (j))
#define XB_XGEN(j)  (2304 + 64 * (j))
#define XB_TOP      3328
#define XB_TOPGEN   3392
#define XCD_BAR_WORDS 3456
#define XB_SPIN_CAP (1u << 18)

__device__ __forceinline__ unsigned xb_ld(unsigned* p)              { return __hip_atomic_load(p, __ATOMIC_RELAXED, __HIP_MEMORY_SCOPE_AGENT); }
__device__ __forceinline__ unsigned xb_add(unsigned* p, unsigned v) { return __hip_atomic_fetch_add(p, v, __ATOMIC_RELAXED, __HIP_MEMORY_SCOPE_AGENT); }
__device__ __forceinline__ unsigned xb_xcc_id() { return (unsigned)__builtin_amdgcn_s_getreg((3 << 11) | 20) & 0xFu; }
#define XB_SPIN(cond, bar) do { unsigned _sp = 0; while (cond) { __builtin_amdgcn_s_sleep(1); \
    if ((++_sp & 255u) == 0u) { if (xb_ld(&(bar)[XB_TMO])) break; if (_sp > XB_SPIN_CAP) { atomicAdd(&(bar)[XB_TMO], 1u); break; } } } } while (0)

struct XcdBarrier {
    unsigned* bar; unsigned x;
    volatile LAS unsigned* st;
};

__device__ __forceinline__ XcdBarrier xcd_barrier_post(unsigned* bar, volatile LAS unsigned* st) {
    XcdBarrier b; b.bar = bar; b.x = xb_xcc_id(); b.st = st;
    if (threadIdx.x == 0) (void)xb_add(&bar[XB_XCNT(b.x)], 1u);
    return b;
}
__device__ __forceinline__ void xcd_barrier_complete(unsigned* bar, unsigned x, unsigned& nloc, unsigned& nx) {
    const unsigned G = gridDim.x * gridDim.y * gridDim.z;
    unsigned sum, cnt, mine, sp = 0u;
    for (;;) {
        sum = 0u; cnt = 0u; mine = 0u;
#pragma unroll
        for (unsigned j = 0; j < 16; ++j) { const unsigned c = xb_ld(&bar[XB_XCNT(j)]); sum += c; cnt += (c > 0u) ? 1u : 0u; mine = (j == x) ? c : mine; }
        if (sum == G) break;
        __builtin_amdgcn_s_sleep(1);
        if ((++sp & 255u) == 0u) { if (xb_ld(&bar[XB_TMO])) break; if (sp > XB_SPIN_CAP) { atomicAdd(&bar[XB_TMO], 1u); break; } }
    }
    nloc = mine > 0u ? mine : 1u; nx = cnt > 0u ? cnt : 1u;
}

__device__ __forceinline__ void xcd_barrier(const XcdBarrier& b) {
    asm volatile("s_waitcnt vmcnt(0)" ::: "memory");
    __syncthreads();
    if (threadIdx.x == 0) {
        unsigned* bar = b.bar;
        __builtin_amdgcn_s_waitcnt(0);
        unsigned nloc = b.st[0], nx = b.st[1];
        if (nloc == 0u) { xcd_barrier_complete(bar, b.x, nloc, nx); b.st[0] = nloc; b.st[1] = nx; }
        const unsigned old = xb_add(&bar[XB_XSUB(b.x)], 1u);
        const unsigned gen = old / nloc;
        if (old + 1u == (gen + 1u) * nloc) {
            __builtin_amdgcn_fence(__ATOMIC_RELEASE, "agent");
            asm volatile("s_waitcnt vmcnt(0)" ::: "memory");
            const unsigned og = xb_add(&bar[XB_TOP], 1u);
            const unsigned tg = og / nx;
            if (og + 1u == (tg + 1u) * nx) xb_add(&bar[XB_TOPGEN], 1u);
            else XB_SPIN(xb_ld(&bar[XB_TOPGEN]) == tg, bar);
            __builtin_amdgcn_fence(__ATOMIC_ACQUIRE, "agent");
            xb_add(&bar[XB_XGEN(b.x)], 1u);
            asm volatile("s_waitcnt vmcnt(0)" ::: "memory");
        } else {
            XB_SPIN(xb_ld(&bar[XB_XGEN(b.x)]) == gen, bar);
            __builtin_amdgcn_fence(__ATOMIC_ACQUIRE, "agent");
            asm volatile("s_waitcnt vmcnt(0)" ::: "memory");
        }
    }
    __syncthreads();
}


namespace pg8 {
constexpr int BM = 256, BK = 64, HALF = 128, HTB = HALF * BK * 2, STAGE_BYTES = 8 * HTB, NXCD = 8, WGM = 8;
__host__ __device__ __forceinline__ int lds_byte(int r, int c) { const int st = (r >> 4) * 2 + (c >> 5), rr = r & 15, cc = c & 31, ob = rr * 64 + cc * 2; return st * 1024 + (ob ^ (((ob >> 9) & 1) << 5)); }
__host__ __device__ __forceinline__ void stage_rc(int b, int& R, int& C) { const int st = b / 1024, sb = b % 1024, swz = sb ^ (((sb >> 9) & 1) << 5); R = (st >> 1) * 16 + swz / 64; C = (st & 1) * 32 + (swz % 64) / 2; }
__host__ __device__ __forceinline__ int perm32(int rho) { const int n = rho >> 4, i = rho & 15; return 8 * (i >> 2) + 4 * n + (i & 3); }

struct Unit { int pm, pn, ka, nt, br; };
struct Gemm { const bf16_t* A; const bf16_t* Bt; int lda, ldb; };

__device__ __forceinline__ bool tile_of(long L, int nM, int nN, int& pm, int& pn) {
    const int nwg = nM * nN; if (L >= nwg) return false;
    int wgid = (int)L; { const int q = nwg / NXCD, r = nwg % NXCD, xcd = wgid % NXCD, off = wgid / NXCD; wgid = (xcd < r ? xcd * (q + 1) : r * (q + 1) + (xcd - r) * q) + off; }
    const int nig = WGM * nN, gid = wgid / nig, fm = gid * WGM, gsz = (nM - fm) < WGM ? (nM - fm) : WGM;
    pm = fm + ((wgid % nig) % gsz); pn = (wgid % nig) / gsz; return true;
}
struct StaticOrder {
    int nM, nN, G, c, nt;
    __device__ void init(int M, int N, int K, int G_, int c_) { nM = M / BM; nN = N / BM; G = G_; c = c_; nt = K / BK; }
    __device__ bool next(int i, Unit& u) const { u.ka = 0; u.nt = nt; u.br = 0; return tile_of((long)i * G + c, nM, nN, u.pm, u.pn); }
};
struct BranchOrder {
    int nM, nN, G, c;
    __device__ void init(int M, int N, int G_, int c_) { nM = M / BM; nN = N / BM; G = G_; c = c_; }
    __device__ bool next(int i, Unit& u) const { const int ti = i / 3, br = i - ti * 3; u.br = br; u.ka = br * 512; u.nt = (br == 2) ? 16 : 8; return tile_of((long)ti * G + c, nM, nN, u.pm, u.pn); }
};

template <class Epi, class Sched>
__device__ __forceinline__ void gemm_phase(LAS unsigned char* lds, const Gemm g, const Sched& S, const Epi& E) {
    const int tid = phase_tid(), wid = __builtin_amdgcn_readfirstlane(tid >> 6), lane = tid & 63, wr = wid >> 2, wc = wid & 3, fr = lane & 15, fq = lane >> 4;
    unsigned voffA[2], voffB[2];
#pragma unroll
    for (int i = 0; i < 2; ++i) { int R, C; stage_rc(tid * 16 + i * 8192, R, C); const int Rb = Epi::PERM ? ((R & ~31) + perm32(R & 31)) : R;
        voffA[i] = (unsigned)(R * g.lda + C) * 2u; voffB[i] = (unsigned)(Rb * g.ldb + C) * 2u; }
    const size_t kstep = (size_t)(BK * 2);
    const size_t hsA = (size_t)HALF * g.lda * 2, hsB = (size_t)HALF * g.ldb * 2;
    const size_t tsA = 2 * hsA, tsB = 2 * hsB;
    const unsigned ldsw = (unsigned)wid * 1024u;
    const int aoff = lds_byte(wr * 64 + fr, fq * 8), boff = lds_byte(wc * 32 + fr, fq * 8);
#define PG8_SA(b, h) (((b) * 2 + (h)) * HTB)
#define PG8_SB(b, h) ((4 + (b) * 2 + (h)) * HTB)
#define PG8_STAGE(bufoff, gbase, voff) do { _Pragma("unroll") for (int _i = 0; _i < 2; ++_i) \
        __builtin_amdgcn_global_load_lds((const unsigned*)((const char*)(gbase) + (voff)[_i]), (LAS unsigned*)(lds + (bufoff) + ldsw + _i * 8192), 16, 0, 0); } while (0)
#define PG8_LDA(dst, b, h) do { _Pragma("unroll") for (int m = 0; m < 4; ++m) _Pragma("unroll") for (int k = 0; k < 2; ++k) dst[m][k] = *(const LAS bf16x8*)(lds + PG8_SA(b, h) + aoff + m * 2048 + k * 1024); } while (0)
#define PG8_LDB(dst, b, h) do { _Pragma("unroll") for (int n = 0; n < 2; ++n) _Pragma("unroll") for (int k = 0; k < 2; ++k) dst[n][k] = *(const LAS bf16x8*)(lds + PG8_SB(b, h) + boff + n * 2048 + k * 1024); } while (0)
#define PG8_MMA(ai, bj, At, Bt) do { __builtin_amdgcn_s_setprio(1); _Pragma("unroll") for (int m = 0; m < 4; ++m) _Pragma("unroll") for (int n = 0; n < 2; ++n) _Pragma("unroll") for (int k = 0; k < 2; ++k) \
        acc[ai][bj][m][n] = __builtin_amdgcn_mfma_f32_16x16x32_bf16(Bt[n][k], At[m][k], acc[ai][bj][m][n], 0, 0, 0); __builtin_amdgcn_s_setprio(0); } while (0)
#define PG8_WAIT_V(n) asm volatile("s_waitcnt vmcnt(" #n ")" ::: "memory")
#define PG8_WAIT_L(n) asm volatile("s_waitcnt lgkmcnt(" #n ")" ::: "memory")
#define PG8_BAR __builtin_amdgcn_s_barrier()
#define PG8_SCHED __builtin_amdgcn_sched_barrier(0)
    Unit cur, nxt; int ui = 0;
    if (!S.next(0, cur)) return;
    f32x4 acc[2][2][4][2];
#pragma unroll
    for (int a = 0; a < 2; ++a)
#pragma unroll
        for (int b = 0; b < 2; ++b)
#pragma unroll
            for (int m = 0; m < 4; ++m)
#pragma unroll
                for (int n = 0; n < 2; ++n) acc[a][b][m][n] = (f32x4){0.f, 0.f, 0.f, 0.f};
    bf16x8 At[4][2], B0[2][2], B1[2][2];
    const char* cA = (const char*)g.A + (size_t)cur.pm * tsA + (size_t)cur.ka * 2; const char* cB = (const char*)g.Bt + (size_t)cur.pn * tsB + (size_t)cur.ka * 2;
    PG8_STAGE(PG8_SB(0, 0), cB, voffB); PG8_STAGE(PG8_SA(0, 0), cA, voffA); PG8_STAGE(PG8_SB(0, 1), cB + hsB, voffB); PG8_STAGE(PG8_SA(0, 1), cA + hsA, voffA);
    if (wr == 1) PG8_BAR;
    PG8_WAIT_V(4); PG8_BAR;
    PG8_STAGE(PG8_SB(1, 0), cB + kstep, voffB); PG8_STAGE(PG8_SA(1, 0), cA + kstep, voffA); PG8_STAGE(PG8_SB(1, 1), cB + hsB + kstep, voffB);
    PG8_WAIT_V(6); PG8_BAR;
    for (;;) {
        const bool has_next = S.next(ui + 1, nxt);
        const char* nA = has_next ? (const char*)g.A + (size_t)nxt.pm * tsA + (size_t)nxt.ka * 2 : cA; const char* nB = has_next ? (const char*)g.Bt + (size_t)nxt.pn * tsB + (size_t)nxt.ka * 2 : cB;
        const int nt = cur.nt;
        for (int t = 0; t < nt; t += 2) {
            const bool last = (t == nt - 2);
            const char* a1 = cA + (size_t)(t + 1) * kstep;
            const char* a2 = last ? nA : cA + (size_t)(t + 2) * kstep; const char* b2 = last ? nB : cB + (size_t)(t + 2) * kstep;
            const char* a3 = a2 + kstep; const char* b3 = b2 + kstep;
            PG8_LDB(B0, 0, 0); PG8_SCHED; PG8_LDA(At, 0, 0); PG8_STAGE(PG8_SA(1, 1), a1 + hsA, voffA);
            PG8_WAIT_L(8); PG8_BAR; PG8_WAIT_L(0); PG8_MMA(0, 0, At, B0); PG8_BAR; PG8_SCHED;
            PG8_LDB(B1, 0, 1); PG8_STAGE(PG8_SB(0, 0), b2, voffB);
            PG8_BAR; PG8_WAIT_L(0); PG8_MMA(0, 1, At, B1); PG8_BAR;
            PG8_LDA(At, 0, 1); PG8_STAGE(PG8_SA(0, 0), a2, voffA);
            PG8_BAR; PG8_WAIT_L(0); PG8_MMA(1, 0, At, B0); PG8_BAR; PG8_SCHED;
            PG8_STAGE(PG8_SB(0, 1), b2 + hsB, voffB);
            PG8_WAIT_V(6); PG8_BAR; PG8_MMA(1, 1, At, B1); PG8_BAR;
            PG8_LDB(B0, 1, 0); PG8_SCHED; PG8_LDA(At, 1, 0); PG8_STAGE(PG8_SA(0, 1), a2 + hsA, voffA);
            PG8_WAIT_L(8); PG8_BAR; PG8_WAIT_L(0); PG8_MMA(0, 0, At, B0); PG8_BAR; PG8_SCHED;
            PG8_LDB(B1, 1, 1); PG8_STAGE(PG8_SB(1, 0), b3, voffB);
            PG8_BAR; PG8_WAIT_L(0); PG8_MMA(0, 1, At, B1); PG8_BAR;
            PG8_LDA(At, 1, 1); PG8_STAGE(PG8_SA(1, 0), a3, voffA);
            PG8_BAR; PG8_WAIT_L(0); PG8_MMA(1, 0, At, B0); PG8_BAR; PG8_SCHED;
            PG8_STAGE(PG8_SB(1, 1), b3 + hsB, voffB);
            PG8_WAIT_V(6); PG8_BAR; PG8_MMA(1, 1, At, B1); PG8_BAR;
        }
        E(acc, cur, wr, wc, fr, fq);
        if (!has_next) break;
#pragma unroll
        for (int a = 0; a < 2; ++a)
#pragma unroll
            for (int b = 0; b < 2; ++b)
#pragma unroll
                for (int m = 0; m < 4; ++m)
#pragma unroll
                    for (int n = 0; n < 2; ++n) acc[a][b][m][n] = (f32x4){0.f, 0.f, 0.f, 0.f};
        cur = nxt; cA = nA; cB = nB; ++ui;
    }
    PG8_WAIT_V(0);
    if (wr == 0) PG8_BAR;
    PG8_BAR;
#undef PG8_SA
#undef PG8_SB
#undef PG8_STAGE
#undef PG8_LDA
#undef PG8_LDB
#undef PG8_MMA
#undef PG8_WAIT_V
#undef PG8_WAIT_L
#undef PG8_BAR
#undef PG8_SCHED
}

struct EpiF32 {
    static constexpr bool PERM = false;
    float* C; int ldc;
    __device__ __forceinline__ void operator()(const f32x4 (&acc)[2][2][4][2], const Unit& u, int wr, int wc, int fr, int fq) const {
        const int row0 = u.pm * BM + wr * 64 + fr, col0 = u.pn * BM + wc * 32 + 4 * fq;
#pragma unroll
        for (int ai = 0; ai < 2; ++ai)
#pragma unroll
            for (int m = 0; m < 4; ++m) { float* rowp = C + (size_t)(row0 + ai * HALF + m * 16) * ldc + col0;
#pragma unroll
                for (int bj = 0; bj < 2; ++bj)
#pragma unroll
                    for (int n = 0; n < 2; ++n) *(f32x4*)(rowp + bj * HALF + n * 16) = acc[ai][bj][m][n]; }
    }
};
struct EpiProj {
    static constexpr bool PERM = true;
    unsigned char* ws;
    __device__ __forceinline__ void operator()(const f32x4 (&acc)[2][2][4][2], const Unit& u, int wr, int wc, int fr, int fq) const {
        bf16_t* base = (bf16_t*)(ws + kP1Off[u.pn]); const int ld = kP1Ld[u.pn], ncol = kP1Nc[u.pn];
        const int row0 = u.pm * BM + wr * 64 + fr, col0 = kP1C0[u.pn] + wc * 32 + 8 * fq;
#pragma unroll
        for (int ai = 0; ai < 2; ++ai)
#pragma unroll
            for (int m = 0; m < 4; ++m) { bf16_t* rowp = base + (size_t)(row0 + ai * HALF + m * 16) * ld + col0;
#pragma unroll
                for (int bj = 0; bj < 2; ++bj) { if (bj * HALF >= ncol) continue;
                    const f32x4 v0 = acc[ai][bj][m][0], v1 = acc[ai][bj][m][1];
                    u32x4 w; w.x = cvt_pk_bf16(v0[0], v0[1]); w.y = cvt_pk_bf16(v0[2], v0[3]); w.z = cvt_pk_bf16(v1[0], v1[1]); w.w = cvt_pk_bf16(v1[2], v1[3]);
                    *(u32x4*)(rowp + bj * HALF) = w; } }
    }
};
struct EpiGate {
    static constexpr bool PERM = true;
    bf16_t* G0;
    __device__ __forceinline__ void operator()(const f32x4 (&acc)[2][2][4][2], const Unit& u, int wr, int wc, int fr, int fq) const {
        bf16_t* base = G0 + (size_t)(u.pn >> 1) * ((size_t)NTOK * 512);
        const int row0 = u.pm * BM + wr * 64 + fr, col0 = (u.pn & 1) * 256 + wc * 32 + 8 * fq;
#pragma unroll
        for (int ai = 0; ai < 2; ++ai)
#pragma unroll
            for (int m = 0; m < 4; ++m) { bf16_t* rowp = base + (size_t)(row0 + ai * HALF + m * 16) * 512 + col0;
#pragma unroll
                for (int bj = 0; bj < 2; ++bj) {
                    f32x4 v0 = acc[ai][bj][m][0], v1 = acc[ai][bj][m][1];
#pragma unroll
                    for (int j = 0; j < 4; ++j) { v0[j] = sigmoidf_(v0[j]); v1[j] = sigmoidf_(v1[j]); }
                    u32x4 w; w.x = cvt_pk_bf16(v0[0], v0[1]); w.y = cvt_pk_bf16(v0[2], v0[3]); w.z = cvt_pk_bf16(v1[0], v1[1]); w.w = cvt_pk_bf16(v1[2], v1[3]);
                    *(u32x4*)(rowp + bj * HALF) = w; } }
    }
};
struct EpiSwiglu {
    static constexpr bool PERM = true;
    bf16_t* O; int ldc;
    __device__ __forceinline__ void operator()(const f32x4 (&acc)[2][2][4][2], const Unit& u, int wr, int wc, int fr, int fq) const {
        const int row0 = u.pm * BM + wr * 64 + fr, col0 = u.pn * HALF + wc * 32 + 8 * fq;
#pragma unroll
        for (int ai = 0; ai < 2; ++ai)
#pragma unroll
            for (int m = 0; m < 4; ++m) { bf16_t* rowp = O + (size_t)(row0 + ai * HALF + m * 16) * ldc + col0;
                float r[8];
#pragma unroll
                for (int n = 0; n < 2; ++n)
#pragma unroll
                    for (int j = 0; j < 4; ++j) { const float gv = acc[ai][0][m][n][j], uv = acc[ai][1][m][n][j]; r[n * 4 + j] = gv * sigmoidf_(gv) * uv; }
                u32x4 w; w.x = cvt_pk_bf16(r[0], r[1]); w.y = cvt_pk_bf16(r[2], r[3]); w.z = cvt_pk_bf16(r[4], r[5]); w.w = cvt_pk_bf16(r[6], r[7]);
                *(u32x4*)rowp = w; }
    }
};
struct EpiBranch {
    static constexpr bool PERM = true;
    bf16_t* Mg; const bf16_t* G0;
    __device__ __forceinline__ void operator()(const f32x4 (&acc)[2][2][4][2], const Unit& u, int wr, int wc, int fr, int fq) const {
        const bf16_t* gb = G0 + (size_t)(u.br * 2 + (u.pn >> 1)) * ((size_t)NTOK * 512);
        const int row0 = u.pm * BM + wr * 64 + fr, cl = wc * 32 + 8 * fq;
#pragma unroll
        for (int ai = 0; ai < 2; ++ai)
#pragma unroll
            for (int m = 0; m < 4; ++m) { const size_t row = (size_t)(row0 + ai * HALF + m * 16);
#pragma unroll
                for (int bj = 0; bj < 2; ++bj) {
                    const u32x4 gw = *(const u32x4*)(gb + row * 512 + (u.pn & 1) * 256 + bj * HALF + cl);
                    bf16_t* mp = Mg + row * 1024 + u.pn * 256 + bj * HALF + cl;
                    float r[8];
#pragma unroll
                    for (int q = 0; q < 4; ++q) { const unsigned g2 = gw[q]; const int n = q >> 1, j = (q & 1) * 2;
                        r[q * 2] = __uint_as_float(g2 << 16) * acc[ai][bj][m][n][j]; r[q * 2 + 1] = __uint_as_float(g2 & 0xffff0000u) * acc[ai][bj][m][n][j + 1]; }
                    if (u.br != 0) { u32x4 ow;
#pragma unroll
                        for (int q = 0; q < 4; ++q) ow[q] = __hip_atomic_load((const unsigned*)mp + q, __ATOMIC_RELAXED, __HIP_MEMORY_SCOPE_AGENT);
#pragma unroll
                        for (int q = 0; q < 4; ++q) { r[q * 2] += __uint_as_float(ow[q] << 16); r[q * 2 + 1] += __uint_as_float(ow[q] & 0xffff0000u); } }
                    u32x4 w; w.x = cvt_pk_bf16(r[0], r[1]); w.y = cvt_pk_bf16(r[2], r[3]); w.z = cvt_pk_bf16(r[4], r[5]); w.w = cvt_pk_bf16(r[6], r[7]);
                    *(u32x4*)mp = w; } }
    }
};
}

template <int MAP> __device__ __forceinline__ int colmap(int n, int off) {
    if (MAP == 0) return n + off;
    if (MAP == 1) { if (n < 3584) return n; const int s = n - 512; return s < C_G ? s : -1; }
    const int pn = n >> 8, r = n & 255; return (r < 128) ? 128 * pn + r : D_FF + 128 * pn + (r - 128);
}
template <int MAP>
__device__ void conv_job(LAS unsigned char* lds, bf16_t* dst, int ld_dst, int koff, const float* src, int ld_src, int K, int n_lo, int n_hi, int off, int bid, int nb) {
    LAS float* tile = (LAS float*)lds;
    const int tid = phase_tid(), nk = K / 64, nn = (n_hi - n_lo) / 64;
    for (int it = bid; it < nk * nn; it += nb) {
        const int n0 = n_lo + (it / nk) * 64, k0 = (it % nk) * 64;
        { const int kk = tid >> 3, c8 = (tid & 7) * 8;
          const int cfirst = colmap<MAP>(n0 + c8, off), clast = colmap<MAP>(n0 + c8 + 7, off);
          if (cfirst >= 0 && clast == cfirst + 7 && ((cfirst | ld_src) & 3) == 0) {
              const f32x4 v0 = *(const f32x4*)(src + (size_t)(k0 + kk) * ld_src + cfirst), v1 = *(const f32x4*)(src + (size_t)(k0 + kk) * ld_src + cfirst + 4);
#pragma unroll
              for (int j = 0; j < 4; ++j) { tile[kk * 65 + c8 + j] = v0[j]; tile[kk * 65 + c8 + 4 + j] = v1[j]; }
          } else {
#pragma unroll
              for (int j = 0; j < 8; ++j) { const int col = colmap<MAP>(n0 + c8 + j, off); tile[kk * 65 + c8 + j] = (col >= 0) ? src[(size_t)(k0 + kk) * ld_src + col] : 0.f; } } }
        __syncthreads();
        { const int nr = tid >> 3, k8 = (tid & 7) * 8; float v[8];
#pragma unroll
          for (int j = 0; j < 8; ++j) v[j] = tile[(k8 + j) * 65 + nr];
          u32x4 w; w.x = cvt_pk_bf16(v[0], v[1]); w.y = cvt_pk_bf16(v[2], v[3]); w.z = cvt_pk_bf16(v[4], v[5]); w.w = cvt_pk_bf16(v[6], v[7]);
          *(u32x4*)(dst + (size_t)(n0 + nr) * ld_dst + koff + k0 + k8) = w; }
        __syncthreads();
    }
}
__device__ void fold_tile(LAS unsigned char* lds, bf16_t* out, long sOi, long sOj, const float* A, long sAi, long sAd, const float* B, long sBj, long sBd) {
    LAS float* As = (LAS float*)lds; LAS float* Bs = As + 64 * 129;
    const int tid = phase_tid();
    for (int e = tid; e < 64 * 128; e += 512) {
        int i, d; if (sAd == 1) { i = e >> 7; d = e & 127; } else { d = e >> 6; i = e & 63; }
        As[i * 129 + d] = A[i * sAi + d * sAd];
        int j, d2; if (sBd == 1) { j = e >> 7; d2 = e & 127; } else { d2 = e >> 6; j = e & 63; }
        Bs[j * 129 + d2] = B[j * sBj + d2 * sBd];
    }
    __syncthreads();
    const int i = tid & 63, jg = tid >> 6;
    float acc[8];
#pragma unroll
    for (int q = 0; q < 8; ++q) acc[q] = 0.f;
    for (int d = 0; d < 128; ++d) { const float a = As[i * 129 + d];
#pragma unroll
        for (int q = 0; q < 8; ++q) acc[q] += a * Bs[(jg * 8 + q) * 129 + d]; }
#pragma unroll
    for (int q = 0; q < 8; ++q) out[i * sOi + (jg * 8 + q) * sOj] = f2bf(acc[q]);
    __syncthreads();
}

__device__ void phase_conv_in(const Params& p, int l, LAS unsigned char* lds, int bid, int nb) {
    const float* Win = p.in[I_WIN] + (size_t)l * D_MODEL * IN_W;
    conv_job<1>(lds, BF(p, OFF_WIN), 1024, 0, Win, IN_W, 1024, 0, 3584, 0, bid, nb);
    conv_job<1>(lds, BF(p, OFF_WIN), 1024, 0, Win, IN_W, 1024, 4608, NP1, 0, bid, nb);
    const float* wuk = p.in[I_WUK] + (size_t)l * 256 * 512;
    for (int it = bid; it < 256; it += nb) { const int h = it >> 6, rb = (it >> 4) & 3, kb = it & 15;
        fold_tile(lds, BF(p, OFF_WIN) + (size_t)(3584 + h * 256 + rb * 64) * 1024 + kb * 64, 1, 1024,
                  Win + (size_t)(kb * 64) * IN_W + C_DQ + h * 128, IN_W, 1, wuk + ((size_t)(rb * 64) * 4 + h) * 128, 512, 1); }
}
__device__ void phase_conv_post(const Params& p, int l, LAS unsigned char* lds, int bid, int nb) {
    const float* Win = p.in[I_WIN] + (size_t)l * D_MODEL * IN_W;
    conv_job<0>(lds, BF(p, OFF_WG), 1024, 0, Win, IN_W, 1024, 0, 3072, C_G, bid, nb);
    conv_job<0>(lds, BF(p, OFF_WBR), 2048, 0, p.in[I_WA] + (size_t)l * 512 * 1024, 1024, 512, 0, 1024, 0, bid, nb);
    conv_job<0>(lds, BF(p, OFF_WBR), 2048, 512, p.in[I_WB] + (size_t)l * 512 * 1024, 1024, 512, 0, 1024, 0, bid, nb);
    conv_job<0>(lds, BF(p, OFF_WOUT), 1024, 0, p.in[I_WOUT] + (size_t)l * 1024 * 1024, 1024, 1024, 0, 1024, 0, bid, nb);
    conv_job<2>(lds, BF(p, OFF_WF1), 1024, 0, p.in[I_WF1] + (size_t)l * 1024 * 2 * D_FF, 2 * D_FF, 1024, 0, 2 * D_FF, 0, bid, nb);
    conv_job<0>(lds, BF(p, OFF_WF2), D_FF, 0, p.in[I_WF2] + (size_t)l * D_FF * 1024, 1024, D_FF, 0, 1024, 0, bid, nb);
    const float* wuv = p.in[I_WUV] + (size_t)l * 256 * 512; const float* wc = p.in[I_WC] + (size_t)l * 512 * 1024;
    for (int it = bid; it < 256; it += nb) { const int h = it >> 6, rb = (it >> 4) & 3, nbk = it & 15;
        fold_tile(lds, BF(p, OFF_WBR) + (size_t)(nbk * 64) * 2048 + 1024 + h * 256 + rb * 64, 1, 2048,
                  wuv + ((size_t)(rb * 64) * 4 + h) * 128, 512, 1, wc + (size_t)(h * 128) * 1024 + nbk * 64, 1, 1024); }
}

__device__ __forceinline__ float wave_sum(float v) {
#pragma unroll
    for (int o = 32; o >= 1; o >>= 1) v += __shfl_xor(v, o);
    return v;
}
template <int MODE>
__device__ void phase_norm(const float* xin, float* xout, const float* O, const float* wpost, const float* w1, bf16_t* H, int bid, int nb) {
    const int tidn = phase_tid(); const int wv = tidn >> 6, lane = tidn & 63;
    for (int row = bid * 8 + wv; row < NTOK; row += nb * 8) {
        f32x4 xv[4];
#pragma unroll
        for (int j = 0; j < 4; ++j) xv[j] = *(const f32x4*)(xin + (size_t)row * 1024 + j * 256 + lane * 4);
        if (MODE >= 1) {
            f32x4 ov[4]; float ss = 0.f;
#pragma unroll
            for (int j = 0; j < 4; ++j) { ov[j] = *(const f32x4*)(O + (size_t)row * 1024 + j * 256 + lane * 4); ss += ov[j][0] * ov[j][0] + ov[j][1] * ov[j][1] + ov[j][2] * ov[j][2] + ov[j][3] * ov[j][3]; }
            ss = wave_sum(ss); const float r = rsqrtf(ss * (1.f / 1024.f) + 1e-6f);
#pragma unroll
            for (int j = 0; j < 4; ++j) { const f32x4 wv4 = *(const f32x4*)(wpost + j * 256 + lane * 4); xv[j] = xv[j] + ov[j] * r * wv4; *(f32x4*)(xout + (size_t)row * 1024 + j * 256 + lane * 4) = xv[j]; }
        }
        if (MODE <= 1) {
            float ss = 0.f;
#pragma unroll
            for (int j = 0; j < 4; ++j) ss += xv[j][0] * xv[j][0] + xv[j][1] * xv[j][1] + xv[j][2] * xv[j][2] + xv[j][3] * xv[j][3];
            ss = wave_sum(ss); const float r = rsqrtf(ss * (1.f / 1024.f) + 1e-6f);
#pragma unroll
            for (int j = 0; j < 4; ++j) { const f32x4 wv4 = *(const f32x4*)(w1 + j * 256 + lane * 4); const f32x4 y = xv[j] * r * wv4;
                u32x2 w; w.x = cvt_pk_bf16(y[0], y[1]); w.y = cvt_pk_bf16(y[2], y[3]); *(u32x2*)(H + (size_t)row * 1024 + j * 256 + lane * 4) = w; }
        }
    }
}

__device__ void phase_gemm_in(const Params& p, LAS unsigned char* lds, int bid, int nb) {
    pg8::EpiProj E{p.ws};
    pg8::Gemm g{BF(p, OFF_H), BF(p, OFF_WIN), 1024, 1024};
    pg8::StaticOrder S; S.init(NTOK, NP1, 1024, nb, bid);
    pg8::gemm_phase(lds, g, S, E);
}
__device__ void phase_gemm_gates(const Params& p, LAS unsigned char* lds, int bid, int nb) {
    pg8::EpiGate E{BF(p, OFF_HF)};
    pg8::Gemm g{BF(p, OFF_H), BF(p, OFF_WG), 1024, 1024};
    pg8::StaticOrder S; S.init(NTOK, 3072, 1024, nb, bid);
    pg8::gemm_phase(lds, g, S, E);
}
__device__ void phase_gemm_branch(const Params& p, LAS unsigned char* lds, int bid, int nb) {
    pg8::EpiBranch E; E.Mg = BF(p, OFF_H); E.G0 = BF(p, OFF_HF);
    pg8::Gemm g{BF(p, OFF_Y), BF(p, OFF_WBR), 2048, 2048};
    pg8::BranchOrder S; S.init(NTOK, 1024, nb, bid);
    pg8::gemm_phase(lds, g, S, E);
}
__device__ void phase_gemm_out(const Params& p, LAS unsigned char* lds, int bid, int nb) {
    pg8::EpiF32 E{F32P(p, OFF_OUT), 1024};
    pg8::Gemm g{BF(p, OFF_H), BF(p, OFF_WOUT), 1024, 1024};
    pg8::StaticOrder S; S.init(NTOK, 1024, 1024, nb, bid);
    pg8::gemm_phase(lds, g, S, E);
}
__device__ void phase_gemm_ffn1(const Params& p, LAS unsigned char* lds, int bid, int nb) {
    pg8::EpiSwiglu E{BF(p, OFF_ACT), D_FF};
    pg8::Gemm g{BF(p, OFF_H), BF(p, OFF_WF1), 1024, 1024};
    pg8::StaticOrder S; S.init(NTOK, 2 * D_FF, 1024, nb, bid);
    pg8::gemm_phase(lds, g, S, E);
}
__device__ void phase_gemm_ffn2(const Params& p, LAS unsigned char* lds, int bid, int nb) {
    pg8::EpiF32 E{F32P(p, OFF_OUT), 1024};
    pg8::Gemm g{BF(p, OFF_ACT), BF(p, OFF_WF2), D_FF, D_FF};
    pg8::StaticOrder S; S.init(NTOK, 1024, D_FF, nb, bid);
    pg8::gemm_phase(lds, g, S, E);
}


__device__ __forceinline__ float hg_lower_bound(const float* lbl, int l, int idx) {
    const float l0 = lbl[idx], l1 = lbl[512 + idx]; const float m = fmaxf(l0, l1), e0 = __expf(l0 - m), e1 = __expf(l1 - m), p0 = e0 / (e0 + e1), p1 = e1 / (e0 + e1);
    return ((l == 0) ? p0 : (p0 + p1)) - p0;
}
__device__ __forceinline__ void pack16_store(LAS unsigned char* dst, const float (&v)[16]) {
    u32x4 a, b; a.x = cvt_pk_bf16(v[0], v[1]); a.y = cvt_pk_bf16(v[2], v[3]); a.z = cvt_pk_bf16(v[4], v[5]); a.w = cvt_pk_bf16(v[6], v[7]);
    b.x = cvt_pk_bf16(v[8], v[9]); b.y = cvt_pk_bf16(v[10], v[11]); b.z = cvt_pk_bf16(v[12], v[13]); b.w = cvt_pk_bf16(v[14], v[15]);
    *(LAS u32x4*)dst = a; *(LAS u32x4*)(dst + 16) = b;
}
#define HG_FRONT()                                                                                                   \
    const int d = tid & 127, seg = tid >> 7;                                                                         \
    const float lbd = hg_lower_bound(p.in[I_LB], l, h * 128 + d);                                                    \
    float kk[16], cs[16];                                                                                            \
    { float run = 0.f;                                                                                               \
      _Pragma("unroll") for (int jj = 0; jj < 16; ++jj) {                                                            \
          const float fp = bf2f(HF[(size_t)(row0 + seg * 16 + jj) * 512 + h * 128 + d]);                            \
          const float sg = sigmoidf_(fp); const float f = fmaxf(lbd + (1.f - lbd) * sg, 1e-20f);                     \
          kk[jj] = (1.f - lbd) * (1.f - sg); run += __logf(f); cs[jj] = run; }                                       \
      SEG[seg * 128 + d] = run; }

__device__ void phase_hg1(const Params& p, int l, LAS unsigned char* lds, int bid, int nb) {
    const int tid = phase_tid(), lane = tid & 63, w = __builtin_amdgcn_readfirstlane(tid >> 6), fr = lane & 15, g = lane >> 4;
    LAS float* SEG = (LAS float*)lds; LAS unsigned char* KT = lds + 2048; LAS unsigned char* VT = KT + 128 * 144;
    const bf16_t* HF = BF(p, OFF_HF); const bf16_t* HI = BF(p, OFF_HI); bf16_t* ST = BF(p, OFF_ST); float* DEC = F32P(p, OFF_DEC);
    for (int unit = bid; unit < 1024; unit += nb) {
        const int bh = unit >> 6, c = unit & 63, h = bh & 3, row0 = (bh >> 2) * SEQ + c * 64;
        HG_FRONT();
        float vv[16];
#pragma unroll
        for (int jj = 0; jj < 16; ++jj) vv[jj] = bf2f(HI[(size_t)(row0 + seg * 16 + jj) * 512 + h * 128 + d]);
        __syncthreads();
        float off = 0.f, bl = 0.f;
#pragma unroll
        for (int s2 = 0; s2 < 4; ++s2) { const float t = SEG[s2 * 128 + d]; off += (s2 < seg) ? t : 0.f; bl += t; }
        float kb[16];
#pragma unroll
        for (int jj = 0; jj < 16; ++jj) kb[jj] = kk[jj] * __expf(bl - (off + cs[jj]));
        pack16_store(KT + d * 144 + seg * 32, kb);
        pack16_store(VT + d * 144 + seg * 32, vv);
        if (seg == 0) DEC[(size_t)unit * 128 + d] = __expf(bl);
        __syncthreads();
        bf16x8 a[2];
#pragma unroll
        for (int ks = 0; ks < 2; ++ks) a[ks] = *(const LAS bf16x8*)(KT + (16 * w + fr) * 144 + (32 * ks + 8 * g) * 2);
#pragma unroll
        for (int et = 0; et < 8; ++et) {
            f32x4 acc = {0.f, 0.f, 0.f, 0.f};
#pragma unroll
            for (int ks = 0; ks < 2; ++ks) { const bf16x8 b = *(const LAS bf16x8*)(VT + (16 * et + fr) * 144 + (32 * ks + 8 * g) * 2); acc = __builtin_amdgcn_mfma_f32_16x16x32_bf16(a[ks], b, acc, 0, 0, 0); }
            mfma_fence(acc);
            u32x2 o; o.x = cvt_pk_bf16(acc[0], acc[1]); o.y = cvt_pk_bf16(acc[2], acc[3]);
            *(u32x2*)(ST + ((size_t)unit * 128 + 16 * et + fr) * 128 + 16 * w + 4 * g) = o;
        }
        __syncthreads();
    }
}
__device__ void phase_hg2(const Params& p, int bid, int nb) {
    bf16_t* ST = BF(p, OFF_ST); const float* DEC = F32P(p, OFF_DEC);
    for (int gid = bid * 512 + phase_tid(); gid < 16 * 8192; gid += nb * 512) {
        const int bh = gid >> 13, within = gid & 8191, e = within >> 6, d = (within & 63) * 2;
        float s0 = 0.f, s1 = 0.f;
        for (int c0 = 0; c0 < 64; c0 += 8) {
            unsigned u[8]; float d0[8], d1[8];
#pragma unroll
            for (int k = 0; k < 8; ++k) { const size_t un = (size_t)(bh * 64 + c0 + k);
                u[k] = *(const unsigned*)(ST + (un * 128 + e) * 128 + d); d0[k] = DEC[un * 128 + d]; d1[k] = DEC[un * 128 + d + 1]; }
            asm volatile("s_waitcnt vmcnt(0)" ::: "memory");
#pragma unroll
            for (int k = 0; k < 8; ++k) { const size_t un = (size_t)(bh * 64 + c0 + k);
                *(unsigned*)(ST + (un * 128 + e) * 128 + d) = cvt_pk_bf16(s0, s1);
                s0 = d0[k] * s0 + __uint_as_float(u[k] << 16); s1 = d1[k] * s1 + __uint_as_float(u[k] & 0xffff0000u); }
        }
    }
}
template <int PROBE = 0> __device__ void phase_hg3(const Params& p, int l, LAS unsigned char* lds, int bid, int nb) {
    const int tid = phase_tid(), lane = tid & 63, w = __builtin_amdgcn_readfirstlane(tid >> 6), fr = lane & 15, g = lane >> 4;
    LAS float* SEG = (LAS float*)lds;
    LAS unsigned char* QH = lds + 2048; LAS unsigned char* QT = QH + 64 * 272; LAS float* OL = (LAS float*)(lds + 2048);
    LAS unsigned char* KB = lds + 36864; LAS unsigned char* VT = lds + 54272; LAS unsigned char* SP = lds + 72704; LAS unsigned char* PL = lds + 107520;
    const bf16_t* HF = BF(p, OFF_HF); const bf16_t* HI = BF(p, OFF_HI); const bf16_t* HG = BF(p, OFF_HG); const bf16_t* ST = BF(p, OFF_ST); bf16_t* Y = BF(p, OFF_Y);
    for (int unit = bid; unit < 1024; unit += nb) {
        const int bh = unit >> 6, c = unit & 63, h = bh & 3, row0 = (bh >> 2) * SEQ + c * 64;
        HG_FRONT();
        {
#pragma unroll
            for (int k = 0; k < 4; ++k) { const int ch = tid + 512 * k, e = ch >> 4, dc = ch & 15;
                *(LAS u32x4*)(SP + e * 272 + dc * 16) = *(const u32x4*)(ST + ((size_t)unit * 128 + e) * 128 + dc * 8); }
            float vv[16];
#pragma unroll
            for (int jj = 0; jj < 16; ++jj) vv[jj] = bf2f(HI[(size_t)(row0 + seg * 16 + jj) * 512 + h * 128 + d]);
            pack16_store(VT + d * 144 + seg * 32, vv);
        }
        __syncthreads();
        float beta[4]; { float run = 0.f;
#pragma unroll
            for (int s2 = 0; s2 < 4; ++s2) { beta[s2] = run; run += SEG[s2 * 128 + d]; } }
        float off = 0.f;
#pragma unroll
        for (int s2 = 0; s2 < 4; ++s2) off = (s2 == seg) ? beta[s2] : off;
#pragma unroll
        for (int jj = 0; jj < 16; ++jj) {
            const float q = bf2f(Y[(size_t)(row0 + seg * 16 + jj) * 2048 + h * 128 + d]);
            const int i = seg * 16 + jj;
            *(LAS bf16_t*)(QH + i * 272 + d * 2) = f2bf(q * __expf(off + cs[jj]));
            *(LAS bf16_t*)(QT + i * 272 + d * 2) = f2bf(q * __expf(cs[jj]));
        }
#pragma unroll
        for (int I = 0; I < 4; ++I) {
            if (seg <= I) {
                float bI = 0.f;
#pragma unroll
                for (int s2 = 0; s2 < 4; ++s2) bI = (s2 == I) ? beta[s2] : bI;
#pragma unroll
                for (int jj = 0; jj < 16; ++jj) *(LAS bf16_t*)(KB + (seg * 16 + jj) * 272 + d * 2) = f2bf(kk[jj] * __expf(fminf(bI - (off + cs[jj]), 60.f)));
            }
            __syncthreads();
            if (w < 4) {
                f32x4 acc = {0.f, 0.f, 0.f, 0.f};
                if (w <= I) {
#pragma unroll
                    for (int ks = 0; ks < 4; ++ks) {
                        const bf16x8 a = *(const LAS bf16x8*)(QT + (16 * I + fr) * 272 + (32 * ks + 8 * g) * 2);
                        const bf16x8 b = *(const LAS bf16x8*)(KB + (16 * w + fr) * 272 + (32 * ks + 8 * g) * 2);
                        acc = __builtin_amdgcn_mfma_f32_16x16x32_bf16(a, b, acc, 0, 0, 0); }
                    mfma_fence(acc);
                    const int lim = (w == I) ? (4 * g) : 1000;
#pragma unroll
                    for (int r = 0; r < 4; ++r) acc[r] = (fr <= lim + r) ? acc[r] : 0.f;
                }
#pragma unroll
                for (int r = 0; r < 4; ++r) *(LAS bf16_t*)(PL + (16 * I + 4 * g + r) * 144 + (16 * w + fr) * 2) = f2bf(acc[r]);
            }
            __syncthreads();
        }
        f32x4 oacc[4];
        { const int ib = w >> 1;
          bf16x8 aq[4], ap[2];
#pragma unroll
          for (int ks = 0; ks < 4; ++ks) aq[ks] = *(const LAS bf16x8*)(QH + (16 * ib + fr) * 272 + (32 * ks + 8 * g) * 2);
#pragma unroll
          for (int ks = 0; ks < 2; ++ks) ap[ks] = *(const LAS bf16x8*)(PL + (16 * ib + fr) * 144 + (32 * ks + 8 * g) * 2);
#pragma unroll
          for (int q4 = 0; q4 < 4; ++q4) { const int et = 4 * (w & 1) + q4; f32x4 acc = {0.f, 0.f, 0.f, 0.f};
#pragma unroll
              for (int ks = 0; ks < 4; ++ks) { const bf16x8 b = *(const LAS bf16x8*)(SP + (16 * et + fr) * 272 + (32 * ks + 8 * g) * 2); acc = __builtin_amdgcn_mfma_f32_16x16x32_bf16(aq[ks], b, acc, 0, 0, 0); }
#pragma unroll
              for (int ks = 0; ks < 2; ++ks) { const bf16x8 b = *(const LAS bf16x8*)(VT + (16 * et + fr) * 144 + (32 * ks + 8 * g) * 2); acc = __builtin_amdgcn_mfma_f32_16x16x32_bf16(ap[ks], b, acc, 0, 0, 0); }
              oacc[q4] = acc; } }
        mfma_fence(oacc[0], oacc[1], oacc[2], oacc[3]);
        __syncthreads();
#pragma unroll
        for (int q4 = 0; q4 < 4; ++q4)
#pragma unroll
            for (int r = 0; r < 4; ++r) OL[(16 * (w >> 1) + 4 * g + r) * 132 + 16 * (4 * (w & 1) + q4) + fr] = oacc[q4][r];
        __syncthreads();
        {
            const int i = tid >> 3, es = (tid & 7) * 16;
            float o[16], ss = 0.f;
#pragma unroll
            for (int k = 0; k < 16; ++k) { o[k] = OL[i * 132 + es + k]; ss += o[k] * o[k]; }
            ss += __shfl_xor(ss, 1); ss += __shfl_xor(ss, 2); ss += __shfl_xor(ss, 4);
            const float rstd = rsqrtf(ss * (1.f / 128.f) + 1e-6f);
            const u32x4 g0 = *(const u32x4*)(HG + (size_t)(row0 + i) * 512 + h * 128 + es), g1 = *(const u32x4*)(HG + (size_t)(row0 + i) * 512 + h * 128 + es + 8);
            float y[16];
#pragma unroll
            for (int k = 0; k < 16; ++k) { const unsigned gw = (k < 8) ? g0[k >> 1] : g1[(k - 8) >> 1]; const float gv = (k & 1) ? __uint_as_float(gw & 0xffff0000u) : __uint_as_float(gw << 16);
                y[k] = o[k] * rstd * p.in[I_HGNW][l * 128 + es + k] * (gv * sigmoidf_(gv)); }
            u32x4 a, b; a.x = cvt_pk_bf16(y[0], y[1]); a.y = cvt_pk_bf16(y[2], y[3]); a.z = cvt_pk_bf16(y[4], y[5]); a.w = cvt_pk_bf16(y[6], y[7]);
            b.x = cvt_pk_bf16(y[8], y[9]); b.y = cvt_pk_bf16(y[10], y[11]); b.z = cvt_pk_bf16(y[12], y[13]); b.w = cvt_pk_bf16(y[14], y[15]);
            bf16_t* yo = PROBE ? ((bf16_t*)((unsigned char*)p.x + 16 * MiB) + (size_t)(row0 + i) * 512 + h * 128 + es) : (Y + (size_t)(row0 + i) * 2048 + h * 128 + es);
            *(u32x4*)yo = a; *(u32x4*)(yo + 8) = b;
        }
        __syncthreads();
    }
}


__device__ void phase_prep(const Params& p, int l, LAS unsigned char* lds, int bid, int nb) {
    const int tid = phase_tid(), lane = tid & 63, wv = tid >> 6;
    {
        LAS float* red = (LAS float*)lds; const bf16_t* MK = BF(p, OFF_MK); float* KM = F32P(p, OFF_KMEAN);
        for (int it = bid; it < 256; it += nb) {
            const int bh = it >> 4, n = it & 15, h = bh & 3, d = tid & 127, part = tid >> 7; const size_t row0 = (size_t)(bh >> 2) * SEQ + n * 256 + part * 64;
            float s = 0.f;
            for (int j = 0; j < 64; ++j) s += bf2f(MK[(row0 + j) * 512 + h * 128 + d]);
            red[part * 128 + d] = s; __syncthreads();
            if (part == 0) KM[(size_t)it * 128 + d] = (red[d] + red[128 + d] + red[256 + d] + red[384 + d]) * (1.f / 256.f);
            __syncthreads();
        }
    }
    bf16_t* CKV = BF(p, OFF_CKV); bf16_t* IKW = BF(p, OFF_IKW);
    const float* kvw = p.in[I_KVN] + l * 256; const float* ikw = p.in[I_IKNW] + l * 64; const float* ikb = p.in[I_IKNB] + l * 64;
    for (int row = bid * 8 + wv; row < NTOK; row += nb * 8) {
        {   u32x2* cp = (u32x2*)(CKV + (size_t)row * 256 + lane * 4); const u32x2 v = *cp;
            const float a0 = __uint_as_float(v.x << 16), a1 = __uint_as_float(v.x & 0xffff0000u), a2 = __uint_as_float(v.y << 16), a3 = __uint_as_float(v.y & 0xffff0000u);
            const float ss = wave_sum(a0 * a0 + a1 * a1 + a2 * a2 + a3 * a3); const float r = rsqrtf(ss * (1.f / 256.f) + 1e-6f);
            const f32x4 w4 = *(const f32x4*)(kvw + lane * 4);
            u32x2 o; o.x = cvt_pk_bf16(a0 * r * w4[0], a1 * r * w4[1]); o.y = cvt_pk_bf16(a2 * r * w4[2], a3 * r * w4[3]); *cp = o; }
        {   bf16_t* ip = IKW + (size_t)row * 128; const float u = bf2f(ip[lane]);
            const float mu = wave_sum(u) * (1.f / 64.f); const float xc = u - mu; const float var = wave_sum(xc * xc) * (1.f / 64.f);
            const float y = xc * rsqrtf(var + 1e-6f) * ikw[lane] + ikb[lane];
            const float wgt = (lane < 8) ? bf2f(ip[64 + lane]) * (0.35355339059327373f * 0.125f) : 0.f;
            ip[lane] = f2bf(y); if (lane < 8) ip[64 + lane] = f2bf(wgt); }
    }
}

typedef short v4i16_t __attribute__((ext_vector_type(4)));
__device__ __forceinline__ v4i16_t lds_tr16(const LAS unsigned char* pp) { return __builtin_amdgcn_ds_read_tr16_b64_v4i16((LAS v4i16_t*)pp); }
template <int PROBE = 0> __device__ void phase_moba(const Params& p, LAS unsigned char* lds, int bid, int nb) {
    const int tid = phase_tid(), lane = tid & 63, w = __builtin_amdgcn_readfirstlane(tid >> 6), fr = lane & 15, g = lane >> 4;
    LAS float* BL = (LAS float*)lds; LAS float* KM = (LAS float*)(lds + 16384); LAS float* GG = (LAS float*)(lds + 24576);
    LAS unsigned* SM = (LAS unsigned*)(lds + 32768); LAS unsigned* UM = SM + 128; LAS unsigned* TL = SM + 132;
    LAS unsigned char* QS = lds + 33792; LAS unsigned char* KS = lds + 68608; LAS unsigned char* VS = lds + 86016;
    bf16_t* Y = BF(p, OFF_Y); const bf16_t* MK = BF(p, OFF_MK); const bf16_t* MV = BF(p, OFF_MV);
    const float scale = 0.08838834764831845f;
    for (int j = bid; j < 512; j += nb) {
        const int bh = j & 15, qt = (j < 256) ? (j >> 4) : (31 - ((j - 256) >> 4));
        const int h = bh & 3, brow = (bh >> 2) * SEQ, t0 = qt * 128, blk = qt >> 1;
        for (int dd = tid; dd < 4096; dd += 512) BL[dd] = p.in[I_REL][rel_bucket(dd) * 8 + h];
        for (int e = tid; e < 2048; e += 512) KM[e] = F32P(p, OFF_KMEAN)[(size_t)bh * 2048 + e];
#pragma unroll
        for (int k = 0; k < 4; ++k) { const int ch = tid + 512 * k, r = ch >> 4, c = ch & 15;
            *(LAS u32x4*)(QS + r * 272 + c * 16) = *(const u32x4*)(Y + (size_t)(brow + t0 + r) * 2048 + 512 + h * 128 + c * 8); }
        if (tid == 0) *UM = 0u;
        __syncthreads();
        {
            const int q = tid >> 2, ng = tid & 3; float ga[4] = {0.f, 0.f, 0.f, 0.f};
            for (int c = 0; c < 16; ++c) { const u32x4 qv = *(const LAS u32x4*)(QS + q * 272 + c * 16);
#pragma unroll
                for (int e2 = 0; e2 < 8; ++e2) { const unsigned wq = qv[e2 >> 1]; const float qf = (e2 & 1) ? __uint_as_float(wq & 0xffff0000u) : __uint_as_float(wq << 16);
#pragma unroll
                    for (int n4 = 0; n4 < 4; ++n4) ga[n4] += qf * KM[(ng * 4 + n4) * 128 + c * 8 + e2]; } }
#pragma unroll
            for (int n4 = 0; n4 < 4; ++n4) GG[q * 16 + ng * 4 + n4] = ga[n4];
        }
        __syncthreads();
        if (tid < 128) {
            unsigned used = 0u;
            for (int k = 0; k < 3; ++k) { int best = -1; float bv = 0.f;
                for (int n = 0; n < blk; ++n) { const float v = GG[tid * 16 + n]; if (!((used >> n) & 1u) && (best < 0 || v > bv)) { best = n; bv = v; } }
                if (best >= 0) used |= 1u << best; }
            SM[tid] = used; __hip_atomic_fetch_or((unsigned*)UM, used, __ATOMIC_RELAXED, __HIP_MEMORY_SCOPE_WORKGROUP);
        }
        __syncthreads();
        const unsigned mysel = SM[16 * w + fr];
        const int own_tiles = 2 + 2 * (qt & 1);
        if (tid == 0) {
            const unsigned umask = *UM; int c = 0;
            for (int kt = 0; kt < own_tiles; ++kt) TL[c++] = (unsigned)(blk * 4 + kt);
            for (int n = 0; n < blk; ++n) if ((umask >> n) & 1u) { for (int kt = 0; kt < 4; ++kt) TL[c++] = (unsigned)(n * 4 + kt); }
            TL[64] = (unsigned)c; }
        __syncthreads();
        const int ntiles = (int)TL[64];
        const int tq = t0 + 16 * w + fr;
        bf16x8 qf[4];
#pragma unroll
        for (int ks = 0; ks < 4; ++ks) qf[ks] = *(const LAS bf16x8*)(QS + (16 * w + fr) * 272 + (32 * ks + 8 * g) * 2);
        f32x4 oacc[8];
#pragma unroll
        for (int dt = 0; dt < 8; ++dt) oacc[dt] = (f32x4){0.f, 0.f, 0.f, 0.f};
        float mrun = -1e30f, lsum = 0.f;
        u32x4 kpre[2], vpre[2];
        { const int key0 = (int)TL[0] * 64;
#pragma unroll
          for (int k = 0; k < 2; ++k) { const int ch = tid + 512 * k, r = ch >> 4, c = ch & 15; const size_t go = (size_t)(brow + key0 + r) * 512 + h * 128 + c * 8; kpre[k] = *(const u32x4*)(MK + go); vpre[k] = *(const u32x4*)(MV + go); } }
        for (int ti = 0; ti < ntiles; ++ti) {
            const int ent = (int)TL[ti], n = ent >> 2, key0 = ent * 64;
            const bool qsel = (n == blk) || ((mysel >> n) & 1u);
            __syncthreads();
#pragma unroll
            for (int k = 0; k < 2; ++k) { const int ch = tid + 512 * k, r = ch >> 4, c = ch & 15; *(LAS u32x4*)(KS + r * 272 + c * 16) = kpre[k]; *(LAS u32x4*)(VS + r * 272 + c * 16) = vpre[k]; }
            __syncthreads();
            if (ti + 1 < ntiles) { const int keyn = (int)TL[ti + 1] * 64;
#pragma unroll
                for (int k = 0; k < 2; ++k) { const int ch = tid + 512 * k, r = ch >> 4, c = ch & 15; const size_t go = (size_t)(brow + keyn + r) * 512 + h * 128 + c * 8; kpre[k] = *(const u32x4*)(MK + go); vpre[k] = *(const u32x4*)(MV + go); } }
            {
                f32x4 s[4];
#pragma unroll
                for (int k4 = 0; k4 < 4; ++k4) { f32x4 acc = {0.f, 0.f, 0.f, 0.f};
#pragma unroll
                    for (int ks = 0; ks < 4; ++ks) { const bf16x8 a = *(const LAS bf16x8*)(KS + (16 * k4 + fr) * 272 + (32 * ks + 8 * g) * 2); acc = __builtin_amdgcn_mfma_f32_16x16x32_bf16(a, qf[ks], acc, 0, 0, 0); }
                    s[k4] = acc; }
                mfma_fence(s[0], s[1], s[2], s[3]);
                float mx = -1e30f;
#pragma unroll
                for (int k4 = 0; k4 < 4; ++k4)
#pragma unroll
                    for (int r = 0; r < 4; ++r) { const int dist = tq - (key0 + 16 * k4 + 4 * g + r); const bool ok = qsel && (dist >= 0);
                        const float lg = s[k4][r] * scale + BL[dist < 0 ? 0 : dist]; s[k4][r] = ok ? lg : -1e30f; mx = fmaxf(mx, s[k4][r]); }
                mx = fmaxf(mx, __shfl_xor(mx, 16)); mx = fmaxf(mx, __shfl_xor(mx, 32));
                const float mnew = fmaxf(mrun, mx), alpha = __expf(mrun - mnew); mrun = mnew;
                float ps = 0.f;
#pragma unroll
                for (int k4 = 0; k4 < 4; ++k4)
#pragma unroll
                    for (int r = 0; r < 4; ++r) { const float pv = (s[k4][r] > -1e29f) ? __expf(s[k4][r] - mnew) : 0.f; s[k4][r] = pv; ps += pv; }
                lsum = lsum * alpha + ps;
#pragma unroll
                for (int dt = 0; dt < 8; ++dt) oacc[dt] = oacc[dt] * alpha;
                bf16x8 pb[2];
#pragma unroll
                for (int m2 = 0; m2 < 2; ++m2) { u32x4 t; t.x = cvt_pk_bf16(s[2 * m2][0], s[2 * m2][1]); t.y = cvt_pk_bf16(s[2 * m2][2], s[2 * m2][3]);
                    t.z = cvt_pk_bf16(s[2 * m2 + 1][0], s[2 * m2 + 1][1]); t.w = cvt_pk_bf16(s[2 * m2 + 1][2], s[2 * m2 + 1][3]); pb[m2] = __builtin_bit_cast(bf16x8, t); }
#pragma unroll
                for (int dt = 0; dt < 8; ++dt)
#pragma unroll
                    for (int m2 = 0; m2 < 2; ++m2) {
                        const LAS unsigned char* va = VS + (32 * m2 + 4 * g + (fr >> 2)) * 272 + (16 * dt + 4 * (fr & 3)) * 2;
                        const v4i16_t lo = lds_tr16(va), hi = lds_tr16(va + 16 * 272);
                        const bf16x8 a = {lo[0], lo[1], lo[2], lo[3], hi[0], hi[1], hi[2], hi[3]};
                        oacc[dt] = __builtin_amdgcn_mfma_f32_16x16x32_bf16(a, pb[m2], oacc[dt], 0, 0, 0); }
            }
        }
        lsum += __shfl_xor(lsum, 16); lsum += __shfl_xor(lsum, 32);
        const float inv = 1.f / lsum;
        mfma_fence(oacc[0], oacc[1], oacc[2], oacc[3]); mfma_fence(oacc[4], oacc[5], oacc[6], oacc[7]);
        __syncthreads();
#pragma unroll
        for (int dt = 0; dt < 8; ++dt) { u32x2 o; o.x = cvt_pk_bf16(oacc[dt][0] * inv, oacc[dt][1] * inv); o.y = cvt_pk_bf16(oacc[dt][2] * inv, oacc[dt][3] * inv);
            if (PROBE) *(u32x2*)((bf16_t*)p.x + (size_t)(brow + tq) * 512 + h * 128 + 16 * dt + 4 * g) = o; else *(u32x2*)(Y + (size_t)(brow + tq) * 2048 + 512 + h * 128 + 16 * dt + 4 * g) = o; }
        __syncthreads();
    }
}


template <int PROBE = 0> __device__ void phase_dsel(const Params& p, LAS unsigned char* lds, int bid, int nb) {
    const int tid = phase_tid(), lane = tid & 63, w = __builtin_amdgcn_readfirstlane(tid >> 6), fr = lane & 15, g = lane >> 4, q8 = fr & 7;
    LAS unsigned char* KEYS = lds;
    LAS unsigned char* IQS = lds + 131072;
    const bf16_t* IQ = BF(p, OFF_IQ); const bf16_t* IKW = BF(p, OFF_IKW);
    unsigned* MASK = PROBE ? (unsigned*)((unsigned char*)p.x + (size_t)(PROBE - 1) * 8 * MiB) : (unsigned*)(p.ws + OFF_MASK);
    for (int u = 0; u < 2048; ++u) {
        int k;
        if (nb == 256) { if (u >= 8) break; k = (u & 1) ? (512 * (u >> 1) + 511 - bid) : (512 * (u >> 1) + bid); }
        else { k = bid + u * nb; if (k >= 2048) break; }
        const int b = k & 3, qt = k >> 2, brow = b * SEQ, t0 = qt * 8, nkt = (t0 + 7) / 16 + 1;
        __syncthreads();
        { const int r = tid >> 6, c = tid & 63;
          *(LAS u32x4*)(IQS + r * 1040 + c * 16) = *(const u32x4*)(IQ + (size_t)(brow + t0 + r) * 512 + c * 8); }
        float iw[8];
        { const u32x4 wv = *(const u32x4*)(IKW + (size_t)(brow + t0 + q8) * 128 + 64);
#pragma unroll
          for (int hh = 0; hh < 8; ++hh) iw[hh] = (hh & 1) ? __uint_as_float(wv[hh >> 1] & 0xffff0000u) : __uint_as_float(wv[hh >> 1] << 16); }
        __syncthreads();
        {
            bf16x8 bq[8][2];
#pragma unroll
            for (int hh = 0; hh < 8; ++hh) { bq[hh][0] = *(const LAS bf16x8*)(IQS + q8 * 1040 + (hh * 64 + 8 * g) * 2); bq[hh][1] = *(const LAS bf16x8*)(IQS + q8 * 1040 + (hh * 64 + 32 + 8 * g) * 2); }
            const int tq = t0 + q8;
            const bf16_t* krp = IKW + (size_t)(brow + 16 * w + fr) * 128 + 8 * g;
            bf16x8 an0 = *(const bf16x8*)krp, an1 = *(const bf16x8*)(krp + 32);
            for (int kt = w; kt < nkt; kt += 8, krp += 16384) {
                const bf16x8 a0 = an0, a1 = an1;
                if (kt + 8 < nkt) { an0 = *(const bf16x8*)(krp + 16384); an1 = *(const bf16x8*)(krp + 16384 + 32); }
                float sc0 = 0.f, sc1 = 0.f, sc2 = 0.f, sc3 = 0.f;
#pragma unroll
                for (int hg4 = 0; hg4 < 2; ++hg4) {
                    f32x4 ah[4];
#pragma unroll
                    for (int h2 = 0; h2 < 4; ++h2) { const int hh = hg4 * 4 + h2; f32x4 acc = {0.f, 0.f, 0.f, 0.f};
                        acc = __builtin_amdgcn_mfma_f32_16x16x32_bf16(a0, bq[hh][0], acc, 0, 0, 0);
                        acc = __builtin_amdgcn_mfma_f32_16x16x32_bf16(a1, bq[hh][1], acc, 0, 0, 0);
                        ah[h2] = acc; }
                    mfma_fence(ah[0], ah[1], ah[2], ah[3]);
#pragma unroll
                    for (int h2 = 0; h2 < 4; ++h2) { const float wgt = iw[hg4 * 4 + h2];
                        sc0 += wgt * fmaxf(ah[h2][0], 0.f); sc1 += wgt * fmaxf(ah[h2][1], 0.f); sc2 += wgt * fmaxf(ah[h2][2], 0.f); sc3 += wgt * fmaxf(ah[h2][3], 0.f); }
                }
                const int sp0 = 16 * kt + 4 * g; u32x4 kv;
                { unsigned uu = __float_as_uint(sc0 + 0.0f); uu = (uu & 0x80000000u) ? ~uu : (uu | 0x80000000u); kv.x = (sp0 + 0 <= tq) ? ((uu & 0xfffff000u) | (unsigned)(4095 - sp0)) : 0u; }
                { unsigned uu = __float_as_uint(sc1 + 0.0f); uu = (uu & 0x80000000u) ? ~uu : (uu | 0x80000000u); kv.y = (sp0 + 1 <= tq) ? ((uu & 0xfffff000u) | (unsigned)(4094 - sp0)) : 0u; }
                { unsigned uu = __float_as_uint(sc2 + 0.0f); uu = (uu & 0x80000000u) ? ~uu : (uu | 0x80000000u); kv.z = (sp0 + 2 <= tq) ? ((uu & 0xfffff000u) | (unsigned)(4093 - sp0)) : 0u; }
                { unsigned uu = __float_as_uint(sc3 + 0.0f); uu = (uu & 0x80000000u) ? ~uu : (uu | 0x80000000u); kv.w = (sp0 + 3 <= tq) ? ((uu & 0xfffff000u) | (unsigned)(4092 - sp0)) : 0u; }
                if (fr < 8) *(LAS u32x4*)(KEYS + fr * 16384 + sp0 * 4) = kv;
            }
        }
        __syncthreads();
        {
            const int t = t0 + w; const int nch = 4 * nkt;
            const int mmax = (nch + 63) >> 6;
            u32x4 kr[16];
#pragma unroll
            for (int m = 0; m < 16; ++m) { const int c = lane + 64 * m; const u32x4 z = {0u, 0u, 0u, 0u};
                kr[m] = (m < mmax && c < nch) ? *(const LAS u32x4*)(KEYS + w * 16384 + c * 16) : z; }
            unsigned thr = 1u;
            if (t + 1 > 256 && PROBE < 3) { thr = 0u;
                for (int it = 0; it < 32; ++it) {
                    const unsigned cand = thr | (0x80000000u >> it);
                    unsigned cn = 0u;
#pragma unroll
                    for (int m = 0; m < 16; ++m) if (m < mmax) {
                        cn += (unsigned)__builtin_popcountll(__builtin_amdgcn_ballot_w64(kr[m].x >= cand)); cn += (unsigned)__builtin_popcountll(__builtin_amdgcn_ballot_w64(kr[m].y >= cand));
                        cn += (unsigned)__builtin_popcountll(__builtin_amdgcn_ballot_w64(kr[m].z >= cand)); cn += (unsigned)__builtin_popcountll(__builtin_amdgcn_ballot_w64(kr[m].w >= cand)); }
                    if (cn >= 256u) thr = cand;
                    if (cn == 256u) break;
                } }
            if (PROBE >= 3) thr = 0x80000000u;
            unsigned* mrow = MASK + (size_t)(brow + t) * 128;
#pragma unroll
            for (int m = 0; m < 16; ++m) {
                unsigned nib = 0u;
                if (m < mmax) nib = ((kr[m].x >= thr) ? 1u : 0u) | ((kr[m].y >= thr) ? 2u : 0u) | ((kr[m].z >= thr) ? 4u : 0u) | ((kr[m].w >= thr) ? 8u : 0u);
                unsigned v = nib << (4 * (lane & 7));
                v |= (unsigned)__shfl_xor((int)v, 1); v |= (unsigned)__shfl_xor((int)v, 2); v |= (unsigned)__shfl_xor((int)v, 4);
                if ((lane & 7) == 0) mrow[(lane >> 3) + 8 * m] = v;
            }
        }
    }
}

template <int PROBE = 0> __device__ void phase_datt(const Params& p, LAS unsigned char* lds, int bid, int nb) {
    const int tid = phase_tid(), lane = tid & 63, w = __builtin_amdgcn_readfirstlane(tid >> 6), fr = lane & 15, g = lane >> 4;
    LAS unsigned char* BK = lds;
    LAS float* RL = (LAS float*)(lds + 4096);
    LAS unsigned short* IDX = (LAS unsigned short*)(lds + 5120 + w * 512);
    LAS unsigned char* CT = lds + 9216 + w * (32 * 528);
    const bf16_t* CKV = BF(p, OFF_CKV); bf16_t* Y = BF(p, OFF_Y); const unsigned* MASK = (const unsigned*)(p.ws + OFF_MASK);
    for (int dd = tid; dd < 4096; dd += 512) BK[dd] = (unsigned char)rel_bucket(dd);
    if (tid < 256) RL[tid] = p.in[I_REL][tid];
    __syncthreads();
    const float scale = 0.08838834764831845f;
    const int hd = fr & 3;
    for (int it = bid; it < NTOK / 8; it += nb) {
        const int tg = it * 8 + w, brow = (tg >> 12) * SEQ, t = tg & 4095;
        const u32x2 mw = *(const u32x2*)(MASK + (size_t)tg * 128 + 2 * lane);
        const int cnt = __popc(mw.x) + __popc(mw.y);
        int pre = cnt;
#pragma unroll
        for (int o = 1; o < 64; o <<= 1) { const int v = __shfl_up(pre, o); if (lane >= o) pre += v; }
        const int nsel = __shfl(pre, 63);
        int pos = pre - cnt;
        { unsigned m0 = mw.x; while (m0) { const int bpos = __ffs(m0) - 1; m0 &= m0 - 1; IDX[pos++] = (unsigned short)(64 * lane + bpos); }
          unsigned m1 = mw.y; while (m1) { const int bpos = __ffs(m1) - 1; m1 &= m1 - 1; IDX[pos++] = (unsigned short)(64 * lane + 32 + bpos); } }
        for (int e = nsel + lane; e < 256; e += 64) IDX[e] = 0;
        bf16x8 qb[8];
#pragma unroll
        for (int ks = 0; ks < 8; ++ks) { const u32x4 z = {0u, 0u, 0u, 0u}; const u32x4 v = (fr < 4) ? *(const u32x4*)(Y + (size_t)tg * 2048 + 1024 + fr * 256 + 32 * ks + 8 * g) : z; qb[ks] = __builtin_bit_cast(bf16x8, v); }
        f32x4 oacc[16];
#pragma unroll
        for (int rt = 0; rt < 16; ++rt) oacc[rt] = (f32x4){0.f, 0.f, 0.f, 0.f};
        float mrun = -1e30f, lsum = 0.f;
        const int nstep = (nsel + 31) >> 5;
        bf16x8 a0[8], a1[8];
        { const bf16_t* c0 = CKV + (size_t)(brow + IDX[fr]) * 256 + 8 * g; const bf16_t* c1 = CKV + (size_t)(brow + IDX[16 + fr]) * 256 + 8 * g;
#pragma unroll
          for (int ks = 0; ks < 8; ++ks) { a0[ks] = *(const bf16x8*)(c0 + 32 * ks); a1[ks] = *(const bf16x8*)(c1 + 32 * ks); } }
        for (int st = 0; st < nstep; ++st) {
#pragma unroll
            for (int ks = 0; ks < 8; ++ks) { *(LAS bf16x8*)(CT + fr * 528 + (32 * ks + 8 * g) * 2) = a0[ks]; *(LAS bf16x8*)(CT + (16 + fr) * 528 + (32 * ks + 8 * g) * 2) = a1[ks]; }
            f32x4 s0 = {0.f, 0.f, 0.f, 0.f}, s1 = {0.f, 0.f, 0.f, 0.f};
#pragma unroll
            for (int ks = 0; ks < 8; ++ks) { s0 = __builtin_amdgcn_mfma_f32_16x16x32_bf16(a0[ks], qb[ks], s0, 0, 0, 0); s1 = __builtin_amdgcn_mfma_f32_16x16x32_bf16(a1[ks], qb[ks], s1, 0, 0, 0); }
            mfma_fence(s0); mfma_fence(s1);
            if (st + 1 < nstep) {
                const bf16_t* c0 = CKV + (size_t)(brow + IDX[32 * (st + 1) + fr]) * 256 + 8 * g; const bf16_t* c1 = CKV + (size_t)(brow + IDX[32 * (st + 1) + 16 + fr]) * 256 + 8 * g;
#pragma unroll
                for (int ks = 0; ks < 8; ++ks) { a0[ks] = *(const bf16x8*)(c0 + 32 * ks); a1[ks] = *(const bf16x8*)(c1 + 32 * ks); } }
            float mx = -1e30f;
#pragma unroll
            for (int r = 0; r < 4; ++r) {
                { const int slot = 32 * st + 4 * g + r; const int dist = t - (int)IDX[slot]; const float lg = s0[r] * scale + RL[BK[dist < 0 ? 0 : dist] * 8 + 4 + hd]; s0[r] = (slot < nsel) ? lg : -1e30f; mx = fmaxf(mx, s0[r]); }
                { const int slot = 32 * st + 16 + 4 * g + r; const int dist = t - (int)IDX[slot]; const float lg = s1[r] * scale + RL[BK[dist < 0 ? 0 : dist] * 8 + 4 + hd]; s1[r] = (slot < nsel) ? lg : -1e30f; mx = fmaxf(mx, s1[r]); } }
            mx = fmaxf(mx, __shfl_xor(mx, 16)); mx = fmaxf(mx, __shfl_xor(mx, 32));
            const float mnew = fmaxf(mrun, mx), alpha = __expf(mrun - mnew); mrun = mnew;
            float ps = 0.f;
#pragma unroll
            for (int r = 0; r < 4; ++r) { const float p0 = (s0[r] > -1e29f) ? __expf(s0[r] - mnew) : 0.f, p1 = (s1[r] > -1e29f) ? __expf(s1[r] - mnew) : 0.f; s0[r] = p0; s1[r] = p1; ps += p0 + p1; }
            lsum = lsum * alpha + ps;
#pragma unroll
            for (int rt = 0; rt < 16; ++rt) oacc[rt] = oacc[rt] * alpha;
            u32x4 pt; pt.x = cvt_pk_bf16(s0[0], s0[1]); pt.y = cvt_pk_bf16(s0[2], s0[3]); pt.z = cvt_pk_bf16(s1[0], s1[1]); pt.w = cvt_pk_bf16(s1[2], s1[3]);
            const bf16x8 pb = __builtin_bit_cast(bf16x8, pt);
#pragma unroll
            for (int rt = 0; rt < 16; ++rt) {
                const LAS unsigned char* va = CT + (4 * g + (fr >> 2)) * 528 + (16 * rt + 4 * (fr & 3)) * 2;
                const v4i16_t lo = lds_tr16(va), hi = lds_tr16(va + 16 * 528);
                const bf16x8 a = {lo[0], lo[1], lo[2], lo[3], hi[0], hi[1], hi[2], hi[3]};
                oacc[rt] = __builtin_amdgcn_mfma_f32_16x16x32_bf16(a, pb, oacc[rt], 0, 0, 0); }
        }
        lsum += __shfl_xor(lsum, 16); lsum += __shfl_xor(lsum, 32);
        const float inv = 1.f / lsum;
        mfma_fence(oacc[0], oacc[1], oacc[2], oacc[3]); mfma_fence(oacc[4], oacc[5], oacc[6], oacc[7]); mfma_fence(oacc[8], oacc[9], oacc[10], oacc[11]); mfma_fence(oacc[12], oacc[13], oacc[14], oacc[15]);
        if (fr < 4) {
            bf16_t* yo = PROBE ? ((bf16_t*)((unsigned char*)p.x + 32 * MiB) + (size_t)tg * 1024 + fr * 256 + 4 * g) : (Y + (size_t)tg * 2048 + 1024 + fr * 256 + 4 * g);
#pragma unroll
            for (int rt = 0; rt < 16; ++rt) { u32x2 o; o.x = cvt_pk_bf16(oacc[rt][0] * inv, oacc[rt][1] * inv); o.y = cvt_pk_bf16(oacc[rt][2] * inv, oacc[rt][3] * inv); *(u32x2*)(yo + 16 * rt) = o; }
        }
    }
}

__device__ __forceinline__ Params opq(const Params& p) { Params q = p; asm volatile("" : "+s"(q.ws), "+s"(q.x)); return q; }
__device__ __forceinline__ int opqi(int v) { asm volatile("" : "+s"(v)); return v; }
#define GRID_BARRIER() do { XcdBarrier _b; _b.bar = (unsigned*)(opq(p).ws + OFF_CTL); _b.x = xb_xcc_id(); _b.st = (volatile LAS unsigned*)(lds + LDS_PHASE_BYTES); xcd_barrier(_b); } while (0)
#define PP opq(p)
#define BB opqi(bid)
__device__ __forceinline__ void layer_body(const Params& p, LAS unsigned char* lds, const int bid, const int nb, const int l) {
        for (int rep = 0; rep < opqi(MK_PROBE == 1 ? 2 : 1); ++rep) phase_gemm_in(PP, lds, BB, nb);
        GRID_BARRIER();
        phase_prep(PP, l, lds, BB, nb);
        for (int rep = 0; rep < opqi(MK_PROBE == 6 ? 2 : 1); ++rep) phase_hg1(PP, l, lds, BB, nb);
        GRID_BARRIER();
        phase_hg2(PP, BB, nb);
        phase_moba(PP, lds, BB, nb);
        for (int rep = 0; rep < opqi(MK_PROBE == 4 ? 2 : 1); ++rep) phase_dsel(PP, lds, BB, nb);
#if MK_PROBE == 2
        if (l == 0) phase_moba<1>(PP, lds, BB, nb);
#endif
        GRID_BARRIER();
#if MK_PROBE == 3
        if (l == 0) phase_datt<1>(PP, lds, BB, nb);
#endif
#if MK_PROBE == 6
        if (l == 0) phase_hg3<1>(PP, l, lds, BB, nb);
#endif
        phase_hg3(PP, l, lds, BB, nb);
        phase_datt(PP, lds, BB, nb);
        GRID_BARRIER();
        for (int rep = 0; rep < opqi(MK_PROBE == 5 ? 2 : 1); ++rep) phase_conv_post(PP, l, lds, BB, nb);
        GRID_BARRIER();
        for (int rep = 0; rep < opqi(MK_PROBE == 1 ? 2 : 1); ++rep) phase_gemm_gates(PP, lds, BB, nb);
        GRID_BARRIER();
        for (int rep = 0; rep < opqi(MK_PROBE == 1 ? 2 : 1); ++rep) phase_gemm_branch(PP, lds, BB, nb);
        GRID_BARRIER();
        for (int rep = 0; rep < opqi(MK_PROBE == 1 ? 2 : 1); ++rep) phase_gemm_out(PP, lds, BB, nb);
        GRID_BARRIER();
        { const Params q = PP; phase_norm<1>(l == 0 ? q.in[I_X] : q.x, q.x, F32P(q, OFF_OUT), q.in[I_POSTMIX] + l * 1024, q.in[I_PREFFN] + l * 1024, BF(q, OFF_H), BB, nb); }
        GRID_BARRIER();
        for (int rep = 0; rep < opqi(MK_PROBE == 1 ? 2 : 1); ++rep) phase_gemm_ffn1(PP, lds, BB, nb);
        GRID_BARRIER();
        for (int rep = 0; rep < opqi(MK_PROBE == 1 ? 2 : 1); ++rep) phase_gemm_ffn2(PP, lds, BB, nb);
        GRID_BARRIER();
        if (l + 1 < DEPTH) { { const Params q = PP; phase_norm<1>(q.x, q.x, F32P(q, OFF_OUT), q.in[I_POSTFFN] + l * 1024, q.in[I_PREMIX] + (l + 1) * 1024, BF(q, OFF_H), BB, nb); } phase_conv_in(PP, l + 1, lds, BB, nb); GRID_BARRIER(); }
        else { const Params q = PP; phase_norm<2>(q.x, q.x, F32P(q, OFF_OUT), q.in[I_POSTFFN] + l * 1024, nullptr, nullptr, BB, nb); }
}
__global__ __launch_bounds__(512, 2) void mega_fwd(Params p) {
    extern __shared__ __attribute__((aligned(16))) unsigned char shm[];
    LAS unsigned char* lds = (LAS unsigned char*)shm;
    const int bid = blockIdx.x, nb = gridDim.x;
    volatile LAS unsigned* xbw = (volatile LAS unsigned*)(lds + LDS_PHASE_BYTES);
    if (threadIdx.x < 4) xbw[threadIdx.x] = 0u;
    __syncthreads();
    (void)xcd_barrier_post((unsigned*)(p.ws + OFF_CTL), xbw);
    { const Params q = PP; phase_norm<0>(q.in[I_X], nullptr, nullptr, nullptr, q.in[I_PREMIX], BF(q, OFF_H), BB, nb); }
    phase_conv_in(PP, 0, lds, BB, nb);
    GRID_BARRIER();
    for (int l = 0; l < DEPTH; ++l) layer_body(p, lds, bid, nb, l);
}

#define LDS_BYTES (LDS_PHASE_BYTES + 16)
extern "C" void kernel_launch(void* const* d_in, const int* in_sizes, int n_in, void* d_out, int out_size, void* d_ws, size_t ws_size, hipStream_t stream) {
    static int grid = 0;
    if (grid == 0) {
        int dev = 0, cus = 0;
        if (hipGetDevice(&dev) != hipSuccess || hipDeviceGetAttribute(&cus, hipDeviceAttributeMultiprocessorCount, dev) != hipSuccess || cus < 1) { fprintf(stderr, "kernel_launch: no device info\n"); grid = -1; return; }
        if (hipFuncSetAttribute((const void*)mega_fwd, hipFuncAttributeMaxDynamicSharedMemorySize, LDS_BYTES) != hipSuccess) { fprintf(stderr, "kernel_launch: hipFuncSetAttribute failed\n"); grid = -1; return; }
        int per_cu = 0;
        if (hipOccupancyMaxActiveBlocksPerMultiprocessor(&per_cu, (const void*)mega_fwd, 512, LDS_BYTES) != hipSuccess || per_cu < 1) { fprintf(stderr, "kernel_launch: occupancy query says %d blocks per CU\n", per_cu); }
        (void)hipGetLastError();
        grid = cus;
    }
    if (grid < 0) return;
    Params p{};
    for (int i = 0; i < 20; ++i) p.in[i] = (const float*)d_in[i];
    p.x = (float*)d_out; p.ws = (unsigned char*)d_ws;
    if (WS_NEED > ws_size) { fprintf(stderr, "kernel_launch: workspace too small (%zu < %zu)\n", ws_size, (size_t)WS_NEED); return; }
    (void)hipMemsetAsync(p.ws + OFF_CTL, 0, 16384, stream);
    hipLaunchKernelGGL(mega_fwd, dim3(grid), dim3(512), LDS_BYTES, stream, p);
}
```

```cpp
#include <hip/hip_runtime.h>
#include <stdint.h>
#include <stdio.h>

#define D_MODEL 1024
#define BATCH 4
#define SEQ 4096
#define NTOK 16384
#define DEPTH 2
#define IN_W 8008
#define D_FF 2816
#define NEG_BIG (-1e30f)
#define C_HQ 0
#define C_HF 512
#define C_HI 1024
#define C_HG 1536
#define C_MQ 2048
#define C_MK 2560
#define C_MV 3072
#define C_DQ 3584
#define C_DKV 4096
#define C_IQ 4352
#define C_IK 4864
#define C_IW 4928
#define C_G 4936
#define NP1 5632

#define LAS __attribute__((address_space(3)))
typedef unsigned short bf16_t;
typedef short bf16x8 __attribute__((ext_vector_type(8)));
typedef float f32x4 __attribute__((ext_vector_type(4)));
typedef unsigned u32x4 __attribute__((ext_vector_type(4)));
typedef unsigned u32x2 __attribute__((ext_vector_type(2)));

__device__ __forceinline__ float sigmoidf_(float x) { return 1.f / (1.f + __expf(-x)); }
__device__ __forceinline__ float bf2f(bf16_t b) { return __uint_as_float(((unsigned)b) << 16); }
typedef __bf16 bf16x2_t __attribute__((ext_vector_type(2)));
typedef float f32x2_t __attribute__((ext_vector_type(2)));
__device__ __forceinline__ unsigned cvt_pk_bf16(float lo, float hi) { const f32x2_t f = {lo, hi}; const bf16x2_t v = __builtin_convertvector(f, bf16x2_t); return __builtin_bit_cast(unsigned, v); }
__device__ __forceinline__ bf16_t f2bf(float f) { return (bf16_t)(cvt_pk_bf16(f, 0.f) & 0xffffu); }
__device__ __forceinline__ int phase_tid() { int t = threadIdx.x; asm volatile("" : "+v"(t)); return t; }
__device__ __forceinline__ void mfma_fence(f32x4& a) { asm volatile("s_nop 15\n\ts_nop 3" : "+v"(a)); }
__device__ __forceinline__ void mfma_fence(f32x4& a, f32x4& b, f32x4& c, f32x4& d) { asm volatile("s_nop 15\n\ts_nop 3" : "+v"(a), "+v"(b), "+v"(c), "+v"(d)); }
__device__ __forceinline__ int rel_bucket(int dist) {
    int n = dist > 0 ? dist : 0;
    if (n < 16) return n;
    float nf = (float)n;
    int large = 16 + (int)(logf(nf / 16.f) / 4.852030263919617f * 16.f);
    return large < 31 ? large : 31;
}

enum { I_X = 0, I_WIN, I_PREMIX, I_POSTMIX, I_PREFFN, I_POSTFFN, I_LB, I_HGNW, I_KVN, I_WUK, I_WUV, I_IKNW, I_IKNB, I_REL, I_WA, I_WB, I_WC, I_WOUT, I_WF1, I_WF2 };
struct Params { const float* in[20]; float* x; unsigned char* ws; };
constexpr size_t MiB = 1024 * 1024;
#define LDS_PHASE_BYTES (150 * 1024)
#ifndef MK_PROBE
#define MK_PROBE 0
#endif
constexpr size_t OFF_CTL = 0, OFF_Y = 65536, OFF_HF = OFF_Y + 64 * MiB, OFF_HI = OFF_HF + 16 * MiB, OFF_HG = OFF_HI + 16 * MiB, OFF_MK = OFF_HG + 16 * MiB,
                 OFF_MV = OFF_MK + 16 * MiB, OFF_IQ = OFF_MV + 16 * MiB, OFF_CKV = OFF_IQ + 16 * MiB, OFF_IKW = OFF_CKV + 8 * MiB, OFF_H = OFF_IKW + 4 * MiB,
                 OFF_WIN = OFF_H + 32 * MiB, OFF_RS = OFF_WIN + 11 * MiB;
constexpr size_t OFF_WG = OFF_WIN, OFF_WBR = OFF_WG + 6 * MiB, OFF_WOUT = OFF_RS, OFF_WF1 = OFF_WOUT + 2 * MiB, OFF_WF2 = OFF_WF1 + 11 * MiB, OFF_WEND = OFF_WF2 + 6 * MiB;
constexpr size_t OFF_ST = OFF_RS, OFF_TMPF = OFF_RS, OFF_DEC = OFF_ST + 32 * MiB, OFF_MASK = OFF_DEC + MiB / 2, OFF_KMEAN = OFF_MASK + 8 * MiB, OFF_MEND = OFF_KMEAN + MiB / 8;
constexpr size_t OFF_OUT = OFF_HG, OFF_ACT = OFF_Y;
constexpr size_t WS_NEED = (OFF_WEND > OFF_MEND ? OFF_WEND : OFF_MEND);
#define BF(p, off) ((bf16_t*)((p).ws + (off)))
#define F32P(p, off) ((float*)((p).ws + (off)))
__device__ const unsigned long long kP1Off[22] = {OFF_Y, OFF_Y, OFF_HF, OFF_HF, OFF_HI, OFF_HI, OFF_HG, OFF_HG, OFF_Y, OFF_Y, OFF_MK, OFF_MK, OFF_MV, OFF_MV, OFF_Y, OFF_Y, OFF_Y, OFF_Y, OFF_CKV, OFF_IQ, OFF_IQ, OFF_IKW};
__device__ const int kP1Ld[22]  = {2048, 2048, 512, 512, 512, 512, 512, 512, 2048, 2048, 512, 512, 512, 512, 2048, 2048, 2048, 2048, 256, 512, 512, 128};
__device__ const int kP1C0[22]  = {0, 256, 0, 256, 0, 256, 0, 256, 512, 768, 0, 256, 0, 256, 1024, 1280, 1536, 1792, 0, 0, 256, 0};
__device__ const int kP1Nc[22]  = {256, 256, 256, 256, 256, 256, 256, 256, 256, 256, 256, 256, 256, 256, 256, 256, 256, 256, 256, 256, 256, 128};

#define XB_TMO      128
#define XB_XCNT(j)  (256  + 64 * (j))
#define XB_XSUB(j)  (1280 + 64 * (j))
#define XB_XGEN(j)  (2304 + 64 * (j))
#define XB_TOP      3328
#define XB_TOPGEN   3392
#define XCD_BAR_WORDS 3456
#define XB_SPIN_CAP (1u << 18)

__device__ __forceinline__ unsigned xb_ld(unsigned* p)              { return __hip_atomic_load(p, __ATOMIC_RELAXED, __HIP_MEMORY_SCOPE_AGENT); }
__device__ __forceinline__ unsigned xb_add(unsigned* p, unsigned v) { return __hip_atomic_fetch_add(p, v, __ATOMIC_RELAXED, __HIP_MEMORY_SCOPE_AGENT); }
__device__ __forceinline__ unsigned xb_xcc_id() { return (unsigned)__builtin_amdgcn_s_getreg((3 << 11) | 20) & 0xFu; }
#define XB_SPIN(cond, bar) do { unsigned _sp = 0; while (cond) { __builtin_amdgcn_s_sleep(1); \
    if ((++_sp & 255u) == 0u) { if (xb_ld(&(bar)[XB_TMO])) break; if (_sp > XB_SPIN_CAP) { atomicAdd(&(bar)[XB_TMO], 1u); break; } } } } while (0)

struct XcdBarrier {
    unsigned* bar; unsigned x;
    volatile LAS unsigned* st;
};

__device__ __forceinline__ XcdBarrier xcd_barrier_post(unsigned* bar, volatile LAS unsigned* st) {
    XcdBarrier b; b.bar = bar; b.x = xb_xcc_id(); b.st = st;
    if (threadIdx.x == 0) (void)xb_add(&bar[XB_XCNT(b.x)], 1u);
    return b;
}
__device__ __forceinline__ void xcd_barrier_complete(unsigned* bar, unsigned x, unsigned& nloc, unsigned& nx) {
    const unsigned G = gridDim.x * gridDim.y * gridDim.z;
    unsigned sum, cnt, mine, sp = 0u;
    for (;;) {
        sum = 0u; cnt = 0u; mine = 0u;
#pragma unroll
        for (unsigned j = 0; j < 16; ++j) { const unsigned c = xb_ld(&bar[XB_XCNT(j)]); sum += c; cnt += (c > 0u) ? 1u : 0u; mine = (j == x) ? c : mine; }
        if (sum == G) break;
        __builtin_amdgcn_s_sleep(1);
        if ((++sp & 255u) == 0u) { if (xb_ld(&bar[XB_TMO])) break; if (sp > XB_SPIN_CAP) { atomicAdd(&bar[XB_TMO], 1u); break; } }
    }
    nloc = mine > 0u ? mine : 1u; nx = cnt > 0u ? cnt : 1u;
}

__device__ __forceinline__ void xcd_barrier(const XcdBarrier& b) {
    asm volatile("s_waitcnt vmcnt(0)" ::: "memory");
    __syncthreads();
    if (threadIdx.x == 0) {
        unsigned* bar = b.bar;
        __builtin_amdgcn_s_waitcnt(0);
        unsigned nloc = b.st[0], nx = b.st[1];
        if (nloc == 0u) { xcd_barrier_complete(bar, b.x, nloc, nx); b.st[0] = nloc; b.st[1] = nx; }
        const unsigned old = xb_add(&bar[XB_XSUB(b.x)], 1u);
        const unsigned gen = old / nloc;
        if (old + 1u == (gen + 1u) * nloc) {
            __builtin_amdgcn_fence(__ATOMIC_RELEASE, "agent");
            asm volatile("s_waitcnt vmcnt(0)" ::: "memory");
            const unsigned og = xb_add(&bar[XB_TOP], 1u);
            const unsigned tg = og / nx;
            if (og + 1u == (tg + 1u) * nx) xb_add(&bar[XB_TOPGEN], 1u);
            else XB_SPIN(xb_ld(&bar[XB_TOPGEN]) == tg, bar);
            __builtin_amdgcn_fence(__ATOMIC_ACQUIRE, "agent");
            xb_add(&bar[XB_XGEN(b.x)], 1u);
            asm volatile("s_waitcnt vmcnt(0)" ::: "memory");
        } else {
            XB_SPIN(xb_ld(&bar[XB_XGEN(b.x)]) == gen, bar);
            __builtin_amdgcn_fence(__ATOMIC_ACQUIRE, "agent");
            asm volatile("s_waitcnt vmcnt(0)" ::: "memory");
        }
    }
    __syncthreads();
}


namespace pg8 {
constexpr int BM = 256, BK = 64, HALF = 128, HTB = HALF * BK * 2, STAGE_BYTES = 8 * HTB, NXCD = 8, WGM = 8;
__host__ __device__ __forceinline__ int lds_byte(int r, int c) { const int st = (r >> 4) * 2 + (c >> 5), rr = r & 15, cc = c & 31, ob = rr * 64 + cc * 2; return st * 1024 + (ob ^ (((ob >> 9) & 1) << 5)); }
__host__ __device__ __forceinline__ void stage_rc(int b, int& R, int& C) { const int st = b / 1024, sb = b % 1024, swz = sb ^ (((sb >> 9) & 1) << 5); R = (st >> 1) * 16 + swz / 64; C = (st & 1) * 32 + (swz % 64) / 2; }
__host__ __device__ __forceinline__ int perm32(int rho) { const int n = rho >> 4, i = rho & 15; return 8 * (i >> 2) + 4 * n + (i & 3); }

struct Unit { int pm, pn, ka, nt, br; };
struct Gemm { const bf16_t* A; const bf16_t* Bt; int lda, ldb; };

__device__ __forceinline__ bool tile_of(long L, int nM, int nN, int& pm, int& pn) {
    const int nwg = nM * nN; if (L >= nwg) return false;
    int wgid = (int)L; { const int q = nwg / NXCD, r = nwg % NXCD, xcd = wgid % NXCD, off = wgid / NXCD; wgid = (xcd < r ? xcd * (q + 1) : r * (q + 1) + (xcd - r) * q) + off; }
    const int nig = WGM * nN, gid = wgid / nig, fm = gid * WGM, gsz = (nM - fm) < WGM ? (nM - fm) : WGM;
    pm = fm + ((wgid % nig) % gsz); pn = (wgid % nig) / gsz; return true;
}
struct StaticOrder {
    int nM, nN, G, c, nt;
    __device__ void init(int M, int N, int K, int G_, int c_) { nM = M / BM; nN = N / BM; G = G_; c = c_; nt = K / BK; }
    __device__ bool next(int i, Unit& u) const { u.ka = 0; u.nt = nt; u.br = 0; return tile_of((long)i * G + c, nM, nN, u.pm, u.pn); }
};
struct BranchOrder {
    int nM, nN, G, c;
    __device__ void init(int M, int N, int G_, int c_) { nM = M / BM; nN = N / BM; G = G_; c = c_; }
    __device__ bool next(int i, Unit& u) const { const int ti = i / 3, br = i - ti * 3; u.br = br; u.ka = br * 512; u.nt = (br == 2) ? 16 : 8; return tile_of((long)ti * G + c, nM, nN, u.pm, u.pn); }
};

template <class Epi, class Sched>
__device__ __forceinline__ void gemm_phase(LAS unsigned char* lds, const Gemm g, const Sched& S, const Epi& E) {
    const int tid = phase_tid(), wid = __builtin_amdgcn_readfirstlane(tid >> 6), lane = tid & 63, wr = wid >> 2, wc = wid & 3, fr = lane & 15, fq = lane >> 4;
    unsigned voffA[2], voffB[2];
#pragma unroll
    for (int i = 0; i < 2; ++i) { int R, C; stage_rc(tid * 16 + i * 8192, R, C); const int Rb = Epi::PERM ? ((R & ~31) + perm32(R & 31)) : R;
        voffA[i] = (unsigned)(R * g.lda + C) * 2u; voffB[i] = (unsigned)(Rb * g.ldb + C) * 2u; }
    const size_t kstep = (size_t)(BK * 2);
    const size_t hsA = (size_t)HALF * g.lda * 2, hsB = (size_t)HALF * g.ldb * 2;
    const size_t tsA = 2 * hsA, tsB = 2 * hsB;
    const unsigned ldsw = (unsigned)wid * 1024u;
    const int aoff = lds_byte(wr * 64 + fr, fq * 8), boff = lds_byte(wc * 32 + fr, fq * 8);
#define PG8_SA(b, h) (((b) * 2 + (h)) * HTB)
#define PG8_SB(b, h) ((4 + (b) * 2 + (h)) * HTB)
#define PG8_STAGE(bufoff, gbase, voff) do { _Pragma("unroll") for (int _i = 0; _i < 2; ++_i) \
        __builtin_amdgcn_global_load_lds((const unsigned*)((const char*)(gbase) + (voff)[_i]), (LAS unsigned*)(lds + (bufoff) + ldsw + _i * 8192), 16, 0, 0); } while (0)
#define PG8_LDA(dst, b, h) do { _Pragma("unroll") for (int m = 0; m < 4; ++m) _Pragma("unroll") for (int k = 0; k < 2; ++k) dst[m][k] = *(const LAS bf16x8*)(lds + PG8_SA(b, h) + aoff + m * 2048 + k * 1024); } while (0)
#define PG8_LDB(dst, b, h) do { _Pragma("unroll") for (int n = 0; n < 2; ++n) _Pragma("unroll") for (int k = 0; k < 2; ++k) dst[n][k] = *(const LAS bf16x8*)(lds + PG8_SB(b, h) + boff + n * 2048 + k * 1024); } while (0)
#define PG8_MMA(ai, bj, At, Bt) do { __builtin_amdgcn_s_setprio(1); _Pragma("unroll") for (int m = 0; m < 4; ++m) _Pragma("unroll") for (int n = 0; n < 2; ++n) _Pragma("unroll") for (int k = 0; k < 2; ++k) \
        acc[ai][bj][m][n] = __builtin_amdgcn_mfma_f32_16x16x32_bf16(Bt[n][k], At[m][k], acc[ai][bj][m][n], 0, 0, 0); __builtin_amdgcn_s_setprio(0); } while (0)
#define PG8_WAIT_V(n) asm volatile("s_waitcnt vmcnt(" #n ")" ::: "memory")
#define PG8_WAIT_L(n) asm volatile("s_waitcnt lgkmcnt(" #n ")" ::: "memory")
#define PG8_BAR __builtin_amdgcn_s_barrier()
#define PG8_SCHED __builtin_amdgcn_sched_barrier(0)
    Unit cur, nxt; int ui = 0;
    if (!S.next(0, cur)) return;
    f32x4 acc[2][2][4][2];
#pragma unroll
    for (int a = 0; a < 2; ++a)
#pragma unroll
        for (int b = 0; b < 2; ++b)
#pragma unroll
            for (int m = 0; m < 4; ++m)
#pragma unroll
                for (int n = 0; n < 2; ++n) acc[a][b][m][n] = (f32x4){0.f, 0.f, 0.f, 0.f};
    bf16x8 At[4][2], B0[2][2], B1[2][2];
    const char* cA = (const char*)g.A + (size_t)cur.pm * tsA + (size_t)cur.ka * 2; const char* cB = (const char*)g.Bt + (size_t)cur.pn * tsB + (size_t)cur.ka * 2;
    PG8_STAGE(PG8_SB(0, 0), cB, voffB); PG8_STAGE(PG8_SA(0, 0), cA, voffA); PG8_STAGE(PG8_SB(0, 1), cB + hsB, voffB); PG8_STAGE(PG8_SA(0, 1), cA + hsA, voffA);
    if (wr == 1) PG8_BAR;
    PG8_WAIT_V(4); PG8_BAR;
    PG8_STAGE(PG8_SB(1, 0), cB + kstep, voffB); PG8_STAGE(PG8_SA(1, 0), cA + kstep, voffA); PG8_STAGE(PG8_SB(1, 1), cB + hsB + kstep, voffB);
    PG8_WAIT_V(6); PG8_BAR;
    for (;;) {
        const bool has_next = S.next(ui + 1, nxt);
        const char* nA = has_next ? (const char*)g.A + (size_t)nxt.pm * tsA + (size_t)nxt.ka * 2 : cA; const char* nB = has_next ? (const char*)g.Bt + (size_t)nxt.pn * tsB + (size_t)nxt.ka * 2 : cB;
        const int nt = cur.nt;
        for (int t = 0; t < nt; t += 2) {
            const bool last = (t == nt - 2);
            const char* a1 = cA + (size_t)(t + 1) * kstep;
            const char* a2 = last ? nA : cA + (size_t)(t + 2) * kstep; const char* b2 = last ? nB : cB + (size_t)(t + 2) * kstep;
            const char* a3 = a2 + kstep; const char* b3 = b2 + kstep;
            PG8_LDB(B0, 0, 0); PG8_SCHED; PG8_LDA(At, 0, 0); PG8_STAGE(PG8_SA(1, 1), a1 + hsA, voffA);
            PG8_WAIT_L(8); PG8_BAR; PG8_WAIT_L(0); PG8_MMA(0, 0, At, B0); PG8_BAR; PG8_SCHED;
            PG8_LDB(B1, 0, 1); PG8_STAGE(PG8_SB(0, 0), b2, voffB);
            PG8_BAR; PG8_WAIT_L(0); PG8_MMA(0, 1, At, B1); PG8_BAR;
            PG8_LDA(At, 0, 1); PG8_STAGE(PG8_SA(0, 0), a2, voffA);
            PG8_BAR; PG8_WAIT_L(0); PG8_MMA(1, 0, At, B0); PG8_BAR; PG8_SCHED;
            PG8_STAGE(PG8_SB(0, 1), b2 + hsB, voffB);
            PG8_WAIT_V(6); PG8_BAR; PG8_MMA(1, 1, At, B1); PG8_BAR;
            PG8_LDB(B0, 1, 0); PG8_SCHED; PG8_LDA(At, 1, 0); PG8_STAGE(PG8_SA(0, 1), a2 + hsA, voffA);
            PG8_WAIT_L(8); PG8_BAR; PG8_WAIT_L(0); PG8_MMA(0, 0, At, B0); PG8_BAR; PG8_SCHED;
            PG8_LDB(B1, 1, 1); PG8_STAGE(PG8_SB(1, 0), b3, voffB);
            PG8_BAR; PG8_WAIT_L(0); PG8_MMA(0, 1, At, B1); PG8_BAR;
            PG8_LDA(At, 1, 1); PG8_STAGE(PG8_SA(1, 0), a3, voffA);
            PG8_BAR; PG8_WAIT_L(0); PG8_MMA(1, 0, At, B0); PG8_BAR; PG8_SCHED;
            PG8_STAGE(PG8_SB(1, 1), b3 + hsB, voffB);
            PG8_WAIT_V(6); PG8_BAR; PG8_MMA(1, 1, At, B1); PG8_BAR;
        }
        E(acc, cur, wr, wc, fr, fq);
        if (!has_next) break;
#pragma unroll
        for (int a = 0; a < 2; ++a)
#pragma unroll
            for (int b = 0; b < 2; ++b)
#pragma unroll
                for (int m = 0; m < 4; ++m)
#pragma unroll
                    for (int n = 0; n < 2; ++n) acc[a][b][m][n] = (f32x4){0.f, 0.f, 0.f, 0.f};
        cur = nxt; cA = nA; cB = nB; ++ui;
    }
    PG8_WAIT_V(0);
    if (wr == 0) PG8_BAR;
    PG8_BAR;
#undef PG8_SA
#undef PG8_SB
#undef PG8_STAGE
#undef PG8_LDA
#undef PG8_LDB
#undef PG8_MMA
#undef PG8_WAIT_V
#undef PG8_WAIT_L
#undef PG8_BAR
#undef PG8_SCHED
}

struct EpiF32 {
    static constexpr bool PERM = false;
    float* C; int ldc;
    __device__ __forceinline__ void operator()(const f32x4 (&acc)[2][2][4][2], const Unit& u, int wr, int wc, int fr, int fq) const {
        const int row0 = u.pm * BM + wr * 64 + fr, col0 = u.pn * BM + wc * 32 + 4 * fq;
#pragma unroll
        for (int ai = 0; ai < 2; ++ai)
#pragma unroll
            for (int m = 0; m < 4; ++m) { float* rowp = C + (size_t)(row0 + ai * HALF + m * 16) * ldc + col0;
#pragma unroll
                for (int bj = 0; bj < 2; ++bj)
#pragma unroll
                    for (int n = 0; n < 2; ++n) *(f32x4*)(rowp + bj * HALF + n * 16) = acc[ai][bj][m][n]; }
    }
};
struct EpiProj {
    static constexpr bool PERM = true;
    unsigned char* ws;
    __device__ __forceinline__ void operator()(const f32x4 (&acc)[2][2][4][2], const Unit& u, int wr, int wc, int fr, int fq) const {
        bf16_t* base = (bf16_t*)(ws + kP1Off[u.pn]); const int ld = kP1Ld[u.pn], ncol = kP1Nc[u.pn];
        const int row0 = u.pm * BM + wr * 64 + fr, col0 = kP1C0[u.pn] + wc * 32 + 8 * fq;
#pragma unroll
        for (int ai = 0; ai < 2; ++ai)
#pragma unroll
            for (int m = 0; m < 4; ++m) { bf16_t* rowp = base + (size_t)(row0 + ai * HALF + m * 16) * ld + col0;
#pragma unroll
                for (int bj = 0; bj < 2; ++bj) { if (bj * HALF >= ncol) continue;
                    const f32x4 v0 = acc[ai][bj][m][0], v1 = acc[ai][bj][m][1];
                    u32x4 w; w.x = cvt_pk_bf16(v0[0], v0[1]); w.y = cvt_pk_bf16(v0[2], v0[3]); w.z = cvt_pk_bf16(v1[0], v1[1]); w.w = cvt_pk_bf16(v1[2], v1[3]);
                    *(u32x4*)(rowp + bj * HALF) = w; } }
    }
};
struct EpiGate {
    static constexpr bool PERM = true;
    bf16_t* G0;
    __device__ __forceinline__ void operator()(const f32x4 (&acc)[2][2][4][2], const Unit& u, int wr, int wc, int fr, int fq) const {
        bf16_t* base = G0 + (size_t)(u.pn >> 1) * ((size_t)NTOK * 512);
        const int row0 = u.pm * BM + wr * 64 + fr, col0 = (u.pn & 1) * 256 + wc * 32 + 8 * fq;
#pragma unroll
        for (int ai = 0; ai < 2; ++ai)
#pragma unroll
            for (int m = 0; m < 4; ++m) { bf16_t* rowp = base + (size_t)(row0 + ai * HALF + m * 16) * 512 + col0;
#pragma unroll
                for (int bj = 0; bj < 2; ++bj) {
                    f32x4 v0 = acc[ai][bj][m][0], v1 = acc[ai][bj][m][1];
#pragma unroll
                    for (int j = 0; j < 4; ++j) { v0[j] = sigmoidf_(v0[j]); v1[j] = sigmoidf_(v1[j]); }
                    u32x4 w; w.x = cvt_pk_bf16(v0[0], v0[1]); w.y = cvt_pk_bf16(v0[2], v0[3]); w.z = cvt_pk_bf16(v1[0], v1[1]); w.w = cvt_pk_bf16(v1[2], v1[3]);
                    *(u32x4*)(rowp + bj * HALF) = w; } }
    }
};
struct EpiSwiglu {
    static constexpr bool PERM = true;
    bf16_t* O; int ldc;
    __device__ __forceinline__ void operator()(const f32x4 (&acc)[2][2][4][2], const Unit& u, int wr, int wc, int fr, int fq) const {
        const int row0 = u.pm * BM + wr * 64 + fr, col0 = u.pn * HALF + wc * 32 + 8 * fq;
#pragma unroll
        for (int ai = 0; ai < 2; ++ai)
#pragma unroll
            for (int m = 0; m < 4; ++m) { bf16_t* rowp = O + (size_t)(row0 + ai * HALF + m * 16) * ldc + col0;
                float r[8];
#pragma unroll
                for (int n = 0; n < 2; ++n)
#pragma unroll
                    for (int j = 0; j < 4; ++j) { const float gv = acc[ai][0][m][n][j], uv = acc[ai][1][m][n][j]; r[n * 4 + j] = gv * sigmoidf_(gv) * uv; }
                u32x4 w; w.x = cvt_pk_bf16(r[0], r[1]); w.y = cvt_pk_bf16(r[2], r[3]); w.z = cvt_pk_bf16(r[4], r[5]); w.w = cvt_pk_bf16(r[6], r[7]);
                *(u32x4*)rowp = w; }
    }
};
struct EpiBranch {
    static constexpr bool PERM = true;
    bf16_t* Mg; const bf16_t* G0;
    __device__ __forceinline__ void operator()(const f32x4 (&acc)[2][2][4][2], const Unit& u, int wr, int wc, int fr, int fq) const {
        const bf16_t* gb = G0 + (size_t)(u.br * 2 + (u.pn >> 1)) * ((size_t)NTOK * 512);
        const int row0 = u.pm * BM + wr * 64 + fr, cl = wc * 32 + 8 * fq;
#pragma unroll
        for (int ai = 0; ai < 2; ++ai)
#pragma unroll
            for (int m = 0; m < 4; ++m) { const size_t row = (size_t)(row0 + ai * HALF + m * 16);
#pragma unroll
                for (int bj = 0; bj < 2; ++bj) {
                    const u32x4 gw = *(const u32x4*)(gb + row * 512 + (u.pn & 1) * 256 + bj * HALF + cl);
                    bf16_t* mp = Mg + row * 1024 + u.pn * 256 + bj * HALF + cl;
                    float r[8];
#pragma unroll
                    for (int q = 0; q < 4; ++q) { const unsigned g2 = gw[q]; const int n = q >> 1, j = (q & 1) * 2;
                        r[q * 2] = __uint_as_float(g2 << 16) * acc[ai][bj][m][n][j]; r[q * 2 + 1] = __uint_as_float(g2 & 0xffff0000u) * acc[ai][bj][m][n][j + 1]; }
                    if (u.br != 0) { u32x4 ow;
#pragma unroll
                        for (int q = 0; q < 4; ++q) ow[q] = __hip_atomic_load((const unsigned*)mp + q, __ATOMIC_RELAXED, __HIP_MEMORY_SCOPE_AGENT);
#pragma unroll
                        for (int q = 0; q < 4; ++q) { r[q * 2] += __uint_as_float(ow[q] << 16); r[q * 2 + 1] += __uint_as_float(ow[q] & 0xffff0000u); } }
                    u32x4 w; w.x = cvt_pk_bf16(r[0], r[1]); w.y = cvt_pk_bf16(r[2], r[3]); w.z = cvt_pk_bf16(r[4], r[5]); w.w = cvt_pk_bf16(r[6], r[7]);
                    *(u32x4*)mp = w; } }
    }
};
}

template <int MAP> __device__ __forceinline__ int colmap(int n, int off) {
    if (MAP == 0) return n + off;
    if (MAP == 1) { if (n < 3584) return n; const int s = n - 512; return s < C_G ? s : -1; }
    const int pn = n >> 8, r = n & 255; return (r < 128) ? 128 * pn + r : D_FF + 128 * pn + (r - 128);
}
template <int MAP>
__device__ void conv_job(LAS unsigned char* lds, bf16_t* dst, int ld_dst, int koff, const float* src, int ld_src, int K, int n_lo, int n_hi, int off, int bid, int nb) {
    LAS float* tile = (LAS float*)lds;
    const int tid = phase_tid(), nk = K / 64, nn = (n_hi - n_lo) / 64;
    for (int it = bid; it < nk * nn; it += nb) {
        const int n0 = n_lo + (it / nk) * 64, k0 = (it % nk) * 64;
        { const int kk = tid >> 3, c8 = (tid & 7) * 8;
          const int cfirst = colmap<MAP>(n0 + c8, off), clast = colmap<MAP>(n0 + c8 + 7, off);
          if (cfirst >= 0 && clast == cfirst + 7 && ((cfirst | ld_src) & 3) == 0) {
              const f32x4 v0 = *(const f32x4*)(src + (size_t)(k0 + kk) * ld_src + cfirst), v1 = *(const f32x4*)(src + (size_t)(k0 + kk) * ld_src + cfirst + 4);
#pragma unroll
              for (int j = 0; j < 4; ++j) { tile[kk * 65 + c8 + j] = v0[j]; tile[kk * 65 + c8 + 4 + j] = v1[j]; }
          } else {
#pragma unroll
              for (int j = 0; j < 8; ++j) { const int col = colmap<MAP>(n0 + c8 + j, off); tile[kk * 65 + c8 + j] = (col >= 0) ? src[(size_t)(k0 + kk) * ld_src + col] : 0.f; } } }
        __syncthreads();
        { const int nr = tid >> 3, k8 = (tid & 7) * 8; float v[8];
#pragma unroll
          for (int j = 0; j < 8; ++j) v[j] = tile[(k8 + j) * 65 + nr];
          u32x4 w; w.x = cvt_pk_bf16(v[0], v[1]); w.y = cvt_pk_bf16(v[2], v[3]); w.z = cvt_pk_bf16(v[4], v[5]); w.w = cvt_pk_bf16(v[6], v[7]);
          *(u32x4*)(dst + (size_t)(n0 + nr) * ld_dst + koff + k0 + k8) = w; }
        __syncthreads();
    }
}
__device__ void fold_tile(LAS unsigned char* lds, bf16_t* out, long sOi, long sOj, const float* A, long sAi, long sAd, const float* B, long sBj, long sBd) {
    LAS float* As = (LAS float*)lds; LAS float* Bs = As + 64 * 129;
    const int tid = phase_tid();
    for (int e = tid; e < 64 * 128; e += 512) {
        int i, d; if (sAd == 1) { i = e >> 7; d = e & 127; } else { d = e >> 6; i = e & 63; }
        As[i * 129 + d] = A[i * sAi + d * sAd];
        int j, d2; if (sBd == 1) { j = e >> 7; d2 = e & 127; } else { d2 = e >> 6; j = e & 63; }
        Bs[j * 129 + d2] = B[j * sBj + d2 * sBd];
    }
    __syncthreads();
    const int i = tid & 63, jg = tid >> 6;
    float acc[8];
#pragma unroll
    for (int q = 0; q < 8; ++q) acc[q] = 0.f;
    for (int d = 0; d < 128; ++d) { const float a = As[i * 129 + d];
#pragma unroll
        for (int q = 0; q < 8; ++q) acc[q] += a * Bs[(jg * 8 + q) * 129 + d]; }
#pragma unroll
    for (int q = 0; q < 8; ++q) out[i * sOi + (jg * 8 + q) * sOj] = f2bf(acc[q]);
    __syncthreads();
}

__device__ void phase_conv_in(const Params& p, int l, LAS unsigned char* lds, int bid, int nb) {
    const float* Win = p.in[I_WIN] + (size_t)l * D_MODEL * IN_W;
    conv_job<1>(lds, BF(p, OFF_WIN), 1024, 0, Win, IN_W, 1024, 0, 3584, 0, bid, nb);
    conv_job<1>(lds, BF(p, OFF_WIN), 1024, 0, Win, IN_W, 1024, 4608, NP1, 0, bid, nb);
    const float* wuk = p.in[I_WUK] + (size_t)l * 256 * 512;
    for (int it = bid; it < 256; it += nb) { const int h = it >> 6, rb = (it >> 4) & 3, kb = it & 15;
        fold_tile(lds, BF(p, OFF_WIN) + (size_t)(3584 + h * 256 + rb * 64) * 1024 + kb * 64, 1, 1024,
                  Win + (size_t)(kb * 64) * IN_W + C_DQ + h * 128, IN_W, 1, wuk + ((size_t)(rb * 64) * 4 + h) * 128, 512, 1); }
}
__device__ void phase_conv_postA(const Params& p, int l, LAS unsigned char* lds, int bid, int nb) {
    const float* Win = p.in[I_WIN] + (size_t)l * D_MODEL * IN_W;
    conv_job<0>(lds, BF(p, OFF_WG), 1024, 0, Win, IN_W, 1024, 0, 3072, C_G, bid, nb);
    conv_job<0>(lds, BF(p, OFF_WBR), 2048, 0, p.in[I_WA] + (size_t)l * 512 * 1024, 1024, 512, 0, 1024, 0, bid, nb);
    conv_job<0>(lds, BF(p, OFF_WBR), 2048, 512, p.in[I_WB] + (size_t)l * 512 * 1024, 1024, 512, 0, 1024, 0, bid, nb);
    const float* wuv = p.in[I_WUV] + (size_t)l * 256 * 512; const float* wc = p.in[I_WC] + (size_t)l * 512 * 1024;
    for (int it = bid; it < 256; it += nb) { const int h = it >> 6, rb = (it >> 4) & 3, nbk = it & 15;
        fold_tile(lds, BF(p, OFF_WBR) + (size_t)(nbk * 64) * 2048 + 1024 + h * 256 + rb * 64, 1, 2048,
                  wuv + ((size_t)(rb * 64) * 4 + h) * 128, 512, 1, wc + (size_t)(h * 128) * 1024 + nbk * 64, 1, 1024); }
}
__device__ void phase_conv_postB(const Params& p, int l, LAS unsigned char* lds, int bid, int nb) {
    conv_job<0>(lds, BF(p, OFF_WOUT), 1024, 0, p.in[I_WOUT] + (size_t)l * 1024 * 1024, 1024, 1024, 0, 1024, 0, bid, nb);
    conv_job<2>(lds, BF(p, OFF_WF1), 1024, 0, p.in[I_WF1] + (size_t)l * 1024 * 2 * D_FF, 2 * D_FF, 1024, 0, 2 * D_FF, 0, bid, nb);
    conv_job<0>(lds, BF(p, OFF_WF2), D_FF, 0, p.in[I_WF2] + (size_t)l * D_FF * 1024, 1024, D_FF, 0, 1024, 0, bid, nb);
}

__device__ __forceinline__ float wave_sum(float v) {
#pragma unroll
    for (int o = 32; o >= 1; o >>= 1) v += __shfl_xor(v, o);
    return v;
}
template <int MODE>
__device__ void phase_norm(const float* xin, float* xout, const float* O, const float* wpost, const float* w1, bf16_t* H, int bid, int nb) {
    const int tidn = phase_tid(); const int wv = tidn >> 6, lane = tidn & 63;
    constexpr int NR = 2;
    for (int row0 = bid * 8 + wv; row0 < NTOK; row0 += NR * nb * 8) {
        f32x4 xv[NR][4], ov[NR][4];
#pragma unroll
        for (int q = 0; q < NR; ++q) { const int row = (row0 + q * nb * 8 < NTOK) ? row0 + q * nb * 8 : row0;
#pragma unroll
            for (int j = 0; j < 4; ++j) { xv[q][j] = *(const f32x4*)(xin + (size_t)row * 1024 + j * 256 + lane * 4);
                if (MODE >= 1) ov[q][j] = *(const f32x4*)(O + (size_t)row * 1024 + j * 256 + lane * 4); } }
        if (MODE >= 1) {
            float ss[NR];
#pragma unroll
            for (int q = 0; q < NR; ++q) { ss[q] = 0.f;
#pragma unroll
                for (int j = 0; j < 4; ++j) ss[q] += ov[q][j][0] * ov[q][j][0] + ov[q][j][1] * ov[q][j][1] + ov[q][j][2] * ov[q][j][2] + ov[q][j][3] * ov[q][j][3]; }
#pragma unroll
            for (int o = 32; o >= 1; o >>= 1)
#pragma unroll
                for (int q = 0; q < NR; ++q) ss[q] += __shfl_xor(ss[q], o);
#pragma unroll
            for (int q = 0; q < NR; ++q) { const int row = row0 + q * nb * 8; const float r = rsqrtf(ss[q] * (1.f / 1024.f) + 1e-6f);
#pragma unroll
                for (int j = 0; j < 4; ++j) { const f32x4 wv4 = *(const f32x4*)(wpost + j * 256 + lane * 4); xv[q][j] = xv[q][j] + ov[q][j] * r * wv4;
                    if (row < NTOK) *(f32x4*)(xout + (size_t)row * 1024 + j * 256 + lane * 4) = xv[q][j]; } }
        }
        if (MODE <= 1) {
            float ss[NR];
#pragma unroll
            for (int q = 0; q < NR; ++q) { ss[q] = 0.f;
#pragma unroll
                for (int j = 0; j < 4; ++j) ss[q] += xv[q][j][0] * xv[q][j][0] + xv[q][j][1] * xv[q][j][1] + xv[q][j][2] * xv[q][j][2] + xv[q][j][3] * xv[q][j][3]; }
#pragma unroll
            for (int o = 32; o >= 1; o >>= 1)
#pragma unroll
                for (int q = 0; q < NR; ++q) ss[q] += __shfl_xor(ss[q], o);
#pragma unroll
            for (int q = 0; q < NR; ++q) { const int row = row0 + q * nb * 8; const float r = rsqrtf(ss[q] * (1.f / 1024.f) + 1e-6f);
#pragma unroll
                for (int j = 0; j < 4; ++j) { const f32x4 wv4 = *(const f32x4*)(w1 + j * 256 + lane * 4); const f32x4 y = xv[q][j] * r * wv4;
                    u32x2 w; w.x = cvt_pk_bf16(y[0], y[1]); w.y = cvt_pk_bf16(y[2], y[3]); if (row < NTOK) *(u32x2*)(H + (size_t)row * 1024 + j * 256 + lane * 4) = w; } }
        }
    }
}

__device__ void phase_gemm_in(const Params& p, LAS unsigned char* lds, int bid, int nb) {
    pg8::EpiProj E{p.ws};
    pg8::Gemm g{BF(p, OFF_H), BF(p, OFF_WIN), 1024, 1024};
    pg8::StaticOrder S; S.init(NTOK, NP1, 1024, nb, bid);
    pg8::gemm_phase(lds, g, S, E);
}
__device__ void phase_gemm_gates(const Params& p, LAS unsigned char* lds, int bid, int nb) {
    pg8::EpiGate E{BF(p, OFF_HF)};
    pg8::Gemm g{BF(p, OFF_H), BF(p, OFF_WG), 1024, 1024};
    pg8::StaticOrder S; S.init(NTOK, 3072, 1024, nb, bid);
    pg8::gemm_phase(lds, g, S, E);
}
__device__ void phase_gemm_branch(const Params& p, LAS unsigned char* lds, int bid, int nb) {
    pg8::EpiBranch E; E.Mg = BF(p, OFF_H); E.G0 = BF(p, OFF_HF);
    pg8::Gemm g{BF(p, OFF_Y), BF(p, OFF_WBR), 2048, 2048};
    pg8::BranchOrder S; S.init(NTOK, 1024, nb, bid);
    pg8::gemm_phase(lds, g, S, E);
}
__device__ void phase_gemm_out(const Params& p, LAS unsigned char* lds, int bid, int nb) {
    pg8::EpiF32 E{F32P(p, OFF_OUT), 1024};
    pg8::Gemm g{BF(p, OFF_H), BF(p, OFF_WOUT), 1024, 1024};
    pg8::StaticOrder S; S.init(NTOK, 1024, 1024, nb, bid);
    pg8::gemm_phase(lds, g, S, E);
}
__device__ void phase_gemm_ffn1(const Params& p, LAS unsigned char* lds, int bid, int nb) {
    pg8::EpiSwiglu E{BF(p, OFF_ACT), D_FF};
    pg8::Gemm g{BF(p, OFF_H), BF(p, OFF_WF1), 1024, 1024};
    pg8::StaticOrder S; S.init(NTOK, 2 * D_FF, 1024, nb, bid);
    pg8::gemm_phase(lds, g, S, E);
}
__device__ void phase_gemm_ffn2(const Params& p, LAS unsigned char* lds, int bid, int nb) {
    pg8::EpiF32 E{F32P(p, OFF_OUT), 1024};
    pg8::Gemm g{BF(p, OFF_ACT), BF(p, OFF_WF2), D_FF, D_FF};
    pg8::StaticOrder S; S.init(NTOK, 1024, D_FF, nb, bid);
    pg8::gemm_phase(lds, g, S, E);
}


__device__ __forceinline__ float hg_lower_bound(const float* lbl, int l, int idx) {
    const float l0 = lbl[idx], l1 = lbl[512 + idx]; const float m = fmaxf(l0, l1), e0 = __expf(l0 - m), e1 = __expf(l1 - m), p0 = e0 / (e0 + e1), p1 = e1 / (e0 + e1);
    return ((l == 0) ? p0 : (p0 + p1)) - p0;
}
__device__ __forceinline__ void pack16_store(LAS unsigned char* dst, const float (&v)[16]) {
    u32x4 a, b; a.x = cvt_pk_bf16(v[0], v[1]); a.y = cvt_pk_bf16(v[2], v[3]); a.z = cvt_pk_bf16(v[4], v[5]); a.w = cvt_pk_bf16(v[6], v[7]);
    b.x = cvt_pk_bf16(v[8], v[9]); b.y = cvt_pk_bf16(v[10], v[11]); b.z = cvt_pk_bf16(v[12], v[13]); b.w = cvt_pk_bf16(v[14], v[15]);
    *(LAS u32x4*)dst = a; *(LAS u32x4*)(dst + 16) = b;
}
#define HG_FRONT()                                                                                                   \
    const int d = tid & 127, seg = tid >> 7;                                                                         \
    const float lbd = hg_lower_bound(p.in[I_LB], l, h * 128 + d);                                                    \
    float kk[16], cs[16];                                                                                            \
    { float run = 0.f;                                                                                               \
      _Pragma("unroll") for (int jj = 0; jj < 16; ++jj) {                                                            \
          const float fp = bf2f(HF[(size_t)(row0 + seg * 16 + jj) * 512 + h * 128 + d]);                            \
          const float sg = sigmoidf_(fp); const float f = fmaxf(lbd + (1.f - lbd) * sg, 1e-20f);                     \
          kk[jj] = (1.f - lbd) * (1.f - sg); run += __logf(f); cs[jj] = run; }                                       \
      SEG[seg * 128 + d] = run; }

__device__ void phase_hg1(const Params& p, int l, LAS unsigned char* lds, int bid, int nb) {
    const int tid = phase_tid(), lane = tid & 63, w = __builtin_amdgcn_readfirstlane(tid >> 6), fr = lane & 15, g = lane >> 4;
    LAS float* SEG = (LAS float*)lds; LAS unsigned char* KT = lds + 2048; LAS unsigned char* VT = KT + 128 * 144;
    const bf16_t* HF = BF(p, OFF_HF); const bf16_t* HI = BF(p, OFF_HI); bf16_t* ST = BF(p, OFF_ST); float* DEC = F32P(p, OFF_DEC);
    for (int unit = bid; unit < 1024; unit += nb) {
        const int bh = unit >> 6, c = unit & 63, h = bh & 3, row0 = (bh >> 2) * SEQ + c * 64;
        HG_FRONT();
        float vv[16];
#pragma unroll
        for (int jj = 0; jj < 16; ++jj) vv[jj] = bf2f(HI[(size_t)(row0 + seg * 16 + jj) * 512 + h * 128 + d]);
        __syncthreads();
        float off = 0.f, bl = 0.f;
#pragma unroll
        for (int s2 = 0; s2 < 4; ++s2) { const float t = SEG[s2 * 128 + d]; off += (s2 < seg) ? t : 0.f; bl += t; }
        float kb[16];
#pragma unroll
        for (int jj = 0; jj < 16; ++jj) kb[jj] = kk[jj] * __expf(bl - (off + cs[jj]));
        pack16_store(KT + d * 144 + seg * 32, kb);
        pack16_store(VT + d * 144 + seg * 32, vv);
        if (seg == 0) DEC[(size_t)unit * 128 + d] = __expf(bl);
        __syncthreads();
        bf16x8 a[2];
#pragma unroll
        for (int ks = 0; ks < 2; ++ks) a[ks] = *(const LAS bf16x8*)(KT + (16 * w + fr) * 144 + (32 * ks + 8 * g) * 2);
#pragma unroll
        for (int et = 0; et < 8; ++et) {
            f32x4 acc = {0.f, 0.f, 0.f, 0.f};
#pragma unroll
            for (int ks = 0; ks < 2; ++ks) { const bf16x8 b = *(const LAS bf16x8*)(VT + (16 * et + fr) * 144 + (32 * ks + 8 * g) * 2); acc = __builtin_amdgcn_mfma_f32_16x16x32_bf16(a[ks], b, acc, 0, 0, 0); }
            mfma_fence(acc);
            u32x2 o; o.x = cvt_pk_bf16(acc[0], acc[1]); o.y = cvt_pk_bf16(acc[2], acc[3]);
            *(u32x2*)(ST + ((size_t)unit * 128 + 16 * et + fr) * 128 + 16 * w + 4 * g) = o;
        }
        __syncthreads();
    }
}
__device__ void phase_hg2(const Params& p, int bid, int nb) {
    bf16_t* ST = BF(p, OFF_ST); const float* DEC = F32P(p, OFF_DEC);
    for (int gid = bid * 512 + phase_tid(); gid < 16 * 8192; gid += nb * 512) {
        const int bh = gid >> 13, within = gid & 8191, e = within >> 6, d = (within & 63) * 2;
        float s0 = 0.f, s1 = 0.f;
        for (int c0 = 0; c0 < 64; c0 += 8) {
            unsigned u[8]; float d0[8], d1[8];
#pragma unroll
            for (int k = 0; k < 8; ++k) { const size_t un = (size_t)(bh * 64 + c0 + k);
                u[k] = *(const unsigned*)(ST + (un * 128 + e) * 128 + d); d0[k] = DEC[un * 128 + d]; d1[k] = DEC[un * 128 + d + 1]; }
            asm volatile("s_waitcnt vmcnt(0)" ::: "memory");
#pragma unroll
            for (int k = 0; k < 8; ++k) { const size_t un = (size_t)(bh * 64 + c0 + k);
                *(unsigned*)(ST + (un * 128 + e) * 128 + d) = cvt_pk_bf16(s0, s1);
                s0 = d0[k] * s0 + __uint_as_float(u[k] << 16); s1 = d1[k] * s1 + __uint_as_float(u[k] & 0xffff0000u); }
        }
    }
}
template <int PROBE = 0> __device__ void phase_hg3(const Params& p, int l, LAS unsigned char* lds, int bid, int nb) {
    const int tid = phase_tid(), lane = tid & 63, w = __builtin_amdgcn_readfirstlane(tid >> 6), fr = lane & 15, g = lane >> 4;
    LAS float* SEG = (LAS float*)lds;
    LAS unsigned char* QH = lds + 2048; LAS unsigned char* QT = QH + 64 * 272; LAS float* OL = (LAS float*)(lds + 2048);
    LAS unsigned char* KB = lds + 36864; LAS unsigned char* VT = lds + 54272; LAS unsigned char* SP = lds + 72704; LAS unsigned char* PL = lds + 107520;
    const bf16_t* HF = BF(p, OFF_HF); const bf16_t* HI = BF(p, OFF_HI); const bf16_t* HG = BF(p, OFF_HG); const bf16_t* ST = BF(p, OFF_ST); bf16_t* Y = BF(p, OFF_Y);
    for (int unit = bid; unit < 1024; unit += nb) {
        const int bh = unit >> 6, c = unit & 63, h = bh & 3, row0 = (bh >> 2) * SEQ + c * 64;
        HG_FRONT();
        {
#pragma unroll
            for (int k = 0; k < 4; ++k) { const int ch = tid + 512 * k, e = ch >> 4, dc = ch & 15;
                *(LAS u32x4*)(SP + e * 272 + dc * 16) = *(const u32x4*)(ST + ((size_t)unit * 128 + e) * 128 + dc * 8); }
            float vv[16];
#pragma unroll
            for (int jj = 0; jj < 16; ++jj) vv[jj] = bf2f(HI[(size_t)(row0 + seg * 16 + jj) * 512 + h * 128 + d]);
            pack16_store(VT + d * 144 + seg * 32, vv);
        }
        __syncthreads();
        float beta[4]; { float run = 0.f;
#pragma unroll
            for (int s2 = 0; s2 < 4; ++s2) { beta[s2] = run; run += SEG[s2 * 128 + d]; } }
        float off = 0.f;
#pragma unroll
        for (int s2 = 0; s2 < 4; ++s2) off = (s2 == seg) ? beta[s2] : off;
#pragma unroll
        for (int jj = 0; jj < 16; ++jj) {
            const float q = bf2f(Y[(size_t)(row0 + seg * 16 + jj) * 2048 + h * 128 + d]);
            const int i = seg * 16 + jj;
            *(LAS bf16_t*)(QH + i * 272 + d * 2) = f2bf(q * __expf(off + cs[jj]));
            *(LAS bf16_t*)(QT + i * 272 + d * 2) = f2bf(q * __expf(cs[jj]));
        }
#pragma unroll
        for (int I = 0; I < 4; ++I) {
            if (seg <= I) {
                float bI = 0.f;
#pragma unroll
                for (int s2 = 0; s2 < 4; ++s2) bI = (s2 == I) ? beta[s2] : bI;
#pragma unroll
                for (int jj = 0; jj < 16; ++jj) *(LAS bf16_t*)(KB + (seg * 16 + jj) * 272 + d * 2) = f2bf(kk[jj] * __expf(fminf(bI - (off + cs[jj]), 60.f)));
            }
            __syncthreads();
            if (w < 4) {
                f32x4 acc = {0.f, 0.f, 0.f, 0.f};
                if (w <= I) {
#pragma unroll
                    for (int ks = 0; ks < 4; ++ks) {
                        const bf16x8 a = *(const LAS bf16x8*)(QT + (16 * I + fr) * 272 + (32 * ks + 8 * g) * 2);
                        const bf16x8 b = *(const LAS bf16x8*)(KB + (16 * w + fr) * 272 + (32 * ks + 8 * g) * 2);
                        acc = __builtin_amdgcn_mfma_f32_16x16x32_bf16(a, b, acc, 0, 0, 0); }
                    mfma_fence(acc);
                    const int lim = (w == I) ? (4 * g) : 1000;
#pragma unroll
                    for (int r = 0; r < 4; ++r) acc[r] = (fr <= lim + r) ? acc[r] : 0.f;
                }
#pragma unroll
                for (int r = 0; r < 4; ++r) *(LAS bf16_t*)(PL + (16 * I + 4 * g + r) * 144 + (16 * w + fr) * 2) = f2bf(acc[r]);
            }
            __syncthreads();
        }
        f32x4 oacc[4];
        { const int ib = w >> 1;
          bf16x8 aq[4], ap[2];
#pragma unroll
          for (int ks = 0; ks < 4; ++ks) aq[ks] = *(const LAS bf16x8*)(QH + (16 * ib + fr) * 272 + (32 * ks + 8 * g) * 2);
#pragma unroll
          for (int ks = 0; ks < 2; ++ks) ap[ks] = *(const LAS bf16x8*)(PL + (16 * ib + fr) * 144 + (32 * ks + 8 * g) * 2);
#pragma unroll
          for (int q4 = 0; q4 < 4; ++q4) { const int et = 4 * (w & 1) + q4; f32x4 acc = {0.f, 0.f, 0.f, 0.f};
#pragma unroll
              for (int ks = 0; ks < 4; ++ks) { const bf16x8 b = *(const LAS bf16x8*)(SP + (16 * et + fr) * 272 + (32 * ks + 8 * g) * 2); acc = __builtin_amdgcn_mfma_f32_16x16x32_bf16(aq[ks], b, acc, 0, 0, 0); }
#pragma unroll
              for (int ks = 0; ks < 2; ++ks) { const bf16x8 b = *(const LAS bf16x8*)(VT + (16 * et + fr) * 144 + (32 * ks + 8 * g) * 2); acc = __builtin_amdgcn_mfma_f32_16x16x32_bf16(ap[ks], b, acc, 0, 0, 0); }
              oacc[q4] = acc; } }
        mfma_fence(oacc[0], oacc[1], oacc[2], oacc[3]);
        __syncthreads();
#pragma unroll
        for (int q4 = 0; q4 < 4; ++q4)
#pragma unroll
            for (int r = 0; r < 4; ++r) OL[(16 * (w >> 1) + 4 * g + r) * 132 + 16 * (4 * (w & 1) + q4) + fr] = oacc[q4][r];
        __syncthreads();
        {
            const int i = tid >> 3, es = (tid & 7) * 16;
            float o[16], ss = 0.f;
#pragma unroll
            for (int k = 0; k < 16; ++k) { o[k] = OL[i * 132 + es + k]; ss += o[k] * o[k]; }
            ss += __shfl_xor(ss, 1); ss += __shfl_xor(ss, 2); ss += __shfl_xor(ss, 4);
            const float rstd = rsqrtf(ss * (1.f / 128.f) + 1e-6f);
            const u32x4 g0 = *(const u32x4*)(HG + (size_t)(row0 + i) * 512 + h * 128 + es), g1 = *(const u32x4*)(HG + (size_t)(row0 + i) * 512 + h * 128 + es + 8);
            float y[16];
#pragma unroll
            for (int k = 0; k < 16; ++k) { const unsigned gw = (k < 8) ? g0[k >> 1] : g1[(k - 8) >> 1]; const float gv = (k & 1) ? __uint_as_float(gw & 0xffff0000u) : __uint_as_float(gw << 16);
                y[k] = o[k] * rstd * p.in[I_HGNW][l * 128 + es + k] * (gv * sigmoidf_(gv)); }
            u32x4 a, b; a.x = cvt_pk_bf16(y[0], y[1]); a.y = cvt_pk_bf16(y[2], y[3]); a.z = cvt_pk_bf16(y[4], y[5]); a.w = cvt_pk_bf16(y[6], y[7]);
            b.x = cvt_pk_bf16(y[8], y[9]); b.y = cvt_pk_bf16(y[10], y[11]); b.z = cvt_pk_bf16(y[12], y[13]); b.w = cvt_pk_bf16(y[14], y[15]);
            bf16_t* yo = PROBE ? ((bf16_t*)((unsigned char*)p.x + 16 * MiB) + (size_t)(row0 + i) * 512 + h * 128 + es) : (Y + (size_t)(row0 + i) * 2048 + h * 128 + es);
            *(u32x4*)yo = a; *(u32x4*)(yo + 8) = b;
        }
        __syncthreads();
    }
}


__device__ void phase_prep(const Params& p, int l, LAS unsigned char* lds, int bid, int nb) {
    const int tid = phase_tid(), lane = tid & 63, wv = tid >> 6;
    {
        LAS float* red = (LAS float*)lds; const bf16_t* MK = BF(p, OFF_MK); float* KM = F32P(p, OFF_KMEAN);
        for (int it = bid; it < 256; it += nb) {
            const int bh = it >> 4, n = it & 15, h = bh & 3, d = tid & 127, part = tid >> 7; const size_t row0 = (size_t)(bh >> 2) * SEQ + n * 256 + part * 64;
            float s = 0.f;
            for (int j = 0; j < 64; ++j) s += bf2f(MK[(row0 + j) * 512 + h * 128 + d]);
            red[part * 128 + d] = s; __syncthreads();
            if (part == 0) KM[(size_t)it * 128 + d] = (red[d] + red[128 + d] + red[256 + d] + red[384 + d]) * (1.f / 256.f);
            __syncthreads();
        }
    }
    bf16_t* CKV = BF(p, OFF_CKV); bf16_t* IKW = BF(p, OFF_IKW);
    const float* kvw = p.in[I_KVN] + l * 256; const float* ikw = p.in[I_IKNW] + l * 64; const float* ikb = p.in[I_IKNB] + l * 64;
    for (int row = bid * 8 + wv; row < NTOK; row += nb * 8) {
        {   u32x2* cp = (u32x2*)(CKV + (size_t)row * 256 + lane * 4); const u32x2 v = *cp;
            const float a0 = __uint_as_float(v.x << 16), a1 = __uint_as_float(v.x & 0xffff0000u), a2 = __uint_as_float(v.y << 16), a3 = __uint_as_float(v.y & 0xffff0000u);
            const float ss = wave_sum(a0 * a0 + a1 * a1 + a2 * a2 + a3 * a3); const float r = rsqrtf(ss * (1.f / 256.f) + 1e-6f);
            const f32x4 w4 = *(const f32x4*)(kvw + lane * 4);
            u32x2 o; o.x = cvt_pk_bf16(a0 * r * w4[0], a1 * r * w4[1]); o.y = cvt_pk_bf16(a2 * r * w4[2], a3 * r * w4[3]); *cp = o; }
        {   bf16_t* ip = IKW + (size_t)row * 128; const float u = bf2f(ip[lane]);
            const float mu = wave_sum(u) * (1.f / 64.f); const float xc = u - mu; const float var = wave_sum(xc * xc) * (1.f / 64.f);
            const float y = xc * rsqrtf(var + 1e-6f) * ikw[lane] + ikb[lane];
            const float wgt = (lane < 8) ? bf2f(ip[64 + lane]) * (0.35355339059327373f * 0.125f) : 0.f;
            ip[lane] = f2bf(y); if (lane < 8) ip[64 + lane] = f2bf(wgt); }
    }
}

typedef short v4i16_t __attribute__((ext_vector_type(4)));
__device__ __forceinline__ v4i16_t lds_tr16(const LAS unsigned char* pp) { return __builtin_amdgcn_ds_read_tr16_b64_v4i16((LAS v4i16_t*)pp); }
template <int PROBE = 0> __device__ void phase_moba(const Params& p, LAS unsigned char* lds, int bid, int nb) {
    const int tid = phase_tid(), lane = tid & 63, w = __builtin_amdgcn_readfirstlane(tid >> 6), fr = lane & 15, g = lane >> 4;
    LAS float* BL = (LAS float*)lds; LAS float* KM = (LAS float*)(lds + 16384); LAS float* GG = (LAS float*)(lds + 24576);
    LAS unsigned* SM = (LAS unsigned*)(lds + 32768); LAS unsigned* UM = SM + 128; LAS unsigned* TL = SM + 132;
    LAS unsigned char* QS = lds + 33792; LAS unsigned char* KS = lds + 68608; LAS unsigned char* VS = lds + 86016;
    bf16_t* Y = BF(p, OFF_Y); const bf16_t* MK = BF(p, OFF_MK); const bf16_t* MV = BF(p, OFF_MV);
    const float scale = 0.08838834764831845f;
    for (int j = bid; j < 512; j += nb) {
        const int bh = j & 15, qt = (j < 256) ? (j >> 4) : (31 - ((j - 256) >> 4));
        const int h = bh & 3, brow = (bh >> 2) * SEQ, t0 = qt * 128, blk = qt >> 1;
        for (int dd = tid; dd < 4096; dd += 512) BL[dd] = p.in[I_REL][rel_bucket(dd) * 8 + h];
        for (int e = tid; e < 2048; e += 512) KM[e] = F32P(p, OFF_KMEAN)[(size_t)bh * 2048 + e];
#pragma unroll
        for (int k = 0; k < 4; ++k) { const int ch = tid + 512 * k, r = ch >> 4, c = ch & 15;
            *(LAS u32x4*)(QS + r * 272 + c * 16) = *(const u32x4*)(Y + (size_t)(brow + t0 + r) * 2048 + 512 + h * 128 + c * 8); }
        if (tid == 0) *UM = 0u;
        __syncthreads();
        {
            const int q = tid >> 2, ng = tid & 3; float ga[4] = {0.f, 0.f, 0.f, 0.f};
            for (int c = 0; c < 16; ++c) { const u32x4 qv = *(const LAS u32x4*)(QS + q * 272 + c * 16);
#pragma unroll
                for (int e2 = 0; e2 < 8; ++e2) { const unsigned wq = qv[e2 >> 1]; const float qf = (e2 & 1) ? __uint_as_float(wq & 0xffff0000u) : __uint_as_float(wq << 16);
#pragma unroll
                    for (int n4 = 0; n4 < 4; ++n4) ga[n4] += qf * KM[(ng * 4 + n4) * 128 + c * 8 + e2]; } }
#pragma unroll
            for (int n4 = 0; n4 < 4; ++n4) GG[q * 16 + ng * 4 + n4] = ga[n4];
        }
        __syncthreads();
        if (tid < 128) {
            unsigned used = 0u;
            for (int k = 0; k < 3; ++k) { int best = -1; float bv = 0.f;
                for (int n = 0; n < blk; ++n) { const float v = GG[tid * 16 + n]; if (!((used >> n) & 1u) && (best < 0 || v > bv)) { best = n; bv = v; } }
                if (best >= 0) used |= 1u << best; }
            SM[tid] = used; __hip_atomic_fetch_or((unsigned*)UM, used, __ATOMIC_RELAXED, __HIP_MEMORY_SCOPE_WORKGROUP);
        }
        __syncthreads();
        const unsigned mysel = SM[16 * w + fr];
        const int own_tiles = 2 + 2 * (qt & 1);
        if (tid == 0) {
            const unsigned umask = *UM; int c = 0;
            for (int kt = 0; kt < own_tiles; ++kt) TL[c++] = (unsigned)(blk * 4 + kt);
            for (int n = 0; n < blk; ++n) if ((umask >> n) & 1u) { for (int kt = 0; kt < 4; ++kt) TL[c++] = (unsigned)(n * 4 + kt); }
            TL[64] = (unsigned)c; }
        __syncthreads();
        const int ntiles = (int)TL[64];
        const int tq = t0 + 16 * w + fr;
        bf16x8 qf[4];
#pragma unroll
        for (int ks = 0; ks < 4; ++ks) qf[ks] = *(const LAS bf16x8*)(QS + (16 * w + fr) * 272 + (32 * ks + 8 * g) * 2);
        f32x4 oacc[8];
#pragma unroll
        for (int dt = 0; dt < 8; ++dt) oacc[dt] = (f32x4){0.f, 0.f, 0.f, 0.f};
        float mrun = -1e30f, lsum = 0.f;
        u32x4 kpre[2], vpre[2];
        { const int key0 = (int)TL[0] * 64;
#pragma unroll
          for (int k = 0; k < 2; ++k) { const int ch = tid + 512 * k, r = ch >> 4, c = ch & 15; const size_t go = (size_t)(brow + key0 + r) * 512 + h * 128 + c * 8; kpre[k] = *(const u32x4*)(MK + go); vpre[k] = *(const u32x4*)(MV + go); } }
        for (int ti = 0; ti < ntiles; ++ti) {
            const int ent = (int)TL[ti], n = ent >> 2, key0 = ent * 64;
            const bool qsel = (n == blk) || ((mysel >> n) & 1u);
            __syncthreads();
#pragma unroll
            for (int k = 0; k < 2; ++k) { const int ch = tid + 512 * k, r = ch >> 4, c = ch & 15; *(LAS u32x4*)(KS + r * 272 + c * 16) = kpre[k]; *(LAS u32x4*)(VS + r * 288 + c * 16) = vpre[k]; }
            __syncthreads();
            if (ti + 1 < ntiles) { const int keyn = (int)TL[ti + 1] * 64;
#pragma unroll
                for (int k = 0; k < 2; ++k) { const int ch = tid + 512 * k, r = ch >> 4, c = ch & 15; const size_t go = (size_t)(brow + keyn + r) * 512 + h * 128 + c * 8; kpre[k] = *(const u32x4*)(MK + go); vpre[k] = *(const u32x4*)(MV + go); } }
            {
                f32x4 s[4];
#pragma unroll
                for (int k4 = 0; k4 < 4; ++k4) { f32x4 acc = {0.f, 0.f, 0.f, 0.f};
#pragma unroll
                    for (int ks = 0; ks < 4; ++ks) { const bf16x8 a = *(const LAS bf16x8*)(KS + (16 * k4 + fr) * 272 + (32 * ks + 8 * g) * 2); acc = __builtin_amdgcn_mfma_f32_16x16x32_bf16(a, qf[ks], acc, 0, 0, 0); }
                    s[k4] = acc; }
                mfma_fence(s[0], s[1], s[2], s[3]);
                float mx = -1e30f;
#pragma unroll
                for (int k4 = 0; k4 < 4; ++k4)
#pragma unroll
                    for (int r = 0; r < 4; ++r) { const int dist = tq - (key0 + 16 * k4 + 4 * g + r); const bool ok = qsel && (dist >= 0);
                        const float lg = s[k4][r] * scale + BL[dist < 0 ? 0 : dist]; s[k4][r] = ok ? lg : -1e30f; mx = fmaxf(mx, s[k4][r]); }
                mx = fmaxf(mx, __shfl_xor(mx, 16)); mx = fmaxf(mx, __shfl_xor(mx, 32));
                const float mnew = fmaxf(mrun, mx), alpha = __expf(mrun - mnew); mrun = mnew;
                float ps = 0.f;
#pragma unroll
                for (int k4 = 0; k4 < 4; ++k4)
#pragma unroll
                    for (int r = 0; r < 4; ++r) { const float pv = (s[k4][r] > -1e29f) ? __expf(s[k4][r] - mnew) : 0.f; s[k4][r] = pv; ps += pv; }
                lsum = lsum * alpha + ps;
                if (__any(alpha != 1.0f)) {
#pragma unroll
                    for (int dt = 0; dt < 8; ++dt) oacc[dt] = oacc[dt] * alpha; }
                bf16x8 pb[2];
#pragma unroll
                for (int m2 = 0; m2 < 2; ++m2) { u32x4 t; t.x = cvt_pk_bf16(s[2 * m2][0], s[2 * m2][1]); t.y = cvt_pk_bf16(s[2 * m2][2], s[2 * m2][3]);
                    t.z = cvt_pk_bf16(s[2 * m2 + 1][0], s[2 * m2 + 1][1]); t.w = cvt_pk_bf16(s[2 * m2 + 1][2], s[2 * m2 + 1][3]); pb[m2] = __builtin_bit_cast(bf16x8, t); }
#pragma unroll
                for (int dt = 0; dt < 8; ++dt)
#pragma unroll
                    for (int m2 = 0; m2 < 2; ++m2) {
                        const LAS unsigned char* va = VS + (32 * m2 + 4 * g + (fr >> 2)) * 288 + (16 * dt + 4 * (fr & 3)) * 2;
                        const v4i16_t lo = lds_tr16(va), hi = lds_tr16(va + 16 * 288);
                        const bf16x8 a = {lo[0], lo[1], lo[2], lo[3], hi[0], hi[1], hi[2], hi[3]};
                        oacc[dt] = __builtin_amdgcn_mfma_f32_16x16x32_bf16(a, pb[m2], oacc[dt], 0, 0, 0); }
            }
        }
        lsum += __shfl_xor(lsum, 16); lsum += __shfl_xor(lsum, 32);
        const float inv = 1.f / lsum;
        mfma_fence(oacc[0], oacc[1], oacc[2], oacc[3]); mfma_fence(oacc[4], oacc[5], oacc[6], oacc[7]);
        __syncthreads();
#pragma unroll
        for (int dt = 0; dt < 8; ++dt) { u32x2 o; o.x = cvt_pk_bf16(oacc[dt][0] * inv, oacc[dt][1] * inv); o.y = cvt_pk_bf16(oacc[dt][2] * inv, oacc[dt][3] * inv);
            if (PROBE) *(u32x2*)((bf16_t*)p.x + (size_t)(brow + tq) * 512 + h * 128 + 16 * dt + 4 * g) = o; else *(u32x2*)(Y + (size_t)(brow + tq) * 2048 + 512 + h * 128 + 16 * dt + 4 * g) = o; }
        __syncthreads();
    }
}


template <int PROBE = 0> __device__ void phase_dsel(const Params& p, LAS unsigned char* lds, int bid, int nb) {
    const int tid = phase_tid(), lane = tid & 63, w = __builtin_amdgcn_readfirstlane(tid >> 6), fr = lane & 15, g = lane >> 4, q8 = fr & 7;
    LAS unsigned char* KEYS = lds;
    LAS unsigned char* IQS = lds + 131072;
    const bf16_t* IQ = BF(p, OFF_IQ); const bf16_t* IKW = BF(p, OFF_IKW);
    unsigned* MASK = PROBE ? (unsigned*)((unsigned char*)p.x + (size_t)(PROBE - 1) * 8 * MiB) : (unsigned*)(p.ws + OFF_MASK);
    for (int u = 0; u < 2048; ++u) {
        int k;
        if (nb == 256) { if (u >= 8) break; k = (u & 1) ? (512 * (u >> 1) + 511 - bid) : (512 * (u >> 1) + bid); }
        else { k = bid + u * nb; if (k >= 2048) break; }
        const int b = k & 3, qt = k >> 2, brow = b * SEQ, t0 = qt * 8, nkt = (t0 + 7) / 16 + 1;
        __syncthreads();
        { const int r = tid >> 6, c = tid & 63;
          *(LAS u32x4*)(IQS + r * 1040 + c * 16) = *(const u32x4*)(IQ + (size_t)(brow + t0 + r) * 512 + c * 8); }
        __syncthreads();
        {
            bf16x8 aq[4][2];
#pragma unroll
            for (int hp = 0; hp < 4; ++hp)
#pragma unroll
                for (int ks = 0; ks < 2; ++ks) aq[hp][ks] = *(const LAS bf16x8*)(IQS + (fr >> 1) * 1040 + ((2 * hp + (fr & 1)) * 64 + 32 * ks + 8 * g) * 2);
            float wa[8], wb[8];
            { const u32x4 va = *(const u32x4*)(IKW + (size_t)(brow + t0 + 2 * g) * 128 + 64), vb = *(const u32x4*)(IKW + (size_t)(brow + t0 + 2 * g + 1) * 128 + 64);
#pragma unroll
              for (int hh = 0; hh < 8; ++hh) { wa[hh] = (hh & 1) ? __uint_as_float(va[hh >> 1] & 0xffff0000u) : __uint_as_float(va[hh >> 1] << 16); wb[hh] = (hh & 1) ? __uint_as_float(vb[hh >> 1] & 0xffff0000u) : __uint_as_float(vb[hh >> 1] << 16); } }
            const int tqa = t0 + 2 * g, tqb = tqa + 1;
            const bf16_t* kbase = IKW + (size_t)(brow + fr) * 128 + 8 * g;
            bf16x8 kb0[4][2], kb1[4][2];
#define DSEL_ISSUE(buf, base_) do { _Pragma("unroll") for (int j = 0; j < 4; ++j) { int ktl = (base_) + 8 * j; ktl = ktl < 256 ? ktl : 255; const bf16_t* kp = kbase + (size_t)ktl * 2048; \
                (buf)[j][0] = *(const bf16x8*)kp; (buf)[j][1] = *(const bf16x8*)(kp + 32); } } while (0)
#define DSEL_COMPUTE(buf, base_) do { _Pragma("unroll") for (int j = 0; j < 4; ++j) { const int kt = (base_) + 8 * j; if (kt < nkt) { \
                float sa = 0.f, sb = 0.f; \
                f32x4 ah[4]; \
                _Pragma("unroll") for (int hp = 0; hp < 4; ++hp) { f32x4 acc = {0.f, 0.f, 0.f, 0.f}; \
                    acc = __builtin_amdgcn_mfma_f32_16x16x32_bf16(aq[hp][0], (buf)[j][0], acc, 0, 0, 0); acc = __builtin_amdgcn_mfma_f32_16x16x32_bf16(aq[hp][1], (buf)[j][1], acc, 0, 0, 0); ah[hp] = acc; } \
                mfma_fence(ah[0], ah[1], ah[2], ah[3]); \
                _Pragma("unroll") for (int hp = 0; hp < 4; ++hp) { sa += wa[2 * hp] * fmaxf(ah[hp][0], 0.f) + wa[2 * hp + 1] * fmaxf(ah[hp][1], 0.f); sb += wb[2 * hp] * fmaxf(ah[hp][2], 0.f) + wb[2 * hp + 1] * fmaxf(ah[hp][3], 0.f); } \
                const int spos = 16 * kt + fr; \
                unsigned ua = __float_as_uint(sa + 0.0f); ua = (ua & 0x80000000u) ? ~ua : (ua | 0x80000000u); \
                unsigned ub = __float_as_uint(sb + 0.0f); ub = (ub & 0x80000000u) ? ~ub : (ub | 0x80000000u); \
                *(LAS unsigned*)(KEYS + (2 * g) * 16384 + spos * 4) = (spos <= tqa) ? ((ua & 0xfffff000u) | (unsigned)(4095 - spos)) : 0u; \
                *(LAS unsigned*)(KEYS + (2 * g + 1) * 16384 + spos * 4) = (spos <= tqb) ? ((ub & 0xfffff000u) | (unsigned)(4095 - spos)) : 0u; } } } while (0)
            DSEL_ISSUE(kb0, w);
            for (int base = w; base < nkt; base += 64) {
                DSEL_ISSUE(kb1, base + 32);
                DSEL_COMPUTE(kb0, base);
                DSEL_ISSUE(kb0, base + 64);
                DSEL_COMPUTE(kb1, base + 32);
            }
#undef DSEL_ISSUE
#undef DSEL_COMPUTE
        }
        __syncthreads();
        {
            const int t = t0 + w; const int nch = 4 * nkt;
            const int mmax = (nch + 63) >> 6;
            u32x4 kr[16];
#pragma unroll
            for (int m = 0; m < 16; ++m) { const int c = lane + 64 * m; const u32x4 z = {0u, 0u, 0u, 0u};
                kr[m] = (m < mmax && c < nch) ? *(const LAS u32x4*)(KEYS + w * 16384 + c * 16) : z; }
            unsigned thr = 1u;
            if (t + 1 > 256 && PROBE < 3) { thr = 0u;
                for (int it = 0; it < 32; ++it) {
                    const unsigned cand = thr | (0x80000000u >> it);
                    unsigned cn = 0u;
#pragma unroll
                    for (int m = 0; m < 16; ++m) if (m < mmax) {
                        cn += (unsigned)__builtin_popcountll(__builtin_amdgcn_ballot_w64(kr[m].x >= cand)); cn += (unsigned)__builtin_popcountll(__builtin_amdgcn_ballot_w64(kr[m].y >= cand));
                        cn += (unsigned)__builtin_popcountll(__builtin_amdgcn_ballot_w64(kr[m].z >= cand)); cn += (unsigned)__builtin_popcountll(__builtin_amdgcn_ballot_w64(kr[m].w >= cand)); }
                    if (cn >= 256u) thr = cand;
                    if (cn == 256u) break;
                } }
            if (PROBE >= 3) thr = 0x80000000u;
            unsigned* mrow = MASK + (size_t)(brow + t) * 128;
#pragma unroll
            for (int m = 0; m < 16; ++m) {
                unsigned nib = 0u;
                if (m < mmax) nib = ((kr[m].x >= thr) ? 1u : 0u) | ((kr[m].y >= thr) ? 2u : 0u) | ((kr[m].z >= thr) ? 4u : 0u) | ((kr[m].w >= thr) ? 8u : 0u);
                unsigned v = nib << (4 * (lane & 7));
                v |= (unsigned)__shfl_xor((int)v, 1); v |= (unsigned)__shfl_xor((int)v, 2); v |= (unsigned)__shfl_xor((int)v, 4);
                if ((lane & 7) == 0) mrow[(lane >> 3) + 8 * m] = v;
            }
        }
    }
}

template <int PROBE = 0> __device__ void phase_datt(const Params& p, LAS unsigned char* lds, int bid, int nb) {
    const int tid = phase_tid(), lane = tid & 63, w = __builtin_amdgcn_readfirstlane(tid >> 6), fr = lane & 15, g = lane >> 4;
    LAS unsigned char* BK = lds;
    LAS float* RL = (LAS float*)(lds + 4096);
    LAS unsigned short* IDX = (LAS unsigned short*)(lds + 5120 + w * 512);
    LAS unsigned char* CT = lds + 9216 + w * (32 * 544);
    const bf16_t* CKV = BF(p, OFF_CKV); bf16_t* Y = BF(p, OFF_Y); const unsigned* MASK = (const unsigned*)(p.ws + OFF_MASK);
    for (int dd = tid; dd < 4096; dd += 512) BK[dd] = (unsigned char)rel_bucket(dd);
    if (tid < 256) RL[tid] = p.in[I_REL][tid];
    __syncthreads();
    const float scale = 0.08838834764831845f;
    const int hd = fr & 3;
    for (int it = bid; it < NTOK / 8; it += nb) {
        const int tg = it * 8 + w, brow = (tg >> 12) * SEQ, t = tg & 4095;
        const u32x2 mw = *(const u32x2*)(MASK + (size_t)tg * 128 + 2 * lane);
        const int cnt = __popc(mw.x) + __popc(mw.y);
        int pre = cnt;
#pragma unroll
        for (int o = 1; o < 64; o <<= 1) { const int v = __shfl_up(pre, o); if (lane >= o) pre += v; }
        const int nsel = __shfl(pre, 63);
        int pos = pre - cnt;
        { unsigned m0 = mw.x; while (m0) { const int bpos = __ffs(m0) - 1; m0 &= m0 - 1; IDX[pos++] = (unsigned short)(64 * lane + bpos); }
          unsigned m1 = mw.y; while (m1) { const int bpos = __ffs(m1) - 1; m1 &= m1 - 1; IDX[pos++] = (unsigned short)(64 * lane + 32 + bpos); } }
        for (int e = nsel + lane; e < 256; e += 64) IDX[e] = 0;
        bf16x8 qb[8];
#pragma unroll
        for (int ks = 0; ks < 8; ++ks) { const u32x4 z = {0u, 0u, 0u, 0u}; const u32x4 v = (fr < 4) ? *(const u32x4*)(Y + (size_t)tg * 2048 + 1024 + fr * 256 + 32 * ks + 8 * g) : z; qb[ks] = __builtin_bit_cast(bf16x8, v); }
        f32x4 oacc[16];
#pragma unroll
        for (int rt = 0; rt < 16; ++rt) oacc[rt] = (f32x4){0.f, 0.f, 0.f, 0.f};
        float mrun = -1e30f, lsum = 0.f;
        const int nstep = (nsel + 31) >> 5;
        bf16x8 a0[8], a1[8];
        { const bf16_t* c0 = CKV + (size_t)(brow + IDX[fr]) * 256 + 8 * g; const bf16_t* c1 = CKV + (size_t)(brow + IDX[16 + fr]) * 256 + 8 * g;
#pragma unroll
          for (int ks = 0; ks < 8; ++ks) { a0[ks] = *(const bf16x8*)(c0 + 32 * ks); a1[ks] = *(const bf16x8*)(c1 + 32 * ks); } }
        for (int st = 0; st < nstep; ++st) {
#pragma unroll
            for (int ks = 0; ks < 8; ++ks) { *(LAS bf16x8*)(CT + fr * 544 + (32 * ks + 8 * g) * 2) = a0[ks]; *(LAS bf16x8*)(CT + (16 + fr) * 544 + (32 * ks + 8 * g) * 2) = a1[ks]; }
            f32x4 s0 = {0.f, 0.f, 0.f, 0.f}, s1 = {0.f, 0.f, 0.f, 0.f};
#pragma unroll
            for (int ks = 0; ks < 8; ++ks) { s0 = __builtin_amdgcn_mfma_f32_16x16x32_bf16(a0[ks], qb[ks], s0, 0, 0, 0); s1 = __builtin_amdgcn_mfma_f32_16x16x32_bf16(a1[ks], qb[ks], s1, 0, 0, 0); }
            mfma_fence(s0); mfma_fence(s1);
            if (st + 1 < nstep) {
                const bf16_t* c0 = CKV + (size_t)(brow + IDX[32 * (st + 1) + fr]) * 256 + 8 * g; const bf16_t* c1 = CKV + (size_t)(brow + IDX[32 * (st + 1) + 16 + fr]) * 256 + 8 * g;
#pragma unroll
                for (int ks = 0; ks < 8; ++ks) { a0[ks] = *(const bf16x8*)(c0 + 32 * ks); a1[ks] = *(const bf16x8*)(c1 + 32 * ks); } }
            float mx = -1e30f;
#pragma unroll
            for (int r = 0; r < 4; ++r) {
                { const int slot = 32 * st + 4 * g + r; const int dist = t - (int)IDX[slot]; const float lg = s0[r] * scale + RL[BK[dist < 0 ? 0 : dist] * 8 + 4 + hd]; s0[r] = (slot < nsel) ? lg : -1e30f; mx = fmaxf(mx, s0[r]); }
                { const int slot = 32 * st + 16 + 4 * g + r; const int dist = t - (int)IDX[slot]; const float lg = s1[r] * scale + RL[BK[dist < 0 ? 0 : dist] * 8 + 4 + hd]; s1[r] = (slot < nsel) ? lg : -1e30f; mx = fmaxf(mx, s1[r]); } }
            mx = fmaxf(mx, __shfl_xor(mx, 16)); mx = fmaxf(mx, __shfl_xor(mx, 32));
            const float mnew = fmaxf(mrun, mx), alpha = __expf(mrun - mnew); mrun = mnew;
            float ps = 0.f;
#pragma unroll
            for (int r = 0; r < 4; ++r) { const float p0 = (s0[r] > -1e29f) ? __expf(s0[r] - mnew) : 0.f, p1 = (s1[r] > -1e29f) ? __expf(s1[r] - mnew) : 0.f; s0[r] = p0; s1[r] = p1; ps += p0 + p1; }
            lsum = lsum * alpha + ps;
#pragma unroll
            for (int rt = 0; rt < 16; ++rt) oacc[rt] = oacc[rt] * alpha;
            u32x4 pt; pt.x = cvt_pk_bf16(s0[0], s0[1]); pt.y = cvt_pk_bf16(s0[2], s0[3]); pt.z = cvt_pk_bf16(s1[0], s1[1]); pt.w = cvt_pk_bf16(s1[2], s1[3]);
            const bf16x8 pb = __builtin_bit_cast(bf16x8, pt);
#pragma unroll
            for (int rt = 0; rt < 16; ++rt) {
                const LAS unsigned char* va = CT + (4 * g + (fr >> 2)) * 544 + (16 * rt + 4 * (fr & 3)) * 2;
                const v4i16_t lo = lds_tr16(va), hi = lds_tr16(va + 16 * 544);
                const bf16x8 a = {lo[0], lo[1], lo[2], lo[3], hi[0], hi[1], hi[2], hi[3]};
                oacc[rt] = __builtin_amdgcn_mfma_f32_16x16x32_bf16(a, pb, oacc[rt], 0, 0, 0); }
        }
        lsum += __shfl_xor(lsum, 16); lsum += __shfl_xor(lsum, 32);
        const float inv = 1.f / lsum;
        mfma_fence(oacc[0], oacc[1], oacc[2], oacc[3]); mfma_fence(oacc[4], oacc[5], oacc[6], oacc[7]); mfma_fence(oacc[8], oacc[9], oacc[10], oacc[11]); mfma_fence(oacc[12], oacc[13], oacc[14], oacc[15]);
        if (fr < 4) {
            bf16_t* yo = PROBE ? ((bf16_t*)((unsigned char*)p.x + 32 * MiB) + (size_t)tg * 1024 + fr * 256 + 4 * g) : (Y + (size_t)tg * 2048 + 1024 + fr * 256 + 4 * g);
#pragma unroll
            for (int rt = 0; rt < 16; ++rt) { u32x2 o; o.x = cvt_pk_bf16(oacc[rt][0] * inv, oacc[rt][1] * inv); o.y = cvt_pk_bf16(oacc[rt][2] * inv, oacc[rt][3] * inv); *(u32x2*)(yo + 16 * rt) = o; }
        }
    }
}

__device__ __forceinline__ Params opq(const Params& p) { Params q = p; asm volatile("" : "+s"(q.ws), "+s"(q.x)); return q; }
__device__ __forceinline__ int opqi(int v) { asm volatile("" : "+s"(v)); return v; }
#define GRID_BARRIER() do { XcdBarrier _b; _b.bar = (unsigned*)(opq(p).ws + OFF_CTL); _b.x = xb_xcc_id(); _b.st = (volatile LAS unsigned*)(lds + LDS_PHASE_BYTES); xcd_barrier(_b); } while (0)
#define PP opq(p)
#define BB opqi(bid)
__device__ __forceinline__ void layer_body(const Params& p, LAS unsigned char* lds, const int bid, const int nb, const int l) {
        for (int rep = 0; rep < opqi(MK_PROBE == 1 ? 2 : 1); ++rep) phase_gemm_in(PP, lds, BB, nb);
        GRID_BARRIER();
        phase_prep(PP, l, lds, BB, nb);
        for (int rep = 0; rep < opqi(MK_PROBE == 6 ? 2 : 1); ++rep) phase_hg1(PP, l, lds, BB, nb);
        GRID_BARRIER();
        phase_hg2(PP, BB, nb);
        phase_moba(PP, lds, BB, nb);
        for (int rep = 0; rep < opqi(MK_PROBE == 4 ? 2 : 1); ++rep) phase_dsel(PP, lds, BB, nb);
#if MK_PROBE == 2
        if (l == 0) phase_moba<1>(PP, lds, BB, nb);
#endif
        GRID_BARRIER();
#if MK_PROBE == 3
        if (l == 0) phase_datt<1>(PP, lds, BB, nb);
#endif
#if MK_PROBE == 6
        if (l == 0) phase_hg3<1>(PP, l, lds, BB, nb);
#endif
        phase_hg3(PP, l, lds, BB, nb);
        phase_datt(PP, lds, BB, nb);
        __syncthreads();
        phase_conv_postA(PP, l, lds, BB, nb);
        GRID_BARRIER();
        phase_conv_postB(PP, l, lds, BB, nb);
        for (int rep = 0; rep < opqi(MK_PROBE == 1 ? 2 : 1); ++rep) phase_gemm_gates(PP, lds, BB, nb);
        GRID_BARRIER();
        for (int rep = 0; rep < opqi(MK_PROBE == 1 ? 2 : 1); ++rep) phase_gemm_branch(PP, lds, BB, nb);
        GRID_BARRIER();
        for (int rep = 0; rep < opqi(MK_PROBE == 1 ? 2 : 1); ++rep) phase_gemm_out(PP, lds, BB, nb);
        GRID_BARRIER();
        { const Params q = PP; phase_norm<1>(l == 0 ? q.in[I_X] : q.x, q.x, F32P(q, OFF_OUT), q.in[I_POSTMIX] + l * 1024, q.in[I_PREFFN] + l * 1024, BF(q, OFF_H), BB, nb); }
        GRID_BARRIER();
        for (int rep = 0; rep < opqi(MK_PROBE == 1 ? 2 : 1); ++rep) phase_gemm_ffn1(PP, lds, BB, nb);
        GRID_BARRIER();
        for (int rep = 0; rep < opqi(MK_PROBE == 1 ? 2 : 1); ++rep) phase_gemm_ffn2(PP, lds, BB, nb);
        GRID_BARRIER();
        if (l + 1 < DEPTH) { { const Params q = PP; phase_norm<1>(q.x, q.x, F32P(q, OFF_OUT), q.in[I_POSTFFN] + l * 1024, q.in[I_PREMIX] + (l + 1) * 1024, BF(q, OFF_H), BB, nb); } phase_conv_in(PP, l + 1, lds, BB, nb); GRID_BARRIER(); }
        else { const Params q = PP; phase_norm<2>(q.x, q.x, F32P(q, OFF_OUT), q.in[I_POSTFFN] + l * 1024, nullptr, nullptr, BB, nb); }
}
__global__ __launch_bounds__(512, 2) void mega_fwd(Params p) {
    extern __shared__ __attribute__((aligned(16))) unsigned char shm[];
    LAS unsigned char* lds = (LAS unsigned char*)shm;
    const int bid = blockIdx.x, nb = gridDim.x;
    volatile LAS unsigned* xbw = (volatile LAS unsigned*)(lds + LDS_PHASE_BYTES);
    if (threadIdx.x < 4) xbw[threadIdx.x] = 0u;
    __syncthreads();
    (void)xcd_barrier_post((unsigned*)(p.ws + OFF_CTL), xbw);
    { const Params q = PP; phase_norm<0>(q.in[I_X], nullptr, nullptr, nullptr, q.in[I_PREMIX], BF(q, OFF_H), BB, nb); }
    phase_conv_in(PP, 0, lds, BB, nb);
    GRID_BARRIER();
    for (int l = 0; l < DEPTH; ++l) layer_body(p, lds, bid, nb, l);
}

#define LDS_BYTES (LDS_PHASE_BYTES + 16)
extern "C" void kernel_launch(void* const* d_in, const int* in_sizes, int n_in, void* d_out, int out_size, void* d_ws, size_t ws_size, hipStream_t stream) {
    static int grid = 0;
    if (grid == 0) {
        int dev = 0, cus = 0;
        if (hipGetDevice(&dev) != hipSuccess || hipDeviceGetAttribute(&cus, hipDeviceAttributeMultiprocessorCount, dev) != hipSuccess || cus < 1) { fprintf(stderr, "kernel_launch: no device info\n"); grid = -1; return; }
        if (hipFuncSetAttribute((const void*)mega_fwd, hipFuncAttributeMaxDynamicSharedMemorySize, LDS_BYTES) != hipSuccess) { fprintf(stderr, "kernel_launch: hipFuncSetAttribute failed\n"); grid = -1; return; }
        int per_cu = 0;
        if (hipOccupancyMaxActiveBlocksPerMultiprocessor(&per_cu, (const void*)mega_fwd, 512, LDS_BYTES) != hipSuccess || per_cu < 1) { fprintf(stderr, "kernel_launch: occupancy query says %d blocks per CU\n", per_cu); }
        (void)hipGetLastError();
        grid = cus;
    }
    if (grid < 0) return;
    Params p{};
    for (int i = 0; i < 20; ++i) p.in[i] = (const float*)d_in[i];
    p.x = (float*)d_out; p.ws = (unsigned char*)d_ws;
    if (WS_NEED > ws_size) { fprintf(stderr, "kernel_launch: workspace too small (%zu < %zu)\n", ws_size, (size_t)WS_NEED); return; }
    (void)hipMemsetAsync(p.ws + OFF_CTL, 0, 16384, stream);
    hipLaunchKernelGGL(mega_fwd, dim3(grid), dim3(512), LDS_BYTES, stream, p);
}
```

```cpp
#include <hip/hip_runtime.h>
#include <stdint.h>
#include <stdio.h>

#define D_MODEL 1024
#define BATCH 4
#define SEQ 4096
#define NTOK 16384
#define DEPTH 2
#define IN_W 8008
#define D_FF 2816
#define NEG_BIG (-1e30f)
#define C_HQ 0
#define C_HF 512
#define C_HI 1024
#define C_HG 1536
#define C_MQ 2048
#define C_MK 2560
#define C_MV 3072
#define C_DQ 3584
#define C_DKV 4096
#define C_IQ 4352
#define C_IK 4864
#define C_IW 4928
#define C_G 4936
#define NP1 5632

#define LAS __attribute__((address_space(3)))
typedef unsigned short bf16_t;
typedef short bf16x8 __attribute__((ext_vector_type(8)));
typedef float f32x4 __attribute__((ext_vector_type(4)));
typedef unsigned u32x4 __attribute__((ext_vector_type(4)));
typedef unsigned u32x2 __attribute__((ext_vector_type(2)));

__device__ __forceinline__ float sigmoidf_(float x) { return 1.f / (1.f + __expf(-x)); }
__device__ __forceinline__ float bf2f(bf16_t b) { return __uint_as_float(((unsigned)b) << 16); }
typedef __bf16 bf16x2_t __attribute__((ext_vector_type(2)));
typedef float f32x2_t __attribute__((ext_vector_type(2)));
__device__ __forceinline__ unsigned cvt_pk_bf16(float lo, float hi) { const f32x2_t f = {lo, hi}; const bf16x2_t v = __builtin_convertvector(f, bf16x2_t); return __builtin_bit_cast(unsigned, v); }
__device__ __forceinline__ bf16_t f2bf(float f) { return (bf16_t)(cvt_pk_bf16(f, 0.f) & 0xffffu); }
__device__ __forceinline__ int phase_tid() { int t = threadIdx.x; asm volatile("" : "+v"(t)); return t; }
__device__ __forceinline__ void mfma_fence(f32x4& a) { asm volatile("s_nop 15\n\ts_nop 3" : "+v"(a)); }
__device__ __forceinline__ void mfma_fence(f32x4& a, f32x4& b, f32x4& c, f32x4& d) { asm volatile("s_nop 15\n\ts_nop 3" : "+v"(a), "+v"(b), "+v"(c), "+v"(d)); }
__device__ __forceinline__ int rel_bucket(int dist) {
    int n = dist > 0 ? dist : 0;
    if (n < 16) return n;
    float nf = (float)n;
    int large = 16 + (int)(logf(nf / 16.f) / 4.852030263919617f * 16.f);
    return large < 31 ? large : 31;
}

enum { I_X = 0, I_WIN, I_PREMIX, I_POSTMIX, I_PREFFN, I_POSTFFN, I_LB, I_HGNW, I_KVN, I_WUK, I_WUV, I_IKNW, I_IKNB, I_REL, I_WA, I_WB, I_WC, I_WOUT, I_WF1, I_WF2 };
struct Params { const float* in[20]; float* x; unsigned char* ws; };
constexpr size_t MiB = 1024 * 1024;
#define LDS_PHASE_BYTES (150 * 1024)
constexpr size_t OFF_CTL = 0, OFF_Y = 65536, OFF_HF = OFF_Y + 64 * MiB, OFF_HI = OFF_HF + 16 * MiB, OFF_HG = OFF_HI + 16 * MiB, OFF_MK = OFF_HG + 16 * MiB,
                 OFF_MV = OFF_MK + 16 * MiB, OFF_IQ = OFF_MV + 16 * MiB, OFF_CKV = OFF_IQ + 16 * MiB, OFF_IKW = OFF_CKV + 8 * MiB, OFF_H = OFF_IKW + 4 * MiB,
                 OFF_WIN = OFF_H + 32 * MiB, OFF_RS = OFF_WIN + 11 * MiB;
constexpr size_t OFF_WG = OFF_WIN, OFF_WBR = OFF_WG + 6 * MiB, OFF_WOUT = OFF_RS, OFF_WF1 = OFF_WOUT + 2 * MiB, OFF_WF2 = OFF_WF1 + 11 * MiB, OFF_WEND = OFF_WF2 + 6 * MiB;
constexpr size_t OFF_ST = OFF_RS, OFF_TMPF = OFF_RS, OFF_DEC = OFF_ST + 32 * MiB, OFF_MASK = OFF_DEC + MiB / 2, OFF_KMEAN = OFF_MASK + 8 * MiB, OFF_MEND = OFF_KMEAN + MiB / 8;
constexpr size_t OFF_OUT = OFF_HG, OFF_ACT = OFF_Y;
constexpr size_t WS_NEED = (OFF_WEND > OFF_MEND ? OFF_WEND : OFF_MEND);
#define BF(p, off) ((bf16_t*)((p).ws + (off)))
#define F32P(p, off) ((float*)((p).ws + (off)))
__device__ const unsigned long long kP1Off[22] = {OFF_Y, OFF_Y, OFF_HF, OFF_HF, OFF_HI, OFF_HI, OFF_HG, OFF_HG, OFF_Y, OFF_Y, OFF_MK, OFF_MK, OFF_MV, OFF_MV, OFF_Y, OFF_Y, OFF_Y, OFF_Y, OFF_CKV, OFF_IQ, OFF_IQ, OFF_IKW};
__device__ const int kP1Ld[22]  = {2048, 2048, 512, 512, 512, 512, 512, 512, 2048, 2048, 512, 512, 512, 512, 2048, 2048, 2048, 2048, 256, 512, 512, 128};
__device__ const int kP1C0[22]  = {0, 256, 0, 256, 0, 256, 0, 256, 512, 768, 0, 256, 0, 256, 1024, 1280, 1536, 1792, 0, 0, 256, 0};
__device__ const int kP1Nc[22]  = {256, 256, 256, 256, 256, 256, 256, 256, 256, 256, 256, 256, 256, 256, 256, 256, 256, 256, 256, 256, 256, 128};

#define XB_TMO      128
#define XB_XCNT(j)  (256  + 64 * (j))
#define XB_XSUB(j)  (1280 + 64 * (j))
#define XB_XGEN(j)  (2304 + 64 * (j))
#define XB_TOP      3328
#define XB_TOPGEN   3392
#define XCD_BAR_WORDS 3456
#define XB_SPIN_CAP (1u << 18)

__device__ __forceinline__ unsigned xb_ld(unsigned* p)              { return __hip_atomic_load(p, __ATOMIC_RELAXED, __HIP_MEMORY_SCOPE_AGENT); }
__device__ __forceinline__ unsigned xb_add(unsigned* p, unsigned v) { return __hip_atomic_fetch_add(p, v, __ATOMIC_RELAXED, __HIP_MEMORY_SCOPE_AGENT); }
__device__ __forceinline__ unsigned xb_xcc_id() { return (unsigned)__builtin_amdgcn_s_getreg((3 << 11) | 20) & 0xFu; }
#define XB_SPIN(cond, bar) do { unsigned _sp = 0; while (cond) { __builtin_amdgcn_s_sleep(1); \
    if ((++_sp & 255u) == 0u) { if (xb_ld(&(bar)[XB_TMO])) break; if (_sp > XB_SPIN_CAP) { atomicAdd(&(bar)[XB_TMO], 1u); break; } } } } while (0)

struct XcdBarrier {
    unsigned* bar; unsigned x;
    volatile LAS unsigned* st;
};

__device__ __forceinline__ XcdBarrier xcd_barrier_post(unsigned* bar, volatile LAS unsigned* st) {
    XcdBarrier b; b.bar = bar; b.x = xb_xcc_id(); b.st = st;
    if (threadIdx.x == 0) (void)xb_add(&bar[XB_XCNT(b.x)], 1u);
    return b;
}
__device__ __forceinline__ void xcd_barrier_complete(unsigned* bar, unsigned x, unsigned& nloc, unsigned& nx) {
    const unsigned G = gridDim.x * gridDim.y * gridDim.z;
    unsigned sum, cnt, mine, sp = 0u;
    for (;;) {
        sum = 0u; cnt = 0u; mine = 0u;
#pragma unroll
        for (unsigned j = 0; j < 16; ++j) { const unsigned c = xb_ld(&bar[XB_XCNT(j)]); sum += c; cnt += (c > 0u) ? 1u : 0u; mine = (j == x) ? c : mine; }
        if (sum == G) break;
        __builtin_amdgcn_s_sleep(1);
        if ((++sp & 255u) == 0u) { if (xb_ld(&bar[XB_TMO])) break; if (sp > XB_SPIN_CAP) { atomicAdd(&bar[XB_TMO], 1u); break; } }
    }
    nloc = mine > 0u ? mine : 1u; nx = cnt > 0u ? cnt : 1u;
}

__device__ __forceinline__ void xcd_barrier(const XcdBarrier& b) {
    asm volatile("s_waitcnt vmcnt(0)" ::: "memory");
    __syncthreads();
    if (threadIdx.x == 0) {
        unsigned* bar = b.bar;
        __builtin_amdgcn_s_waitcnt(0);
        unsigned nloc = b.st[0], nx = b.st[1];
        if (nloc == 0u) { xcd_barrier_complete(bar, b.x, nloc, nx); b.st[0] = nloc; b.st[1] = nx; }
        const unsigned old = xb_add(&bar[XB_XSUB(b.x)], 1u);
        const unsigned gen = old / nloc;
        if (old + 1u == (gen + 1u) * nloc) {
            __builtin_amdgcn_fence(__ATOMIC_RELEASE, "agent");
            asm volatile("s_waitcnt vmcnt(0)" ::: "memory");
            const unsigned og = xb_add(&bar[XB_TOP], 1u);
            const unsigned tg = og / nx;
            if (og + 1u == (tg + 1u) * nx) xb_add(&bar[XB_TOPGEN], 1u);
            else XB_SPIN(xb_ld(&bar[XB_TOPGEN]) == tg, bar);
            __builtin_amdgcn_fence(__ATOMIC_ACQUIRE, "agent");
            xb_add(&bar[XB_XGEN(b.x)], 1u);
            asm volatile("s_waitcnt vmcnt(0)" ::: "memory");
        } else {
            XB_SPIN(xb_ld(&bar[XB_XGEN(b.x)]) == gen, bar);
            __builtin_amdgcn_fence(__ATOMIC_ACQUIRE, "agent");
            asm volatile("s_waitcnt vmcnt(0)" ::: "memory");
        }
    }
    __syncthreads();
}


namespace pg8 {
constexpr int BM = 256, BK = 64, HALF = 128, HTB = HALF * BK * 2, STAGE_BYTES = 8 * HTB, NXCD = 8, WGM = 8;
__host__ __device__ __forceinline__ int lds_byte(int r, int c) { const int st = (r >> 4) * 2 + (c >> 5), rr = r & 15, cc = c & 31, ob = rr * 64 + cc * 2; return st * 1024 + (ob ^ (((ob >> 9) & 1) << 5)); }
__host__ __device__ __forceinline__ void stage_rc(int b, int& R, int& C) { const int st = b / 1024, sb = b % 1024, swz = sb ^ (((sb >> 9) & 1) << 5); R = (st >> 1) * 16 + swz / 64; C = (st & 1) * 32 + (swz % 64) / 2; }
__host__ __device__ __forceinline__ int perm32(int rho) { const int n = rho >> 4, i = rho & 15; return 8 * (i >> 2) + 4 * n + (i & 3); }

struct Unit { int pm, pn, ka, nt, br; };
struct Gemm { const bf16_t* A; const bf16_t* Bt; int lda, ldb; };

__device__ __forceinline__ bool tile_of(long L, int nM, int nN, int& pm, int& pn) {
    const int nwg = nM * nN; if (L >= nwg) return false;
    int wgid = (int)L; { const int q = nwg / NXCD, r = nwg % NXCD, xcd = wgid % NXCD, off = wgid / NXCD; wgid = (xcd < r ? xcd * (q + 1) : r * (q + 1) + (xcd - r) * q) + off; }
    const int nig = WGM * nN, gid = wgid / nig, fm = gid * WGM, gsz = (nM - fm) < WGM ? (nM - fm) : WGM;
    pm = fm + ((wgid % nig) % gsz); pn = (wgid % nig) / gsz; return true;
}
struct StaticOrder {
    int nM, nN, G, c, nt;
    __device__ void init(int M, int N, int K, int G_, int c_) { nM = M / BM; nN = N / BM; G = G_; c = c_; nt = K / BK; }
    __device__ bool next(int i, Unit& u) const { u.ka = 0; u.nt = nt; u.br = 0; return tile_of((long)i * G + c, nM, nN, u.pm, u.pn); }
};
struct BranchOrder {
    int nM, nN, G, c;
    __device__ void init(int M, int N, int G_, int c_) { nM = M / BM; nN = N / BM; G = G_; c = c_; }
    __device__ bool next(int i, Unit& u) const { const int ti = i / 3, br = i - ti * 3; u.br = br; u.ka = br * 512; u.nt = (br == 2) ? 16 : 8; return tile_of((long)ti * G + c, nM, nN, u.pm, u.pn); }
};

template <class Epi, class Sched>
__device__ __forceinline__ void gemm_phase(LAS unsigned char* lds, const Gemm g, const Sched& S, const Epi& E) {
    const int tid = phase_tid(), wid = __builtin_amdgcn_readfirstlane(tid >> 6), lane = tid & 63, wr = wid >> 2, wc = wid & 3, fr = lane & 15, fq = lane >> 4;
    unsigned voffA[2], voffB[2];
#pragma unroll
    for (int i = 0; i < 2; ++i) { int R, C; stage_rc(tid * 16 + i * 8192, R, C); const int Rb = Epi::PERM ? ((R & ~31) + perm32(R & 31)) : R;
        voffA[i] = (unsigned)(R * g.lda + C) * 2u; voffB[i] = (unsigned)(Rb * g.ldb + C) * 2u; }
    const size_t kstep = (size_t)(BK * 2);
    const size_t hsA = (size_t)HALF * g.lda * 2, hsB = (size_t)HALF * g.ldb * 2;
    const size_t tsA = 2 * hsA, tsB = 2 * hsB;
    const unsigned ldsw = (unsigned)wid * 1024u;
    const int aoff = lds_byte(wr * 64 + fr, fq * 8), boff = lds_byte(wc * 32 + fr, fq * 8);
#define PG8_SA(b, h) (((b) * 2 + (h)) * HTB)
#define PG8_SB(b, h) ((4 + (b) * 2 + (h)) * HTB)
#define PG8_STAGE(bufoff, gbase, voff) do { _Pragma("unroll") for (int _i = 0; _i < 2; ++_i) \
        __builtin_amdgcn_global_load_lds((const unsigned*)((const char*)(gbase) + (voff)[_i]), (LAS unsigned*)(lds + (bufoff) + ldsw + _i * 8192), 16, 0, 0); } while (0)
#define PG8_LDA(dst, b, h) do { _Pragma("unroll") for (int m = 0; m < 4; ++m) _Pragma("unroll") for (int k = 0; k < 2; ++k) dst[m][k] = *(const LAS bf16x8*)(lds + PG8_SA(b, h) + aoff + m * 2048 + k * 1024); } while (0)
#define PG8_LDB(dst, b, h) do { _Pragma("unroll") for (int n = 0; n < 2; ++n) _Pragma("unroll") for (int k = 0; k < 2; ++k) dst[n][k] = *(const LAS bf16x8*)(lds + PG8_SB(b, h) + boff + n * 2048 + k * 1024); } while (0)
#define PG8_MMA(ai, bj, At, Bt) do { __builtin_amdgcn_s_setprio(1); _Pragma("unroll") for (int m = 0; m < 4; ++m) _Pragma("unroll") for (int n = 0; n < 2; ++n) _Pragma("unroll") for (int k = 0; k < 2; ++k) \
        acc[ai][bj][m][n] = __builtin_amdgcn_mfma_f32_16x16x32_bf16(Bt[n][k], At[m][k], acc[ai][bj][m][n], 0, 0, 0); __builtin_amdgcn_s_setprio(0); } while (0)
#define PG8_WAIT_V(n) asm volatile("s_waitcnt vmcnt(" #n ")" ::: "memory")
#define PG8_WAIT_L(n) asm volatile("s_waitcnt lgkmcnt(" #n ")" ::: "memory")
#define PG8_BAR __builtin_amdgcn_s_barrier()
#define PG8_SCHED __builtin_amdgcn_sched_barrier(0)
    Unit cur, nxt; int ui = 0;
    if (!S.next(0, cur)) return;
    f32x4 acc[2][2][4][2];
#pragma unroll
    for (int a = 0; a < 2; ++a)
#pragma unroll
        for (int b = 0; b < 2; ++b)
#pragma unroll
            for (int m = 0; m < 4; ++m)
#pragma unroll
                for (int n = 0; n < 2; ++n) acc[a][b][m][n] = (f32x4){0.f, 0.f, 0.f, 0.f};
    bf16x8 At[4][2], B0[2][2], B1[2][2];
    const char* cA = (const char*)g.A + (size_t)cur.pm * tsA + (size_t)cur.ka * 2; const char* cB = (const char*)g.Bt + (size_t)cur.pn * tsB + (size_t)cur.ka * 2;
    PG8_STAGE(PG8_SB(0, 0), cB, voffB); PG8_STAGE(PG8_SA(0, 0), cA, voffA); PG8_STAGE(PG8_SB(0, 1), cB + hsB, voffB); PG8_STAGE(PG8_SA(0, 1), cA + hsA, voffA);
    if (wr == 1) PG8_BAR;
    PG8_WAIT_V(4); PG8_BAR;
    PG8_STAGE(PG8_SB(1, 0), cB + kstep, voffB); PG8_STAGE(PG8_SA(1, 0), cA + kstep, voffA); PG8_STAGE(PG8_SB(1, 1), cB + hsB + kstep, voffB);
    PG8_WAIT_V(6); PG8_BAR;
    for (;;) {
        const bool has_next = S.next(ui + 1, nxt);
        const char* nA = has_next ? (const char*)g.A + (size_t)nxt.pm * tsA + (size_t)nxt.ka * 2 : cA; const char* nB = has_next ? (const char*)g.Bt + (size_t)nxt.pn * tsB + (size_t)nxt.ka * 2 : cB;
        const int nt = cur.nt;
        for (int t = 0; t < nt; t += 2) {
            const bool last = (t == nt - 2);
            const char* a1 = cA + (size_t)(t + 1) * kstep;
            const char* a2 = last ? nA : cA + (size_t)(t + 2) * kstep; const char* b2 = last ? nB : cB + (size_t)(t + 2) * kstep;
            const char* a3 = a2 + kstep; const char* b3 = b2 + kstep;
            PG8_LDB(B0, 0, 0); PG8_SCHED; PG8_LDA(At, 0, 0); PG8_STAGE(PG8_SA(1, 1), a1 + hsA, voffA);
            PG8_WAIT_L(8); PG8_BAR; PG8_WAIT_L(0); PG8_MMA(0, 0, At, B0); PG8_BAR; PG8_SCHED;
            PG8_LDB(B1, 0, 1); PG8_STAGE(PG8_SB(0, 0), b2, voffB);
            PG8_BAR; PG8_WAIT_L(0); PG8_MMA(0, 1, At, B1); PG8_BAR;
            PG8_LDA(At, 0, 1); PG8_STAGE(PG8_SA(0, 0), a2, voffA);
            PG8_BAR; PG8_WAIT_L(0); PG8_MMA(1, 0, At, B0); PG8_BAR; PG8_SCHED;
            PG8_STAGE(PG8_SB(0, 1), b2 + hsB, voffB);
            PG8_WAIT_V(6); PG8_BAR; PG8_MMA(1, 1, At, B1); PG8_BAR;
            PG8_LDB(B0, 1, 0); PG8_SCHED; PG8_LDA(At, 1, 0); PG8_STAGE(PG8_SA(0, 1), a2 + hsA, voffA);
            PG8_WAIT_L(8); PG8_BAR; PG8_WAIT_L(0); PG8_MMA(0, 0, At, B0); PG8_BAR; PG8_SCHED;
            PG8_LDB(B1, 1, 1); PG8_STAGE(PG8_SB(1, 0), b3, voffB);
            PG8_BAR; PG8_WAIT_L(0); PG8_MMA(0, 1, At, B1); PG8_BAR;
            PG8_LDA(At, 1, 1); PG8_STAGE(PG8_SA(1, 0), a3, voffA);
            PG8_BAR; PG8_WAIT_L(0); PG8_MMA(1, 0, At, B0); PG8_BAR; PG8_SCHED;
            PG8_STAGE(PG8_SB(1, 1), b3 + hsB, voffB);
            PG8_WAIT_V(6); PG8_BAR; PG8_MMA(1, 1, At, B1); PG8_BAR;
        }
        E(acc, cur, wr, wc, fr, fq);
        if (!has_next) break;
#pragma unroll
        for (int a = 0; a < 2; ++a)
#pragma unroll
            for (int b = 0; b < 2; ++b)
#pragma unroll
                for (int m = 0; m < 4; ++m)
#pragma unroll
                    for (int n = 0; n < 2; ++n) acc[a][b][m][n] = (f32x4){0.f, 0.f, 0.f, 0.f};
        cur = nxt; cA = nA; cB = nB; ++ui;
    }
    PG8_WAIT_V(0);
    if (wr == 0) PG8_BAR;
    PG8_BAR;
#undef PG8_SA
#undef PG8_SB
#undef PG8_STAGE
#undef PG8_LDA
#undef PG8_LDB
#undef PG8_MMA
#undef PG8_WAIT_V
#undef PG8_WAIT_L
#undef PG8_BAR
#undef PG8_SCHED
}

struct EpiF32 {
    static constexpr bool PERM = false;
    float* C; int ldc;
    __device__ __forceinline__ void operator()(const f32x4 (&acc)[2][2][4][2], const Unit& u, int wr, int wc, int fr, int fq) const {
        const int row0 = u.pm * BM + wr * 64 + fr, col0 = u.pn * BM + wc * 32 + 4 * fq;
#pragma unroll
        for (int ai = 0; ai < 2; ++ai)
#pragma unroll
            for (int m = 0; m < 4; ++m) { float* rowp = C + (size_t)(row0 + ai * HALF + m * 16) * ldc + col0;
#pragma unroll
                for (int bj = 0; bj < 2; ++bj)
#pragma unroll
                    for (int n = 0; n < 2; ++n) *(f32x4*)(rowp + bj * HALF + n * 16) = acc[ai][bj][m][n]; }
    }
};
struct EpiProj {
    static constexpr bool PERM = true;
    unsigned char* ws;
    __device__ __forceinline__ void operator()(const f32x4 (&acc)[2][2][4][2], const Unit& u, int wr, int wc, int fr, int fq) const {
        bf16_t* base = (bf16_t*)(ws + kP1Off[u.pn]); const int ld = kP1Ld[u.pn], ncol = kP1Nc[u.pn];
        const int row0 = u.pm * BM + wr * 64 + fr, col0 = kP1C0[u.pn] + wc * 32 + 8 * fq;
#pragma unroll
        for (int ai = 0; ai < 2; ++ai)
#pragma unroll
            for (int m = 0; m < 4; ++m) { bf16_t* rowp = base + (size_t)(row0 + ai * HALF + m * 16) * ld + col0;
#pragma unroll
                for (int bj = 0; bj < 2; ++bj) { if (bj * HALF >= ncol) continue;
                    const f32x4 v0 = acc[ai][bj][m][0], v1 = acc[ai][bj][m][1];
                    u32x4 w; w.x = cvt_pk_bf16(v0[0], v0[1]); w.y = cvt_pk_bf16(v0[2], v0[3]); w.z = cvt_pk_bf16(v1[0], v1[1]); w.w = cvt_pk_bf16(v1[2], v1[3]);
                    *(u32x4*)(rowp + bj * HALF) = w; } }
    }
};
struct EpiGate {
    static constexpr bool PERM = true;
    bf16_t* G0;
    __device__ __forceinline__ void operator()(const f32x4 (&acc)[2][2][4][2], const Unit& u, int wr, int wc, int fr, int fq) const {
        bf16_t* base = G0 + (size_t)(u.pn >> 1) * ((size_t)NTOK * 512);
        const int row0 = u.pm * BM + wr * 64 + fr, col0 = (u.pn & 1) * 256 + wc * 32 + 8 * fq;
#pragma unroll
        for (int ai = 0; ai < 2; ++ai)
#pragma unroll
            for (int m = 0; m < 4; ++m) { bf16_t* rowp = base + (size_t)(row0 + ai * HALF + m * 16) * 512 + col0;
#pragma unroll
                for (int bj = 0; bj < 2; ++bj) {
                    f32x4 v0 = acc[ai][bj][m][0], v1 = acc[ai][bj][m][1];
#pragma unroll
                    for (int j = 0; j < 4; ++j) { v0[j] = sigmoidf_(v0[j]); v1[j] = sigmoidf_(v1[j]); }
                    u32x4 w; w.x = cvt_pk_bf16(v0[0], v0[1]); w.y = cvt_pk_bf16(v0[2], v0[3]); w.z = cvt_pk_bf16(v1[0], v1[1]); w.w = cvt_pk_bf16(v1[2], v1[3]);
                    *(u32x4*)(rowp + bj * HALF) = w; } }
    }
};
struct EpiSwiglu {
    static constexpr bool PERM = true;
    bf16_t* O; int ldc;
    __device__ __forceinline__ void operator()(const f32x4 (&acc)[2][2][4][2], const Unit& u, int wr, int wc, int fr, int fq) const {
        const int row0 = u.pm * BM + wr * 64 + fr, col0 = u.pn * HALF + wc * 32 + 8 * fq;
#pragma unroll
        for (int ai = 0; ai < 2; ++ai)
#pragma unroll
            for (int m = 0; m < 4; ++m) { bf16_t* rowp = O + (size_t)(row0 + ai * HALF + m * 16) * ldc + col0;
                float r[8];
#pragma unroll
                for (int n = 0; n < 2; ++n)
#pragma unroll
                    for (int j = 0; j < 4; ++j) { const float gv = acc[ai][0][m][n][j], uv = acc[ai][1][m][n][j]; r[n * 4 + j] = gv * sigmoidf_(gv) * uv; }
                u32x4 w; w.x = cvt_pk_bf16(r[0], r[1]); w.y = cvt_pk_bf16(r[2], r[3]); w.z = cvt_pk_bf16(r[4], r[5]); w.w = cvt_pk_bf16(r[6], r[7]);
                *(u32x4*)rowp = w; }
    }
};
struct EpiBranch {
    static constexpr bool PERM = true;
    bf16_t* Mg; const bf16_t* G0;
    __device__ __forceinline__ void operator()(const f32x4 (&acc)[2][2][4][2], const Unit& u, int wr, int wc, int fr, int fq) const {
        const bf16_t* gb = G0 + (size_t)(u.br * 2 + (u.pn >> 1)) * ((size_t)NTOK * 512);
        const int row0 = u.pm * BM + wr * 64 + fr, cl = wc * 32 + 8 * fq;
#pragma unroll
        for (int ai = 0; ai < 2; ++ai)
#pragma unroll
            for (int m = 0; m < 4; ++m) { const size_t row = (size_t)(row0 + ai * HALF + m * 16);
#pragma unroll
                for (int bj = 0; bj < 2; ++bj) {
                    const u32x4 gw = *(const u32x4*)(gb + row * 512 + (u.pn & 1) * 256 + bj * HALF + cl);
                    bf16_t* mp = Mg + row * 1024 + u.pn * 256 + bj * HALF + cl;
                    float r[8];
#pragma unroll
                    for (int q = 0; q < 4; ++q) { const unsigned g2 = gw[q]; const int n = q >> 1, j = (q & 1) * 2;
                        r[q * 2] = __uint_as_float(g2 << 16) * acc[ai][bj][m][n][j]; r[q * 2 + 1] = __uint_as_float(g2 & 0xffff0000u) * acc[ai][bj][m][n][j + 1]; }
                    if (u.br != 0) { u32x4 ow;
#pragma unroll
                        for (int q = 0; q < 4; ++q) ow[q] = __hip_atomic_load((const unsigned*)mp + q, __ATOMIC_RELAXED, __HIP_MEMORY_SCOPE_AGENT);
#pragma unroll
                        for (int q = 0; q < 4; ++q) { r[q * 2] += __uint_as_float(ow[q] << 16); r[q * 2 + 1] += __uint_as_float(ow[q] & 0xffff0000u); } }
                    u32x4 w; w.x = cvt_pk_bf16(r[0], r[1]); w.y = cvt_pk_bf16(r[2], r[3]); w.z = cvt_pk_bf16(r[4], r[5]); w.w = cvt_pk_bf16(r[6], r[7]);
                    *(u32x4*)mp = w; } }
    }
};
}

template <int MAP> __device__ __forceinline__ int colmap(int n, int off) {
    if (MAP == 0) return n + off;
    if (MAP == 1) { if (n < 3584) return n; const int s = n - 512; return s < C_G ? s : -1; }
    const int pn = n >> 8, r = n & 255; return (r < 128) ? 128 * pn + r : D_FF + 128 * pn + (r - 128);
}
template <int MAP>
__device__ void conv_job(LAS unsigned char* lds, bf16_t* dst, int ld_dst, int koff, const float* src, int ld_src, int K, int n_lo, int n_hi, int off, int bid, int nb) {
    LAS float* tile = (LAS float*)lds;
    const int tid = phase_tid(), nk = K / 64, nn = (n_hi - n_lo) / 64;
    for (int it = bid; it < nk * nn; it += nb) {
        const int n0 = n_lo + (it / nk) * 64, k0 = (it % nk) * 64;
        { const int kk = tid >> 3, c8 = (tid & 7) * 8;
          const int cfirst = colmap<MAP>(n0 + c8, off), clast = colmap<MAP>(n0 + c8 + 7, off);
          if (cfirst >= 0 && clast == cfirst + 7 && ((cfirst | ld_src) & 3) == 0) {
              const f32x4 v0 = *(const f32x4*)(src + (size_t)(k0 + kk) * ld_src + cfirst), v1 = *(const f32x4*)(src + (size_t)(k0 + kk) * ld_src + cfirst + 4);
#pragma unroll
              for (int j = 0; j < 4; ++j) { tile[kk * 65 + c8 + j] = v0[j]; tile[kk * 65 + c8 + 4 + j] = v1[j]; }
          } else {
#pragma unroll
              for (int j = 0; j < 8; ++j) { const int col = colmap<MAP>(n0 + c8 + j, off); tile[kk * 65 + c8 + j] = (col >= 0) ? src[(size_t)(k0 + kk) * ld_src + col] : 0.f; } } }
        __syncthreads();
        { const int nr = tid >> 3, k8 = (tid & 7) * 8; float v[8];
#pragma unroll
          for (int j = 0; j < 8; ++j) v[j] = tile[(k8 + j) * 65 + nr];
          u32x4 w; w.x = cvt_pk_bf16(v[0], v[1]); w.y = cvt_pk_bf16(v[2], v[3]); w.z = cvt_pk_bf16(v[4], v[5]); w.w = cvt_pk_bf16(v[6], v[7]);
          *(u32x4*)(dst + (size_t)(n0 + nr) * ld_dst + koff + k0 + k8) = w; }
        __syncthreads();
    }
}
__device__ void fold_tile(LAS unsigned char* lds, bf16_t* out, long sOi, long sOj, const float* A, long sAi, long sAd, const float* B, long sBj, long sBd) {
    LAS float* As = (LAS float*)lds; LAS float* Bs = As + 64 * 129;
    const int tid = phase_tid();
    for (int e = tid; e < 64 * 128; e += 512) {
        int i, d; if (sAd == 1) { i = e >> 7; d = e & 127; } else { d = e >> 6; i = e & 63; }
        As[i * 129 + d] = A[i * sAi + d * sAd];
        int j, d2; if (sBd == 1) { j = e >> 7; d2 = e & 127; } else { d2 = e >> 6; j = e & 63; }
        Bs[j * 129 + d2] = B[j * sBj + d2 * sBd];
    }
    __syncthreads();
    const int i = tid & 63, jg = tid >> 6;
    float acc[8];
#pragma unroll
    for (int q = 0; q < 8; ++q) acc[q] = 0.f;
    for (int d = 0; d < 128; ++d) { const float a = As[i * 129 + d];
#pragma unroll
        for (int q = 0; q < 8; ++q) acc[q] += a * Bs[(jg * 8 + q) * 129 + d]; }
#pragma unroll
    for (int q = 0; q < 8; ++q) out[i * sOi + (jg * 8 + q) * sOj] = f2bf(acc[q]);
    __syncthreads();
}

__device__ void phase_conv_in(const Params& p, int l, LAS unsigned char* lds, int bid, int nb) {
    const float* Win = p.in[I_WIN] + (size_t)l * D_MODEL * IN_W;
    conv_job<1>(lds, BF(p, OFF_WIN), 1024, 0, Win, IN_W, 1024, 0, 3584, 0, bid, nb);
    conv_job<1>(lds, BF(p, OFF_WIN), 1024, 0, Win, IN_W, 1024, 4608, NP1, 0, bid, nb);
    const float* wuk = p.in[I_WUK] + (size_t)l * 256 * 512;
    for (int it = bid; it < 256; it += nb) { const int h = it >> 6, rb = (it >> 4) & 3, kb = it & 15;
        fold_tile(lds, BF(p, OFF_WIN) + (size_t)(3584 + h * 256 + rb * 64) * 1024 + kb * 64, 1, 1024,
                  Win + (size_t)(kb * 64) * IN_W + C_DQ + h * 128, IN_W, 1, wuk + ((size_t)(rb * 64) * 4 + h) * 128, 512, 1); }
}
__device__ void phase_conv_postA(const Params& p, int l, LAS unsigned char* lds, int bid, int nb) {
    const float* Win = p.in[I_WIN] + (size_t)l * D_MODEL * IN_W;
    conv_job<0>(lds, BF(p, OFF_WG), 1024, 0, Win, IN_W, 1024, 0, 3072, C_G, bid, nb);
    conv_job<0>(lds, BF(p, OFF_WBR), 2048, 0, p.in[I_WA] + (size_t)l * 512 * 1024, 1024, 512, 0, 1024, 0, bid, nb);
    conv_job<0>(lds, BF(p, OFF_WBR), 2048, 512, p.in[I_WB] + (size_t)l * 512 * 1024, 1024, 512, 0, 1024, 0, bid, nb);
    const float* wuv = p.in[I_WUV] + (size_t)l * 256 * 512; const float* wc = p.in[I_WC] + (size_t)l * 512 * 1024;
    for (int it = bid; it < 256; it += nb) { const int h = it >> 6, rb = (it >> 4) & 3, nbk = it & 15;
        fold_tile(lds, BF(p, OFF_WBR) + (size_t)(nbk * 64) * 2048 + 1024 + h * 256 + rb * 64, 1, 2048,
                  wuv + ((size_t)(rb * 64) * 4 + h) * 128, 512, 1, wc + (size_t)(h * 128) * 1024 + nbk * 64, 1, 1024); }
}
__device__ void phase_conv_postB(const Params& p, int l, LAS unsigned char* lds, int bid, int nb) {
    conv_job<0>(lds, BF(p, OFF_WOUT), 1024, 0, p.in[I_WOUT] + (size_t)l * 1024 * 1024, 1024, 1024, 0, 1024, 0, bid, nb);
    conv_job<2>(lds, BF(p, OFF_WF1), 1024, 0, p.in[I_WF1] + (size_t)l * 1024 * 2 * D_FF, 2 * D_FF, 1024, 0, 2 * D_FF, 0, bid, nb);
    conv_job<0>(lds, BF(p, OFF_WF2), D_FF, 0, p.in[I_WF2] + (size_t)l * D_FF * 1024, 1024, D_FF, 0, 1024, 0, bid, nb);
}

__device__ __forceinline__ float wave_sum(float v) {
#pragma unroll
    for (int o = 32; o >= 1; o >>= 1) v += __shfl_xor(v, o);
    return v;
}
template <int MODE>
__device__ void phase_norm(const float* xin, float* xout, const float* O, const float* wpost, const float* w1, bf16_t* H, int bid, int nb) {
    const int tidn = phase_tid(); const int wv = tidn >> 6, lane = tidn & 63;
    constexpr int NR = 2;
    for (int row0 = bid * 8 + wv; row0 < NTOK; row0 += NR * nb * 8) {
        f32x4 xv[NR][4], ov[NR][4];
#pragma unroll
        for (int q = 0; q < NR; ++q) { const int row = (row0 + q * nb * 8 < NTOK) ? row0 + q * nb * 8 : row0;
#pragma unroll
            for (int j = 0; j < 4; ++j) { xv[q][j] = *(const f32x4*)(xin + (size_t)row * 1024 + j * 256 + lane * 4);
                if (MODE >= 1) ov[q][j] = *(const f32x4*)(O + (size_t)row * 1024 + j * 256 + lane * 4); } }
        if (MODE >= 1) {
            float ss[NR];
#pragma unroll
            for (int q = 0; q < NR; ++q) { ss[q] = 0.f;
#pragma unroll
                for (int j = 0; j < 4; ++j) ss[q] += ov[q][j][0] * ov[q][j][0] + ov[q][j][1] * ov[q][j][1] + ov[q][j][2] * ov[q][j][2] + ov[q][j][3] * ov[q][j][3]; }
#pragma unroll
            for (int o = 32; o >= 1; o >>= 1)
#pragma unroll
                for (int q = 0; q < NR; ++q) ss[q] += __shfl_xor(ss[q], o);
#pragma unroll
            for (int q = 0; q < NR; ++q) { const int row = row0 + q * nb * 8; const float r = rsqrtf(ss[q] * (1.f / 1024.f) + 1e-6f);
#pragma unroll
                for (int j = 0; j < 4; ++j) { const f32x4 wv4 = *(const f32x4*)(wpost + j * 256 + lane * 4); xv[q][j] = xv[q][j] + ov[q][j] * r * wv4;
                    if (row < NTOK) *(f32x4*)(xout + (size_t)row * 1024 + j * 256 + lane * 4) = xv[q][j]; } }
        }
        if (MODE <= 1) {
            float ss[NR];
#pragma unroll
            for (int q = 0; q < NR; ++q) { ss[q] = 0.f;
#pragma unroll
                for (int j = 0; j < 4; ++j) ss[q] += xv[q][j][0] * xv[q][j][0] + xv[q][j][1] * xv[q][j][1] + xv[q][j][2] * xv[q][j][2] + xv[q][j][3] * xv[q][j][3]; }
#pragma unroll
            for (int o = 32; o >= 1; o >>= 1)
#pragma unroll
                for (int q = 0; q < NR; ++q) ss[q] += __shfl_xor(ss[q], o);
#pragma unroll
            for (int q = 0; q < NR; ++q) { const int row = row0 + q * nb * 8; const float r = rsqrtf(ss[q] * (1.f / 1024.f) + 1e-6f);
#pragma unroll
                for (int j = 0; j < 4; ++j) { const f32x4 wv4 = *(const f32x4*)(w1 + j * 256 + lane * 4); const f32x4 y = xv[q][j] * r * wv4;
                    u32x2 w; w.x = cvt_pk_bf16(y[0], y[1]); w.y = cvt_pk_bf16(y[2], y[3]); if (row < NTOK) *(u32x2*)(H + (size_t)row * 1024 + j * 256 + lane * 4) = w; } }
        }
    }
}

__device__ void phase_gemm_in(const Params& p, LAS unsigned char* lds, int bid, int nb) {
    pg8::EpiProj E{p.ws};
    pg8::Gemm g{BF(p, OFF_H), BF(p, OFF_WIN), 1024, 1024};
    pg8::StaticOrder S; S.init(NTOK, NP1, 1024, nb, bid);
    pg8::gemm_phase(lds, g, S, E);
}
__device__ void phase_gemm_gates(const Params& p, LAS unsigned char* lds, int bid, int nb) {
    pg8::EpiGate E{BF(p, OFF_HF)};
    pg8::Gemm g{BF(p, OFF_H), BF(p, OFF_WG), 1024, 1024};
    pg8::StaticOrder S; S.init(NTOK, 3072, 1024, nb, bid);
    pg8::gemm_phase(lds, g, S, E);
}
__device__ void phase_gemm_branch(const Params& p, LAS unsigned char* lds, int bid, int nb) {
    pg8::EpiBranch E; E.Mg = BF(p, OFF_H); E.G0 = BF(p, OFF_HF);
    pg8::Gemm g{BF(p, OFF_Y), BF(p, OFF_WBR), 2048, 2048};
    pg8::BranchOrder S; S.init(NTOK, 1024, nb, bid);
    pg8::gemm_phase(lds, g, S, E);
}
__device__ void phase_gemm_out(const Params& p, LAS unsigned char* lds, int bid, int nb) {
    pg8::EpiF32 E{F32P(p, OFF_OUT), 1024};
    pg8::Gemm g{BF(p, OFF_H), BF(p, OFF_WOUT), 1024, 1024};
    pg8::StaticOrder S; S.init(NTOK, 1024, 1024, nb, bid);
    pg8::gemm_phase(lds, g, S, E);
}
__device__ void phase_gemm_ffn1(const Params& p, LAS unsigned char* lds, int bid, int nb) {
    pg8::EpiSwiglu E{BF(p, OFF_ACT), D_FF};
    pg8::Gemm g{BF(p, OFF_H), BF(p, OFF_WF1), 1024, 1024};
    pg8::StaticOrder S; S.init(NTOK, 2 * D_FF, 1024, nb, bid);
    pg8::gemm_phase(lds, g, S, E);
}
__device__ void phase_gemm_ffn2(const Params& p, LAS unsigned char* lds, int bid, int nb) {
    pg8::EpiF32 E{F32P(p, OFF_OUT), 1024};
    pg8::Gemm g{BF(p, OFF_ACT), BF(p, OFF_WF2), D_FF, D_FF};
    pg8::StaticOrder S; S.init(NTOK, 1024, D_FF, nb, bid);
    pg8::gemm_phase(lds, g, S, E);
}


__device__ __forceinline__ float hg_lower_bound(const float* lbl, int l, int idx) {
    const float l0 = lbl[idx], l1 = lbl[512 + idx]; const float m = fmaxf(l0, l1), e0 = __expf(l0 - m), e1 = __expf(l1 - m), p0 = e0 / (e0 + e1), p1 = e1 / (e0 + e1);
    return ((l == 0) ? p0 : (p0 + p1)) - p0;
}
__device__ __forceinline__ void pack16_store(LAS unsigned char* dst, const float (&v)[16]) {
    u32x4 a, b; a.x = cvt_pk_bf16(v[0], v[1]); a.y = cvt_pk_bf16(v[2], v[3]); a.z = cvt_pk_bf16(v[4], v[5]); a.w = cvt_pk_bf16(v[6], v[7]);
    b.x = cvt_pk_bf16(v[8], v[9]); b.y = cvt_pk_bf16(v[10], v[11]); b.z = cvt_pk_bf16(v[12], v[13]); b.w = cvt_pk_bf16(v[14], v[15]);
    *(LAS u32x4*)dst = a; *(LAS u32x4*)(dst + 16) = b;
}
#define HG_FRONT()                                                                                                   \
    const int d = tid & 127, seg = tid >> 7;                                                                         \
    const float lbd = hg_lower_bound(p.in[I_LB], l, h * 128 + d);                                                    \
    float kk[16], cs[16];                                                                                            \
    { float run = 0.f;                                                                                               \
      _Pragma("unroll") for (int jj = 0; jj < 16; ++jj) {                                                            \
          const float fp = bf2f(HF[(size_t)(row0 + seg * 16 + jj) * 512 + h * 128 + d]);                            \
          const float sg = sigmoidf_(fp); const float f = fmaxf(lbd + (1.f - lbd) * sg, 1e-20f);                     \
          kk[jj] = (1.f - lbd) * (1.f - sg); run += __logf(f); cs[jj] = run; }                                       \
      SEG[seg * 128 + d] = run; }

__device__ void phase_hg1(const Params& p, int l, LAS unsigned char* lds, int bid, int nb) {
    const int tid = phase_tid(), lane = tid & 63, w = __builtin_amdgcn_readfirstlane(tid >> 6), fr = lane & 15, g = lane >> 4;
    LAS float* SEG = (LAS float*)lds; LAS unsigned char* KT = lds + 2048; LAS unsigned char* VT = KT + 128 * 144;
    const bf16_t* HF = BF(p, OFF_HF); const bf16_t* HI = BF(p, OFF_HI); bf16_t* ST = BF(p, OFF_ST); float* DEC = F32P(p, OFF_DEC);
    for (int unit = bid; unit < 1024; unit += nb) {
        const int bh = unit >> 6, c = unit & 63, h = bh & 3, row0 = (bh >> 2) * SEQ + c * 64;
        HG_FRONT();
        float vv[16];
#pragma unroll
        for (int jj = 0; jj < 16; ++jj) vv[jj] = bf2f(HI[(size_t)(row0 + seg * 16 + jj) * 512 + h * 128 + d]);
        __syncthreads();
        float off = 0.f, bl = 0.f;
#pragma unroll
        for (int s2 = 0; s2 < 4; ++s2) { const float t = SEG[s2 * 128 + d]; off += (s2 < seg) ? t : 0.f; bl += t; }
        float kb[16];
#pragma unroll
        for (int jj = 0; jj < 16; ++jj) kb[jj] = kk[jj] * __expf(bl - (off + cs[jj]));
        pack16_store(KT + d * 144 + seg * 32, kb);
        pack16_store(VT + d * 144 + seg * 32, vv);
        if (seg == 0) DEC[(size_t)unit * 128 + d] = __expf(bl);
        __syncthreads();
        bf16x8 a[2];
#pragma unroll
        for (int ks = 0; ks < 2; ++ks) a[ks] = *(const LAS bf16x8*)(KT + (16 * w + fr) * 144 + (32 * ks + 8 * g) * 2);
#pragma unroll
        for (int et = 0; et < 8; ++et) {
            f32x4 acc = {0.f, 0.f, 0.f, 0.f};
#pragma unroll
            for (int ks = 0; ks < 2; ++ks) { const bf16x8 b = *(const LAS bf16x8*)(VT + (16 * et + fr) * 144 + (32 * ks + 8 * g) * 2); acc = __builtin_amdgcn_mfma_f32_16x16x32_bf16(a[ks], b, acc, 0, 0, 0); }
            mfma_fence(acc);
            u32x2 o; o.x = cvt_pk_bf16(acc[0], acc[1]); o.y = cvt_pk_bf16(acc[2], acc[3]);
            *(u32x2*)(ST + ((size_t)unit * 128 + 16 * et + fr) * 128 + 16 * w + 4 * g) = o;
        }
        __syncthreads();
    }
}
__device__ void phase_hg2(const Params& p, int bid, int nb) {
    bf16_t* ST = BF(p, OFF_ST); const float* DEC = F32P(p, OFF_DEC);
    for (int gid = bid * 512 + phase_tid(); gid < 16 * 8192; gid += nb * 512) {
        const int bh = gid >> 13, within = gid & 8191, e = within >> 6, d = (within & 63) * 2;
        float s0 = 0.f, s1 = 0.f;
        for (int c0 = 0; c0 < 64; c0 += 8) {
            unsigned u[8]; float d0[8], d1[8];
#pragma unroll
            for (int k = 0; k < 8; ++k) { const size_t un = (size_t)(bh * 64 + c0 + k);
                u[k] = *(const unsigned*)(ST + (un * 128 + e) * 128 + d); d0[k] = DEC[un * 128 + d]; d1[k] = DEC[un * 128 + d + 1]; }
            asm volatile("s_waitcnt vmcnt(0)" ::: "memory");
#pragma unroll
            for (int k = 0; k < 8; ++k) { const size_t un = (size_t)(bh * 64 + c0 + k);
                *(unsigned*)(ST + (un * 128 + e) * 128 + d) = cvt_pk_bf16(s0, s1);
                s0 = d0[k] * s0 + __uint_as_float(u[k] << 16); s1 = d1[k] * s1 + __uint_as_float(u[k] & 0xffff0000u); }
        }
    }
}
template <int PROBE = 0> __device__ void phase_hg3(const Params& p, int l, LAS unsigned char* lds, int bid, int nb) {
    const int tid = phase_tid(), lane = tid & 63, w = __builtin_amdgcn_readfirstlane(tid >> 6), fr = lane & 15, g = lane >> 4;
    LAS float* SEG = (LAS float*)lds;
    LAS unsigned char* QH = lds + 2048; LAS unsigned char* QT = QH + 64 * 272; LAS float* OL = (LAS float*)(lds + 2048);
    LAS unsigned char* KB = lds + 36864; LAS unsigned char* VT = lds + 54272; LAS unsigned char* SP = lds + 72704; LAS unsigned char* PL = lds + 107520;
    const bf16_t* HF = BF(p, OFF_HF); const bf16_t* HI = BF(p, OFF_HI); const bf16_t* HG = BF(p, OFF_HG); const bf16_t* ST = BF(p, OFF_ST); bf16_t* Y = BF(p, OFF_Y);
    for (int unit = bid; unit < 1024; unit += nb) {
        const int bh = unit >> 6, c = unit & 63, h = bh & 3, row0 = (bh >> 2) * SEQ + c * 64;
        HG_FRONT();
        {
#pragma unroll
            for (int k = 0; k < 4; ++k) { const int ch = tid + 512 * k, e = ch >> 4, dc = ch & 15;
                *(LAS u32x4*)(SP + e * 272 + dc * 16) = *(const u32x4*)(ST + ((size_t)unit * 128 + e) * 128 + dc * 8); }
            float vv[16];
#pragma unroll
            for (int jj = 0; jj < 16; ++jj) vv[jj] = bf2f(HI[(size_t)(row0 + seg * 16 + jj) * 512 + h * 128 + d]);
            pack16_store(VT + d * 144 + seg * 32, vv);
        }
        __syncthreads();
        float beta[4]; { float run = 0.f;
#pragma unroll
            for (int s2 = 0; s2 < 4; ++s2) { beta[s2] = run; run += SEG[s2 * 128 + d]; } }
        float off = 0.f;
#pragma unroll
        for (int s2 = 0; s2 < 4; ++s2) off = (s2 == seg) ? beta[s2] : off;
#pragma unroll
        for (int jj = 0; jj < 16; ++jj) {
            const float q = bf2f(Y[(size_t)(row0 + seg * 16 + jj) * 2048 + h * 128 + d]);
            const int i = seg * 16 + jj;
            *(LAS bf16_t*)(QH + i * 272 + d * 2) = f2bf(q * __expf(off + cs[jj]));
            *(LAS bf16_t*)(QT + i * 272 + d * 2) = f2bf(q * __expf(cs[jj]));
        }
#pragma unroll
        for (int I = 0; I < 4; ++I) {
            if (seg <= I) {
                float bI = 0.f;
#pragma unroll
                for (int s2 = 0; s2 < 4; ++s2) bI = (s2 == I) ? beta[s2] : bI;
#pragma unroll
                for (int jj = 0; jj < 16; ++jj) *(LAS bf16_t*)(KB + (seg * 16 + jj) * 272 + d * 2) = f2bf(kk[jj] * __expf(fminf(bI - (off + cs[jj]), 60.f)));
            }
            __syncthreads();
            if (w < 4) {
                f32x4 acc = {0.f, 0.f, 0.f, 0.f};
                if (w <= I) {
#pragma unroll
                    for (int ks = 0; ks < 4; ++ks) {
                        const bf16x8 a = *(const LAS bf16x8*)(QT + (16 * I + fr) * 272 + (32 * ks + 8 * g) * 2);
                        const bf16x8 b = *(const LAS bf16x8*)(KB + (16 * w + fr) * 272 + (32 * ks + 8 * g) * 2);
                        acc = __builtin_amdgcn_mfma_f32_16x16x32_bf16(a, b, acc, 0, 0, 0); }
                    mfma_fence(acc);
                    const int lim = (w == I) ? (4 * g) : 1000;
#pragma unroll
                    for (int r = 0; r < 4; ++r) acc[r] = (fr <= lim + r) ? acc[r] : 0.f;
                }
#pragma unroll
                for (int r = 0; r < 4; ++r) *(LAS bf16_t*)(PL + (16 * I + 4 * g + r) * 144 + (16 * w + fr) * 2) = f2bf(acc[r]);
            }
            __syncthreads();
        }
        f32x4 oacc[4];
        { const int ib = w >> 1;
          bf16x8 aq[4], ap[2];
#pragma unroll
          for (int ks = 0; ks < 4; ++ks) aq[ks] = *(const LAS bf16x8*)(QH + (16 * ib + fr) * 272 + (32 * ks + 8 * g) * 2);
#pragma unroll
          for (int ks = 0; ks < 2; ++ks) ap[ks] = *(const LAS bf16x8*)(PL + (16 * ib + fr) * 144 + (32 * ks + 8 * g) * 2);
#pragma unroll
          for (int q4 = 0; q4 < 4; ++q4) { const int et = 4 * (w & 1) + q4; f32x4 acc = {0.f, 0.f, 0.f, 0.f};
#pragma unroll
              for (int ks = 0; ks < 4; ++ks) { const bf16x8 b = *(const LAS bf16x8*)(SP + (16 * et + fr) * 272 + (32 * ks + 8 * g) * 2); acc = __builtin_amdgcn_mfma_f32_16x16x32_bf16(aq[ks], b, acc, 0, 0, 0); }
#pragma unroll
              for (int ks = 0; ks < 2; ++ks) { const bf16x8 b = *(const LAS bf16x8*)(VT + (16 * et + fr) * 144 + (32 * ks + 8 * g) * 2); acc = __builtin_amdgcn_mfma_f32_16x16x32_bf16(ap[ks], b, acc, 0, 0, 0); }
              oacc[q4] = acc; } }
        mfma_fence(oacc[0], oacc[1], oacc[2], oacc[3]);
        __syncthreads();
#pragma unroll
        for (int q4 = 0; q4 < 4; ++q4)
#pragma unroll
            for (int r = 0; r < 4; ++r) OL[(16 * (w >> 1) + 4 * g + r) * 132 + 16 * (4 * (w & 1) + q4) + fr] = oacc[q4][r];
        __syncthreads();
        {
            const int i = tid >> 3, es = (tid & 7) * 16;
            float o[16], ss = 0.f;
#pragma unroll
            for (int k = 0; k < 16; ++k) { o[k] = OL[i * 132 + es + k]; ss += o[k] * o[k]; }
            ss += __shfl_xor(ss, 1); ss += __shfl_xor(ss, 2); ss += __shfl_xor(ss, 4);
            const float rstd = rsqrtf(ss * (1.f / 128.f) + 1e-6f);
            const u32x4 g0 = *(const u32x4*)(HG + (size_t)(row0 + i) * 512 + h * 128 + es), g1 = *(const u32x4*)(HG + (size_t)(row0 + i) * 512 + h * 128 + es + 8);
            float y[16];
#pragma unroll
            for (int k = 0; k < 16; ++k) { const unsigned gw = (k < 8) ? g0[k >> 1] : g1[(k - 8) >> 1]; const float gv = (k & 1) ? __uint_as_float(gw & 0xffff0000u) : __uint_as_float(gw << 16);
                y[k] = o[k] * rstd * p.in[I_HGNW][l * 128 + es + k] * (gv * sigmoidf_(gv)); }
            u32x4 a, b; a.x = cvt_pk_bf16(y[0], y[1]); a.y = cvt_pk_bf16(y[2], y[3]); a.z = cvt_pk_bf16(y[4], y[5]); a.w = cvt_pk_bf16(y[6], y[7]);
            b.x = cvt_pk_bf16(y[8], y[9]); b.y = cvt_pk_bf16(y[10], y[11]); b.z = cvt_pk_bf16(y[12], y[13]); b.w = cvt_pk_bf16(y[14], y[15]);
            bf16_t* yo = PROBE ? ((bf16_t*)((unsigned char*)p.x + 16 * MiB) + (size_t)(row0 + i) * 512 + h * 128 + es) : (Y + (size_t)(row0 + i) * 2048 + h * 128 + es);
            *(u32x4*)yo = a; *(u32x4*)(yo + 8) = b;
        }
        __syncthreads();
    }
}


__device__ void phase_prep(const Params& p, int l, LAS unsigned char* lds, int bid, int nb) {
    const int tid = phase_tid(), lane = tid & 63, wv = tid >> 6;
    {
        LAS float* red = (LAS float*)lds; const bf16_t* MK = BF(p, OFF_MK); float* KM = F32P(p, OFF_KMEAN);
        for (int it = bid; it < 256; it += nb) {
            const int bh = it >> 4, n = it & 15, h = bh & 3, d = tid & 127, part = tid >> 7; const size_t row0 = (size_t)(bh >> 2) * SEQ + n * 256 + part * 64;
            float s = 0.f;
            for (int j = 0; j < 64; ++j) s += bf2f(MK[(row0 + j) * 512 + h * 128 + d]);
            red[part * 128 + d] = s; __syncthreads();
            if (part == 0) KM[(size_t)it * 128 + d] = (red[d] + red[128 + d] + red[256 + d] + red[384 + d]) * (1.f / 256.f);
            __syncthreads();
        }
    }
    bf16_t* CKV = BF(p, OFF_CKV); bf16_t* IKW = BF(p, OFF_IKW);
    const float* kvw = p.in[I_KVN] + l * 256; const float* ikw = p.in[I_IKNW] + l * 64; const float* ikb = p.in[I_IKNB] + l * 64;
    for (int row = bid * 8 + wv; row < NTOK; row += nb * 8) {
        {   u32x2* cp = (u32x2*)(CKV + (size_t)row * 256 + lane * 4); const u32x2 v = *cp;
            const float a0 = __uint_as_float(v.x << 16), a1 = __uint_as_float(v.x & 0xffff0000u), a2 = __uint_as_float(v.y << 16), a3 = __uint_as_float(v.y & 0xffff0000u);
            const float ss = wave_sum(a0 * a0 + a1 * a1 + a2 * a2 + a3 * a3); const float r = rsqrtf(ss * (1.f / 256.f) + 1e-6f);
            const f32x4 w4 = *(const f32x4*)(kvw + lane * 4);
            u32x2 o; o.x = cvt_pk_bf16(a0 * r * w4[0], a1 * r * w4[1]); o.y = cvt_pk_bf16(a2 * r * w4[2], a3 * r * w4[3]); *cp = o; }
        {   bf16_t* ip = IKW + (size_t)row * 128; const float u = bf2f(ip[lane]);
            const float mu = wave_sum(u) * (1.f / 64.f); const float xc = u - mu; const float var = wave_sum(xc * xc) * (1.f / 64.f);
            const float y = xc * rsqrtf(var + 1e-6f) * ikw[lane] + ikb[lane];
            const float wgt = (lane < 8) ? bf2f(ip[64 + lane]) * (0.35355339059327373f * 0.125f) : 0.f;
            ip[lane] = f2bf(y); if (lane < 8) ip[64 + lane] = f2bf(wgt); }
    }
}

typedef short v4i16_t __attribute__((ext_vector_type(4)));
__device__ __forceinline__ v4i16_t lds_tr16(const LAS unsigned char* pp) { return __builtin_amdgcn_ds_read_tr16_b64_v4i16((LAS v4i16_t*)pp); }
template <int PROBE = 0> __device__ void phase_moba(const Params& p, LAS unsigned char* lds, int bid, int nb) {
    const int tid = phase_tid(), lane = tid & 63, w = __builtin_amdgcn_readfirstlane(tid >> 6), fr = lane & 15, g = lane >> 4;
    LAS float* BL = (LAS float*)lds; LAS float* KM = (LAS float*)(lds + 16384); LAS float* GG = (LAS float*)(lds + 24576);
    LAS unsigned* SM = (LAS unsigned*)(lds + 32768); LAS unsigned* UM = SM + 128; LAS unsigned* TL = SM + 132;
    LAS unsigned char* QS = lds + 33792; LAS unsigned char* KS = lds + 68608; LAS unsigned char* VS = lds + 86016;
    bf16_t* Y = BF(p, OFF_Y); const bf16_t* MK = BF(p, OFF_MK); const bf16_t* MV = BF(p, OFF_MV);
    const float scale = 0.08838834764831845f;
    int hprev = -1;
    for (int j = bid; j < 512; j += nb) {
        const int bh = j & 15, qt = (j < 256) ? (j >> 4) : (31 - ((j - 256) >> 4));
        const int h = bh & 3, brow = (bh >> 2) * SEQ, t0 = qt * 128, blk = qt >> 1;
        if (h != hprev) { __syncthreads(); for (int dd = tid; dd < 4096; dd += 512) BL[dd] = p.in[I_REL][rel_bucket(dd) * 8 + h]; hprev = h; }
        for (int e = tid; e < 2048; e += 512) KM[e] = F32P(p, OFF_KMEAN)[(size_t)bh * 2048 + e];
#pragma unroll
        for (int k = 0; k < 4; ++k) { const int ch = tid + 512 * k, r = ch >> 4, c = ch & 15;
            *(LAS u32x4*)(QS + r * 272 + c * 16) = *(const u32x4*)(Y + (size_t)(brow + t0 + r) * 2048 + 512 + h * 128 + c * 8); }
        if (tid == 0) *UM = 0u;
        __syncthreads();
        bf16x8 qf[4];
#pragma unroll
        for (int ks = 0; ks < 4; ++ks) qf[ks] = *(const LAS bf16x8*)(QS + (16 * w + fr) * 272 + (32 * ks + 8 * g) * 2);
        {
            f32x4 ga = {0.f, 0.f, 0.f, 0.f};
#pragma unroll
            for (int ks = 0; ks < 4; ++ks) { const f32x4 k0 = *(const LAS f32x4*)(KM + fr * 128 + 32 * ks + 8 * g), k1 = *(const LAS f32x4*)(KM + fr * 128 + 32 * ks + 8 * g + 4);
                u32x4 t; t.x = cvt_pk_bf16(k0[0], k0[1]); t.y = cvt_pk_bf16(k0[2], k0[3]); t.z = cvt_pk_bf16(k1[0], k1[1]); t.w = cvt_pk_bf16(k1[2], k1[3]);
                ga = __builtin_amdgcn_mfma_f32_16x16x32_bf16(__builtin_bit_cast(bf16x8, t), qf[ks], ga, 0, 0, 0); }
            mfma_fence(ga);
            *(LAS f32x4*)(GG + (16 * w + fr) * 16 + 4 * g) = ga;
        }
        __syncthreads();
        if (tid < 128) {
            unsigned used = 0u;
            for (int k = 0; k < 3; ++k) { int best = -1; float bv = 0.f;
                for (int n = 0; n < blk; ++n) { const float v = GG[tid * 16 + n]; if (!((used >> n) & 1u) && (best < 0 || v > bv)) { best = n; bv = v; } }
                if (best >= 0) used |= 1u << best; }
            SM[tid] = used; __hip_atomic_fetch_or((unsigned*)UM, used, __ATOMIC_RELAXED, __HIP_MEMORY_SCOPE_WORKGROUP);
        }
        __syncthreads();
        const unsigned mysel = SM[16 * w + fr];
        const int own_tiles = 2 + 2 * (qt & 1);
        if (tid == 0) {
            const unsigned umask = *UM; int c = 0;
            for (int kt = 0; kt < own_tiles; ++kt) TL[c++] = (unsigned)(blk * 4 + kt);
            for (int n = 0; n < blk; ++n) if ((umask >> n) & 1u) { for (int kt = 0; kt < 4; ++kt) TL[c++] = (unsigned)(n * 4 + kt); }
            TL[64] = (unsigned)c; }
        __syncthreads();
        const int ntiles = (int)TL[64];
        const int tq = t0 + 16 * w + fr;
        f32x4 oacc[8];
#pragma unroll
        for (int dt = 0; dt < 8; ++dt) oacc[dt] = (f32x4){0.f, 0.f, 0.f, 0.f};
        float mrun = -1e30f, lsum = 0.f;
        u32x4 kpre[2], vpre[2];
        { const int key0 = (int)TL[0] * 64;
#pragma unroll
          for (int k = 0; k < 2; ++k) { const int ch = tid + 512 * k, r = ch >> 4, c = ch & 15; const size_t go = (size_t)(brow + key0 + r) * 512 + h * 128 + c * 8; kpre[k] = *(const u32x4*)(MK + go); vpre[k] = *(const u32x4*)(MV + go); } }
        for (int ti = 0; ti < ntiles; ++ti) {
            const int ent = (int)TL[ti], n = ent >> 2, key0 = ent * 64;
            const bool qsel = (n == blk) || ((mysel >> n) & 1u);
            __syncthreads();
#pragma unroll
            for (int k = 0; k < 2; ++k) { const int ch = tid + 512 * k, r = ch >> 4, c = ch & 15; *(LAS u32x4*)(KS + r * 272 + c * 16) = kpre[k]; *(LAS u32x4*)(VS + r * 288 + c * 16) = vpre[k]; }
            __syncthreads();
            if (ti + 1 < ntiles) { const int keyn = (int)TL[ti + 1] * 64;
#pragma unroll
                for (int k = 0; k < 2; ++k) { const int ch = tid + 512 * k, r = ch >> 4, c = ch & 15; const size_t go = (size_t)(brow + keyn + r) * 512 + h * 128 + c * 8; kpre[k] = *(const u32x4*)(MK + go); vpre[k] = *(const u32x4*)(MV + go); } }
            {
                f32x4 s[4];
#pragma unroll
                for (int k4 = 0; k4 < 4; ++k4) { f32x4 acc = {0.f, 0.f, 0.f, 0.f};
#pragma unroll
                    for (int ks = 0; ks < 4; ++ks) { const bf16x8 a = *(const LAS bf16x8*)(KS + (16 * k4 + fr) * 272 + (32 * ks + 8 * g) * 2); acc = __builtin_amdgcn_mfma_f32_16x16x32_bf16(a, qf[ks], acc, 0, 0, 0); }
                    s[k4] = acc; }
                mfma_fence(s[0], s[1], s[2], s[3]);
                float mx = -1e30f;
#pragma unroll
                for (int k4 = 0; k4 < 4; ++k4)
#pragma unroll
                    for (int r = 0; r < 4; ++r) { const int dist = tq - (key0 + 16 * k4 + 4 * g + r); const bool ok = qsel && (dist >= 0);
                        const float lg = s[k4][r] * scale + BL[dist < 0 ? 0 : dist]; s[k4][r] = ok ? lg : -1e30f; mx = fmaxf(mx, s[k4][r]); }
                mx = fmaxf(mx, __shfl_xor(mx, 16)); mx = fmaxf(mx, __shfl_xor(mx, 32));
                const float mnew = fmaxf(mrun, mx), alpha = __expf(mrun - mnew); mrun = mnew;
                float ps = 0.f;
#pragma unroll
                for (int k4 = 0; k4 < 4; ++k4)
#pragma unroll
                    for (int r = 0; r < 4; ++r) { const float pv = (s[k4][r] > -1e29f) ? __expf(s[k4][r] - mnew) : 0.f; s[k4][r] = pv; ps += pv; }
                lsum = lsum * alpha + ps;
                if (__any(alpha != 1.0f)) {
#pragma unroll
                    for (int dt = 0; dt < 8; ++dt) oacc[dt] = oacc[dt] * alpha; }
                bf16x8 pb[2];
#pragma unroll
                for (int m2 = 0; m2 < 2; ++m2) { u32x4 t; t.x = cvt_pk_bf16(s[2 * m2][0], s[2 * m2][1]); t.y = cvt_pk_bf16(s[2 * m2][2], s[2 * m2][3]);
                    t.z = cvt_pk_bf16(s[2 * m2 + 1][0], s[2 * m2 + 1][1]); t.w = cvt_pk_bf16(s[2 * m2 + 1][2], s[2 * m2 + 1][3]); pb[m2] = __builtin_bit_cast(bf16x8, t); }
#pragma unroll
                for (int dt = 0; dt < 8; ++dt)
#pragma unroll
                    for (int m2 = 0; m2 < 2; ++m2) {
                        const LAS unsigned char* va = VS + (32 * m2 + 4 * g + (fr >> 2)) * 288 + (16 * dt + 4 * (fr & 3)) * 2;
                        const v4i16_t lo = lds_tr16(va), hi = lds_tr16(va + 16 * 288);
                        const bf16x8 a = {lo[0], lo[1], lo[2], lo[3], hi[0], hi[1], hi[2], hi[3]};
                        oacc[dt] = __builtin_amdgcn_mfma_f32_16x16x32_bf16(a, pb[m2], oacc[dt], 0, 0, 0); }
            }
        }
        lsum += __shfl_xor(lsum, 16); lsum += __shfl_xor(lsum, 32);
        const float inv = 1.f / lsum;
        mfma_fence(oacc[0], oacc[1], oacc[2], oacc[3]); mfma_fence(oacc[4], oacc[5], oacc[6], oacc[7]);
        __syncthreads();
#pragma unroll
        for (int dt = 0; dt < 8; ++dt) { u32x2 o; o.x = cvt_pk_bf16(oacc[dt][0] * inv, oacc[dt][1] * inv); o.y = cvt_pk_bf16(oacc[dt][2] * inv, oacc[dt][3] * inv);
            if (PROBE) *(u32x2*)((bf16_t*)p.x + (size_t)(brow + tq) * 512 + h * 128 + 16 * dt + 4 * g) = o; else *(u32x2*)(Y + (size_t)(brow + tq) * 2048 + 512 + h * 128 + 16 * dt + 4 * g) = o; }
        __syncthreads();
    }
}


template <int PROBE = 0> __device__ void phase_dsel(const Params& p, LAS unsigned char* lds, int bid, int nb) {
    const int tid = phase_tid(), lane = tid & 63, w = __builtin_amdgcn_readfirstlane(tid >> 6), fr = lane & 15, g = lane >> 4;
    LAS unsigned char* KEYS = lds;
    LAS unsigned char* IQS = lds + 131072;
    const bf16_t* IQ = BF(p, OFF_IQ); const bf16_t* IKW = BF(p, OFF_IKW);
    unsigned* MASK = PROBE ? (unsigned*)((unsigned char*)p.x + (size_t)(PROBE - 1) * 8 * MiB) : (unsigned*)(p.ws + OFF_MASK);
    const int nun = (nb == 256) ? 8 : ((2048 - bid + nb - 1) / nb);
#define DSEL_ITEM(u_) ((nb == 256) ? (((u_) & 1) ? (512 * ((u_) >> 1) + 511 - bid) : (512 * ((u_) >> 1) + bid)) : (bid + (u_) * nb))
    u32x4 iqpre, wpa, wpb; bf16x8 kb0[4][2], kb1[4][2];
#define DSEL_ISSUE(buf, kbase_, base_) do { _Pragma("unroll") for (int j = 0; j < 4; ++j) { int ktl = (base_) + 8 * j; ktl = ktl < 256 ? ktl : 255; const bf16_t* kp = (kbase_) + (size_t)ktl * 2048; \
        (buf)[j][0] = *(const bf16x8*)kp; (buf)[j][1] = *(const bf16x8*)(kp + 32); } } while (0)
#define DSEL_PREFETCH(u_) do { const int k_ = DSEL_ITEM(u_); const int brow_ = (k_ & 3) * SEQ, t0_ = (k_ >> 2) * 8; \
        iqpre = *(const u32x4*)(IQ + (size_t)(brow_ + t0_ + (tid >> 6)) * 512 + (tid & 63) * 8); \
        wpa = *(const u32x4*)(IKW + (size_t)(brow_ + t0_ + 2 * g) * 128 + 64); wpb = *(const u32x4*)(IKW + (size_t)(brow_ + t0_ + 2 * g + 1) * 128 + 64); \
        const bf16_t* kb_ = IKW + (size_t)(brow_ + fr) * 128 + 8 * g; DSEL_ISSUE(kb0, kb_, w); } while (0)
    if (nun > 0) DSEL_PREFETCH(0);
    for (int u = 0; u < nun; ++u) {
        const int k = DSEL_ITEM(u);
        const int b = k & 3, qt = k >> 2, brow = b * SEQ, t0 = qt * 8, nkt = (t0 + 7) / 16 + 1;
        __syncthreads();
        *(LAS u32x4*)(IQS + (tid >> 6) * 1040 + (tid & 63) * 16) = iqpre;
        __syncthreads();
        {
            bf16x8 aq[4][2];
#pragma unroll
            for (int hp = 0; hp < 4; ++hp)
#pragma unroll
                for (int ks = 0; ks < 2; ++ks) aq[hp][ks] = *(const LAS bf16x8*)(IQS + (fr >> 1) * 1040 + ((2 * hp + (fr & 1)) * 64 + 32 * ks + 8 * g) * 2);
            float wa[8], wb[8];
#pragma unroll
            for (int hh = 0; hh < 8; ++hh) { wa[hh] = (hh & 1) ? __uint_as_float(wpa[hh >> 1] & 0xffff0000u) : __uint_as_float(wpa[hh >> 1] << 16); wb[hh] = (hh & 1) ? __uint_as_float(wpb[hh >> 1] & 0xffff0000u) : __uint_as_float(wpb[hh >> 1] << 16); }
            const int tqa = t0 + 2 * g, tqb = tqa + 1;
            const bf16_t* kbase = IKW + (size_t)(brow + fr) * 128 + 8 * g;
#define DSEL_COMPUTE(buf, base_) do { _Pragma("unroll") for (int j = 0; j < 4; ++j) { const int kt = (base_) + 8 * j; if (kt < nkt) { \
                float sa = 0.f, sb = 0.f; \
                f32x4 ah[4]; \
                _Pragma("unroll") for (int hp = 0; hp < 4; ++hp) { f32x4 acc = {0.f, 0.f, 0.f, 0.f}; \
                    acc = __builtin_amdgcn_mfma_f32_16x16x32_bf16(aq[hp][0], (buf)[j][0], acc, 0, 0, 0); acc = __builtin_amdgcn_mfma_f32_16x16x32_bf16(aq[hp][1], (buf)[j][1], acc, 0, 0, 0); ah[hp] = acc; } \
                mfma_fence(ah[0], ah[1], ah[2], ah[3]); \
                _Pragma("unroll") for (int hp = 0; hp < 4; ++hp) { sa += wa[2 * hp] * fmaxf(ah[hp][0], 0.f) + wa[2 * hp + 1] * fmaxf(ah[hp][1], 0.f); sb += wb[2 * hp] * fmaxf(ah[hp][2], 0.f) + wb[2 * hp + 1] * fmaxf(ah[hp][3], 0.f); } \
                const int spos = 16 * kt + fr; \
                unsigned ua = __float_as_uint(sa + 0.0f); ua = (ua & 0x80000000u) ? ~ua : (ua | 0x80000000u); \
                unsigned ub = __float_as_uint(sb + 0.0f); ub = (ub & 0x80000000u) ? ~ub : (ub | 0x80000000u); \
                *(LAS unsigned*)(KEYS + (2 * g) * 16384 + spos * 4) = (spos <= tqa) ? ((ua & 0xfffff000u) | (unsigned)(4095 - spos)) : 0u; \
                *(LAS unsigned*)(KEYS + (2 * g + 1) * 16384 + spos * 4) = (spos <= tqb) ? ((ub & 0xfffff000u) | (unsigned)(4095 - spos)) : 0u; } } } while (0)
            for (int base = w; base < nkt; base += 64) {
                DSEL_ISSUE(kb1, kbase, base + 32);
                DSEL_COMPUTE(kb0, base);
                DSEL_ISSUE(kb0, kbase, base + 64);
                DSEL_COMPUTE(kb1, base + 32);
            }
#undef DSEL_COMPUTE
        }
        __syncthreads();
        if (u + 1 < nun) DSEL_PREFETCH(u + 1);
        {
            const int t = t0 + w; const int nch = 4 * nkt;
            const int mmax = (nch + 63) >> 6;
            u32x4 kr[16];
#pragma unroll
            for (int m = 0; m < 16; ++m) { const int c = lane + 64 * m; const u32x4 z = {0u, 0u, 0u, 0u};
                kr[m] = (m < mmax && c < nch) ? *(const LAS u32x4*)(KEYS + w * 16384 + c * 16) : z; }
            unsigned thr = 1u;
            if (t + 1 > 256) { thr = 0u;
                for (int it = 0; it < 32; ++it) {
                    const unsigned cand = thr | (0x80000000u >> it);
                    unsigned cn = 0u;
#pragma unroll
                    for (int m = 0; m < 16; ++m) if (m < mmax) {
                        cn += (unsigned)__builtin_popcountll(__builtin_amdgcn_ballot_w64(kr[m].x >= cand)); cn += (unsigned)__builtin_popcountll(__builtin_amdgcn_ballot_w64(kr[m].y >= cand));
                        cn += (unsigned)__builtin_popcountll(__builtin_amdgcn_ballot_w64(kr[m].z >= cand)); cn += (unsigned)__builtin_popcountll(__builtin_amdgcn_ballot_w64(kr[m].w >= cand)); }
                    if (cn >= 256u) thr = cand;
                    if (cn == 256u) break;
                } }
            unsigned* mrow = MASK + (size_t)(brow + t) * 128;
#pragma unroll
            for (int m = 0; m < 16; ++m) {
                unsigned nib = 0u;
                if (m < mmax) nib = ((kr[m].x >= thr) ? 1u : 0u) | ((kr[m].y >= thr) ? 2u : 0u) | ((kr[m].z >= thr) ? 4u : 0u) | ((kr[m].w >= thr) ? 8u : 0u);
                unsigned v = nib << (4 * (lane & 7));
                v |= (unsigned)__shfl_xor((int)v, 1); v |= (unsigned)__shfl_xor((int)v, 2); v |= (unsigned)__shfl_xor((int)v, 4);
                if ((lane & 7) == 0) mrow[(lane >> 3) + 8 * m] = v;
            }
        }
    }
#undef DSEL_ISSUE
#undef DSEL_PREFETCH
#undef DSEL_ITEM
}

template <int PROBE = 0> __device__ void phase_datt(const Params& p, LAS unsigned char* lds, int bid, int nb) {
    const int tid = phase_tid(), lane = tid & 63, w = __builtin_amdgcn_readfirstlane(tid >> 6), fr = lane & 15, g = lane >> 4;
    LAS unsigned char* BK = lds;
    LAS float* RL = (LAS float*)(lds + 4096);
    LAS unsigned short* IDX = (LAS unsigned short*)(lds + 5120 + w * 512);
    LAS unsigned char* CT = lds + 9216 + w * (32 * 544);
    const bf16_t* CKV = BF(p, OFF_CKV); bf16_t* Y = BF(p, OFF_Y); const unsigned* MASK = (const unsigned*)(p.ws + OFF_MASK);
    for (int dd = tid; dd < 4096; dd += 512) BK[dd] = (unsigned char)rel_bucket(dd);
    if (tid < 256) RL[tid] = p.in[I_REL][tid];
    __syncthreads();
    const float scale = 0.08838834764831845f;
    const int hd = fr & 3;
    for (int it = bid; it < NTOK / 8; it += nb) {
        const int tg = it * 8 + w, brow = (tg >> 12) * SEQ, t = tg & 4095;
        const u32x2 mw = *(const u32x2*)(MASK + (size_t)tg * 128 + 2 * lane);
        const int cnt = __popc(mw.x) + __popc(mw.y);
        int pre = cnt;
#pragma unroll
        for (int o = 1; o < 64; o <<= 1) { const int v = __shfl_up(pre, o); if (lane >= o) pre += v; }
        const int nsel = __shfl(pre, 63);
        int pos = pre - cnt;
        { unsigned m0 = mw.x; while (m0) { const int bpos = __ffs(m0) - 1; m0 &= m0 - 1; IDX[pos++] = (unsigned short)(64 * lane + bpos); }
          unsigned m1 = mw.y; while (m1) { const int bpos = __ffs(m1) - 1; m1 &= m1 - 1; IDX[pos++] = (unsigned short)(64 * lane + 32 + bpos); } }
        for (int e = nsel + lane; e < 256; e += 64) IDX[e] = 0;
        bf16x8 qb[8];
#pragma unroll
        for (int ks = 0; ks < 8; ++ks) { const u32x4 z = {0u, 0u, 0u, 0u}; const u32x4 v = (fr < 4) ? *(const u32x4*)(Y + (size_t)tg * 2048 + 1024 + fr * 256 + 32 * ks + 8 * g) : z; qb[ks] = __builtin_bit_cast(bf16x8, v); }
        f32x4 oacc[16];
#pragma unroll
        for (int rt = 0; rt < 16; ++rt) oacc[rt] = (f32x4){0.f, 0.f, 0.f, 0.f};
        float mrun = -1e30f, lsum = 0.f;
        const int nstep = (nsel + 31) >> 5;
        bf16x8 a0[8], a1[8];
        { const bf16_t* c0 = CKV + (size_t)(brow + IDX[fr]) * 256 + 8 * g; const bf16_t* c1 = CKV + (size_t)(brow + IDX[16 + fr]) * 256 + 8 * g;
#pragma unroll
          for (int ks = 0; ks < 8; ++ks) { a0[ks] = *(const bf16x8*)(c0 + 32 * ks); a1[ks] = *(const bf16x8*)(c1 + 32 * ks); } }
        for (int st = 0; st < nstep; ++st) {
#pragma unroll
            for (int ks = 0; ks < 8; ++ks) { *(LAS bf16x8*)(CT + fr * 544 + (32 * ks + 8 * g) * 2) = a0[ks]; *(LAS bf16x8*)(CT + (16 + fr) * 544 + (32 * ks + 8 * g) * 2) = a1[ks]; }
            f32x4 s0 = {0.f, 0.f, 0.f, 0.f}, s1 = {0.f, 0.f, 0.f, 0.f};
#pragma unroll
            for (int ks = 0; ks < 8; ++ks) { s0 = __builtin_amdgcn_mfma_f32_16x16x32_bf16(a0[ks], qb[ks], s0, 0, 0, 0); s1 = __builtin_amdgcn_mfma_f32_16x16x32_bf16(a1[ks], qb[ks], s1, 0, 0, 0); }
            mfma_fence(s0); mfma_fence(s1);
            if (st + 1 < nstep) {
                const bf16_t* c0 = CKV + (size_t)(brow + IDX[32 * (st + 1) + fr]) * 256 + 8 * g; const bf16_t* c1 = CKV + (size_t)(brow + IDX[32 * (st + 1) + 16 + fr]) * 256 + 8 * g;
#pragma unroll
                for (int ks = 0; ks < 8; ++ks) { a0[ks] = *(const bf16x8*)(c0 + 32 * ks); a1[ks] = *(const bf16x8*)(c1 + 32 * ks); } }
            float mx = -1e30f;
#pragma unroll
            for (int r = 0; r < 4; ++r) {
                { const int slot = 32 * st + 4 * g + r; const int dist = t - (int)IDX[slot]; const float lg = s0[r] * scale + RL[BK[dist < 0 ? 0 : dist] * 8 + 4 + hd]; s0[r] = (slot < nsel) ? lg : -1e30f; mx = fmaxf(mx, s0[r]); }
                { const int slot = 32 * st + 16 + 4 * g + r; const int dist = t - (int)IDX[slot]; const float lg = s1[r] * scale + RL[BK[dist < 0 ? 0 : dist] * 8 + 4 + hd]; s1[r] = (slot < nsel) ? lg : -1e30f; mx = fmaxf(mx, s1[r]); } }
            mx = fmaxf(mx, __shfl_xor(mx, 16)); mx = fmaxf(mx, __shfl_xor(mx, 32));
            const float mnew = fmaxf(mrun, mx), alpha = __expf(mrun - mnew); mrun = mnew;
            float ps = 0.f;
#pragma unroll
            for (int r = 0; r < 4; ++r) { const float p0 = (s0[r] > -1e29f) ? __expf(s0[r] - mnew) : 0.f, p1 = (s1[r] > -1e29f) ? __expf(s1[r] - mnew) : 0.f; s0[r] = p0; s1[r] = p1; ps += p0 + p1; }
            lsum = lsum * alpha + ps;
#pragma unroll
            for (int rt = 0; rt < 16; ++rt) oacc[rt] = oacc[rt] * alpha;
            u32x4 pt; pt.x = cvt_pk_bf16(s0[0], s0[1]); pt.y = cvt_pk_bf16(s0[2], s0[3]); pt.z = cvt_pk_bf16(s1[0], s1[1]); pt.w = cvt_pk_bf16(s1[2], s1[3]);
            const bf16x8 pb = __builtin_bit_cast(bf16x8, pt);
#pragma unroll
            for (int rt = 0; rt < 16; ++rt) {
                const LAS unsigned char* va = CT + (4 * g + (fr >> 2)) * 544 + (16 * rt + 4 * (fr & 3)) * 2;
                const v4i16_t lo = lds_tr16(va), hi = lds_tr16(va + 16 * 544);
                const bf16x8 a = {lo[0], lo[1], lo[2], lo[3], hi[0], hi[1], hi[2], hi[3]};
                oacc[rt] = __builtin_amdgcn_mfma_f32_16x16x32_bf16(a, pb, oacc[rt], 0, 0, 0); }
        }
        lsum += __shfl_xor(lsum, 16); lsum += __shfl_xor(lsum, 32);
        const float inv = 1.f / lsum;
        mfma_fence(oacc[0], oacc[1], oacc[2], oacc[3]); mfma_fence(oacc[4], oacc[5], oacc[6], oacc[7]); mfma_fence(oacc[8], oacc[9], oacc[10], oacc[11]); mfma_fence(oacc[12], oacc[13], oacc[14], oacc[15]);
        if (fr < 4) {
            bf16_t* yo = PROBE ? ((bf16_t*)((unsigned char*)p.x + 32 * MiB) + (size_t)tg * 1024 + fr * 256 + 4 * g) : (Y + (size_t)tg * 2048 + 1024 + fr * 256 + 4 * g);
#pragma unroll
            for (int rt = 0; rt < 16; ++rt) { u32x2 o; o.x = cvt_pk_bf16(oacc[rt][0] * inv, oacc[rt][1] * inv); o.y = cvt_pk_bf16(oacc[rt][2] * inv, oacc[rt][3] * inv); *(u32x2*)(yo + 16 * rt) = o; }
        }
    }
}

__device__ __forceinline__ Params opq(const Params& p) { Params q = p; asm volatile("" : "+s"(q.ws), "+s"(q.x)); return q; }
__device__ __forceinline__ int opqi(int v) { asm volatile("" : "+s"(v)); return v; }
#define GRID_BARRIER() do { XcdBarrier _b; _b.bar = (unsigned*)(opq(p).ws + OFF_CTL); _b.x = xb_xcc_id(); _b.st = (volatile LAS unsigned*)(lds + LDS_PHASE_BYTES); xcd_barrier(_b); } while (0)
#define PP opq(p)
#define BB opqi(bid)
__device__ __forceinline__ void layer_body(const Params& p, LAS unsigned char* lds, const int bid, const int nb, const int l) {
        phase_gemm_in(PP, lds, BB, nb);
        GRID_BARRIER();
        phase_prep(PP, l, lds, BB, nb);
        phase_hg1(PP, l, lds, BB, nb);
        GRID_BARRIER();
        phase_hg2(PP, BB, nb);
        phase_moba(PP, lds, BB, nb);
        phase_dsel(PP, lds, BB, nb);
        GRID_BARRIER();
        phase_hg3(PP, l, lds, BB, nb);
        phase_datt(PP, lds, BB, nb);
        __syncthreads();
        phase_conv_postA(PP, l, lds, BB, nb);
        GRID_BARRIER();
        phase_conv_postB(PP, l, lds, BB, nb);
        phase_gemm_gates(PP, lds, BB, nb);
        GRID_BARRIER();
        phase_gemm_branch(PP, lds, BB, nb);
        GRID_BARRIER();
        phase_gemm_out(PP, lds, BB, nb);
        GRID_BARRIER();
        { const Params q = PP; phase_norm<1>(l == 0 ? q.in[I_X] : q.x, q.x, F32P(q, OFF_OUT), q.in[I_POSTMIX] + l * 1024, q.in[I_PREFFN] + l * 1024, BF(q, OFF_H), BB, nb); }
        GRID_BARRIER();
        phase_gemm_ffn1(PP, lds, BB, nb);
        GRID_BARRIER();
        phase_gemm_ffn2(PP, lds, BB, nb);
        GRID_BARRIER();
        if (l + 1 < DEPTH) { { const Params q = PP; phase_norm<1>(q.x, q.x, F32P(q, OFF_OUT), q.in[I_POSTFFN] + l * 1024, q.in[I_PREMIX] + (l + 1) * 1024, BF(q, OFF_H), BB, nb); } phase_conv_in(PP, l + 1, lds, BB, nb); GRID_BARRIER(); }
        else { const Params q = PP; phase_norm<2>(q.x, q.x, F32P(q, OFF_OUT), q.in[I_POSTFFN] + l * 1024, nullptr, nullptr, BB, nb); }
}
__global__ __launch_bounds__(512, 2) void mega_fwd(Params p) {
    extern __shared__ __attribute__((aligned(16))) unsigned char shm[];
    LAS unsigned char* lds = (LAS unsigned char*)shm;
    const int bid = blockIdx.x, nb = gridDim.x;
    volatile LAS unsigned* xbw = (volatile LAS unsigned*)(lds + LDS_PHASE_BYTES);
    if (threadIdx.x < 4) xbw[threadIdx.x] = 0u;
    __syncthreads();
    (void)xcd_barrier_post((unsigned*)(p.ws + OFF_CTL), xbw);
    { const Params q = PP; phase_norm<0>(q.in[I_X], nullptr, nullptr, nullptr, q.in[I_PREMIX], BF(q, OFF_H), BB, nb); }
    phase_conv_in(PP, 0, lds, BB, nb);
    GRID_BARRIER();
    for (int l = 0; l < DEPTH; ++l) layer_body(p, lds, bid, nb, l);
}

#define LDS_BYTES (LDS_PHASE_BYTES + 16)
extern "C" void kernel_launch(void* const* d_in, const int* in_sizes, int n_in, void* d_out, int out_size, void* d_ws, size_t ws_size, hipStream_t stream) {
    static int grid = 0;
    if (grid == 0) {
        int dev = 0, cus = 0;
        if (hipGetDevice(&dev) != hipSuccess || hipDeviceGetAttribute(&cus, hipDeviceAttributeMultiprocessorCount, dev) != hipSuccess || cus < 1) { fprintf(stderr, "kernel_launch: no device info\n"); grid = -1; return; }
        if (hipFuncSetAttribute((const void*)mega_fwd, hipFuncAttributeMaxDynamicSharedMemorySize, LDS_BYTES) != hipSuccess) { fprintf(stderr, "kernel_launch: hipFuncSetAttribute failed\n"); grid = -1; return; }
        int per_cu = 0;
        if (hipOccupancyMaxActiveBlocksPerMultiprocessor(&per_cu, (const void*)mega_fwd, 512, LDS_BYTES) != hipSuccess || per_cu < 1) { fprintf(stderr, "kernel_launch: occupancy query says %d blocks per CU\n", per_cu); }
        (void)hipGetLastError();
        grid = cus;
    }
    if (grid < 0) return;
    Params p{};
    for (int i = 0; i < 20; ++i) p.in[i] = (const float*)d_in[i];
    p.x = (float*)d_out; p.ws = (unsigned char*)d_ws;
    if (WS_NEED > ws_size) { fprintf(stderr, "kernel_launch: workspace too small (%zu < %zu)\n", ws_size, (size_t)WS_NEED); return; }
    (void)hipMemsetAsync(p.ws + OFF_CTL, 0, 16384, stream);
    hipLaunchKernelGGL(mega_fwd, dim3(grid), dim3(512), LDS_BYTES, stream, p);
}
```

```cpp
#include <hip/hip_runtime.h>
#include <stdint.h>
#include <stdio.h>

#define D_MODEL 1024
#define BATCH 4
#define SEQ 4096
#define NTOK 16384
#define DEPTH 2
#define IN_W 8008
#define D_FF 2816
#define NEG_BIG (-1e30f)
#define C_HQ 0
#define C_HF 512
#define C_HI 1024
#define C_HG 1536
#define C_MQ 2048
#define C_MK 2560
#define C_MV 3072
#define C_DQ 3584
#define C_DKV 4096
#define C_IQ 4352
#define C_IK 4864
#define C_IW 4928
#define C_G 4936
#define NP1 5632

#define LAS __attribute__((address_space(3)))
typedef unsigned short bf16_t;
typedef short bf16x8 __attribute__((ext_vector_type(8)));
typedef float f32x4 __attribute__((ext_vector_type(4)));
typedef unsigned u32x4 __attribute__((ext_vector_type(4)));
typedef unsigned u32x2 __attribute__((ext_vector_type(2)));

__device__ __forceinline__ float sigmoidf_(float x) { return 1.f / (1.f + __expf(-x)); }
__device__ __forceinline__ float bf2f(bf16_t b) { return __uint_as_float(((unsigned)b) << 16); }
typedef __bf16 bf16x2_t __attribute__((ext_vector_type(2)));
typedef float f32x2_t __attribute__((ext_vector_type(2)));
__device__ __forceinline__ unsigned cvt_pk_bf16(float lo, float hi) { const f32x2_t f = {lo, hi}; const bf16x2_t v = __builtin_convertvector(f, bf16x2_t); return __builtin_bit_cast(unsigned, v); }
__device__ __forceinline__ bf16_t f2bf(float f) { return (bf16_t)(cvt_pk_bf16(f, 0.f) & 0xffffu); }
__device__ __forceinline__ int phase_tid() { int t = threadIdx.x; asm volatile("" : "+v"(t)); return t; }
__device__ __forceinline__ void mfma_fence(f32x4& a) { asm volatile("s_nop 15\n\ts_nop 3" : "+v"(a)); }
__device__ __forceinline__ void mfma_fence(f32x4& a, f32x4& b, f32x4& c, f32x4& d) { asm volatile("s_nop 15\n\ts_nop 3" : "+v"(a), "+v"(b), "+v"(c), "+v"(d)); }
__device__ __forceinline__ int rel_bucket(int dist) {
    int n = dist > 0 ? dist : 0;
    if (n < 16) return n;
    float nf = (float)n;
    int large = 16 + (int)(logf(nf / 16.f) / 4.852030263919617f * 16.f);
    return large < 31 ? large : 31;
}

enum { I_X = 0, I_WIN, I_PREMIX, I_POSTMIX, I_PREFFN, I_POSTFFN, I_LB, I_HGNW, I_KVN, I_WUK, I_WUV, I_IKNW, I_IKNB, I_REL, I_WA, I_WB, I_WC, I_WOUT, I_WF1, I_WF2 };
struct Params { const float* in[20]; float* x; unsigned char* ws; };
constexpr size_t MiB = 1024 * 1024;
#define LDS_PHASE_BYTES (150 * 1024)
constexpr size_t OFF_CTL = 0, OFF_Y = 65536, OFF_HF = OFF_Y + 64 * MiB, OFF_HI = OFF_HF + 16 * MiB, OFF_HG = OFF_HI + 16 * MiB, OFF_MK = OFF_HG + 16 * MiB,
                 OFF_MV = OFF_MK + 16 * MiB, OFF_IQ = OFF_MV + 16 * MiB, OFF_CKV = OFF_IQ + 16 * MiB, OFF_IKW = OFF_CKV + 8 * MiB, OFF_H = OFF_IKW + 4 * MiB,
                 OFF_WIN = OFF_H + 32 * MiB, OFF_RS = OFF_WIN + 11 * MiB;
constexpr size_t OFF_WG = OFF_WIN, OFF_WBR = OFF_WG + 6 * MiB, OFF_WOUT = OFF_RS, OFF_WF1 = OFF_WOUT + 2 * MiB, OFF_WF2 = OFF_WF1 + 11 * MiB, OFF_WEND = OFF_WF2 + 6 * MiB;
constexpr size_t OFF_ST = OFF_RS, OFF_TMPF = OFF_RS, OFF_DEC = OFF_ST + 32 * MiB, OFF_MASK = OFF_DEC + MiB / 2, OFF_KMEAN = OFF_MASK + 8 * MiB, OFF_MEND = OFF_KMEAN + MiB / 8;
constexpr size_t OFF_OUT = OFF_HG, OFF_ACT = OFF_Y, OFF_XB = OFF_MV;
constexpr size_t WS_NEED = (OFF_WEND > OFF_MEND ? OFF_WEND : OFF_MEND);
#define BF(p, off) ((bf16_t*)((p).ws + (off)))
#define F32P(p, off) ((float*)((p).ws + (off)))
__device__ const unsigned long long kP1Off[22] = {OFF_Y, OFF_Y, OFF_HF, OFF_HF, OFF_HI, OFF_HI, OFF_HG, OFF_HG, OFF_Y, OFF_Y, OFF_MK, OFF_MK, OFF_MV, OFF_MV, OFF_Y, OFF_Y, OFF_Y, OFF_Y, OFF_CKV, OFF_IQ, OFF_IQ, OFF_IKW};
__device__ const int kP1Ld[22]  = {2048, 2048, 512, 512, 512, 512, 512, 512, 2048, 2048, 512, 512, 512, 512, 2048, 2048, 2048, 2048, 256, 512, 512, 128};
__device__ const int kP1C0[22]  = {0, 256, 0, 256, 0, 256, 0, 256, 512, 768, 0, 256, 0, 256, 1024, 1280, 1536, 1792, 0, 0, 256, 0};
__device__ const int kP1Nc[22]  = {256, 256, 256, 256, 256, 256, 256, 256, 256, 256, 256, 256, 256, 256, 256, 256, 256, 256, 256, 256, 256, 128};

#define XB_TMO      128
#define XB_XCNT(j)  (256  + 64 * (j))
#define XB_XSUB(j)  (1280 + 64 * (j))
#define XB_XGEN(j)  (2304 + 64 * (j))
#define XB_TOP      3328
#define XB_TOPGEN   3392
#define XCD_BAR_WORDS 3456
#define XB_SPIN_CAP (1u << 18)

__device__ __forceinline__ unsigned xb_ld(unsigned* p)              { return __hip_atomic_load(p, __ATOMIC_RELAXED, __HIP_MEMORY_SCOPE_AGENT); }
__device__ __forceinline__ unsigned xb_add(unsigned* p, unsigned v) { return __hip_atomic_fetch_add(p, v, __ATOMIC_RELAXED, __HIP_MEMORY_SCOPE_AGENT); }
__device__ __forceinline__ unsigned xb_xcc_id() { return (unsigned)__builtin_amdgcn_s_getreg((3 << 11) | 20) & 0xFu; }
#define XB_SPIN(cond, bar) do { unsigned _sp = 0; while (cond) { __builtin_amdgcn_s_sleep(1); \
    if ((++_sp & 255u) == 0u) { if (xb_ld(&(bar)[XB_TMO])) break; if (_sp > XB_SPIN_CAP) { atomicAdd(&(bar)[XB_TMO], 1u); break; } } } } while (0)

struct XcdBarrier {
    unsigned* bar; unsigned x;
    volatile LAS unsigned* st;
};

__device__ __forceinline__ XcdBarrier xcd_barrier_post(unsigned* bar, volatile LAS unsigned* st) {
    XcdBarrier b; b.bar = bar; b.x = xb_xcc_id(); b.st = st;
    if (threadIdx.x == 0) (void)xb_add(&bar[XB_XCNT(b.x)], 1u);
    return b;
}
__device__ __forceinline__ void xcd_barrier_complete(unsigned* bar, unsigned x, unsigned& nloc, unsigned& nx) {
    const unsigned G = gridDim.x * gridDim.y * gridDim.z;
    unsigned sum, cnt, mine, sp = 0u;
    for (;;) {
        sum = 0u; cnt = 0u; mine = 0u;
#pragma unroll
        for (unsigned j = 0; j < 16; ++j) { const unsigned c = xb_ld(&bar[XB_XCNT(j)]); sum += c; cnt += (c > 0u) ? 1u : 0u; mine = (j == x) ? c : mine; }
        if (sum == G) break;
        __builtin_amdgcn_s_sleep(1);
        if ((++sp & 255u) == 0u) { if (xb_ld(&bar[XB_TMO])) break; if (sp > XB_SPIN_CAP) { atomicAdd(&bar[XB_TMO], 1u); break; } }
    }
    nloc = mine > 0u ? mine : 1u; nx = cnt > 0u ? cnt : 1u;
}

__device__ __forceinline__ void xcd_barrier(const XcdBarrier& b) {
    asm volatile("s_waitcnt vmcnt(0)" ::: "memory");
    __syncthreads();
    if (threadIdx.x == 0) {
        unsigned* bar = b.bar;
        __builtin_amdgcn_s_waitcnt(0);
        unsigned nloc = b.st[0], nx = b.st[1];
        if (nloc == 0u) { xcd_barrier_complete(bar, b.x, nloc, nx); b.st[0] = nloc; b.st[1] = nx; }
        const unsigned old = xb_add(&bar[XB_XSUB(b.x)], 1u);
        const unsigned gen = old / nloc;
        if (old + 1u == (gen + 1u) * nloc) {
            __builtin_amdgcn_fence(__ATOMIC_RELEASE, "agent");
            asm volatile("s_waitcnt vmcnt(0)" ::: "memory");
            const unsigned og = xb_add(&bar[XB_TOP], 1u);
            const unsigned tg = og / nx;
            if (og + 1u == (tg + 1u) * nx) xb_add(&bar[XB_TOPGEN], 1u);
            else XB_SPIN(xb_ld(&bar[XB_TOPGEN]) == tg, bar);
            __builtin_amdgcn_fence(__ATOMIC_ACQUIRE, "agent");
            xb_add(&bar[XB_XGEN(b.x)], 1u);
            asm volatile("s_waitcnt vmcnt(0)" ::: "memory");
        } else {
            XB_SPIN(xb_ld(&bar[XB_XGEN(b.x)]) == gen, bar);
            __builtin_amdgcn_fence(__ATOMIC_ACQUIRE, "agent");
            asm volatile("s_waitcnt vmcnt(0)" ::: "memory");
        }
    }
    __syncthreads();
}


namespace pg8 {
constexpr int BM = 256, BK = 64, HALF = 128, HTB = HALF * BK * 2, STAGE_BYTES = 8 * HTB, NXCD = 8, WGM = 8;
__host__ __device__ __forceinline__ int lds_byte(int r, int c) { const int st = (r >> 4) * 2 + (c >> 5), rr = r & 15, cc = c & 31, ob = rr * 64 + cc * 2; return st * 1024 + (ob ^ (((ob >> 9) & 1) << 5)); }
__host__ __device__ __forceinline__ void stage_rc(int b, int& R, int& C) { const int st = b / 1024, sb = b % 1024, swz = sb ^ (((sb >> 9) & 1) << 5); R = (st >> 1) * 16 + swz / 64; C = (st & 1) * 32 + (swz % 64) / 2; }
__host__ __device__ __forceinline__ int perm32(int rho) { const int n = rho >> 4, i = rho & 15; return 8 * (i >> 2) + 4 * n + (i & 3); }

struct Unit { int pm, pn, ka, nt, br; };
struct Gemm { const bf16_t* A; const bf16_t* Bt; int lda, ldb; };

__device__ __forceinline__ bool tile_of(long L, int nM, int nN, int& pm, int& pn) {
    const int nwg = nM * nN; if (L >= nwg) return false;
    int wgid = (int)L; { const int q = nwg / NXCD, r = nwg % NXCD, xcd = wgid % NXCD, off = wgid / NXCD; wgid = (xcd < r ? xcd * (q + 1) : r * (q + 1) + (xcd - r) * q) + off; }
    const int nig = WGM * nN, gid = wgid / nig, fm = gid * WGM, gsz = (nM - fm) < WGM ? (nM - fm) : WGM;
    pm = fm + ((wgid % nig) % gsz); pn = (wgid % nig) / gsz; return true;
}
struct StaticOrder {
    int nM, nN, G, c, nt;
    __device__ void init(int M, int N, int K, int G_, int c_) { nM = M / BM; nN = N / BM; G = G_; c = c_; nt = K / BK; }
    __device__ bool next(int i, Unit& u) const { u.ka = 0; u.nt = nt; u.br = 0; return tile_of((long)i * G + c, nM, nN, u.pm, u.pn); }
};
struct BranchOrder {
    int nM, nN, G, c;
    __device__ void init(int M, int N, int G_, int c_) { nM = M / BM; nN = N / BM; G = G_; c = c_; }
    __device__ bool next(int i, Unit& u) const { const int ti = i / 3, br = i - ti * 3; u.br = br; u.ka = br * 512; u.nt = (br == 2) ? 16 : 8; return tile_of((long)ti * G + c, nM, nN, u.pm, u.pn); }
};

template <class Epi, class Sched>
__device__ __forceinline__ void gemm_phase(LAS unsigned char* lds, const Gemm g, const Sched& S, const Epi& E) {
    const int tid = phase_tid(), wid = __builtin_amdgcn_readfirstlane(tid >> 6), lane = tid & 63, wr = wid >> 2, wc = wid & 3, fr = lane & 15, fq = lane >> 4;
    unsigned voffA[2], voffB[2];
#pragma unroll
    for (int i = 0; i < 2; ++i) { int R, C; stage_rc(tid * 16 + i * 8192, R, C); const int Rb = Epi::PERM ? ((R & ~31) + perm32(R & 31)) : R;
        voffA[i] = (unsigned)(R * g.lda + C) * 2u; voffB[i] = (unsigned)(Rb * g.ldb + C) * 2u; }
    const size_t kstep = (size_t)(BK * 2);
    const size_t hsA = (size_t)HALF * g.lda * 2, hsB = (size_t)HALF * g.ldb * 2;
    const size_t tsA = 2 * hsA, tsB = 2 * hsB;
    const unsigned ldsw = (unsigned)wid * 1024u;
    const int aoff = lds_byte(wr * 64 + fr, fq * 8), boff = lds_byte(wc * 32 + fr, fq * 8);
#define PG8_SA(b, h) (((b) * 2 + (h)) * HTB)
#define PG8_SB(b, h) ((4 + (b) * 2 + (h)) * HTB)
#define PG8_STAGE(bufoff, gbase, voff) do { _Pragma("unroll") for (int _i = 0; _i < 2; ++_i) \
        __builtin_amdgcn_global_load_lds((const unsigned*)((const char*)(gbase) + (voff)[_i]), (LAS unsigned*)(lds + (bufoff) + ldsw + _i * 8192), 16, 0, 0); } while (0)
#define PG8_LDA(dst, b, h) do { _Pragma("unroll") for (int m = 0; m < 4; ++m) _Pragma("unroll") for (int k = 0; k < 2; ++k) dst[m][k] = *(const LAS bf16x8*)(lds + PG8_SA(b, h) + aoff + m * 2048 + k * 1024); } while (0)
#define PG8_LDB(dst, b, h) do { _Pragma("unroll") for (int n = 0; n < 2; ++n) _Pragma("unroll") for (int k = 0; k < 2; ++k) dst[n][k] = *(const LAS bf16x8*)(lds + PG8_SB(b, h) + boff + n * 2048 + k * 1024); } while (0)
#define PG8_MMA(ai, bj, At, Bt) do { __builtin_amdgcn_s_setprio(1); _Pragma("unroll") for (int m = 0; m < 4; ++m) _Pragma("unroll") for (int n = 0; n < 2; ++n) _Pragma("unroll") for (int k = 0; k < 2; ++k) \
        acc[ai][bj][m][n] = __builtin_amdgcn_mfma_f32_16x16x32_bf16(Bt[n][k], At[m][k], acc[ai][bj][m][n], 0, 0, 0); __builtin_amdgcn_s_setprio(0); } while (0)
#define PG8_WAIT_V(n) asm volatile("s_waitcnt vmcnt(" #n ")" ::: "memory")
#define PG8_WAIT_L(n) asm volatile("s_waitcnt lgkmcnt(" #n ")" ::: "memory")
#define PG8_BAR __builtin_amdgcn_s_barrier()
#define PG8_SCHED __builtin_amdgcn_sched_barrier(0)
    Unit cur, nxt; int ui = 0;
    if (!S.next(0, cur)) return;
    f32x4 acc[2][2][4][2];
#pragma unroll
    for (int a = 0; a < 2; ++a)
#pragma unroll
        for (int b = 0; b < 2; ++b)
#pragma unroll
            for (int m = 0; m < 4; ++m)
#pragma unroll
                for (int n = 0; n < 2; ++n) acc[a][b][m][n] = (f32x4){0.f, 0.f, 0.f, 0.f};
    bf16x8 At[4][2], B0[2][2], B1[2][2];
    const char* cA = (const char*)g.A + (size_t)cur.pm * tsA + (size_t)cur.ka * 2; const char* cB = (const char*)g.Bt + (size_t)cur.pn * tsB + (size_t)cur.ka * 2;
    PG8_STAGE(PG8_SB(0, 0), cB, voffB); PG8_STAGE(PG8_SA(0, 0), cA, voffA); PG8_STAGE(PG8_SB(0, 1), cB + hsB, voffB); PG8_STAGE(PG8_SA(0, 1), cA + hsA, voffA);
    if (wr == 1) PG8_BAR;
    PG8_WAIT_V(4); PG8_BAR;
    PG8_STAGE(PG8_SB(1, 0), cB + kstep, voffB); PG8_STAGE(PG8_SA(1, 0), cA + kstep, voffA); PG8_STAGE(PG8_SB(1, 1), cB + hsB + kstep, voffB);
    PG8_WAIT_V(6); PG8_BAR;
    for (;;) {
        const bool has_next = S.next(ui + 1, nxt);
        const char* nA = has_next ? (const char*)g.A + (size_t)nxt.pm * tsA + (size_t)nxt.ka * 2 : cA; const char* nB = has_next ? (const char*)g.Bt + (size_t)nxt.pn * tsB + (size_t)nxt.ka * 2 : cB;
        const int nt = cur.nt;
        for (int t = 0; t < nt; t += 2) {
            const bool last = (t == nt - 2);
            const char* a1 = cA + (size_t)(t + 1) * kstep;
            const char* a2 = last ? nA : cA + (size_t)(t + 2) * kstep; const char* b2 = last ? nB : cB + (size_t)(t + 2) * kstep;
            const char* a3 = a2 + kstep; const char* b3 = b2 + kstep;
            PG8_LDB(B0, 0, 0); PG8_SCHED; PG8_LDA(At, 0, 0); PG8_STAGE(PG8_SA(1, 1), a1 + hsA, voffA);
            PG8_WAIT_L(8); PG8_BAR; PG8_WAIT_L(0); PG8_MMA(0, 0, At, B0); PG8_BAR; PG8_SCHED;
            PG8_LDB(B1, 0, 1); PG8_STAGE(PG8_SB(0, 0), b2, voffB);
            PG8_BAR; PG8_WAIT_L(0); PG8_MMA(0, 1, At, B1); PG8_BAR;
            PG8_LDA(At, 0, 1); PG8_STAGE(PG8_SA(0, 0), a2, voffA);
            PG8_BAR; PG8_WAIT_L(0); PG8_MMA(1, 0, At, B0); PG8_BAR; PG8_SCHED;
            PG8_STAGE(PG8_SB(0, 1), b2 + hsB, voffB);
            PG8_WAIT_V(6); PG8_BAR; PG8_MMA(1, 1, At, B1); PG8_BAR;
            PG8_LDB(B0, 1, 0); PG8_SCHED; PG8_LDA(At, 1, 0); PG8_STAGE(PG8_SA(0, 1), a2 + hsA, voffA);
            PG8_WAIT_L(8); PG8_BAR; PG8_WAIT_L(0); PG8_MMA(0, 0, At, B0); PG8_BAR; PG8_SCHED;
            PG8_LDB(B1, 1, 1); PG8_STAGE(PG8_SB(1, 0), b3, voffB);
            PG8_BAR; PG8_WAIT_L(0); PG8_MMA(0, 1, At, B1); PG8_BAR;
            PG8_LDA(At, 1, 1); PG8_STAGE(PG8_SA(1, 0), a3, voffA);
            PG8_BAR; PG8_WAIT_L(0); PG8_MMA(1, 0, At, B0); PG8_BAR; PG8_SCHED;
            PG8_STAGE(PG8_SB(1, 1), b3 + hsB, voffB);
            PG8_WAIT_V(6); PG8_BAR; PG8_MMA(1, 1, At, B1); PG8_BAR;
        }
        E(acc, cur, wr, wc, fr, fq);
        if (!has_next) break;
#pragma unroll
        for (int a = 0; a < 2; ++a)
#pragma unroll
            for (int b = 0; b < 2; ++b)
#pragma unroll
                for (int m = 0; m < 4; ++m)
#pragma unroll
                    for (int n = 0; n < 2; ++n) acc[a][b][m][n] = (f32x4){0.f, 0.f, 0.f, 0.f};
        cur = nxt; cA = nA; cB = nB; ++ui;
    }
    PG8_WAIT_V(0);
    if (wr == 0) PG8_BAR;
    PG8_BAR;
#undef PG8_SA
#undef PG8_SB
#undef PG8_STAGE
#undef PG8_LDA
#undef PG8_LDB
#undef PG8_MMA
#undef PG8_WAIT_V
#undef PG8_WAIT_L
#undef PG8_BAR
#undef PG8_SCHED
}

struct EpiF32 {
    static constexpr bool PERM = false;
    float* C; int ldc;
    __device__ __forceinline__ void operator()(const f32x4 (&acc)[2][2][4][2], const Unit& u, int wr, int wc, int fr, int fq) const {
        const int row0 = u.pm * BM + wr * 64 + fr, col0 = u.pn * BM + wc * 32 + 4 * fq;
#pragma unroll
        for (int ai = 0; ai < 2; ++ai)
#pragma unroll
            for (int m = 0; m < 4; ++m) { float* rowp = C + (size_t)(row0 + ai * HALF + m * 16) * ldc + col0;
#pragma unroll
                for (int bj = 0; bj < 2; ++bj)
#pragma unroll
                    for (int n = 0; n < 2; ++n) *(f32x4*)(rowp + bj * HALF + n * 16) = acc[ai][bj][m][n]; }
    }
};
struct EpiProj {
    static constexpr bool PERM = true;
    unsigned char* ws;
    __device__ __forceinline__ void operator()(const f32x4 (&acc)[2][2][4][2], const Unit& u, int wr, int wc, int fr, int fq) const {
        bf16_t* base = (bf16_t*)(ws + kP1Off[u.pn]); const int ld = kP1Ld[u.pn], ncol = kP1Nc[u.pn];
        const int row0 = u.pm * BM + wr * 64 + fr, col0 = kP1C0[u.pn] + wc * 32 + 8 * fq;
#pragma unroll
        for (int ai = 0; ai < 2; ++ai)
#pragma unroll
            for (int m = 0; m < 4; ++m) { bf16_t* rowp = base + (size_t)(row0 + ai * HALF + m * 16) * ld + col0;
#pragma unroll
                for (int bj = 0; bj < 2; ++bj) { if (bj * HALF >= ncol) continue;
                    const f32x4 v0 = acc[ai][bj][m][0], v1 = acc[ai][bj][m][1];
                    u32x4 w; w.x = cvt_pk_bf16(v0[0], v0[1]); w.y = cvt_pk_bf16(v0[2], v0[3]); w.z = cvt_pk_bf16(v1[0], v1[1]); w.w = cvt_pk_bf16(v1[2], v1[3]);
                    *(u32x4*)(rowp + bj * HALF) = w; } }
    }
};
struct EpiBf16 {
    static constexpr bool PERM = true;
    bf16_t* C; int ldc;
    __device__ __forceinline__ void operator()(const f32x4 (&acc)[2][2][4][2], const Unit& u, int wr, int wc, int fr, int fq) const {
        const int row0 = u.pm * BM + wr * 64 + fr, col0 = u.pn * BM + wc * 32 + 8 * fq;
#pragma unroll
        for (int ai = 0; ai < 2; ++ai)
#pragma unroll
            for (int m = 0; m < 4; ++m) { bf16_t* rowp = C + (size_t)(row0 + ai * HALF + m * 16) * ldc + col0;
#pragma unroll
                for (int bj = 0; bj < 2; ++bj) {
                    const f32x4 v0 = acc[ai][bj][m][0], v1 = acc[ai][bj][m][1];
                    u32x4 w; w.x = cvt_pk_bf16(v0[0], v0[1]); w.y = cvt_pk_bf16(v0[2], v0[3]); w.z = cvt_pk_bf16(v1[0], v1[1]); w.w = cvt_pk_bf16(v1[2], v1[3]);
                    *(u32x4*)(rowp + bj * HALF) = w; } }
    }
};
struct EpiGate {
    static constexpr bool PERM = true;
    bf16_t* G0;
    __device__ __forceinline__ void operator()(const f32x4 (&acc)[2][2][4][2], const Unit& u, int wr, int wc, int fr, int fq) const {
        bf16_t* base = G0 + (size_t)(u.pn >> 1) * ((size_t)NTOK * 512);
        const int row0 = u.pm * BM + wr * 64 + fr, col0 = (u.pn & 1) * 256 + wc * 32 + 8 * fq;
#pragma unroll
        for (int ai = 0; ai < 2; ++ai)
#pragma unroll
            for (int m = 0; m < 4; ++m) { bf16_t* rowp = base + (size_t)(row0 + ai * HALF + m * 16) * 512 + col0;
#pragma unroll
                for (int bj = 0; bj < 2; ++bj) {
                    f32x4 v0 = acc[ai][bj][m][0], v1 = acc[ai][bj][m][1];
#pragma unroll
                    for (int j = 0; j < 4; ++j) { v0[j] = sigmoidf_(v0[j]); v1[j] = sigmoidf_(v1[j]); }
                    u32x4 w; w.x = cvt_pk_bf16(v0[0], v0[1]); w.y = cvt_pk_bf16(v0[2], v0[3]); w.z = cvt_pk_bf16(v1[0], v1[1]); w.w = cvt_pk_bf16(v1[2], v1[3]);
                    *(u32x4*)(rowp + bj * HALF) = w; } }
    }
};
struct EpiSwiglu {
    static constexpr bool PERM = true;
    bf16_t* O; int ldc;
    __device__ __forceinline__ void operator()(const f32x4 (&acc)[2][2][4][2], const Unit& u, int wr, int wc, int fr, int fq) const {
        const int row0 = u.pm * BM + wr * 64 + fr, col0 = u.pn * HALF + wc * 32 + 8 * fq;
#pragma unroll
        for (int ai = 0; ai < 2; ++ai)
#pragma unroll
            for (int m = 0; m < 4; ++m) { bf16_t* rowp = O + (size_t)(row0 + ai * HALF + m * 16) * ldc + col0;
                float r[8];
#pragma unroll
                for (int n = 0; n < 2; ++n)
#pragma unroll
                    for (int j = 0; j < 4; ++j) { const float gv = acc[ai][0][m][n][j], uv = acc[ai][1][m][n][j]; r[n * 4 + j] = gv * sigmoidf_(gv) * uv; }
                u32x4 w; w.x = cvt_pk_bf16(r[0], r[1]); w.y = cvt_pk_bf16(r[2], r[3]); w.z = cvt_pk_bf16(r[4], r[5]); w.w = cvt_pk_bf16(r[6], r[7]);
                *(u32x4*)rowp = w; }
    }
};
struct EpiBranch {
    static constexpr bool PERM = true;
    bf16_t* Mg; const bf16_t* G0;
    __device__ __forceinline__ void operator()(const f32x4 (&acc)[2][2][4][2], const Unit& u, int wr, int wc, int fr, int fq) const {
        const bf16_t* gb = G0 + (size_t)(u.br * 2 + (u.pn >> 1)) * ((size_t)NTOK * 512);
        const int row0 = u.pm * BM + wr * 64 + fr, cl = wc * 32 + 8 * fq;
#pragma unroll
        for (int ai = 0; ai < 2; ++ai)
#pragma unroll
            for (int m = 0; m < 4; ++m) { const size_t row = (size_t)(row0 + ai * HALF + m * 16);
#pragma unroll
                for (int bj = 0; bj < 2; ++bj) {
                    const u32x4 gw = *(const u32x4*)(gb + row * 512 + (u.pn & 1) * 256 + bj * HALF + cl);
                    bf16_t* mp = Mg + row * 1024 + u.pn * 256 + bj * HALF + cl;
                    float r[8];
#pragma unroll
                    for (int q = 0; q < 4; ++q) { const unsigned g2 = gw[q]; const int n = q >> 1, j = (q & 1) * 2;
                        r[q * 2] = __uint_as_float(g2 << 16) * acc[ai][bj][m][n][j]; r[q * 2 + 1] = __uint_as_float(g2 & 0xffff0000u) * acc[ai][bj][m][n][j + 1]; }
                    if (u.br != 0) { u32x4 ow;
#pragma unroll
                        for (int q = 0; q < 4; ++q) ow[q] = __hip_atomic_load((const unsigned*)mp + q, __ATOMIC_RELAXED, __HIP_MEMORY_SCOPE_AGENT);
#pragma unroll
                        for (int q = 0; q < 4; ++q) { r[q * 2] += __uint_as_float(ow[q] << 16); r[q * 2 + 1] += __uint_as_float(ow[q] & 0xffff0000u); } }
                    u32x4 w; w.x = cvt_pk_bf16(r[0], r[1]); w.y = cvt_pk_bf16(r[2], r[3]); w.z = cvt_pk_bf16(r[4], r[5]); w.w = cvt_pk_bf16(r[6], r[7]);
                    *(u32x4*)mp = w; } }
    }
};
}

template <int MAP> __device__ __forceinline__ int colmap(int n, int off) {
    if (MAP == 0) return n + off;
    if (MAP == 1) { if (n < 3584) return n; const int s = n - 512; return s < C_G ? s : -1; }
    const int pn = n >> 8, r = n & 255; return (r < 128) ? 128 * pn + r : D_FF + 128 * pn + (r - 128);
}
template <int MAP>
__device__ void conv_job(LAS unsigned char* lds, bf16_t* dst, int ld_dst, int koff, const float* src, int ld_src, int K, int n_lo, int n_hi, int off, int bid, int nb) {
    const int tid = phase_tid(), wid = __builtin_amdgcn_readfirstlane(tid >> 6), lane = tid & 63;
    LAS float* tile = (LAS float*)lds + wid * (64 * 65);
    const int nk = K / 64, nn = (n_hi - n_lo) / 64;
    const int l4 = lane >> 4, c4 = (lane & 15) * 4, l8 = lane >> 3, k8 = (lane & 7) * 8;
    for (int it = bid * 8 + wid; it < nk * nn; it += nb * 8) {
        const int n0 = n_lo + (it % nn) * 64, k0 = (it / nn) * 64;
        const int cfirst = colmap<MAP>(n0 + c4, off), clast = colmap<MAP>(n0 + c4 + 3, off);
        const float* sp = src + (size_t)(k0 + l4) * ld_src;
        f32x4 v[16];
        if (cfirst >= 0 && clast == cfirst + 3 && ((cfirst | ld_src) & 3) == 0) {
#pragma unroll
            for (int j = 0; j < 16; ++j) v[j] = *(const f32x4*)(sp + (size_t)(4 * j) * ld_src + cfirst);
        } else {
            const int q0 = colmap<MAP>(n0 + c4, off), q1 = colmap<MAP>(n0 + c4 + 1, off), q2 = colmap<MAP>(n0 + c4 + 2, off), q3 = colmap<MAP>(n0 + c4 + 3, off);
#pragma unroll
            for (int j = 0; j < 16; ++j) { const float* r = sp + (size_t)(4 * j) * ld_src;
                v[j][0] = (q0 >= 0) ? r[q0] : 0.f; v[j][1] = (q1 >= 0) ? r[q1] : 0.f; v[j][2] = (q2 >= 0) ? r[q2] : 0.f; v[j][3] = (q3 >= 0) ? r[q3] : 0.f; }
        }
#pragma unroll
        for (int j = 0; j < 16; ++j) { LAS float* t = tile + (4 * j + l4) * 65 + c4; t[0] = v[j][0]; t[1] = v[j][1]; t[2] = v[j][2]; t[3] = v[j][3]; }
        asm volatile("s_waitcnt lgkmcnt(0)" ::: "memory");
#pragma unroll
        for (int jj = 0; jj < 8; ++jj) { const int nr = l8 + 8 * jj; float w8[8];
#pragma unroll
            for (int e = 0; e < 8; ++e) w8[e] = tile[(k8 + e) * 65 + nr];
            u32x4 w; w.x = cvt_pk_bf16(w8[0], w8[1]); w.y = cvt_pk_bf16(w8[2], w8[3]); w.z = cvt_pk_bf16(w8[4], w8[5]); w.w = cvt_pk_bf16(w8[6], w8[7]);
            *(u32x4*)(dst + (size_t)(n0 + nr) * ld_dst + koff + k0 + k8) = w; }
        asm volatile("s_waitcnt lgkmcnt(0)" ::: "memory");
    }
}
__device__ void fold_tile(LAS unsigned char* lds, bf16_t* out, long sOi, long sOj, const float* A, long sAi, long sAd, const float* B, long sBj, long sBd) {
    LAS float* As = (LAS float*)lds; LAS float* Bs = As + 64 * 132;
    const int tid = phase_tid();
    for (int e = tid; e < 64 * 128; e += 512) {
        int i, d; if (sAd == 1) { i = e >> 7; d = e & 127; } else { d = e >> 6; i = e & 63; }
        As[i * 132 + d] = A[i * sAi + d * sAd];
        int j, d2; if (sBd == 1) { j = e >> 7; d2 = e & 127; } else { d2 = e >> 6; j = e & 63; }
        Bs[j * 132 + d2] = B[j * sBj + d2 * sBd];
    }
    __syncthreads();
    const int i = tid & 63, jg = tid >> 6;
    float acc[8];
#pragma unroll
    for (int q = 0; q < 8; ++q) acc[q] = 0.f;
    for (int d = 0; d < 128; d += 4) { const f32x4 a = *(const LAS f32x4*)(As + i * 132 + d);
#pragma unroll
        for (int q = 0; q < 8; ++q) { const f32x4 b = *(const LAS f32x4*)(Bs + (jg * 8 + q) * 132 + d); acc[q] += a[0] * b[0] + a[1] * b[1] + a[2] * b[2] + a[3] * b[3]; } }
#pragma unroll
    for (int q = 0; q < 8; ++q) out[i * sOi + (jg * 8 + q) * sOj] = f2bf(acc[q]);
    __syncthreads();
}

__device__ void phase_conv_in(const Params& p, int l, LAS unsigned char* lds, int bid, int nb) {
    const float* Win = p.in[I_WIN] + (size_t)l * D_MODEL * IN_W;
    __syncthreads();
    conv_job<1>(lds, BF(p, OFF_WIN), 1024, 0, Win, IN_W, 1024, 0, 3584, 0, bid, nb);
    conv_job<1>(lds, BF(p, OFF_WIN), 1024, 0, Win, IN_W, 1024, 4608, NP1, 0, bid, nb);
    __syncthreads();
    const float* wuk = p.in[I_WUK] + (size_t)l * 256 * 512;
    for (int it = bid; it < 256; it += nb) { const int h = it >> 6, rb = (it >> 4) & 3, kb = it & 15;
        fold_tile(lds, BF(p, OFF_WIN) + (size_t)(3584 + h * 256 + rb * 64) * 1024 + kb * 64, 1, 1024,
                  Win + (size_t)(kb * 64) * IN_W + C_DQ + h * 128, IN_W, 1, wuk + ((size_t)(rb * 64) * 4 + h) * 128, 512, 1); }
}
__device__ void phase_conv_postA(const Params& p, int l, LAS unsigned char* lds, int bid, int nb) {
    const float* Win = p.in[I_WIN] + (size_t)l * D_MODEL * IN_W;
    __syncthreads();
    conv_job<0>(lds, BF(p, OFF_WG), 1024, 0, Win, IN_W, 1024, 0, 3072, C_G, bid, nb);
    conv_job<0>(lds, BF(p, OFF_WBR), 2048, 0, p.in[I_WA] + (size_t)l * 512 * 1024, 1024, 512, 0, 1024, 0, bid, nb);
    conv_job<0>(lds, BF(p, OFF_WBR), 2048, 512, p.in[I_WB] + (size_t)l * 512 * 1024, 1024, 512, 0, 1024, 0, bid, nb);
    __syncthreads();
    const float* wuv = p.in[I_WUV] + (size_t)l * 256 * 512; const float* wc = p.in[I_WC] + (size_t)l * 512 * 1024;
    for (int it = bid; it < 256; it += nb) { const int h = it >> 6, rb = (it >> 4) & 3, nbk = it & 15;
        fold_tile(lds, BF(p, OFF_WBR) + (size_t)(nbk * 64) * 2048 + 1024 + h * 256 + rb * 64, 1, 2048,
                  wuv + ((size_t)(rb * 64) * 4 + h) * 128, 512, 1, wc + (size_t)(h * 128) * 1024 + nbk * 64, 1, 1024); }
}
__device__ void phase_conv_postB(const Params& p, int l, LAS unsigned char* lds, int bid, int nb) {
    __syncthreads();
    conv_job<0>(lds, BF(p, OFF_WOUT), 1024, 0, p.in[I_WOUT] + (size_t)l * 1024 * 1024, 1024, 1024, 0, 1024, 0, bid, nb);
    conv_job<2>(lds, BF(p, OFF_WF1), 1024, 0, p.in[I_WF1] + (size_t)l * 1024 * 2 * D_FF, 2 * D_FF, 1024, 0, 2 * D_FF, 0, bid, nb);
    conv_job<0>(lds, BF(p, OFF_WF2), D_FF, 0, p.in[I_WF2] + (size_t)l * D_FF * 1024, 1024, D_FF, 0, 1024, 0, bid, nb);
    __syncthreads();
}

__device__ __forceinline__ float wave_sum(float v) {
#pragma unroll
    for (int o = 32; o >= 1; o >>= 1) v += __shfl_xor(v, o);
    return v;
}
template <int MODE, bool XIN_BF, bool XOUT_BF>
__device__ void phase_norm(const void* xin_, void* xout_, const bf16_t* O, const float* wpost, const float* w1, bf16_t* H, int bid, int nb) {
    const float* xin = (const float*)xin_; float* xout = (float*)xout_; const bf16_t* xinb = (const bf16_t*)xin_; bf16_t* xoutb = (bf16_t*)xout_;
    const int tidn = phase_tid(); const int wv = tidn >> 6, lane = tidn & 63;
    constexpr int NR = 2;
    for (int row0 = bid * 8 + wv; row0 < NTOK; row0 += NR * nb * 8) {
        f32x4 xv[NR][4], ov[NR][4];
#pragma unroll
        for (int q = 0; q < NR; ++q) { const int row = (row0 + q * nb * 8 < NTOK) ? row0 + q * nb * 8 : row0;
#pragma unroll
            for (int j = 0; j < 4; ++j) {
                if (XIN_BF) { const u32x2 xw = *(const u32x2*)(xinb + (size_t)row * 1024 + j * 256 + lane * 4);
                    xv[q][j] = (f32x4){__uint_as_float(xw.x << 16), __uint_as_float(xw.x & 0xffff0000u), __uint_as_float(xw.y << 16), __uint_as_float(xw.y & 0xffff0000u)}; }
                else xv[q][j] = *(const f32x4*)(xin + (size_t)row * 1024 + j * 256 + lane * 4);
                if (MODE >= 1) { const u32x2 ow = *(const u32x2*)(O + (size_t)row * 1024 + j * 256 + lane * 4);
                    ov[q][j] = (f32x4){__uint_as_float(ow.x << 16), __uint_as_float(ow.x & 0xffff0000u), __uint_as_float(ow.y << 16), __uint_as_float(ow.y & 0xffff0000u)}; } } }
        if (MODE >= 1) {
            float ss[NR];
#pragma unroll
            for (int q = 0; q < NR; ++q) { ss[q] = 0.f;
#pragma unroll
                for (int j = 0; j < 4; ++j) ss[q] += ov[q][j][0] * ov[q][j][0] + ov[q][j][1] * ov[q][j][1] + ov[q][j][2] * ov[q][j][2] + ov[q][j][3] * ov[q][j][3]; }
#pragma unroll
            for (int o = 32; o >= 1; o >>= 1)
#pragma unroll
                for (int q = 0; q < NR; ++q) ss[q] += __shfl_xor(ss[q], o);
#pragma unroll
            for (int q = 0; q < NR; ++q) { const int row = row0 + q * nb * 8; const float r = rsqrtf(ss[q] * (1.f / 1024.f) + 1e-6f);
#pragma unroll
                for (int j = 0; j < 4; ++j) { const f32x4 wv4 = *(const f32x4*)(wpost + j * 256 + lane * 4); xv[q][j] = xv[q][j] + ov[q][j] * r * wv4;
                    if (XOUT_BF) { u32x2 xw; xw.x = cvt_pk_bf16(xv[q][j][0], xv[q][j][1]); xw.y = cvt_pk_bf16(xv[q][j][2], xv[q][j][3]); if (row < NTOK) *(u32x2*)(xoutb + (size_t)row * 1024 + j * 256 + lane * 4) = xw;
                        xv[q][j] = (f32x4){__uint_as_float(xw.x << 16), __uint_as_float(xw.x & 0xffff0000u), __uint_as_float(xw.y << 16), __uint_as_float(xw.y & 0xffff0000u)}; }
                    else if (row < NTOK) *(f32x4*)(xout + (size_t)row * 1024 + j * 256 + lane * 4) = xv[q][j]; } }
        }
        if (MODE <= 1) {
            float ss[NR];
#pragma unroll
            for (int q = 0; q < NR; ++q) { ss[q] = 0.f;
#pragma unroll
                for (int j = 0; j < 4; ++j) ss[q] += xv[q][j][0] * xv[q][j][0] + xv[q][j][1] * xv[q][j][1] + xv[q][j][2] * xv[q][j][2] + xv[q][j][3] * xv[q][j][3]; }
#pragma unroll
            for (int o = 32; o >= 1; o >>= 1)
#pragma unroll
                for (int q = 0; q < NR; ++q) ss[q] += __shfl_xor(ss[q], o);
#pragma unroll
            for (int q = 0; q < NR; ++q) { const int row = row0 + q * nb * 8; const float r = rsqrtf(ss[q] * (1.f / 1024.f) + 1e-6f);
#pragma unroll
                for (int j = 0; j < 4; ++j) { const f32x4 wv4 = *(const f32x4*)(w1 + j * 256 + lane * 4); const f32x4 y = xv[q][j] * r * wv4;
                    u32x2 w; w.x = cvt_pk_bf16(y[0], y[1]); w.y = cvt_pk_bf16(y[2], y[3]); if (row < NTOK) *(u32x2*)(H + (size_t)row * 1024 + j * 256 + lane * 4) = w; } }
        }
    }
}

__device__ void phase_gemm_in(const Params& p, LAS unsigned char* lds, int bid, int nb) {
    pg8::EpiProj E{p.ws};
    pg8::Gemm g{BF(p, OFF_H), BF(p, OFF_WIN), 1024, 1024};
    pg8::StaticOrder S; S.init(NTOK, NP1, 1024, nb, bid);
    pg8::gemm_phase(lds, g, S, E);
}
__device__ void phase_gemm_gates(const Params& p, LAS unsigned char* lds, int bid, int nb) {
    pg8::EpiGate E{BF(p, OFF_HF)};
    pg8::Gemm g{BF(p, OFF_H), BF(p, OFF_WG), 1024, 1024};
    pg8::StaticOrder S; S.init(NTOK, 3072, 1024, nb, bid);
    pg8::gemm_phase(lds, g, S, E);
}
__device__ void phase_gemm_branch(const Params& p, LAS unsigned char* lds, int bid, int nb) {
    pg8::EpiBranch E; E.Mg = BF(p, OFF_H); E.G0 = BF(p, OFF_HF);
    pg8::Gemm g{BF(p, OFF_Y), BF(p, OFF_WBR), 2048, 2048};
    pg8::BranchOrder S; S.init(NTOK, 1024, nb, bid);
    pg8::gemm_phase(lds, g, S, E);
}
__device__ void phase_gemm_out(const Params& p, LAS unsigned char* lds, int bid, int nb) {
    pg8::EpiBf16 E{BF(p, OFF_OUT), 1024};
    pg8::Gemm g{BF(p, OFF_H), BF(p, OFF_WOUT), 1024, 1024};
    pg8::StaticOrder S; S.init(NTOK, 1024, 1024, nb, bid);
    pg8::gemm_phase(lds, g, S, E);
}
__device__ void phase_gemm_ffn1(const Params& p, LAS unsigned char* lds, int bid, int nb) {
    pg8::EpiSwiglu E{BF(p, OFF_ACT), D_FF};
    pg8::Gemm g{BF(p, OFF_H), BF(p, OFF_WF1), 1024, 1024};
    pg8::StaticOrder S; S.init(NTOK, 2 * D_FF, 1024, nb, bid);
    pg8::gemm_phase(lds, g, S, E);
}
__device__ void phase_gemm_ffn2(const Params& p, LAS unsigned char* lds, int bid, int nb) {
    pg8::EpiBf16 E{BF(p, OFF_OUT), 1024};
    pg8::Gemm g{BF(p, OFF_ACT), BF(p, OFF_WF2), D_FF, D_FF};
    pg8::StaticOrder S; S.init(NTOK, 1024, D_FF, nb, bid);
    pg8::gemm_phase(lds, g, S, E);
}


__device__ __forceinline__ float hg_lower_bound(const float* lbl, int l, int idx) {
    const float l0 = lbl[idx], l1 = lbl[512 + idx]; const float m = fmaxf(l0, l1), e0 = __expf(l0 - m), e1 = __expf(l1 - m), p0 = e0 / (e0 + e1), p1 = e1 / (e0 + e1);
    return ((l == 0) ? p0 : (p0 + p1)) - p0;
}
__device__ __forceinline__ void pack16_store(LAS unsigned char* dst, const float (&v)[16]) {
    u32x4 a, b; a.x = cvt_pk_bf16(v[0], v[1]); a.y = cvt_pk_bf16(v[2], v[3]); a.z = cvt_pk_bf16(v[4], v[5]); a.w = cvt_pk_bf16(v[6], v[7]);
    b.x = cvt_pk_bf16(v[8], v[9]); b.y = cvt_pk_bf16(v[10], v[11]); b.z = cvt_pk_bf16(v[12], v[13]); b.w = cvt_pk_bf16(v[14], v[15]);
    *(LAS u32x4*)dst = a; *(LAS u32x4*)(dst + 16) = b;
}
#define HG_FRONT()                                                                                                   \
    const int d = tid & 127, seg = tid >> 7;                                                                         \
    const float lbd = hg_lower_bound(p.in[I_LB], l, h * 128 + d);                                                    \
    float kk[16], cs[16];                                                                                            \
    { float run = 0.f;                                                                                               \
      _Pragma("unroll") for (int jj = 0; jj < 16; ++jj) {                                                            \
          const float fp = bf2f(HF[(size_t)(row0 + seg * 16 + jj) * 512 + h * 128 + d]);                            \
          const float sg = sigmoidf_(fp); const float f = fmaxf(lbd + (1.f - lbd) * sg, 1e-20f);                     \
          kk[jj] = (1.f - lbd) * (1.f - sg); run += __logf(f); cs[jj] = run; }                                       \
      SEG[seg * 128 + d] = run; }

__device__ void phase_hg1(const Params& p, int l, LAS unsigned char* lds, int bid, int nb) {
    const int tid = phase_tid(), lane = tid & 63, w = __builtin_amdgcn_readfirstlane(tid >> 6), fr = lane & 15, g = lane >> 4;
    LAS float* SEG = (LAS float*)lds; LAS unsigned char* KT = lds + 2048; LAS unsigned char* VT = KT + 128 * 144;
    const bf16_t* HF = BF(p, OFF_HF); const bf16_t* HI = BF(p, OFF_HI); bf16_t* ST = BF(p, OFF_ST); float* DEC = F32P(p, OFF_DEC);
    for (int unit = bid; unit < 1024; unit += nb) {
        const int bh = unit >> 6, c = unit & 63, h = bh & 3, row0 = (bh >> 2) * SEQ + c * 64;
        HG_FRONT();
        float vv[16];
#pragma unroll
        for (int jj = 0; jj < 16; ++jj) vv[jj] = bf2f(HI[(size_t)(row0 + seg * 16 + jj) * 512 + h * 128 + d]);
        __syncthreads();
        float off = 0.f, bl = 0.f;
#pragma unroll
        for (int s2 = 0; s2 < 4; ++s2) { const float t = SEG[s2 * 128 + d]; off += (s2 < seg) ? t : 0.f; bl += t; }
        float kb[16];
#pragma unroll
        for (int jj = 0; jj < 16; ++jj) kb[jj] = kk[jj] * __expf(bl - (off + cs[jj]));
        pack16_store(KT + d * 144 + seg * 32, kb);
        pack16_store(VT + d * 144 + seg * 32, vv);
        if (seg == 0) DEC[(size_t)unit * 128 + d] = __expf(bl);
        __syncthreads();
        bf16x8 a[2];
#pragma unroll
        for (int ks = 0; ks < 2; ++ks) a[ks] = *(const LAS bf16x8*)(KT + (16 * w + fr) * 144 + (32 * ks + 8 * g) * 2);
#pragma unroll
        for (int et = 0; et < 8; ++et) {
            f32x4 acc = {0.f, 0.f, 0.f, 0.f};
#pragma unroll
            for (int ks = 0; ks < 2; ++ks) { const bf16x8 b = *(const LAS bf16x8*)(VT + (16 * et + fr) * 144 + (32 * ks + 8 * g) * 2); acc = __builtin_amdgcn_mfma_f32_16x16x32_bf16(a[ks], b, acc, 0, 0, 0); }
            mfma_fence(acc);
            u32x2 o; o.x = cvt_pk_bf16(acc[0], acc[1]); o.y = cvt_pk_bf16(acc[2], acc[3]);
            *(u32x2*)(ST + ((size_t)unit * 128 + 16 * et + fr) * 128 + 16 * w + 4 * g) = o;
        }
        __syncthreads();
    }
}
__device__ void phase_hg2(const Params& p, int bid, int nb) {
    bf16_t* ST = BF(p, OFF_ST); const float* DEC = F32P(p, OFF_DEC);
    for (int gid = bid * 512 + phase_tid(); gid < 16 * 8192; gid += nb * 512) {
        const int bh = gid >> 13, within = gid & 8191, e = within >> 6, d = (within & 63) * 2;
        float s0 = 0.f, s1 = 0.f;
        for (int c0 = 0; c0 < 64; c0 += 8) {
            unsigned u[8]; float d0[8], d1[8];
#pragma unroll
            for (int k = 0; k < 8; ++k) { const size_t un = (size_t)(bh * 64 + c0 + k);
                u[k] = *(const unsigned*)(ST + (un * 128 + e) * 128 + d); d0[k] = DEC[un * 128 + d]; d1[k] = DEC[un * 128 + d + 1]; }
            asm volatile("s_waitcnt vmcnt(0)" ::: "memory");
#pragma unroll
            for (int k = 0; k < 8; ++k) { const size_t un = (size_t)(bh * 64 + c0 + k);
                *(unsigned*)(ST + (un * 128 + e) * 128 + d) = cvt_pk_bf16(s0, s1);
                s0 = d0[k] * s0 + __uint_as_float(u[k] << 16); s1 = d1[k] * s1 + __uint_as_float(u[k] & 0xffff0000u); }
        }
    }
}
template <int PROBE = 0> __device__ void phase_hg3(const Params& p, int l, LAS unsigned char* lds, int bid, int nb) {
    const int tid = phase_tid(), lane = tid & 63, w = __builtin_amdgcn_readfirstlane(tid >> 6), fr = lane & 15, g = lane >> 4;
    LAS float* SEG = (LAS float*)lds;
    LAS unsigned char* QH = lds + 2048; LAS unsigned char* QT = QH + 64 * 272; LAS float* OL = (LAS float*)(lds + 2048);
    LAS unsigned char* KB = lds + 36864; LAS unsigned char* VT = lds + 54272; LAS unsigned char* SP = lds + 72704; LAS unsigned char* PL = lds + 107520;
    const bf16_t* HF = BF(p, OFF_HF); const bf16_t* HI = BF(p, OFF_HI); const bf16_t* HG = BF(p, OFF_HG); const bf16_t* ST = BF(p, OFF_ST); bf16_t* Y = BF(p, OFF_Y);
    for (int unit = bid; unit < 1024; unit += nb) {
        const int bh = unit >> 6, c = unit & 63, h = bh & 3, row0 = (bh >> 2) * SEQ + c * 64;
        HG_FRONT();
        {
#pragma unroll
            for (int k = 0; k < 4; ++k) { const int ch = tid + 512 * k, e = ch >> 4, dc = ch & 15;
                *(LAS u32x4*)(SP + e * 272 + dc * 16) = *(const u32x4*)(ST + ((size_t)unit * 128 + e) * 128 + dc * 8); }
            float vv[16];
#pragma unroll
            for (int jj = 0; jj < 16; ++jj) vv[jj] = bf2f(HI[(size_t)(row0 + seg * 16 + jj) * 512 + h * 128 + d]);
            pack16_store(VT + d * 144 + seg * 32, vv);
        }
        __syncthreads();
        float beta[4]; { float run = 0.f;
#pragma unroll
            for (int s2 = 0; s2 < 4; ++s2) { beta[s2] = run; run += SEG[s2 * 128 + d]; } }
        float off = 0.f;
#pragma unroll
        for (int s2 = 0; s2 < 4; ++s2) off = (s2 == seg) ? beta[s2] : off;
#pragma unroll
        for (int jj = 0; jj < 16; ++jj) {
            const float q = bf2f(Y[(size_t)(row0 + seg * 16 + jj) * 2048 + h * 128 + d]);
            const int i = seg * 16 + jj;
            *(LAS bf16_t*)(QH + i * 272 + d * 2) = f2bf(q * __expf(off + cs[jj]));
            *(LAS bf16_t*)(QT + i * 272 + d * 2) = f2bf(q * __expf(cs[jj]));
        }
#pragma unroll
        for (int I = 0; I < 4; ++I) {
            if (seg <= I) {
                float bI = 0.f;
#pragma unroll
                for (int s2 = 0; s2 < 4; ++s2) bI = (s2 == I) ? beta[s2] : bI;
#pragma unroll
                for (int jj = 0; jj < 16; ++jj) *(LAS bf16_t*)(KB + (seg * 16 + jj) * 272 + d * 2) = f2bf(kk[jj] * __expf(fminf(bI - (off + cs[jj]), 60.f)));
            }
            __syncthreads();
            if (w < 4) {
                f32x4 acc = {0.f, 0.f, 0.f, 0.f};
                if (w <= I) {
#pragma unroll
                    for (int ks = 0; ks < 4; ++ks) {
                        const bf16x8 a = *(const LAS bf16x8*)(QT + (16 * I + fr) * 272 + (32 * ks + 8 * g) * 2);
                        const bf16x8 b = *(const LAS bf16x8*)(KB + (16 * w + fr) * 272 + (32 * ks + 8 * g) * 2);
                        acc = __builtin_amdgcn_mfma_f32_16x16x32_bf16(a, b, acc, 0, 0, 0); }
                    mfma_fence(acc);
                    const int lim = (w == I) ? (4 * g) : 1000;
#pragma unroll
                    for (int r = 0; r < 4; ++r) acc[r] = (fr <= lim + r) ? acc[r] : 0.f;
                }
#pragma unroll
                for (int r = 0; r < 4; ++r) *(LAS bf16_t*)(PL + (16 * I + 4 * g + r) * 144 + (16 * w + fr) * 2) = f2bf(acc[r]);
            }
            __syncthreads();
        }
        f32x4 oacc[4];
        { const int ib = w >> 1;
          bf16x8 aq[4], ap[2];
#pragma unroll
          for (int ks = 0; ks < 4; ++ks) aq[ks] = *(const LAS bf16x8*)(QH + (16 * ib + fr) * 272 + (32 * ks + 8 * g) * 2);
#pragma unroll
          for (int ks = 0; ks < 2; ++ks) ap[ks] = *(const LAS bf16x8*)(PL + (16 * ib + fr) * 144 + (32 * ks + 8 * g) * 2);
#pragma unroll
          for (int q4 = 0; q4 < 4; ++q4) { const int et = 4 * (w & 1) + q4; f32x4 acc = {0.f, 0.f, 0.f, 0.f};
#pragma unroll
              for (int ks = 0; ks < 4; ++ks) { const bf16x8 b = *(const LAS bf16x8*)(SP + (16 * et + fr) * 272 + (32 * ks + 8 * g) * 2); acc = __builtin_amdgcn_mfma_f32_16x16x32_bf16(aq[ks], b, acc, 0, 0, 0); }
#pragma unroll
              for (int ks = 0; ks < 2; ++ks) { const bf16x8 b = *(const LAS bf16x8*)(VT + (16 * et + fr) * 144 + (32 * ks + 8 * g) * 2); acc = __builtin_amdgcn_mfma_f32_16x16x32_bf16(ap[ks], b, acc, 0, 0, 0); }
              oacc[q4] = acc; } }
        mfma_fence(oacc[0], oacc[1], oacc[2], oacc[3]);
        __syncthreads();
#pragma unroll
        for (int q4 = 0; q4 < 4; ++q4)
#pragma unroll
            for (int r = 0; r < 4; ++r) OL[(16 * (w >> 1) + 4 * g + r) * 132 + 16 * (4 * (w & 1) + q4) + fr] = oacc[q4][r];
        __syncthreads();
        {
            const int i = tid >> 3, es = (tid & 7) * 16;
            float o[16], ss = 0.f;
#pragma unroll
            for (int k = 0; k < 16; ++k) { o[k] = OL[i * 132 + es + k]; ss += o[k] * o[k]; }
            ss += __shfl_xor(ss, 1); ss += __shfl_xor(ss, 2); ss += __shfl_xor(ss, 4);
            const float rstd = rsqrtf(ss * (1.f / 128.f) + 1e-6f);
            const u32x4 g0 = *(const u32x4*)(HG + (size_t)(row0 + i) * 512 + h * 128 + es), g1 = *(const u32x4*)(HG + (size_t)(row0 + i) * 512 + h * 128 + es + 8);
            float y[16];
#pragma unroll
            for (int k = 0; k < 16; ++k) { const unsigned gw = (k < 8) ? g0[k >> 1] : g1[(k - 8) >> 1]; const float gv = (k & 1) ? __uint_as_float(gw & 0xffff0000u) : __uint_as_float(gw << 16);
                y[k] = o[k] * rstd * p.in[I_HGNW][l * 128 + es + k] * (gv * sigmoidf_(gv)); }
            u32x4 a, b; a.x = cvt_pk_bf16(y[0], y[1]); a.y = cvt_pk_bf16(y[2], y[3]); a.z = cvt_pk_bf16(y[4], y[5]); a.w = cvt_pk_bf16(y[6], y[7]);
            b.x = cvt_pk_bf16(y[8], y[9]); b.y = cvt_pk_bf16(y[10], y[11]); b.z = cvt_pk_bf16(y[12], y[13]); b.w = cvt_pk_bf16(y[14], y[15]);
            bf16_t* yo = PROBE ? ((bf16_t*)((unsigned char*)p.x + 16 * MiB) + (size_t)(row0 + i) * 512 + h * 128 + es) : (Y + (size_t)(row0 + i) * 2048 + h * 128 + es);
            *(u32x4*)yo = a; *(u32x4*)(yo + 8) = b;
        }
        __syncthreads();
    }
}


__device__ void phase_prep(const Params& p, int l, LAS unsigned char* lds, int bid, int nb) {
    const int tid = phase_tid(), lane = tid & 63, wv = tid >> 6;
    {
        LAS float* red = (LAS float*)lds; const bf16_t* MK = BF(p, OFF_MK); float* KM = F32P(p, OFF_KMEAN);
        for (int it = bid; it < 256; it += nb) {
            const int bh = it >> 4, n = it & 15, h = bh & 3, d = tid & 127, part = tid >> 7; const size_t row0 = (size_t)(bh >> 2) * SEQ + n * 256 + part * 64;
            float s = 0.f;
            for (int j = 0; j < 64; ++j) s += bf2f(MK[(row0 + j) * 512 + h * 128 + d]);
            red[part * 128 + d] = s; __syncthreads();
            if (part == 0) KM[(size_t)it * 128 + d] = (red[d] + red[128 + d] + red[256 + d] + red[384 + d]) * (1.f / 256.f);
            __syncthreads();
        }
    }
    bf16_t* CKV = BF(p, OFF_CKV); bf16_t* IKW = BF(p, OFF_IKW);
    const float* kvw = p.in[I_KVN] + l * 256; const float* ikw = p.in[I_IKNW] + l * 64; const float* ikb = p.in[I_IKNB] + l * 64;
    for (int row = bid * 8 + wv; row < NTOK; row += nb * 8) {
        {   u32x2* cp = (u32x2*)(CKV + (size_t)row * 256 + lane * 4); const u32x2 v = *cp;
            const float a0 = __uint_as_float(v.x << 16), a1 = __uint_as_float(v.x & 0xffff0000u), a2 = __uint_as_float(v.y << 16), a3 = __uint_as_float(v.y & 0xffff0000u);
            const float ss = wave_sum(a0 * a0 + a1 * a1 + a2 * a2 + a3 * a3); const float r = rsqrtf(ss * (1.f / 256.f) + 1e-6f);
            const f32x4 w4 = *(const f32x4*)(kvw + lane * 4);
            u32x2 o; o.x = cvt_pk_bf16(a0 * r * w4[0], a1 * r * w4[1]); o.y = cvt_pk_bf16(a2 * r * w4[2], a3 * r * w4[3]); *cp = o; }
        {   bf16_t* ip = IKW + (size_t)row * 128; const float u = bf2f(ip[lane]);
            const float mu = wave_sum(u) * (1.f / 64.f); const float xc = u - mu; const float var = wave_sum(xc * xc) * (1.f / 64.f);
            const float y = xc * rsqrtf(var + 1e-6f) * ikw[lane] + ikb[lane];
            const float wgt = (lane < 8) ? bf2f(ip[64 + lane]) * (0.35355339059327373f * 0.125f) : 0.f;
            ip[lane] = f2bf(y); if (lane < 8) ip[64 + lane] = f2bf(wgt); }
    }
}

typedef short v4i16_t __attribute__((ext_vector_type(4)));
__device__ __forceinline__ v4i16_t lds_tr16(const LAS unsigned char* pp) { return __builtin_amdgcn_ds_read_tr16_b64_v4i16((LAS v4i16_t*)pp); }
template <int PROBE = 0> __device__ void phase_moba(const Params& p, LAS unsigned char* lds, int bid, int nb) {
    const int tid = phase_tid(), lane = tid & 63, w = __builtin_amdgcn_readfirstlane(tid >> 6), fr = lane & 15, g = lane >> 4;
    LAS float* BL = (LAS float*)lds; LAS float* KM = (LAS float*)(lds + 16384); LAS float* GG = (LAS float*)(lds + 24576);
    LAS unsigned* SM = (LAS unsigned*)(lds + 32768); LAS unsigned* UM = SM + 128; LAS unsigned* TL = SM + 132;
    LAS unsigned char* QS = lds + 33792; LAS unsigned char* KS = lds + 68608; LAS unsigned char* VS = lds + 86016;
    bf16_t* Y = BF(p, OFF_Y); const bf16_t* MK = BF(p, OFF_MK); const bf16_t* MV = BF(p, OFF_MV);
    const float scale = 0.08838834764831845f;
    int hprev = -1;
    for (int j = bid; j < 512; j += nb) {
        const int bh = j & 15, qt = (j < 256) ? (j >> 4) : (31 - ((j - 256) >> 4));
        const int h = bh & 3, brow = (bh >> 2) * SEQ, t0 = qt * 128, blk = qt >> 1;
        if (h != hprev) { __syncthreads(); for (int dd = tid; dd < 4096; dd += 512) BL[dd] = p.in[I_REL][rel_bucket(dd) * 8 + h]; hprev = h; }
        for (int e = tid; e < 2048; e += 512) KM[e] = F32P(p, OFF_KMEAN)[(size_t)bh * 2048 + e];
#pragma unroll
        for (int k = 0; k < 4; ++k) { const int ch = tid + 512 * k, r = ch >> 4, c = ch & 15;
            *(LAS u32x4*)(QS + r * 272 + c * 16) = *(const u32x4*)(Y + (size_t)(brow + t0 + r) * 2048 + 512 + h * 128 + c * 8); }
        if (tid == 0) *UM = 0u;
        __syncthreads();
        bf16x8 qf[4];
#pragma unroll
        for (int ks = 0; ks < 4; ++ks) qf[ks] = *(const LAS bf16x8*)(QS + (16 * w + fr) * 272 + (32 * ks + 8 * g) * 2);
        {
            f32x4 ga = {0.f, 0.f, 0.f, 0.f};
#pragma unroll
            for (int ks = 0; ks < 4; ++ks) { const f32x4 k0 = *(const LAS f32x4*)(KM + fr * 128 + 32 * ks + 8 * g), k1 = *(const LAS f32x4*)(KM + fr * 128 + 32 * ks + 8 * g + 4);
                u32x4 t; t.x = cvt_pk_bf16(k0[0], k0[1]); t.y = cvt_pk_bf16(k0[2], k0[3]); t.z = cvt_pk_bf16(k1[0], k1[1]); t.w = cvt_pk_bf16(k1[2], k1[3]);
                ga = __builtin_amdgcn_mfma_f32_16x16x32_bf16(__builtin_bit_cast(bf16x8, t), qf[ks], ga, 0, 0, 0); }
            mfma_fence(ga);
            *(LAS f32x4*)(GG + (16 * w + fr) * 16 + 4 * g) = ga;
        }
        __syncthreads();
        if (tid < 128) {
            unsigned used = 0u;
            for (int k = 0; k < 3; ++k) { int best = -1; float bv = 0.f;
                for (int n = 0; n < blk; ++n) { const float v = GG[tid * 16 + n]; if (!((used >> n) & 1u) && (best < 0 || v > bv)) { best = n; bv = v; } }
                if (best >= 0) used |= 1u << best; }
            SM[tid] = used; __hip_atomic_fetch_or((unsigned*)UM, used, __ATOMIC_RELAXED, __HIP_MEMORY_SCOPE_WORKGROUP);
        }
        __syncthreads();
        const unsigned mysel = SM[16 * w + fr];
        const int own_tiles = 2 + 2 * (qt & 1);
        if (tid == 0) {
            const unsigned umask = *UM; int c = 0;
            for (int kt = 0; kt < own_tiles; ++kt) TL[c++] = (unsigned)(blk * 4 + kt);
            for (int n = 0; n < blk; ++n) if ((umask >> n) & 1u) { for (int kt = 0; kt < 4; ++kt) TL[c++] = (unsigned)(n * 4 + kt); }
            TL[64] = (unsigned)c; }
        __syncthreads();
        const int ntiles = (int)TL[64];
        const int tq = t0 + 16 * w + fr;
        f32x4 oacc[8];
#pragma unroll
        for (int dt = 0; dt < 8; ++dt) oacc[dt] = (f32x4){0.f, 0.f, 0.f, 0.f};
        float mrun = -1e30f, lsum = 0.f;
        u32x4 kpre[2], vpre[2];
        { const int key0 = (int)TL[0] * 64;
#pragma unroll
          for (int k = 0; k < 2; ++k) { const int ch = tid + 512 * k, r = ch >> 4, c = ch & 15; const size_t go = (size_t)(brow + key0 + r) * 512 + h * 128 + c * 8; kpre[k] = *(const u32x4*)(MK + go); vpre[k] = *(const u32x4*)(MV + go); } }
        for (int ti = 0; ti < ntiles; ++ti) {
            const int ent = (int)TL[ti], n = ent >> 2, key0 = ent * 64;
            const bool qsel = (n == blk) || ((mysel >> n) & 1u);
            __syncthreads();
#pragma unroll
            for (int k = 0; k < 2; ++k) { const int ch = tid + 512 * k, r = ch >> 4, c = ch & 15; *(LAS u32x4*)(KS + r * 272 + c * 16) = kpre[k]; *(LAS u32x4*)(VS + r * 288 + c * 16) = vpre[k]; }
            __syncthreads();
            if (ti + 1 < ntiles) { const int keyn = (int)TL[ti + 1] * 64;
#pragma unroll
                for (int k = 0; k < 2; ++k) { const int ch = tid + 512 * k, r = ch >> 4, c = ch & 15; const size_t go = (size_t)(brow + keyn + r) * 512 + h * 128 + c * 8; kpre[k] = *(const u32x4*)(MK + go); vpre[k] = *(const u32x4*)(MV + go); } }
            {
                f32x4 s[4];
#pragma unroll
                for (int k4 = 0; k4 < 4; ++k4) { f32x4 acc = {0.f, 0.f, 0.f, 0.f};
#pragma unroll
                    for (int ks = 0; ks < 4; ++ks) { const bf16x8 a = *(const LAS bf16x8*)(KS + (16 * k4 + fr) * 272 + (32 * ks + 8 * g) * 2); acc = __builtin_amdgcn_mfma_f32_16x16x32_bf16(a, qf[ks], acc, 0, 0, 0); }
                    s[k4] = acc; }
                mfma_fence(s[0], s[1], s[2], s[3]);
                float mx = -1e30f;
#pragma unroll
                for (int k4 = 0; k4 < 4; ++k4)
#pragma unroll
                    for (int r = 0; r < 4; ++r) { const int dist = tq - (key0 + 16 * k4 + 4 * g + r); const bool ok = qsel && (dist >= 0);
                        const float lg = s[k4][r] * scale + BL[dist < 0 ? 0 : dist]; s[k4][r] = ok ? lg : -1e30f; mx = fmaxf(mx, s[k4][r]); }
                mx = fmaxf(mx, __shfl_xor(mx, 16)); mx = fmaxf(mx, __shfl_xor(mx, 32));
                const float mnew = fmaxf(mrun, mx), alpha = __expf(mrun - mnew); mrun = mnew;
                float ps = 0.f;
#pragma unroll
                for (int k4 = 0; k4 < 4; ++k4)
#pragma unroll
                    for (int r = 0; r < 4; ++r) { const float pv = (s[k4][r] > -1e29f) ? __expf(s[k4][r] - mnew) : 0.f; s[k4][r] = pv; ps += pv; }
                lsum = lsum * alpha + ps;
                if (__any(alpha != 1.0f)) {
#pragma unroll
                    for (int dt = 0; dt < 8; ++dt) oacc[dt] = oacc[dt] * alpha; }
                bf16x8 pb[2];
#pragma unroll
                for (int m2 = 0; m2 < 2; ++m2) { u32x4 t; t.x = cvt_pk_bf16(s[2 * m2][0], s[2 * m2][1]); t.y = cvt_pk_bf16(s[2 * m2][2], s[2 * m2][3]);
                    t.z = cvt_pk_bf16(s[2 * m2 + 1][0], s[2 * m2 + 1][1]); t.w = cvt_pk_bf16(s[2 * m2 + 1][2], s[2 * m2 + 1][3]); pb[m2] = __builtin_bit_cast(bf16x8, t); }
#pragma unroll
                for (int dt = 0; dt < 8; ++dt)
#pragma unroll
                    for (int m2 = 0; m2 < 2; ++m2) {
                        const LAS unsigned char* va = VS + (32 * m2 + 4 * g + (fr >> 2)) * 288 + (16 * dt + 4 * (fr & 3)) * 2;
                        const v4i16_t lo = lds_tr16(va), hi = lds_tr16(va + 16 * 288);
                        const bf16x8 a = {lo[0], lo[1], lo[2], lo[3], hi[0], hi[1], hi[2], hi[3]};
                        oacc[dt] = __builtin_amdgcn_mfma_f32_16x16x32_bf16(a, pb[m2], oacc[dt], 0, 0, 0); }
            }
        }
        lsum += __shfl_xor(lsum, 16); lsum += __shfl_xor(lsum, 32);
        const float inv = 1.f / lsum;
        mfma_fence(oacc[0], oacc[1], oacc[2], oacc[3]); mfma_fence(oacc[4], oacc[5], oacc[6], oacc[7]);
        __syncthreads();
#pragma unroll
        for (int dt = 0; dt < 8; ++dt) { u32x2 o; o.x = cvt_pk_bf16(oacc[dt][0] * inv, oacc[dt][1] * inv); o.y = cvt_pk_bf16(oacc[dt][2] * inv, oacc[dt][3] * inv);
            if (PROBE) *(u32x2*)((bf16_t*)p.x + (size_t)(brow + tq) * 512 + h * 128 + 16 * dt + 4 * g) = o; else *(u32x2*)(Y + (size_t)(brow + tq) * 2048 + 512 + h * 128 + 16 * dt + 4 * g) = o; }
        __syncthreads();
    }
}


template <int PROBE = 0> __device__ void phase_dsel(const Params& p, LAS unsigned char* lds, int bid, int nb) {
    const int tid = phase_tid(), lane = tid & 63, w = __builtin_amdgcn_readfirstlane(tid >> 6), fr = lane & 15, g = lane >> 4;
    LAS unsigned char* KEYS = lds;
    LAS unsigned char* IQS = lds + 131072;
    const bf16_t* IQ = BF(p, OFF_IQ); const bf16_t* IKW = BF(p, OFF_IKW);
    unsigned* MASK = PROBE ? (unsigned*)((unsigned char*)p.x + (size_t)(PROBE - 1) * 8 * MiB) : (unsigned*)(p.ws + OFF_MASK);
    const int nun = (nb == 256) ? 8 : ((2048 - bid + nb - 1) / nb);
#define DSEL_ITEM(u_) ((nb == 256) ? (((u_) & 1) ? (512 * ((u_) >> 1) + 511 - bid) : (512 * ((u_) >> 1) + bid)) : (bid + (u_) * nb))
    u32x4 iqpre, wpa, wpb; bf16x8 kb0[4][2], kb1[4][2];
#define DSEL_ISSUE(buf, kbase_, base_) do { _Pragma("unroll") for (int j = 0; j < 4; ++j) { int ktl = (base_) + 8 * j; ktl = ktl < 256 ? ktl : 255; const bf16_t* kp = (kbase_) + (size_t)ktl * 2048; \
        (buf)[j][0] = *(const bf16x8*)kp; (buf)[j][1] = *(const bf16x8*)(kp + 32); } } while (0)
#define DSEL_PREFETCH(u_) do { const int k_ = DSEL_ITEM(u_); const int brow_ = (k_ & 3) * SEQ, t0_ = (k_ >> 2) * 8; \
        iqpre = *(const u32x4*)(IQ + (size_t)(brow_ + t0_ + (tid >> 6)) * 512 + (tid & 63) * 8); \
        wpa = *(const u32x4*)(IKW + (size_t)(brow_ + t0_ + 2 * g) * 128 + 64); wpb = *(const u32x4*)(IKW + (size_t)(brow_ + t0_ + 2 * g + 1) * 128 + 64); \
        const bf16_t* kb_ = IKW + (size_t)(brow_ + fr) * 128 + 8 * g; DSEL_ISSUE(kb0, kb_, w); } while (0)
    if (nun > 0) DSEL_PREFETCH(0);
    for (int u = 0; u < nun; ++u) {
        const int k = DSEL_ITEM(u);
        const int b = k & 3, qt = k >> 2, brow = b * SEQ, t0 = qt * 8, nkt = (t0 + 7) / 16 + 1;
        __syncthreads();
        *(LAS u32x4*)(IQS + (tid >> 6) * 1040 + (tid & 63) * 16) = iqpre;
        __syncthreads();
        {
            bf16x8 aq[4][2];
#pragma unroll
            for (int hp = 0; hp < 4; ++hp)
#pragma unroll
                for (int ks = 0; ks < 2; ++ks) aq[hp][ks] = *(const LAS bf16x8*)(IQS + (fr >> 1) * 1040 + ((2 * hp + (fr & 1)) * 64 + 32 * ks + 8 * g) * 2);
            float wa[8], wb[8];
#pragma unroll
            for (int hh = 0; hh < 8; ++hh) { wa[hh] = (hh & 1) ? __uint_as_float(wpa[hh >> 1] & 0xffff0000u) : __uint_as_float(wpa[hh >> 1] << 16); wb[hh] = (hh & 1) ? __uint_as_float(wpb[hh >> 1] & 0xffff0000u) : __uint_as_float(wpb[hh >> 1] << 16); }
            const int tqa = t0 + 2 * g, tqb = tqa + 1;
            const bf16_t* kbase = IKW + (size_t)(brow + fr) * 128 + 8 * g;
#define DSEL_COMPUTE(buf, base_) do { _Pragma("unroll") for (int j = 0; j < 4; ++j) { const int kt = (base_) + 8 * j; if (kt < nkt) { \
                float sa = 0.f, sb = 0.f; \
                f32x4 ah[4]; \
                _Pragma("unroll") for (int hp = 0; hp < 4; ++hp) { f32x4 acc = {0.f, 0.f, 0.f, 0.f}; \
                    acc = __builtin_amdgcn_mfma_f32_16x16x32_bf16(aq[hp][0], (buf)[j][0], acc, 0, 0, 0); acc = __builtin_amdgcn_mfma_f32_16x16x32_bf16(aq[hp][1], (buf)[j][1], acc, 0, 0, 0); ah[hp] = acc; } \
                mfma_fence(ah[0], ah[1], ah[2], ah[3]); \
                _Pragma("unroll") for (int hp = 0; hp < 4; ++hp) { sa += wa[2 * hp] * fmaxf(ah[hp][0], 0.f) + wa[2 * hp + 1] * fmaxf(ah[hp][1], 0.f); sb += wb[2 * hp] * fmaxf(ah[hp][2], 0.f) + wb[2 * hp + 1] * fmaxf(ah[hp][3], 0.f); } \
                const int spos = 16 * kt + fr; \
                unsigned ua = __float_as_uint(sa + 0.0f); ua = (ua & 0x80000000u) ? ~ua : (ua | 0x80000000u); \
                unsigned ub = __float_as_uint(sb + 0.0f); ub = (ub & 0x80000000u) ? ~ub : (ub | 0x80000000u); \
                *(LAS unsigned*)(KEYS + (2 * g) * 16384 + spos * 4) = (spos <= tqa) ? ((ua & 0xfffff000u) | (unsigned)(4095 - spos)) : 0u; \
                *(LAS unsigned*)(KEYS + (2 * g + 1) * 16384 + spos * 4) = (spos <= tqb) ? ((ub & 0xfffff000u) | (unsigned)(4095 - spos)) : 0u; } } } while (0)
            for (int base = w; base < nkt; base += 64) {
                DSEL_ISSUE(kb1, kbase, base + 32);
                DSEL_COMPUTE(kb0, base);
                DSEL_ISSUE(kb0, kbase, base + 64);
                DSEL_COMPUTE(kb1, base + 32);
            }
#undef DSEL_COMPUTE
        }
        __syncthreads();
        if (u + 1 < nun) DSEL_PREFETCH(u + 1);
        {
            const int t = t0 + w; const int nch = 4 * nkt;
            const int mmax = (nch + 63) >> 6;
            u32x4 kr[16];
#pragma unroll
            for (int m = 0; m < 16; ++m) { const int c = lane + 64 * m; const u32x4 z = {0u, 0u, 0u, 0u};
                kr[m] = (m < mmax && c < nch) ? *(const LAS u32x4*)(KEYS + w * 16384 + c * 16) : z; }
            unsigned thr = 1u;
            if (t + 1 > 256) { thr = 0u;
                for (int it = 0; it < 32; ++it) {
                    const unsigned cand = thr | (0x80000000u >> it);
                    unsigned cn = 0u;
#pragma unroll
                    for (int m = 0; m < 16; ++m) if (m < mmax) {
                        cn += (unsigned)__builtin_popcountll(__builtin_amdgcn_ballot_w64(kr[m].x >= cand)); cn += (unsigned)__builtin_popcountll(__builtin_amdgcn_ballot_w64(kr[m].y >= cand));
                        cn += (unsigned)__builtin_popcountll(__builtin_amdgcn_ballot_w64(kr[m].z >= cand)); cn += (unsigned)__builtin_popcountll(__builtin_amdgcn_ballot_w64(kr[m].w >= cand)); }
                    if (cn >= 256u) thr = cand;
                    if (cn == 256u) break;
                } }
            unsigned* mrow = MASK + (size_t)(brow + t) * 128;
#pragma unroll
            for (int m = 0; m < 16; ++m) {
                unsigned nib = 0u;
                if (m < mmax) nib = ((kr[m].x >= thr) ? 1u : 0u) | ((kr[m].y >= thr) ? 2u : 0u) | ((kr[m].z >= thr) ? 4u : 0u) | ((kr[m].w >= thr) ? 8u : 0u);
                unsigned v = nib << (4 * (lane & 7));
                v |= (unsigned)__shfl_xor((int)v, 1); v |= (unsigned)__shfl_xor((int)v, 2); v |= (unsigned)__shfl_xor((int)v, 4);
                if ((lane & 7) == 0) mrow[(lane >> 3) + 8 * m] = v;
            }
        }
    }
#undef DSEL_ISSUE
#undef DSEL_PREFETCH
#undef DSEL_ITEM
}

template <int PROBE = 0> __device__ void phase_datt(const Params& p, LAS unsigned char* lds, int bid, int nb) {
    const int tid = phase_tid(), lane = tid & 63, w = __builtin_amdgcn_readfirstlane(tid >> 6), fr = lane & 15, g = lane >> 4;
    LAS unsigned char* BK = lds;
    LAS float* RL = (LAS float*)(lds + 4096);
    LAS unsigned short* IDX = (LAS unsigned short*)(lds + 5120 + w * 512);
    LAS unsigned char* CT = lds + 9216 + w * (32 * 544);
    const bf16_t* CKV = BF(p, OFF_CKV); bf16_t* Y = BF(p, OFF_Y); const unsigned* MASK = (const unsigned*)(p.ws + OFF_MASK);
    for (int dd = tid; dd < 4096; dd += 512) BK[dd] = (unsigned char)rel_bucket(dd);
    if (tid < 256) RL[tid] = p.in[I_REL][tid];
    __syncthreads();
    const float scale = 0.08838834764831845f;
    const int hd = fr & 3;
    for (int it = bid; it < NTOK / 8; it += nb) {
        const int tg = it * 8 + w, brow = (tg >> 12) * SEQ, t = tg & 4095;
        const u32x2 mw = *(const u32x2*)(MASK + (size_t)tg * 128 + 2 * lane);
        const int cnt = __popc(mw.x) + __popc(mw.y);
        int pre = cnt;
#pragma unroll
        for (int o = 1; o < 64; o <<= 1) { const int v = __shfl_up(pre, o); if (lane >= o) pre += v; }
        const int nsel = __shfl(pre, 63);
        int pos = pre - cnt;
        { unsigned m0 = mw.x; while (m0) { const int bpos = __ffs(m0) - 1; m0 &= m0 - 1; IDX[pos++] = (unsigned short)(64 * lane + bpos); }
          unsigned m1 = mw.y; while (m1) { const int bpos = __ffs(m1) - 1; m1 &= m1 - 1; IDX[pos++] = (unsigned short)(64 * lane + 32 + bpos); } }
        for (int e = nsel + lane; e < 256; e += 64) IDX[e] = 0;
        bf16x8 qb[8];
#pragma unroll
        for (int ks = 0; ks < 8; ++ks) { const u32x4 z = {0u, 0u, 0u, 0u}; const u32x4 v = (fr < 4) ? *(const u32x4*)(Y + (size_t)tg * 2048 + 1024 + fr * 256 + 32 * ks + 8 * g) : z; qb[ks] = __builtin_bit_cast(bf16x8, v); }
        f32x4 oacc[16];
#pragma unroll
        for (int rt = 0; rt < 16; ++rt) oacc[rt] = (f32x4){0.f, 0.f, 0.f, 0.f};
        float mrun = -1e30f, lsum = 0.f;
        const int nstep = (nsel + 31) >> 5;
        bf16x8 a0[8], a1[8];
        { const bf16_t* c0 = CKV + (size_t)(brow + IDX[fr]) * 256 + 8 * g; const bf16_t* c1 = CKV + (size_t)(brow + IDX[16 + fr]) * 256 + 8 * g;
#pragma unroll
          for (int ks = 0; ks < 8; ++ks) { a0[ks] = *(const bf16x8*)(c0 + 32 * ks); a1[ks] = *(const bf16x8*)(c1 + 32 * ks); } }
        for (int st = 0; st < nstep; ++st) {
#pragma unroll
            for (int ks = 0; ks < 8; ++ks) { *(LAS bf16x8*)(CT + fr * 544 + (32 * ks + 8 * g) * 2) = a0[ks]; *(LAS bf16x8*)(CT + (16 + fr) * 544 + (32 * ks + 8 * g) * 2) = a1[ks]; }
            f32x4 s0 = {0.f, 0.f, 0.f, 0.f}, s1 = {0.f, 0.f, 0.f, 0.f};
#pragma unroll
            for (int ks = 0; ks < 8; ++ks) { s0 = __builtin_amdgcn_mfma_f32_16x16x32_bf16(a0[ks], qb[ks], s0, 0, 0, 0); s1 = __builtin_amdgcn_mfma_f32_16x16x32_bf16(a1[ks], qb[ks], s1, 0, 0, 0); }
            mfma_fence(s0); mfma_fence(s1);
            if (st + 1 < nstep) {
                const bf16_t* c0 = CKV + (size_t)(brow + IDX[32 * (st + 1) + fr]) * 256 + 8 * g; const bf16_t* c1 = CKV + (size_t)(brow + IDX[32 * (st + 1) + 16 + fr]) * 256 + 8 * g;
#pragma unroll
                for (int ks = 0; ks < 8; ++ks) { a0[ks] = *(const bf16x8*)(c0 + 32 * ks); a1[ks] = *(const bf16x8*)(c1 + 32 * ks); } }
            float mx = -1e30f;
#pragma unroll
            for (int r = 0; r < 4; ++r) {
                { const int slot = 32 * st + 4 * g + r; const int dist = t - (int)IDX[slot]; const float lg = s0[r] * scale + RL[BK[dist < 0 ? 0 : dist] * 8 + 4 + hd]; s0[r] = (slot < nsel) ? lg : -1e30f; mx = fmaxf(mx, s0[r]); }
                { const int slot = 32 * st + 16 + 4 * g + r; const int dist = t - (int)IDX[slot]; const float lg = s1[r] * scale + RL[BK[dist < 0 ? 0 : dist] * 8 + 4 + hd]; s1[r] = (slot < nsel) ? lg : -1e30f; mx = fmaxf(mx, s1[r]); } }
            mx = fmaxf(mx, __shfl_xor(mx, 16)); mx = fmaxf(mx, __shfl_xor(mx, 32));
            const float mnew = fmaxf(mrun, mx), alpha = __expf(mrun - mnew); mrun = mnew;
            float ps = 0.f;
#pragma unroll
            for (int r = 0; r < 4; ++r) { const float p0 = (s0[r] > -1e29f) ? __expf(s0[r] - mnew) : 0.f, p1 = (s1[r] > -1e29f) ? __expf(s1[r] - mnew) : 0.f; s0[r] = p0; s1[r] = p1; ps += p0 + p1; }
            lsum = lsum * alpha + ps;
#pragma unroll
            for (int rt = 0; rt < 16; ++rt) oacc[rt] = oacc[rt] * alpha;
            u32x4 pt; pt.x = cvt_pk_bf16(s0[0], s0[1]); pt.y = cvt_pk_bf16(s0[2], s0[3]); pt.z = cvt_pk_bf16(s1[0], s1[1]); pt.w = cvt_pk_bf16(s1[2], s1[3]);
            const bf16x8 pb = __builtin_bit_cast(bf16x8, pt);
#pragma unroll
            for (int rt = 0; rt < 16; ++rt) {
                const LAS unsigned char* va = CT + (4 * g + (fr >> 2)) * 544 + (16 * rt + 4 * (fr & 3)) * 2;
                const v4i16_t lo = lds_tr16(va), hi = lds_tr16(va + 16 * 544);
                const bf16x8 a = {lo[0], lo[1], lo[2], lo[3], hi[0], hi[1], hi[2], hi[3]};
                oacc[rt] = __builtin_amdgcn_mfma_f32_16x16x32_bf16(a, pb, oacc[rt], 0, 0, 0); }
        }
        lsum += __shfl_xor(lsum, 16); lsum += __shfl_xor(lsum, 32);
        const float inv = 1.f / lsum;
        mfma_fence(oacc[0], oacc[1], oacc[2], oacc[3]); mfma_fence(oacc[4], oacc[5], oacc[6], oacc[7]); mfma_fence(oacc[8], oacc[9], oacc[10], oacc[11]); mfma_fence(oacc[12], oacc[13], oacc[14], oacc[15]);
        if (fr < 4) {
            bf16_t* yo = PROBE ? ((bf16_t*)((unsigned char*)p.x + 32 * MiB) + (size_t)tg * 1024 + fr * 256 + 4 * g) : (Y + (size_t)tg * 2048 + 1024 + fr * 256 + 4 * g);
#pragma unroll
            for (int rt = 0; rt < 16; ++rt) { u32x2 o; o.x = cvt_pk_bf16(oacc[rt][0] * inv, oacc[rt][1] * inv); o.y = cvt_pk_bf16(oacc[rt][2] * inv, oacc[rt][3] * inv); *(u32x2*)(yo + 16 * rt) = o; }
        }
    }
}

__device__ __forceinline__ Params opq(const Params& p) { Params q = p; asm volatile("" : "+s"(q.ws), "+s"(q.x)); return q; }
__device__ __forceinline__ int opqi(int v) { asm volatile("" : "+s"(v)); return v; }
#define GRID_BARRIER() do { XcdBarrier _b; _b.bar = (unsigned*)(opq(p).ws + OFF_CTL); _b.x = xb_xcc_id(); _b.st = (volatile LAS unsigned*)(lds + LDS_PHASE_BYTES); xcd_barrier(_b); } while (0)
#define PP opq(p)
#define BB opqi(bid)
__device__ __forceinline__ void layer_body(const Params& p, LAS unsigned char* lds, const int bid, const int nb, const int l) {
        phase_gemm_in(PP, lds, BB, nb);
        GRID_BARRIER();
        phase_prep(PP, l, lds, BB, nb);
        phase_hg1(PP, l, lds, BB, nb);
        GRID_BARRIER();
        phase_hg2(PP, BB, nb);
        phase_moba(PP, lds, BB, nb);
        phase_dsel(PP, lds, BB, nb);
        GRID_BARRIER();
        phase_hg3(PP, l, lds, BB, nb);
        phase_datt(PP, lds, BB, nb);
        __syncthreads();
        phase_conv_postA(PP, l, lds, BB, nb);
        GRID_BARRIER();
        phase_conv_postB(PP, l, lds, BB, nb);
        phase_gemm_gates(PP, lds, BB, nb);
        GRID_BARRIER();
        phase_gemm_branch(PP, lds, BB, nb);
        GRID_BARRIER();
        phase_gemm_out(PP, lds, BB, nb);
        GRID_BARRIER();
        { const Params q = PP;
          if (l == 0) phase_norm<1, false, true>(q.in[I_X], BF(q, OFF_XB), BF(q, OFF_OUT), q.in[I_POSTMIX] + l * 1024, q.in[I_PREFFN] + l * 1024, BF(q, OFF_H), BB, nb);
          else        phase_norm<1, true, true>(q.x, BF(q, OFF_XB), BF(q, OFF_OUT), q.in[I_POSTMIX] + l * 1024, q.in[I_PREFFN] + l * 1024, BF(q, OFF_H), BB, nb); }
        GRID_BARRIER();
        phase_gemm_ffn1(PP, lds, BB, nb);
        GRID_BARRIER();
        phase_gemm_ffn2(PP, lds, BB, nb);
        GRID_BARRIER();
        if (l + 1 < DEPTH) { { const Params q = PP; phase_norm<1, true, true>(BF(q, OFF_XB), q.x, BF(q, OFF_OUT), q.in[I_POSTFFN] + l * 1024, q.in[I_PREMIX] + (l + 1) * 1024, BF(q, OFF_H), BB, nb); } phase_conv_in(PP, l + 1, lds, BB, nb); GRID_BARRIER(); }
        else { const Params q = PP; phase_norm<2, true, false>(BF(q, OFF_XB), q.x, BF(q, OFF_OUT), q.in[I_POSTFFN] + l * 1024, nullptr, nullptr, BB, nb); }
}
__global__ __launch_bounds__(512, 2) void mega_fwd(Params p) {
    extern __shared__ __attribute__((aligned(16))) unsigned char shm[];
    LAS unsigned char* lds = (LAS unsigned char*)shm;
    const int bid = blockIdx.x, nb = gridDim.x;
    volatile LAS unsigned* xbw = (volatile LAS unsigned*)(lds + LDS_PHASE_BYTES);
    if (threadIdx.x < 4) xbw[threadIdx.x] = 0u;
    __syncthreads();
    (void)xcd_barrier_post((unsigned*)(p.ws + OFF_CTL), xbw);
    { const Params q = PP; phase_norm<0, false, false>(q.in[I_X], nullptr, nullptr, nullptr, q.in[I_PREMIX], BF(q, OFF_H), BB, nb); }
    phase_conv_in(PP, 0, lds, BB, nb);
    GRID_BARRIER();
    for (int l = 0; l < DEPTH; ++l) layer_body(p, lds, bid, nb, l);
}

#define LDS_BYTES (LDS_PHASE_BYTES + 16)
extern "C" void kernel_launch(void* const* d_in, const int* in_sizes, int n_in, void* d_out, int out_size, void* d_ws, size_t ws_size, hipStream_t stream) {
    static int grid = 0;
    if (grid == 0) {
        int dev = 0, cus = 0;
        if (hipGetDevice(&dev) != hipSuccess || hipDeviceGetAttribute(&cus, hipDeviceAttributeMultiprocessorCount, dev) != hipSuccess || cus < 1) { fprintf(stderr, "kernel_launch: no device info\n"); grid = -1; return; }
        if (hipFuncSetAttribute((const void*)mega_fwd, hipFuncAttributeMaxDynamicSharedMemorySize, LDS_BYTES) != hipSuccess) { fprintf(stderr, "kernel_launch: hipFuncSetAttribute failed\n"); grid = -1; return; }
        int per_cu = 0;
        if (hipOccupancyMaxActiveBlocksPerMultiprocessor(&per_cu, (const void*)mega_fwd, 512, LDS_BYTES) != hipSuccess || per_cu < 1) { fprintf(stderr, "kernel_launch: occupancy query says %d blocks per CU\n", per_cu); }
        (void)hipGetLastError();
        grid = cus;
    }
    if (grid < 0) return;
    Params p{};
    for (int i = 0; i < 20; ++i) p.in[i] = (const float*)d_in[i];
    p.x = (float*)d_out; p.ws = (unsigned char*)d_ws;
    if (WS_NEED > ws_size) { fprintf(stderr, "kernel_launch: workspace too small (%zu < %zu)\n", ws_size, (size_t)WS_NEED); return; }
    (void)hipMemsetAsync(p.ws + OFF_CTL, 0, 16384, stream);
    hipLaunchKernelGGL(mega_fwd, dim3(grid), dim3(512), LDS_BYTES, stream, p);
}
```

```cpp
#include <hip/hip_runtime.h>
#include <stdint.h>
#include <stdio.h>

#define D_MODEL 1024
#define BATCH 4
#define SEQ 4096
#define NTOK 16384
#define DEPTH 2
#define IN_W 8008
#define D_FF 2816
#define NEG_BIG (-1e30f)
#define C_HQ 0
#define C_HF 512
#define C_HI 1024
#define C_HG 1536
#define C_MQ 2048
#define C_MK 2560
#define C_MV 3072
#define C_DQ 3584
#define C_DKV 4096
#define C_IQ 4352
#define C_IK 4864
#define C_IW 4928
#define C_G 4936
#define NP1 5632

#define LAS __attribute__((address_space(3)))
typedef unsigned short bf16_t;
typedef short bf16x8 __attribute__((ext_vector_type(8)));
typedef float f32x4 __attribute__((ext_vector_type(4)));
typedef unsigned u32x4 __attribute__((ext_vector_type(4)));
typedef unsigned u32x2 __attribute__((ext_vector_type(2)));

__device__ __forceinline__ float sigmoidf_(float x) { return 1.f / (1.f + __expf(-x)); }
__device__ __forceinline__ float bf2f(bf16_t b) { return __uint_as_float(((unsigned)b) << 16); }
typedef __bf16 bf16x2_t __attribute__((ext_vector_type(2)));
typedef float f32x2_t __attribute__((ext_vector_type(2)));
__device__ __forceinline__ unsigned cvt_pk_bf16(float lo, float hi) { const f32x2_t f = {lo, hi}; const bf16x2_t v = __builtin_convertvector(f, bf16x2_t); return __builtin_bit_cast(unsigned, v); }
__device__ __forceinline__ bf16_t f2bf(float f) { return (bf16_t)(cvt_pk_bf16(f, 0.f) & 0xffffu); }
__device__ __forceinline__ int phase_tid() { int t = threadIdx.x; asm volatile("" : "+v"(t)); return t; }
__device__ __forceinline__ void mfma_fence(f32x4& a) { asm volatile("s_nop 15\n\ts_nop 3" : "+v"(a)); }
__device__ __forceinline__ void mfma_fence(f32x4& a, f32x4& b, f32x4& c, f32x4& d) { asm volatile("s_nop 15\n\ts_nop 3" : "+v"(a), "+v"(b), "+v"(c), "+v"(d)); }
__device__ __forceinline__ int rel_bucket(int dist) {
    int n = dist > 0 ? dist : 0;
    if (n < 16) return n;
    float nf = (float)n;
    int large = 16 + (int)(logf(nf / 16.f) / 4.852030263919617f * 16.f);
    return large < 31 ? large : 31;
}

enum { I_X = 0, I_WIN, I_PREMIX, I_POSTMIX, I_PREFFN, I_POSTFFN, I_LB, I_HGNW, I_KVN, I_WUK, I_WUV, I_IKNW, I_IKNB, I_REL, I_WA, I_WB, I_WC, I_WOUT, I_WF1, I_WF2 };
#define GAS __attribute__((address_space(1)))
struct Params { GAS const float* in[20]; GAS float* x; GAS unsigned char* ws; };
#define IN(p, i) ((const float*)(p).in[i])
constexpr size_t MiB = 1024 * 1024;
#define LDS_PHASE_BYTES (150 * 1024)
constexpr size_t OFF_CTL = 0, OFF_Y = 65536, OFF_HF = OFF_Y + 64 * MiB, OFF_HI = OFF_HF + 16 * MiB, OFF_HG = OFF_HI + 16 * MiB, OFF_MK = OFF_HG + 16 * MiB,
                 OFF_MV = OFF_MK + 16 * MiB, OFF_IQ = OFF_MV + 16 * MiB, OFF_CKV = OFF_IQ + 16 * MiB, OFF_IKW = OFF_CKV + 8 * MiB, OFF_H = OFF_IKW + 4 * MiB,
                 OFF_WIN = OFF_H + 32 * MiB, OFF_RS = OFF_WIN + 11 * MiB;
constexpr size_t OFF_WG = OFF_WIN, OFF_WBR = OFF_WG + 6 * MiB, OFF_WOUT = OFF_RS, OFF_WF1 = OFF_WOUT + 2 * MiB, OFF_WF2 = OFF_WF1 + 11 * MiB, OFF_WEND = OFF_WF2 + 6 * MiB;
constexpr size_t OFF_ST = OFF_RS, OFF_TMPF = OFF_RS, OFF_DEC = OFF_ST + 32 * MiB, OFF_MASK = OFF_DEC + MiB / 2, OFF_KMEAN = OFF_MASK + 8 * MiB, OFF_MEND = OFF_KMEAN + MiB / 8;
constexpr size_t OFF_OUT = OFF_HG, OFF_ACT = OFF_Y, OFF_XB = OFF_MV;
constexpr size_t WS_NEED = (OFF_WEND > OFF_MEND ? OFF_WEND : OFF_MEND);
#define BF(p, off) ((bf16_t*)((p).ws + (off)))
#define F32P(p, off) ((float*)((p).ws + (off)))
__device__ const unsigned long long kP1Off[22] = {OFF_Y, OFF_Y, OFF_HF, OFF_HF, OFF_HI, OFF_HI, OFF_HG, OFF_HG, OFF_Y, OFF_Y, OFF_MK, OFF_MK, OFF_MV, OFF_MV, OFF_Y, OFF_Y, OFF_Y, OFF_Y, OFF_CKV, OFF_IQ, OFF_IQ, OFF_IKW};
__device__ const int kP1Ld[22]  = {2048, 2048, 512, 512, 512, 512, 512, 512, 2048, 2048, 512, 512, 512, 512, 2048, 2048, 2048, 2048, 256, 512, 512, 128};
__device__ const int kP1C0[22]  = {0, 256, 0, 256, 0, 256, 0, 256, 512, 768, 0, 256, 0, 256, 1024, 1280, 1536, 1792, 0, 0, 256, 0};
__device__ const int kP1Nc[22]  = {256, 256, 256, 256, 256, 256, 256, 256, 256, 256, 256, 256, 256, 256, 256, 256, 256, 256, 256, 256, 256, 128};

#define XB_TMO      128
#define XB_XCNT(j)  (256  + 64 * (j))
#define XB_XSUB(j)  (1280 + 64 * (j))
#define XB_XGEN(j)  (2304 + 64 * (j))
#define XB_TOP      3328
#define XB_TOPGEN   3392
#define XCD_BAR_WORDS 3456
#define XB_SPIN_CAP (1u << 18)

__device__ __forceinline__ unsigned xb_ld(unsigned* p)              { return __hip_atomic_load(p, __ATOMIC_RELAXED, __HIP_MEMORY_SCOPE_AGENT); }
__device__ __forceinline__ unsigned xb_add(unsigned* p, unsigned v) { return __hip_atomic_fetch_add(p, v, __ATOMIC_RELAXED, __HIP_MEMORY_SCOPE_AGENT); }
__device__ __forceinline__ unsigned xb_xcc_id() { return (unsigned)__builtin_amdgcn_s_getreg((3 << 11) | 20) & 0xFu; }
#define XB_SPIN(cond, bar) do { unsigned _sp = 0; while (cond) { __builtin_amdgcn_s_sleep(1); \
    if ((++_sp & 255u) == 0u) { if (xb_ld(&(bar)[XB_TMO])) break; if (_sp > XB_SPIN_CAP) { atomicAdd(&(bar)[XB_TMO], 1u); break; } } } } while (0)

struct XcdBarrier {
    unsigned* bar; unsigned x;
    volatile LAS unsigned* st;
};

__device__ __forceinline__ XcdBarrier xcd_barrier_post(unsigned* bar, volatile LAS unsigned* st) {
    XcdBarrier b; b.bar = bar; b.x = xb_xcc_id(); b.st = st;
    if (threadIdx.x == 0) (void)xb_add(&bar[XB_XCNT(b.x)], 1u);
    return b;
}
__device__ __forceinline__ void xcd_barrier_complete(unsigned* bar, unsigned x, unsigned& nloc, unsigned& nx) {
    const unsigned G = gridDim.x * gridDim.y * gridDim.z;
    unsigned sum, cnt, mine, sp = 0u;
    for (;;) {
        sum = 0u; cnt = 0u; mine = 0u;
#pragma unroll
        for (unsigned j = 0; j < 16; ++j) { const unsigned c = xb_ld(&bar[XB_XCNT(j)]); sum += c; cnt += (c > 0u) ? 1u : 0u; mine = (j == x) ? c : mine; }
        if (sum == G) break;
        __builtin_amdgcn_s_sleep(1);
        if ((++sp & 255u) == 0u) { if (xb_ld(&bar[XB_TMO])) break; if (sp > XB_SPIN_CAP) { atomicAdd(&bar[XB_TMO], 1u); break; } }
    }
    nloc = mine > 0u ? mine : 1u; nx = cnt > 0u ? cnt : 1u;
}

__device__ __forceinline__ void xcd_barrier(const XcdBarrier& b) {
    asm volatile("s_waitcnt vmcnt(0)" ::: "memory");
    __syncthreads();
    if (threadIdx.x == 0) {
        unsigned* bar = b.bar;
        __builtin_amdgcn_s_waitcnt(0);
        unsigned nloc = b.st[0], nx = b.st[1];
        if (nloc == 0u) { xcd_barrier_complete(bar, b.x, nloc, nx); b.st[0] = nloc; b.st[1] = nx; }
        const unsigned old = xb_add(&bar[XB_XSUB(b.x)], 1u);
        const unsigned gen = old / nloc;
        if (old + 1u == (gen + 1u) * nloc) {
            __builtin_amdgcn_fence(__ATOMIC_RELEASE, "agent");
            asm volatile("s_waitcnt vmcnt(0)" ::: "memory");
            const unsigned og = xb_add(&bar[XB_TOP], 1u);
            const unsigned tg = og / nx;
            if (og + 1u == (tg + 1u) * nx) xb_add(&bar[XB_TOPGEN], 1u);
            else XB_SPIN(xb_ld(&bar[XB_TOPGEN]) == tg, bar);
            __builtin_amdgcn_fence(__ATOMIC_ACQUIRE, "agent");
            xb_add(&bar[XB_XGEN(b.x)], 1u);
            asm volatile("s_waitcnt vmcnt(0)" ::: "memory");
        } else {
            XB_SPIN(xb_ld(&bar[XB_XGEN(b.x)]) == gen, bar);
            __builtin_amdgcn_fence(__ATOMIC_ACQUIRE, "agent");
            asm volatile("s_waitcnt vmcnt(0)" ::: "memory");
        }
    }
    __syncthreads();
}


namespace pg8 {
constexpr int BM = 256, BK = 64, HALF = 128, HTB = HALF * BK * 2, STAGE_BYTES = 8 * HTB, NXCD = 8, WGM = 8;
__host__ __device__ __forceinline__ int lds_byte(int r, int c) { const int st = (r >> 4) * 2 + (c >> 5), rr = r & 15, cc = c & 31, ob = rr * 64 + cc * 2; return st * 1024 + (ob ^ (((ob >> 9) & 1) << 5)); }
__host__ __device__ __forceinline__ void stage_rc(int b, int& R, int& C) { const int st = b / 1024, sb = b % 1024, swz = sb ^ (((sb >> 9) & 1) << 5); R = (st >> 1) * 16 + swz / 64; C = (st & 1) * 32 + (swz % 64) / 2; }
__host__ __device__ __forceinline__ int perm32(int rho) { const int n = rho >> 4, i = rho & 15; return 8 * (i >> 2) + 4 * n + (i & 3); }

struct Unit { int pm, pn, ka, nt, br; };
struct Gemm { const bf16_t* A; const bf16_t* Bt; int lda, ldb; };

__device__ __forceinline__ bool tile_of(long L, int nM, int nN, int& pm, int& pn) {
    const int nwg = nM * nN; if (L >= nwg) return false;
    int wgid = (int)L; { const int q = nwg / NXCD, r = nwg % NXCD, xcd = wgid % NXCD, off = wgid / NXCD; wgid = (xcd < r ? xcd * (q + 1) : r * (q + 1) + (xcd - r) * q) + off; }
    const int nig = WGM * nN, gid = wgid / nig, fm = gid * WGM, gsz = (nM - fm) < WGM ? (nM - fm) : WGM;
    pm = fm + ((wgid % nig) % gsz); pn = (wgid % nig) / gsz; return true;
}
struct StaticOrder {
    int nM, nN, G, c, nt;
    __device__ void init(int M, int N, int K, int G_, int c_) { nM = M / BM; nN = N / BM; G = G_; c = c_; nt = K / BK; }
    __device__ bool next(int i, Unit& u) const { u.ka = 0; u.nt = nt; u.br = 0; return tile_of((long)i * G + c, nM, nN, u.pm, u.pn); }
};
struct BranchOrder {
    int nM, nN, G, c;
    __device__ void init(int M, int N, int G_, int c_) { nM = M / BM; nN = N / BM; G = G_; c = c_; }
    __device__ bool next(int i, Unit& u) const { const int ti = i / 3, br = i - ti * 3; u.br = br; u.ka = br * 512; u.nt = (br == 2) ? 16 : 8; return tile_of((long)ti * G + c, nM, nN, u.pm, u.pn); }
};

template <class Epi, class Sched>
__device__ __forceinline__ void gemm_phase(LAS unsigned char* lds, const Gemm g, const Sched& S, const Epi& E) {
    const int tid = phase_tid(), wid = __builtin_amdgcn_readfirstlane(tid >> 6), lane = tid & 63, wr = wid >> 2, wc = wid & 3, fr = lane & 15, fq = lane >> 4;
    unsigned voffA[2], voffB[2];
#pragma unroll
    for (int i = 0; i < 2; ++i) { int R, C; stage_rc(tid * 16 + i * 8192, R, C); const int Rb = Epi::PERM ? ((R & ~31) + perm32(R & 31)) : R;
        voffA[i] = (unsigned)(R * g.lda + C) * 2u; voffB[i] = (unsigned)(Rb * g.ldb + C) * 2u; }
    const size_t kstep = (size_t)(BK * 2);
    const size_t hsA = (size_t)HALF * g.lda * 2, hsB = (size_t)HALF * g.ldb * 2;
    const size_t tsA = 2 * hsA, tsB = 2 * hsB;
    const unsigned ldsw = (unsigned)wid * 1024u;
    const int aoff = lds_byte(wr * 64 + fr, fq * 8), boff = lds_byte(wc * 32 + fr, fq * 8);
#define PG8_SA(b, h) (((b) * 2 + (h)) * HTB)
#define PG8_SB(b, h) ((4 + (b) * 2 + (h)) * HTB)
#define PG8_STAGE(bufoff, gbase, voff) do { _Pragma("unroll") for (int _i = 0; _i < 2; ++_i) \
        __builtin_amdgcn_global_load_lds((const unsigned*)((const char*)(gbase) + (voff)[_i]), (LAS unsigned*)(lds + (bufoff) + ldsw + _i * 8192), 16, 0, 0); } while (0)
#define PG8_LDA(dst, b, h) do { _Pragma("unroll") for (int m = 0; m < 4; ++m) _Pragma("unroll") for (int k = 0; k < 2; ++k) dst[m][k] = *(const LAS bf16x8*)(lds + PG8_SA(b, h) + aoff + m * 2048 + k * 1024); } while (0)
#define PG8_LDB(dst, b, h) do { _Pragma("unroll") for (int n = 0; n < 2; ++n) _Pragma("unroll") for (int k = 0; k < 2; ++k) dst[n][k] = *(const LAS bf16x8*)(lds + PG8_SB(b, h) + boff + n * 2048 + k * 1024); } while (0)
#define PG8_MMA(ai, bj, At, Bt) do { __builtin_amdgcn_s_setprio(1); _Pragma("unroll") for (int m = 0; m < 4; ++m) _Pragma("unroll") for (int n = 0; n < 2; ++n) _Pragma("unroll") for (int k = 0; k < 2; ++k) \
        acc[ai][bj][m][n] = __builtin_amdgcn_mfma_f32_16x16x32_bf16(Bt[n][k], At[m][k], acc[ai][bj][m][n], 0, 0, 0); __builtin_amdgcn_s_setprio(0); } while (0)
#define PG8_WAIT_V(n) asm volatile("s_waitcnt vmcnt(" #n ")" ::: "memory")
#define PG8_WAIT_L(n) asm volatile("s_waitcnt lgkmcnt(" #n ")" ::: "memory")
#define PG8_BAR __builtin_amdgcn_s_barrier()
#define PG8_SCHED __builtin_amdgcn_sched_barrier(0)
    Unit cur, nxt; int ui = 0;
    if (!S.next(0, cur)) return;
    f32x4 acc[2][2][4][2];
#pragma unroll
    for (int a = 0; a < 2; ++a)
#pragma unroll
        for (int b = 0; b < 2; ++b)
#pragma unroll
            for (int m = 0; m < 4; ++m)
#pragma unroll
                for (int n = 0; n < 2; ++n) acc[a][b][m][n] = (f32x4){0.f, 0.f, 0.f, 0.f};
    bf16x8 At[4][2], B0[2][2], B1[2][2];
    const char* cA = (const char*)g.A + (size_t)cur.pm * tsA + (size_t)cur.ka * 2; const char* cB = (const char*)g.Bt + (size_t)cur.pn * tsB + (size_t)cur.ka * 2;
    PG8_STAGE(PG8_SB(0, 0), cB, voffB); PG8_STAGE(PG8_SA(0, 0), cA, voffA); PG8_STAGE(PG8_SB(0, 1), cB + hsB, voffB); PG8_STAGE(PG8_SA(0, 1), cA + hsA, voffA);
    if (wr == 1) PG8_BAR;
    PG8_WAIT_V(4); PG8_BAR;
    PG8_STAGE(PG8_SB(1, 0), cB + kstep, voffB); PG8_STAGE(PG8_SA(1, 0), cA + kstep, voffA); PG8_STAGE(PG8_SB(1, 1), cB + hsB + kstep, voffB);
    PG8_WAIT_V(6); PG8_BAR;
    for (;;) {
        const bool has_next = S.next(ui + 1, nxt);
        const char* nA = has_next ? (const char*)g.A + (size_t)nxt.pm * tsA + (size_t)nxt.ka * 2 : cA; const char* nB = has_next ? (const char*)g.Bt + (size_t)nxt.pn * tsB + (size_t)nxt.ka * 2 : cB;
        const int nt = cur.nt;
        for (int t = 0; t < nt; t += 2) {
            const bool last = (t == nt - 2);
            const char* a1 = cA + (size_t)(t + 1) * kstep;
            const char* a2 = last ? nA : cA + (size_t)(t + 2) * kstep; const char* b2 = last ? nB : cB + (size_t)(t + 2) * kstep;
            const char* a3 = a2 + kstep; const char* b3 = b2 + kstep;
            PG8_LDB(B0, 0, 0); PG8_SCHED; PG8_LDA(At, 0, 0); PG8_STAGE(PG8_SA(1, 1), a1 + hsA, voffA);
            PG8_WAIT_L(8); PG8_BAR; PG8_WAIT_L(0); PG8_MMA(0, 0, At, B0); PG8_BAR; PG8_SCHED;
            PG8_LDB(B1, 0, 1); PG8_STAGE(PG8_SB(0, 0), b2, voffB);
            PG8_BAR; PG8_WAIT_L(0); PG8_MMA(0, 1, At, B1); PG8_BAR;
            PG8_LDA(At, 0, 1); PG8_STAGE(PG8_SA(0, 0), a2, voffA);
            PG8_BAR; PG8_WAIT_L(0); PG8_MMA(1, 0, At, B0); PG8_BAR; PG8_SCHED;
            PG8_STAGE(PG8_SB(0, 1), b2 + hsB, voffB);
            PG8_WAIT_V(6); PG8_BAR; PG8_MMA(1, 1, At, B1); PG8_BAR;
            PG8_LDB(B0, 1, 0); PG8_SCHED; PG8_LDA(At, 1, 0); PG8_STAGE(PG8_SA(0, 1), a2 + hsA, voffA);
            PG8_WAIT_L(8); PG8_BAR; PG8_WAIT_L(0); PG8_MMA(0, 0, At, B0); PG8_BAR; PG8_SCHED;
            PG8_LDB(B1, 1, 1); PG8_STAGE(PG8_SB(1, 0), b3, voffB);
            PG8_BAR; PG8_WAIT_L(0); PG8_MMA(0, 1, At, B1); PG8_BAR;
            PG8_LDA(At, 1, 1); PG8_STAGE(PG8_SA(1, 0), a3, voffA);
            PG8_BAR; PG8_WAIT_L(0); PG8_MMA(1, 0, At, B0); PG8_BAR; PG8_SCHED;
            PG8_STAGE(PG8_SB(1, 1), b3 + hsB, voffB);
            PG8_WAIT_V(6); PG8_BAR; PG8_MMA(1, 1, At, B1); PG8_BAR;
        }
        E(acc, cur, wr, wc, fr, fq);
        if (!has_next) break;
#pragma unroll
        for (int a = 0; a < 2; ++a)
#pragma unroll
            for (int b = 0; b < 2; ++b)
#pragma unroll
                for (int m = 0; m < 4; ++m)
#pragma unroll
                    for (int n = 0; n < 2; ++n) acc[a][b][m][n] = (f32x4){0.f, 0.f, 0.f, 0.f};
        cur = nxt; cA = nA; cB = nB; ++ui;
    }
    PG8_WAIT_V(0);
    if (wr == 0) PG8_BAR;
    PG8_BAR;
#undef PG8_SA
#undef PG8_SB
#undef PG8_STAGE
#undef PG8_LDA
#undef PG8_LDB
#undef PG8_MMA
#undef PG8_WAIT_V
#undef PG8_WAIT_L
#undef PG8_BAR
#undef PG8_SCHED
}

struct EpiF32 {
    static constexpr bool PERM = false;
    float* C; int ldc;
    __device__ __forceinline__ void operator()(const f32x4 (&acc)[2][2][4][2], const Unit& u, int wr, int wc, int fr, int fq) const {
        const int row0 = u.pm * BM + wr * 64 + fr, col0 = u.pn * BM + wc * 32 + 4 * fq;
#pragma unroll
        for (int ai = 0; ai < 2; ++ai)
#pragma unroll
            for (int m = 0; m < 4; ++m) { float* rowp = C + (size_t)(row0 + ai * HALF + m * 16) * ldc + col0;
#pragma unroll
                for (int bj = 0; bj < 2; ++bj)
#pragma unroll
                    for (int n = 0; n < 2; ++n) *(f32x4*)(rowp + bj * HALF + n * 16) = acc[ai][bj][m][n]; }
    }
};
struct EpiProj {
    static constexpr bool PERM = true;
    unsigned char* ws;
    __device__ __forceinline__ void operator()(const f32x4 (&acc)[2][2][4][2], const Unit& u, int wr, int wc, int fr, int fq) const {
        bf16_t* base = (bf16_t*)(ws + kP1Off[u.pn]); const int ld = kP1Ld[u.pn], ncol = kP1Nc[u.pn];
        const int row0 = u.pm * BM + wr * 64 + fr, col0 = kP1C0[u.pn] + wc * 32 + 8 * fq;
#pragma unroll
        for (int ai = 0; ai < 2; ++ai)
#pragma unroll
            for (int m = 0; m < 4; ++m) { bf16_t* rowp = base + (size_t)(row0 + ai * HALF + m * 16) * ld + col0;
#pragma unroll
                for (int bj = 0; bj < 2; ++bj) { if (bj * HALF >= ncol) continue;
                    const f32x4 v0 = acc[ai][bj][m][0], v1 = acc[ai][bj][m][1];
                    u32x4 w; w.x = cvt_pk_bf16(v0[0], v0[1]); w.y = cvt_pk_bf16(v0[2], v0[3]); w.z = cvt_pk_bf16(v1[0], v1[1]); w.w = cvt_pk_bf16(v1[2], v1[3]);
                    *(u32x4*)(rowp + bj * HALF) = w; } }
    }
};
struct EpiBf16 {
    static constexpr bool PERM = true;
    bf16_t* C; int ldc;
    __device__ __forceinline__ void operator()(const f32x4 (&acc)[2][2][4][2], const Unit& u, int wr, int wc, int fr, int fq) const {
        const int row0 = u.pm * BM + wr * 64 + fr, col0 = u.pn * BM + wc * 32 + 8 * fq;
#pragma unroll
        for (int ai = 0; ai < 2; ++ai)
#pragma unroll
            for (int m = 0; m < 4; ++m) { bf16_t* rowp = C + (size_t)(row0 + ai * HALF + m * 16) * ldc + col0;
#pragma unroll
                for (int bj = 0; bj < 2; ++bj) {
                    const f32x4 v0 = acc[ai][bj][m][0], v1 = acc[ai][bj][m][1];
                    u32x4 w; w.x = cvt_pk_bf16(v0[0], v0[1]); w.y = cvt_pk_bf16(v0[2], v0[3]); w.z = cvt_pk_bf16(v1[0], v1[1]); w.w = cvt_pk_bf16(v1[2], v1[3]);
                    *(u32x4*)(rowp + bj * HALF) = w; } }
    }
};
struct EpiGate {
    static constexpr bool PERM = true;
    bf16_t* G0;
    __device__ __forceinline__ void operator()(const f32x4 (&acc)[2][2][4][2], const Unit& u, int wr, int wc, int fr, int fq) const {
        bf16_t* base = G0 + (size_t)(u.pn >> 1) * ((size_t)NTOK * 512);
        const int row0 = u.pm * BM + wr * 64 + fr, col0 = (u.pn & 1) * 256 + wc * 32 + 8 * fq;
#pragma unroll
        for (int ai = 0; ai < 2; ++ai)
#pragma unroll
            for (int m = 0; m < 4; ++m) { bf16_t* rowp = base + (size_t)(row0 + ai * HALF + m * 16) * 512 + col0;
#pragma unroll
                for (int bj = 0; bj < 2; ++bj) {
                    f32x4 v0 = acc[ai][bj][m][0], v1 = acc[ai][bj][m][1];
#pragma unroll
                    for (int j = 0; j < 4; ++j) { v0[j] = sigmoidf_(v0[j]); v1[j] = sigmoidf_(v1[j]); }
                    u32x4 w; w.x = cvt_pk_bf16(v0[0], v0[1]); w.y = cvt_pk_bf16(v0[2], v0[3]); w.z = cvt_pk_bf16(v1[0], v1[1]); w.w = cvt_pk_bf16(v1[2], v1[3]);
                    *(u32x4*)(rowp + bj * HALF) = w; } }
    }
};
struct EpiSwiglu {
    static constexpr bool PERM = true;
    bf16_t* O; int ldc;
    __device__ __forceinline__ void operator()(const f32x4 (&acc)[2][2][4][2], const Unit& u, int wr, int wc, int fr, int fq) const {
        const int row0 = u.pm * BM + wr * 64 + fr, col0 = u.pn * HALF + wc * 32 + 8 * fq;
#pragma unroll
        for (int ai = 0; ai < 2; ++ai)
#pragma unroll
            for (int m = 0; m < 4; ++m) { bf16_t* rowp = O + (size_t)(row0 + ai * HALF + m * 16) * ldc + col0;
                float r[8];
#pragma unroll
                for (int n = 0; n < 2; ++n)
#pragma unroll
                    for (int j = 0; j < 4; ++j) { const float gv = acc[ai][0][m][n][j], uv = acc[ai][1][m][n][j]; r[n * 4 + j] = gv * sigmoidf_(gv) * uv; }
                u32x4 w; w.x = cvt_pk_bf16(r[0], r[1]); w.y = cvt_pk_bf16(r[2], r[3]); w.z = cvt_pk_bf16(r[4], r[5]); w.w = cvt_pk_bf16(r[6], r[7]);
                *(u32x4*)rowp = w; }
    }
};
struct EpiBranch {
    static constexpr bool PERM = true;
    bf16_t* Mg; const bf16_t* G0;
    __device__ __forceinline__ void operator()(const f32x4 (&acc)[2][2][4][2], const Unit& u, int wr, int wc, int fr, int fq) const {
        const bf16_t* gb = G0 + (size_t)(u.br * 2 + (u.pn >> 1)) * ((size_t)NTOK * 512);
        const int row0 = u.pm * BM + wr * 64 + fr, cl = wc * 32 + 8 * fq;
#pragma unroll
        for (int ai = 0; ai < 2; ++ai)
#pragma unroll
            for (int m = 0; m < 4; ++m) { const size_t row = (size_t)(row0 + ai * HALF + m * 16);
#pragma unroll
                for (int bj = 0; bj < 2; ++bj) {
                    const u32x4 gw = *(const u32x4*)(gb + row * 512 + (u.pn & 1) * 256 + bj * HALF + cl);
                    bf16_t* mp = Mg + row * 1024 + u.pn * 256 + bj * HALF + cl;
                    float r[8];
#pragma unroll
                    for (int q = 0; q < 4; ++q) { const unsigned g2 = gw[q]; const int n = q >> 1, j = (q & 1) * 2;
                        r[q * 2] = __uint_as_float(g2 << 16) * acc[ai][bj][m][n][j]; r[q * 2 + 1] = __uint_as_float(g2 & 0xffff0000u) * acc[ai][bj][m][n][j + 1]; }
                    if (u.br != 0) { u32x4 ow;
#pragma unroll
                        for (int q = 0; q < 4; ++q) ow[q] = __hip_atomic_load((const unsigned*)mp + q, __ATOMIC_RELAXED, __HIP_MEMORY_SCOPE_AGENT);
#pragma unroll
                        for (int q = 0; q < 4; ++q) { r[q * 2] += __uint_as_float(ow[q] << 16); r[q * 2 + 1] += __uint_as_float(ow[q] & 0xffff0000u); } }
                    u32x4 w; w.x = cvt_pk_bf16(r[0], r[1]); w.y = cvt_pk_bf16(r[2], r[3]); w.z = cvt_pk_bf16(r[4], r[5]); w.w = cvt_pk_bf16(r[6], r[7]);
                    *(u32x4*)mp = w; } }
    }
};
}

template <int MAP> __device__ __forceinline__ int colmap(int n, int off) {
    if (MAP == 0) return n + off;
    if (MAP == 1) { if (n < 3584) return n; const int s = n - 512; return s < C_G ? s : -1; }
    const int pn = n >> 8, r = n & 255; return (r < 128) ? 128 * pn + r : D_FF + 128 * pn + (r - 128);
}
template <int MAP>
__device__ void conv_job(LAS unsigned char* lds, bf16_t* dst_, int ld_dst, int koff, const float* src_, int ld_src, int K, int n_lo, int n_hi, int off, int bid, int nb) {
    GAS bf16_t* dst = (GAS bf16_t*)dst_; GAS const float* src = (GAS const float*)src_;
    const int tid = phase_tid(), wid = __builtin_amdgcn_readfirstlane(tid >> 6), lane = tid & 63;
    LAS float* tile = (LAS float*)lds + wid * (64 * 65);
    const int nk = K / 64, nn = (n_hi - n_lo) / 64;
    const int l4 = lane >> 4, c4 = (lane & 15) * 4, l8 = lane >> 3, k8 = (lane & 7) * 8;
    for (int it = bid * 8 + wid; it < nk * nn; it += nb * 8) {
        const int n0 = n_lo + (it % nn) * 64, k0 = (it / nn) * 64;
        const int cfirst = colmap<MAP>(n0 + c4, off), clast = colmap<MAP>(n0 + c4 + 3, off);
        GAS const float* sp = src + (size_t)(k0 + l4) * ld_src;
        f32x4 v[16];
        if (cfirst >= 0 && clast == cfirst + 3 && ((cfirst | ld_src) & 3) == 0) {
#pragma unroll
            for (int j = 0; j < 16; ++j) v[j] = *(GAS const f32x4*)(sp + (size_t)(4 * j) * ld_src + cfirst);
        } else {
            const int q0 = colmap<MAP>(n0 + c4, off), q1 = colmap<MAP>(n0 + c4 + 1, off), q2 = colmap<MAP>(n0 + c4 + 2, off), q3 = colmap<MAP>(n0 + c4 + 3, off);
#pragma unroll
            for (int j = 0; j < 16; ++j) { GAS const float* r = sp + (size_t)(4 * j) * ld_src;
                v[j][0] = (q0 >= 0) ? r[q0] : 0.f; v[j][1] = (q1 >= 0) ? r[q1] : 0.f; v[j][2] = (q2 >= 0) ? r[q2] : 0.f; v[j][3] = (q3 >= 0) ? r[q3] : 0.f; }
        }
#pragma unroll
        for (int j = 0; j < 16; ++j) { LAS float* t = tile + (4 * j + l4) * 65 + c4; t[0] = v[j][0]; t[1] = v[j][1]; t[2] = v[j][2]; t[3] = v[j][3]; }
        asm volatile("s_waitcnt lgkmcnt(0)" ::: "memory");
#pragma unroll
        for (int jj = 0; jj < 8; ++jj) { const int nr = l8 + 8 * jj; float w8[8];
#pragma unroll
            for (int e = 0; e < 8; ++e) w8[e] = tile[(k8 + e) * 65 + nr];
            u32x4 w; w.x = cvt_pk_bf16(w8[0], w8[1]); w.y = cvt_pk_bf16(w8[2], w8[3]); w.z = cvt_pk_bf16(w8[4], w8[5]); w.w = cvt_pk_bf16(w8[6], w8[7]);
            *(GAS u32x4*)(dst + (size_t)(n0 + nr) * ld_dst + koff + k0 + k8) = w; }
        asm volatile("s_waitcnt lgkmcnt(0)" ::: "memory");
    }
}
__device__ void fold_tile(LAS unsigned char* lds, bf16_t* out, long sOi, long sOj, const float* A, long sAi, long sAd, const float* B, long sBj, long sBd) {
    LAS float* As = (LAS float*)lds; LAS float* Bs = As + 64 * 132;
    const int tid = phase_tid();
    for (int e = tid; e < 64 * 128; e += 512) {
        int i, d; if (sAd == 1) { i = e >> 7; d = e & 127; } else { d = e >> 6; i = e & 63; }
        As[i * 132 + d] = A[i * sAi + d * sAd];
        int j, d2; if (sBd == 1) { j = e >> 7; d2 = e & 127; } else { d2 = e >> 6; j = e & 63; }
        Bs[j * 132 + d2] = B[j * sBj + d2 * sBd];
    }
    __syncthreads();
    const int i = tid & 63, jg = tid >> 6;
    float acc[8];
#pragma unroll
    for (int q = 0; q < 8; ++q) acc[q] = 0.f;
    for (int d = 0; d < 128; d += 4) { const f32x4 a = *(const LAS f32x4*)(As + i * 132 + d);
#pragma unroll
        for (int q = 0; q < 8; ++q) { const f32x4 b = *(const LAS f32x4*)(Bs + (jg * 8 + q) * 132 + d); acc[q] += a[0] * b[0] + a[1] * b[1] + a[2] * b[2] + a[3] * b[3]; } }
#pragma unroll
    for (int q = 0; q < 8; ++q) out[i * sOi + (jg * 8 + q) * sOj] = f2bf(acc[q]);
    __syncthreads();
}

__device__ void phase_conv_in(const Params& p, int l, LAS unsigned char* lds, int bid, int nb) {
    const float* Win = IN(p, I_WIN) + (size_t)l * D_MODEL * IN_W;
    __syncthreads();
    conv_job<1>(lds, BF(p, OFF_WIN), 1024, 0, Win, IN_W, 1024, 0, 3584, 0, bid, nb);
    conv_job<1>(lds, BF(p, OFF_WIN), 1024, 0, Win, IN_W, 1024, 4608, NP1, 0, bid, nb);
    __syncthreads();
    const float* wuk = IN(p, I_WUK) + (size_t)l * 256 * 512;
    for (int it = bid; it < 256; it += nb) { const int h = it >> 6, rb = (it >> 4) & 3, kb = it & 15;
        fold_tile(lds, BF(p, OFF_WIN) + (size_t)(3584 + h * 256 + rb * 64) * 1024 + kb * 64, 1, 1024,
                  Win + (size_t)(kb * 64) * IN_W + C_DQ + h * 128, IN_W, 1, wuk + ((size_t)(rb * 64) * 4 + h) * 128, 512, 1); }
}
__device__ void phase_conv_postA(const Params& p, int l, LAS unsigned char* lds, int bid, int nb) {
    const float* Win = IN(p, I_WIN) + (size_t)l * D_MODEL * IN_W;
    __syncthreads();
    conv_job<0>(lds, BF(p, OFF_WG), 1024, 0, Win, IN_W, 1024, 0, 3072, C_G, bid, nb);
    conv_job<0>(lds, BF(p, OFF_WBR), 2048, 0, IN(p, I_WA) + (size_t)l * 512 * 1024, 1024, 512, 0, 1024, 0, bid, nb);
    conv_job<0>(lds, BF(p, OFF_WBR), 2048, 512, IN(p, I_WB) + (size_t)l * 512 * 1024, 1024, 512, 0, 1024, 0, bid, nb);
    __syncthreads();
    const float* wuv = IN(p, I_WUV) + (size_t)l * 256 * 512; const float* wc = IN(p, I_WC) + (size_t)l * 512 * 1024;
    for (int it = bid; it < 256; it += nb) { const int h = it >> 6, rb = (it >> 4) & 3, nbk = it & 15;
        fold_tile(lds, BF(p, OFF_WBR) + (size_t)(nbk * 64) * 2048 + 1024 + h * 256 + rb * 64, 1, 2048,
                  wuv + ((size_t)(rb * 64) * 4 + h) * 128, 512, 1, wc + (size_t)(h * 128) * 1024 + nbk * 64, 1, 1024); }
}
__device__ void phase_conv_postB(const Params& p, int l, LAS unsigned char* lds, int bid, int nb) {
    __syncthreads();
    conv_job<0>(lds, BF(p, OFF_WOUT), 1024, 0, IN(p, I_WOUT) + (size_t)l * 1024 * 1024, 1024, 1024, 0, 1024, 0, bid, nb);
    conv_job<2>(lds, BF(p, OFF_WF1), 1024, 0, IN(p, I_WF1) + (size_t)l * 1024 * 2 * D_FF, 2 * D_FF, 1024, 0, 2 * D_FF, 0, bid, nb);
    conv_job<0>(lds, BF(p, OFF_WF2), D_FF, 0, IN(p, I_WF2) + (size_t)l * D_FF * 1024, 1024, D_FF, 0, 1024, 0, bid, nb);
    __syncthreads();
}

__device__ __forceinline__ unsigned wave_sum_u32(unsigned v) {
    v += (unsigned)__builtin_amdgcn_update_dpp(0, (int)v, 0x111, 0xf, 0xf, true);
    v += (unsigned)__builtin_amdgcn_update_dpp(0, (int)v, 0x112, 0xf, 0xf, true);
    v += (unsigned)__builtin_amdgcn_update_dpp(0, (int)v, 0x114, 0xf, 0xf, true);
    v += (unsigned)__builtin_amdgcn_update_dpp(0, (int)v, 0x118, 0xf, 0xf, true);
    v += (unsigned)__builtin_amdgcn_update_dpp(0, (int)v, 0x142, 0xa, 0xf, false);
    v += (unsigned)__builtin_amdgcn_update_dpp(0, (int)v, 0x143, 0xc, 0xf, false);
    return (unsigned)__builtin_amdgcn_readlane((int)v, 63);
}
__device__ __forceinline__ float wave_sum(float v) {
#pragma unroll
    for (int o = 32; o >= 1; o >>= 1) v += __shfl_xor(v, o);
    return v;
}
template <int MODE, bool XIN_BF, bool XOUT_BF>
__device__ void phase_norm(const void* xin_, void* xout_, const bf16_t* O_, const float* wpost_, const float* w1_, bf16_t* H_, int bid, int nb) {
    GAS const float* xin = (GAS const float*)xin_; GAS float* xout = (GAS float*)xout_; GAS const bf16_t* xinb = (GAS const bf16_t*)xin_; GAS bf16_t* xoutb = (GAS bf16_t*)xout_;
    GAS const bf16_t* O = (GAS const bf16_t*)O_; GAS const float* wpost = (GAS const float*)wpost_; GAS const float* w1 = (GAS const float*)w1_; GAS bf16_t* H = (GAS bf16_t*)H_;
    const int tidn = phase_tid(); const int wv = tidn >> 6, lane = tidn & 63;
    constexpr int NR = 2;
    for (int row0 = bid * 8 + wv; row0 < NTOK; row0 += NR * nb * 8) {
        f32x4 xv[NR][4], ov[NR][4];
#pragma unroll
        for (int q = 0; q < NR; ++q) { const int row = (row0 + q * nb * 8 < NTOK) ? row0 + q * nb * 8 : row0;
#pragma unroll
            for (int j = 0; j < 4; ++j) {
                if (XIN_BF) { const u32x2 xw = *(GAS const u32x2*)(xinb + (size_t)row * 1024 + j * 256 + lane * 4);
                    xv[q][j] = (f32x4){__uint_as_float(xw.x << 16), __uint_as_float(xw.x & 0xffff0000u), __uint_as_float(xw.y << 16), __uint_as_float(xw.y & 0xffff0000u)}; }
                else xv[q][j] = *(GAS const f32x4*)(xin + (size_t)row * 1024 + j * 256 + lane * 4);
                if (MODE >= 1) { const u32x2 ow = *(GAS const u32x2*)(O + (size_t)row * 1024 + j * 256 + lane * 4);
                    ov[q][j] = (f32x4){__uint_as_float(ow.x << 16), __uint_as_float(ow.x & 0xffff0000u), __uint_as_float(ow.y << 16), __uint_as_float(ow.y & 0xffff0000u)}; } } }
        if (MODE >= 1) {
            float ss[NR];
#pragma unroll
            for (int q = 0; q < NR; ++q) { ss[q] = 0.f;
#pragma unroll
                for (int j = 0; j < 4; ++j) ss[q] += ov[q][j][0] * ov[q][j][0] + ov[q][j][1] * ov[q][j][1] + ov[q][j][2] * ov[q][j][2] + ov[q][j][3] * ov[q][j][3]; }
#pragma unroll
            for (int o = 32; o >= 1; o >>= 1)
#pragma unroll
                for (int q = 0; q < NR; ++q) ss[q] += __shfl_xor(ss[q], o);
#pragma unroll
            for (int q = 0; q < NR; ++q) { const int row = row0 + q * nb * 8; const float r = rsqrtf(ss[q] * (1.f / 1024.f) + 1e-6f);
#pragma unroll
                for (int j = 0; j < 4; ++j) { const f32x4 wv4 = *(GAS const f32x4*)(wpost + j * 256 + lane * 4); xv[q][j] = xv[q][j] + ov[q][j] * r * wv4;
                    if (XOUT_BF) { u32x2 xw; xw.x = cvt_pk_bf16(xv[q][j][0], xv[q][j][1]); xw.y = cvt_pk_bf16(xv[q][j][2], xv[q][j][3]); if (row < NTOK) *(GAS u32x2*)(xoutb + (size_t)row * 1024 + j * 256 + lane * 4) = xw;
                        xv[q][j] = (f32x4){__uint_as_float(xw.x << 16), __uint_as_float(xw.x & 0xffff0000u), __uint_as_float(xw.y << 16), __uint_as_float(xw.y & 0xffff0000u)}; }
                    else if (row < NTOK) *(GAS f32x4*)(xout + (size_t)row * 1024 + j * 256 + lane * 4) = xv[q][j]; } }
        }
        if (MODE <= 1) {
            float ss[NR];
#pragma unroll
            for (int q = 0; q < NR; ++q) { ss[q] = 0.f;
#pragma unroll
                for (int j = 0; j < 4; ++j) ss[q] += xv[q][j][0] * xv[q][j][0] + xv[q][j][1] * xv[q][j][1] + xv[q][j][2] * xv[q][j][2] + xv[q][j][3] * xv[q][j][3]; }
#pragma unroll
            for (int o = 32; o >= 1; o >>= 1)
#pragma unroll
                for (int q = 0; q < NR; ++q) ss[q] += __shfl_xor(ss[q], o);
#pragma unroll
            for (int q = 0; q < NR; ++q) { const int row = row0 + q * nb * 8; const float r = rsqrtf(ss[q] * (1.f / 1024.f) + 1e-6f);
#pragma unroll
                for (int j = 0; j < 4; ++j) { const f32x4 wv4 = *(GAS const f32x4*)(w1 + j * 256 + lane * 4); const f32x4 y = xv[q][j] * r * wv4;
                    u32x2 w; w.x = cvt_pk_bf16(y[0], y[1]); w.y = cvt_pk_bf16(y[2], y[3]); if (row < NTOK) *(GAS u32x2*)(H + (size_t)row * 1024 + j * 256 + lane * 4) = w; } }
        }
    }
}

__device__ void phase_gemm_in(const Params& p, LAS unsigned char* lds, int bid, int nb) {
    pg8::EpiProj E{(unsigned char*)p.ws};
    pg8::Gemm g{BF(p, OFF_H), BF(p, OFF_WIN), 1024, 1024};
    pg8::StaticOrder S; S.init(NTOK, NP1, 1024, nb, bid);
    pg8::gemm_phase(lds, g, S, E);
}
__device__ void phase_gemm_gates(const Params& p, LAS unsigned char* lds, int bid, int nb) {
    pg8::EpiGate E{BF(p, OFF_HF)};
    pg8::Gemm g{BF(p, OFF_H), BF(p, OFF_WG), 1024, 1024};
    pg8::StaticOrder S; S.init(NTOK, 3072, 1024, nb, bid);
    pg8::gemm_phase(lds, g, S, E);
}
__device__ void phase_gemm_branch(const Params& p, LAS unsigned char* lds, int bid, int nb) {
    pg8::EpiBranch E; E.Mg = BF(p, OFF_H); E.G0 = BF(p, OFF_HF);
    pg8::Gemm g{BF(p, OFF_Y), BF(p, OFF_WBR), 2048, 2048};
    pg8::BranchOrder S; S.init(NTOK, 1024, nb, bid);
    pg8::gemm_phase(lds, g, S, E);
}
__device__ void phase_gemm_out(const Params& p, LAS unsigned char* lds, int bid, int nb) {
    pg8::EpiBf16 E{BF(p, OFF_OUT), 1024};
    pg8::Gemm g{BF(p, OFF_H), BF(p, OFF_WOUT), 1024, 1024};
    pg8::StaticOrder S; S.init(NTOK, 1024, 1024, nb, bid);
    pg8::gemm_phase(lds, g, S, E);
}
__device__ void phase_gemm_ffn1(const Params& p, LAS unsigned char* lds, int bid, int nb) {
    pg8::EpiSwiglu E{BF(p, OFF_ACT), D_FF};
    pg8::Gemm g{BF(p, OFF_H), BF(p, OFF_WF1), 1024, 1024};
    pg8::StaticOrder S; S.init(NTOK, 2 * D_FF, 1024, nb, bid);
    pg8::gemm_phase(lds, g, S, E);
}
__device__ void phase_gemm_ffn2(const Params& p, LAS unsigned char* lds, int bid, int nb) {
    pg8::EpiBf16 E{BF(p, OFF_OUT), 1024};
    pg8::Gemm g{BF(p, OFF_ACT), BF(p, OFF_WF2), D_FF, D_FF};
    pg8::StaticOrder S; S.init(NTOK, 1024, D_FF, nb, bid);
    pg8::gemm_phase(lds, g, S, E);
}


__device__ __forceinline__ float hg_lower_bound(const float* lbl, int l, int idx) {
    const float l0 = lbl[idx], l1 = lbl[512 + idx]; const float m = fmaxf(l0, l1), e0 = __expf(l0 - m), e1 = __expf(l1 - m), p0 = e0 / (e0 + e1), p1 = e1 / (e0 + e1);
    return ((l == 0) ? p0 : (p0 + p1)) - p0;
}
__device__ __forceinline__ void pack16_store(LAS unsigned char* dst, const float (&v)[16]) {
    u32x4 a, b; a.x = cvt_pk_bf16(v[0], v[1]); a.y = cvt_pk_bf16(v[2], v[3]); a.z = cvt_pk_bf16(v[4], v[5]); a.w = cvt_pk_bf16(v[6], v[7]);
    b.x = cvt_pk_bf16(v[8], v[9]); b.y = cvt_pk_bf16(v[10], v[11]); b.z = cvt_pk_bf16(v[12], v[13]); b.w = cvt_pk_bf16(v[14], v[15]);
    *(LAS u32x4*)dst = a; *(LAS u32x4*)(dst + 16) = b;
}
#define HG_FRONT()                                                                                                   \
    const int d = tid & 127, seg = tid >> 7;                                                                         \
    const float lbd = hg_lower_bound(IN(p, I_LB), l, h * 128 + d);                                                    \
    float kk[16], cs[16];                                                                                            \
    { float run = 0.f;                                                                                               \
      _Pragma("unroll") for (int jj = 0; jj < 16; ++jj) {                                                            \
          const float fp = bf2f(HF[(size_t)(row0 + seg * 16 + jj) * 512 + h * 128 + d]);                            \
          const float sg = sigmoidf_(fp); const float f = fmaxf(lbd + (1.f - lbd) * sg, 1e-20f);                     \
          kk[jj] = (1.f - lbd) * (1.f - sg); run += __logf(f); cs[jj] = run; }                                       \
      SEG[seg * 128 + d] = run; }

__device__ void phase_hg1(const Params& p, int l, LAS unsigned char* lds, int bid, int nb) {
    const int tid = phase_tid(), lane = tid & 63, w = __builtin_amdgcn_readfirstlane(tid >> 6), fr = lane & 15, g = lane >> 4;
    LAS float* SEG = (LAS float*)lds; LAS unsigned char* KT = lds + 2048; LAS unsigned char* VT = KT + 128 * 144;
    const bf16_t* HF = BF(p, OFF_HF); const bf16_t* HI = BF(p, OFF_HI); bf16_t* ST = BF(p, OFF_ST); float* DEC = F32P(p, OFF_DEC);
    for (int unit = bid; unit < 1024; unit += nb) {
        const int bh = unit >> 6, c = unit & 63, h = bh & 3, row0 = (bh >> 2) * SEQ + c * 64;
        HG_FRONT();
        float vv[16];
#pragma unroll
        for (int jj = 0; jj < 16; ++jj) vv[jj] = bf2f(HI[(size_t)(row0 + seg * 16 + jj) * 512 + h * 128 + d]);
        __syncthreads();
        float off = 0.f, bl = 0.f;
#pragma unroll
        for (int s2 = 0; s2 < 4; ++s2) { const float t = SEG[s2 * 128 + d]; off += (s2 < seg) ? t : 0.f; bl += t; }
        float kb[16];
#pragma unroll
        for (int jj = 0; jj < 16; ++jj) kb[jj] = kk[jj] * __expf(bl - (off + cs[jj]));
        pack16_store(KT + d * 144 + seg * 32, kb);
        pack16_store(VT + d * 144 + seg * 32, vv);
        if (seg == 0) DEC[(size_t)unit * 128 + d] = __expf(bl);
        __syncthreads();
        bf16x8 a[2];
#pragma unroll
        for (int ks = 0; ks < 2; ++ks) a[ks] = *(const LAS bf16x8*)(KT + (16 * w + fr) * 144 + (32 * ks + 8 * g) * 2);
#pragma unroll
        for (int et = 0; et < 8; ++et) {
            f32x4 acc = {0.f, 0.f, 0.f, 0.f};
#pragma unroll
            for (int ks = 0; ks < 2; ++ks) { const bf16x8 b = *(const LAS bf16x8*)(VT + (16 * et + fr) * 144 + (32 * ks + 8 * g) * 2); acc = __builtin_amdgcn_mfma_f32_16x16x32_bf16(a[ks], b, acc, 0, 0, 0); }
            mfma_fence(acc);
            u32x2 o; o.x = cvt_pk_bf16(acc[0], acc[1]); o.y = cvt_pk_bf16(acc[2], acc[3]);
            *(u32x2*)(ST + ((size_t)unit * 128 + 16 * et + fr) * 128 + 16 * w + 4 * g) = o;
        }
        __syncthreads();
    }
}
__device__ void phase_hg2(const Params& p, int bid, int nb) {
    bf16_t* ST = BF(p, OFF_ST); const float* DEC = F32P(p, OFF_DEC);
    for (int gid = bid * 512 + phase_tid(); gid < 16 * 8192; gid += nb * 512) {
        const int bh = gid >> 13, within = gid & 8191, e = within >> 6, d = (within & 63) * 2;
        float s0 = 0.f, s1 = 0.f;
        for (int c0 = 0; c0 < 64; c0 += 8) {
            unsigned u[8]; float d0[8], d1[8];
#pragma unroll
            for (int k = 0; k < 8; ++k) { const size_t un = (size_t)(bh * 64 + c0 + k);
                u[k] = *(const unsigned*)(ST + (un * 128 + e) * 128 + d); d0[k] = DEC[un * 128 + d]; d1[k] = DEC[un * 128 + d + 1]; }
            asm volatile("s_waitcnt vmcnt(0)" ::: "memory");
#pragma unroll
            for (int k = 0; k < 8; ++k) { const size_t un = (size_t)(bh * 64 + c0 + k);
                *(unsigned*)(ST + (un * 128 + e) * 128 + d) = cvt_pk_bf16(s0, s1);
                s0 = d0[k] * s0 + __uint_as_float(u[k] << 16); s1 = d1[k] * s1 + __uint_as_float(u[k] & 0xffff0000u); }
        }
    }
}
template <int PROBE = 0> __device__ void phase_hg3(const Params& p, int l, LAS unsigned char* lds, int bid, int nb) {
    const int tid = phase_tid(), lane = tid & 63, w = __builtin_amdgcn_readfirstlane(tid >> 6), fr = lane & 15, g = lane >> 4;
    LAS float* SEG = (LAS float*)lds;
    LAS unsigned char* QH = lds + 2048; LAS unsigned char* QT = QH + 64 * 272; LAS float* OL = (LAS float*)(lds + 2048);
    LAS unsigned char* KB = lds + 36864; LAS unsigned char* VT = lds + 54272; LAS unsigned char* SP = lds + 72704; LAS unsigned char* PL = lds + 107520;
    const bf16_t* HF = BF(p, OFF_HF); const bf16_t* HI = BF(p, OFF_HI); const bf16_t* HG = BF(p, OFF_HG); const bf16_t* ST = BF(p, OFF_ST); bf16_t* Y = BF(p, OFF_Y);
    for (int unit = bid; unit < 1024; unit += nb) {
        const int bh = unit >> 6, c = unit & 63, h = bh & 3, row0 = (bh >> 2) * SEQ + c * 64;
        HG_FRONT();
        {
#pragma unroll
            for (int k = 0; k < 4; ++k) { const int ch = tid + 512 * k, e = ch >> 4, dc = ch & 15;
                *(LAS u32x4*)(SP + e * 272 + dc * 16) = *(const u32x4*)(ST + ((size_t)unit * 128 + e) * 128 + dc * 8); }
            float vv[16];
#pragma unroll
            for (int jj = 0; jj < 16; ++jj) vv[jj] = bf2f(HI[(size_t)(row0 + seg * 16 + jj) * 512 + h * 128 + d]);
            pack16_store(VT + d * 144 + seg * 32, vv);
        }
        __syncthreads();
        float beta[4]; { float run = 0.f;
#pragma unroll
            for (int s2 = 0; s2 < 4; ++s2) { beta[s2] = run; run += SEG[s2 * 128 + d]; } }
        float off = 0.f;
#pragma unroll
        for (int s2 = 0; s2 < 4; ++s2) off = (s2 == seg) ? beta[s2] : off;
#pragma unroll
        for (int jj = 0; jj < 16; ++jj) {
            const float q = bf2f(Y[(size_t)(row0 + seg * 16 + jj) * 2048 + h * 128 + d]);
            const int i = seg * 16 + jj;
            *(LAS bf16_t*)(QH + i * 272 + d * 2) = f2bf(q * __expf(off + cs[jj]));
            *(LAS bf16_t*)(QT + i * 272 + d * 2) = f2bf(q * __expf(cs[jj]));
        }
#pragma unroll
        for (int I = 0; I < 4; ++I) {
            if (seg <= I) {
                float bI = 0.f;
#pragma unroll
                for (int s2 = 0; s2 < 4; ++s2) bI = (s2 == I) ? beta[s2] : bI;
#pragma unroll
                for (int jj = 0; jj < 16; ++jj) *(LAS bf16_t*)(KB + (seg * 16 + jj) * 272 + d * 2) = f2bf(kk[jj] * __expf(fminf(bI - (off + cs[jj]), 60.f)));
            }
            __syncthreads();
            if (w < 4) {
                f32x4 acc = {0.f, 0.f, 0.f, 0.f};
                if (w <= I) {
#pragma unroll
                    for (int ks = 0; ks < 4; ++ks) {
                        const bf16x8 a = *(const LAS bf16x8*)(QT + (16 * I + fr) * 272 + (32 * ks + 8 * g) * 2);
                        const bf16x8 b = *(const LAS bf16x8*)(KB + (16 * w + fr) * 272 + (32 * ks + 8 * g) * 2);
                        acc = __builtin_amdgcn_mfma_f32_16x16x32_bf16(a, b, acc, 0, 0, 0); }
                    mfma_fence(acc);
                    const int lim = (w == I) ? (4 * g) : 1000;
#pragma unroll
                    for (int r = 0; r < 4; ++r) acc[r] = (fr <= lim + r) ? acc[r] : 0.f;
                }
#pragma unroll
                for (int r = 0; r < 4; ++r) *(LAS bf16_t*)(PL + (16 * I + 4 * g + r) * 144 + (16 * w + fr) * 2) = f2bf(acc[r]);
            }
            __syncthreads();
        }
        f32x4 oacc[4];
        { const int ib = w >> 1;
          bf16x8 aq[4], ap[2];
#pragma unroll
          for (int ks = 0; ks < 4; ++ks) aq[ks] = *(const LAS bf16x8*)(QH + (16 * ib + fr) * 272 + (32 * ks + 8 * g) * 2);
#pragma unroll
          for (int ks = 0; ks < 2; ++ks) ap[ks] = *(const LAS bf16x8*)(PL + (16 * ib + fr) * 144 + (32 * ks + 8 * g) * 2);
#pragma unroll
          for (int q4 = 0; q4 < 4; ++q4) { const int et = 4 * (w & 1) + q4; f32x4 acc = {0.f, 0.f, 0.f, 0.f};
#pragma unroll
              for (int ks = 0; ks < 4; ++ks) { const bf16x8 b = *(const LAS bf16x8*)(SP + (16 * et + fr) * 272 + (32 * ks + 8 * g) * 2); acc = __builtin_amdgcn_mfma_f32_16x16x32_bf16(aq[ks], b, acc, 0, 0, 0); }
#pragma unroll
              for (int ks = 0; ks < 2; ++ks) { const bf16x8 b = *(const LAS bf16x8*)(VT + (16 * et + fr) * 144 + (32 * ks + 8 * g) * 2); acc = __builtin_amdgcn_mfma_f32_16x16x32_bf16(ap[ks], b, acc, 0, 0, 0); }
              oacc[q4] = acc; } }
        mfma_fence(oacc[0], oacc[1], oacc[2], oacc[3]);
        __syncthreads();
#pragma unroll
        for (int q4 = 0; q4 < 4; ++q4)
#pragma unroll
            for (int r = 0; r < 4; ++r) OL[(16 * (w >> 1) + 4 * g + r) * 132 + 16 * (4 * (w & 1) + q4) + fr] = oacc[q4][r];
        __syncthreads();
        {
            const int i = tid >> 3, es = (tid & 7) * 16;
            float o[16], ss = 0.f;
#pragma unroll
            for (int k = 0; k < 16; ++k) { o[k] = OL[i * 132 + es + k]; ss += o[k] * o[k]; }
            ss += __shfl_xor(ss, 1); ss += __shfl_xor(ss, 2); ss += __shfl_xor(ss, 4);
            const float rstd = rsqrtf(ss * (1.f / 128.f) + 1e-6f);
            const u32x4 g0 = *(const u32x4*)(HG + (size_t)(row0 + i) * 512 + h * 128 + es), g1 = *(const u32x4*)(HG + (size_t)(row0 + i) * 512 + h * 128 + es + 8);
            float y[16];
#pragma unroll
            for (int k = 0; k < 16; ++k) { const unsigned gw = (k < 8) ? g0[k >> 1] : g1[(k - 8) >> 1]; const float gv = (k & 1) ? __uint_as_float(gw & 0xffff0000u) : __uint_as_float(gw << 16);
                y[k] = o[k] * rstd * IN(p, I_HGNW)[l * 128 + es + k] * (gv * sigmoidf_(gv)); }
            u32x4 a, b; a.x = cvt_pk_bf16(y[0], y[1]); a.y = cvt_pk_bf16(y[2], y[3]); a.z = cvt_pk_bf16(y[4], y[5]); a.w = cvt_pk_bf16(y[6], y[7]);
            b.x = cvt_pk_bf16(y[8], y[9]); b.y = cvt_pk_bf16(y[10], y[11]); b.z = cvt_pk_bf16(y[12], y[13]); b.w = cvt_pk_bf16(y[14], y[15]);
            bf16_t* yo = PROBE ? ((bf16_t*)((unsigned char*)p.x + 16 * MiB) + (size_t)(row0 + i) * 512 + h * 128 + es) : (Y + (size_t)(row0 + i) * 2048 + h * 128 + es);
            *(u32x4*)yo = a; *(u32x4*)(yo + 8) = b;
        }
        __syncthreads();
    }
}


__device__ void phase_prep(const Params& p, int l, LAS unsigned char* lds, int bid, int nb) {
    const int tid = phase_tid(), lane = tid & 63, wv = tid >> 6;
    {
        LAS float* red = (LAS float*)lds; const bf16_t* MK = BF(p, OFF_MK); float* KM = F32P(p, OFF_KMEAN);
        for (int it = bid; it < 256; it += nb) {
            const int bh = it >> 4, n = it & 15, h = bh & 3, d = tid & 127, part = tid >> 7; const size_t row0 = (size_t)(bh >> 2) * SEQ + n * 256 + part * 64;
            float s = 0.f;
            for (int j = 0; j < 64; ++j) s += bf2f(MK[(row0 + j) * 512 + h * 128 + d]);
            red[part * 128 + d] = s; __syncthreads();
            if (part == 0) KM[(size_t)it * 128 + d] = (red[d] + red[128 + d] + red[256 + d] + red[384 + d]) * (1.f / 256.f);
            __syncthreads();
        }
    }
    bf16_t* CKV = BF(p, OFF_CKV); bf16_t* IKW = BF(p, OFF_IKW);
    const float* kvw = IN(p, I_KVN) + l * 256; const float* ikw = IN(p, I_IKNW) + l * 64; const float* ikb = IN(p, I_IKNB) + l * 64;
    for (int row = bid * 8 + wv; row < NTOK; row += nb * 8) {
        {   u32x2* cp = (u32x2*)(CKV + (size_t)row * 256 + lane * 4); const u32x2 v = *cp;
            const float a0 = __uint_as_float(v.x << 16), a1 = __uint_as_float(v.x & 0xffff0000u), a2 = __uint_as_float(v.y << 16), a3 = __uint_as_float(v.y & 0xffff0000u);
            const float ss = wave_sum(a0 * a0 + a1 * a1 + a2 * a2 + a3 * a3); const float r = rsqrtf(ss * (1.f / 256.f) + 1e-6f);
            const f32x4 w4 = *(const f32x4*)(kvw + lane * 4);
            u32x2 o; o.x = cvt_pk_bf16(a0 * r * w4[0], a1 * r * w4[1]); o.y = cvt_pk_bf16(a2 * r * w4[2], a3 * r * w4[3]); *cp = o; }
        {   bf16_t* ip = IKW + (size_t)row * 128; const float u = bf2f(ip[lane]);
            const float mu = wave_sum(u) * (1.f / 64.f); const float xc = u - mu; const float var = wave_sum(xc * xc) * (1.f / 64.f);
            const float y = xc * rsqrtf(var + 1e-6f) * ikw[lane] + ikb[lane];
            const float wgt = (lane < 8) ? bf2f(ip[64 + lane]) * (0.35355339059327373f * 0.125f) : 0.f;
            ip[lane] = f2bf(y); if (lane < 8) ip[64 + lane] = f2bf(wgt); }
    }
}

typedef short v4i16_t __attribute__((ext_vector_type(4)));
__device__ __forceinline__ v4i16_t lds_tr16(const LAS unsigned char* pp) { return __builtin_amdgcn_ds_read_tr16_b64_v4i16((LAS v4i16_t*)pp); }
template <int PROBE = 0> __device__ void phase_moba(const Params& p, LAS unsigned char* lds, int bid, int nb) {
    const int tid = phase_tid(), lane = tid & 63, w = __builtin_amdgcn_readfirstlane(tid >> 6), fr = lane & 15, g = lane >> 4;
    LAS float* BL = (LAS float*)lds; LAS float* KM = (LAS float*)(lds + 16384); LAS float* GG = (LAS float*)(lds + 24576);
    LAS unsigned* SM = (LAS unsigned*)(lds + 32768); LAS unsigned* UM = SM + 128; LAS unsigned* TL = SM + 132;
    LAS unsigned char* QS = lds + 33792; LAS unsigned char* KS = lds + 68608; LAS unsigned char* VS = lds + 86016;
    bf16_t* Y = BF(p, OFF_Y); const bf16_t* MK = BF(p, OFF_MK); const bf16_t* MV = BF(p, OFF_MV);
    const float scale = 0.08838834764831845f;
    int hprev = -1;
    for (int j = bid; j < 512; j += nb) {
        const int bh = j & 15, qt = (j < 256) ? (j >> 4) : (31 - ((j - 256) >> 4));
        const int h = bh & 3, brow = (bh >> 2) * SEQ, t0 = qt * 128, blk = qt >> 1;
        if (h != hprev) { __syncthreads(); for (int dd = tid; dd < 4096; dd += 512) BL[dd] = IN(p, I_REL)[rel_bucket(dd) * 8 + h]; hprev = h; }
        for (int e = tid; e < 2048; e += 512) KM[e] = F32P(p, OFF_KMEAN)[(size_t)bh * 2048 + e];
#pragma unroll
        for (int k = 0; k < 4; ++k) { const int ch = tid + 512 * k, r = ch >> 4, c = ch & 15;
            *(LAS u32x4*)(QS + r * 272 + c * 16) = *(const u32x4*)(Y + (size_t)(brow + t0 + r) * 2048 + 512 + h * 128 + c * 8); }
        if (tid == 0) *UM = 0u;
        __syncthreads();
        bf16x8 qf[4];
#pragma unroll
        for (int ks = 0; ks < 4; ++ks) qf[ks] = *(const LAS bf16x8*)(QS + (16 * w + fr) * 272 + (32 * ks + 8 * g) * 2);
        {
            f32x4 ga = {0.f, 0.f, 0.f, 0.f};
#pragma unroll
            for (int ks = 0; ks < 4; ++ks) { const f32x4 k0 = *(const LAS f32x4*)(KM + fr * 128 + 32 * ks + 8 * g), k1 = *(const LAS f32x4*)(KM + fr * 128 + 32 * ks + 8 * g + 4);
                u32x4 t; t.x = cvt_pk_bf16(k0[0], k0[1]); t.y = cvt_pk_bf16(k0[2], k0[3]); t.z = cvt_pk_bf16(k1[0], k1[1]); t.w = cvt_pk_bf16(k1[2], k1[3]);
                ga = __builtin_amdgcn_mfma_f32_16x16x32_bf16(__builtin_bit_cast(bf16x8, t), qf[ks], ga, 0, 0, 0); }
            mfma_fence(ga);
            *(LAS f32x4*)(GG + (16 * w + fr) * 16 + 4 * g) = ga;
        }
        __syncthreads();
        if (tid < 128) {
            unsigned used = 0u;
            for (int k = 0; k < 3; ++k) { int best = -1; float bv = 0.f;
                for (int n = 0; n < blk; ++n) { const float v = GG[tid * 16 + n]; if (!((used >> n) & 1u) && (best < 0 || v > bv)) { best = n; bv = v; } }
                if (best >= 0) used |= 1u << best; }
            SM[tid] = used; __hip_atomic_fetch_or((unsigned*)UM, used, __ATOMIC_RELAXED, __HIP_MEMORY_SCOPE_WORKGROUP);
        }
        __syncthreads();
        const unsigned mysel = SM[16 * w + fr];
        const int own_tiles = 2 + 2 * (qt & 1);
        if (tid == 0) {
            const unsigned umask = *UM; int c = 0;
            for (int kt = 0; kt < own_tiles; ++kt) TL[c++] = (unsigned)(blk * 4 + kt);
            for (int n = 0; n < blk; ++n) if ((umask >> n) & 1u) { for (int kt = 0; kt < 4; ++kt) TL[c++] = (unsigned)(n * 4 + kt); }
            TL[64] = (unsigned)c; }
        __syncthreads();
        const int ntiles = (int)TL[64];
        const int tq = t0 + 16 * w + fr;
        f32x4 oacc[8];
#pragma unroll
        for (int dt = 0; dt < 8; ++dt) oacc[dt] = (f32x4){0.f, 0.f, 0.f, 0.f};
        float mrun = -1e30f, lsum = 0.f;
        u32x4 kpre[2], vpre[2];
        { const int key0 = (int)TL[0] * 64;
#pragma unroll
          for (int k = 0; k < 2; ++k) { const int ch = tid + 512 * k, r = ch >> 4, c = ch & 15; const size_t go = (size_t)(brow + key0 + r) * 512 + h * 128 + c * 8; kpre[k] = *(const u32x4*)(MK + go); vpre[k] = *(const u32x4*)(MV + go); } }
        for (int ti = 0; ti < ntiles; ++ti) {
            const int ent = (int)TL[ti], n = ent >> 2, key0 = ent * 64;
            const bool qsel = (n == blk) || ((mysel >> n) & 1u);
            __syncthreads();
#pragma unroll
            for (int k = 0; k < 2; ++k) { const int ch = tid + 512 * k, r = ch >> 4, c = ch & 15; *(LAS u32x4*)(KS + r * 272 + c * 16) = kpre[k]; *(LAS u32x4*)(VS + r * 288 + c * 16) = vpre[k]; }
            __syncthreads();
            if (ti + 1 < ntiles) { const int keyn = (int)TL[ti + 1] * 64;
#pragma unroll
                for (int k = 0; k < 2; ++k) { const int ch = tid + 512 * k, r = ch >> 4, c = ch & 15; const size_t go = (size_t)(brow + keyn + r) * 512 + h * 128 + c * 8; kpre[k] = *(const u32x4*)(MK + go); vpre[k] = *(const u32x4*)(MV + go); } }
            {
                f32x4 s[4];
#pragma unroll
                for (int k4 = 0; k4 < 4; ++k4) { f32x4 acc = {0.f, 0.f, 0.f, 0.f};
#pragma unroll
                    for (int ks = 0; ks < 4; ++ks) { const bf16x8 a = *(const LAS bf16x8*)(KS + (16 * k4 + fr) * 272 + (32 * ks + 8 * g) * 2); acc = __builtin_amdgcn_mfma_f32_16x16x32_bf16(a, qf[ks], acc, 0, 0, 0); }
                    s[k4] = acc; }
                mfma_fence(s[0], s[1], s[2], s[3]);
                float mx = -1e30f;
#pragma unroll
                for (int k4 = 0; k4 < 4; ++k4)
#pragma unroll
                    for (int r = 0; r < 4; ++r) { const int dist = tq - (key0 + 16 * k4 + 4 * g + r); const bool ok = qsel && (dist >= 0);
                        const float lg = s[k4][r] * scale + BL[dist < 0 ? 0 : dist]; s[k4][r] = ok ? lg : -1e30f; mx = fmaxf(mx, s[k4][r]); }
                mx = fmaxf(mx, __shfl_xor(mx, 16)); mx = fmaxf(mx, __shfl_xor(mx, 32));
                const float mnew = fmaxf(mrun, mx), alpha = __expf(mrun - mnew); mrun = mnew;
                float ps = 0.f;
#pragma unroll
                for (int k4 = 0; k4 < 4; ++k4)
#pragma unroll
                    for (int r = 0; r < 4; ++r) { const float pv = (s[k4][r] > -1e29f) ? __expf(s[k4][r] - mnew) : 0.f; s[k4][r] = pv; ps += pv; }
                lsum = lsum * alpha + ps;
                if (__any(alpha != 1.0f)) {
#pragma unroll
                    for (int dt = 0; dt < 8; ++dt) oacc[dt] = oacc[dt] * alpha; }
                bf16x8 pb[2];
#pragma unroll
                for (int m2 = 0; m2 < 2; ++m2) { u32x4 t; t.x = cvt_pk_bf16(s[2 * m2][0], s[2 * m2][1]); t.y = cvt_pk_bf16(s[2 * m2][2], s[2 * m2][3]);
                    t.z = cvt_pk_bf16(s[2 * m2 + 1][0], s[2 * m2 + 1][1]); t.w = cvt_pk_bf16(s[2 * m2 + 1][2], s[2 * m2 + 1][3]); pb[m2] = __builtin_bit_cast(bf16x8, t); }
#pragma unroll
                for (int dt = 0; dt < 8; ++dt)
#pragma unroll
                    for (int m2 = 0; m2 < 2; ++m2) {
                        const LAS unsigned char* va = VS + (32 * m2 + 4 * g + (fr >> 2)) * 288 + (16 * dt + 4 * (fr & 3)) * 2;
                        const v4i16_t lo = lds_tr16(va), hi = lds_tr16(va + 16 * 288);
                        const bf16x8 a = {lo[0], lo[1], lo[2], lo[3], hi[0], hi[1], hi[2], hi[3]};
                        oacc[dt] = __builtin_amdgcn_mfma_f32_16x16x32_bf16(a, pb[m2], oacc[dt], 0, 0, 0); }
            }
        }
        lsum += __shfl_xor(lsum, 16); lsum += __shfl_xor(lsum, 32);
        const float inv = 1.f / lsum;
        mfma_fence(oacc[0], oacc[1], oacc[2], oacc[3]); mfma_fence(oacc[4], oacc[5], oacc[6], oacc[7]);
        __syncthreads();
#pragma unroll
        for (int dt = 0; dt < 8; ++dt) { u32x2 o; o.x = cvt_pk_bf16(oacc[dt][0] * inv, oacc[dt][1] * inv); o.y = cvt_pk_bf16(oacc[dt][2] * inv, oacc[dt][3] * inv);
            if (PROBE) *(u32x2*)((bf16_t*)p.x + (size_t)(brow + tq) * 512 + h * 128 + 16 * dt + 4 * g) = o; else *(u32x2*)(Y + (size_t)(brow + tq) * 2048 + 512 + h * 128 + 16 * dt + 4 * g) = o; }
        __syncthreads();
    }
}


template <int PROBE = 0> __device__ void phase_dsel(const Params& p, LAS unsigned char* lds, int bid, int nb) {
    const int tid = phase_tid(), lane = tid & 63, w = __builtin_amdgcn_readfirstlane(tid >> 6), fr = lane & 15, g = lane >> 4;
    LAS unsigned char* KEYS = lds;
    LAS unsigned char* IQS = lds + 131072;
    const bf16_t* IQ = BF(p, OFF_IQ); const bf16_t* IKW = BF(p, OFF_IKW);
    unsigned* MASK = PROBE ? (unsigned*)((unsigned char*)p.x + (size_t)(PROBE - 1) * 8 * MiB) : (unsigned*)(p.ws + OFF_MASK);
    const int nun = (nb == 256) ? 8 : ((2048 - bid + nb - 1) / nb);
#define DSEL_ITEM(u_) ((nb == 256) ? (((u_) & 1) ? (512 * ((u_) >> 1) + 511 - bid) : (512 * ((u_) >> 1) + bid)) : (bid + (u_) * nb))
    u32x4 iqpre, wpa, wpb; bf16x8 kb0[4][2], kb1[4][2];
#define DSEL_ISSUE(buf, kbase_, base_) do { _Pragma("unroll") for (int j = 0; j < 4; ++j) { int ktl = (base_) + 8 * j; ktl = ktl < 256 ? ktl : 255; const bf16_t* kp = (kbase_) + (size_t)ktl * 2048; \
        (buf)[j][0] = *(const bf16x8*)kp; (buf)[j][1] = *(const bf16x8*)(kp + 32); } } while (0)
#define DSEL_PREFETCH(u_) do { const int k_ = DSEL_ITEM(u_); const int brow_ = (k_ & 3) * SEQ, t0_ = (k_ >> 2) * 8; \
        iqpre = *(const u32x4*)(IQ + (size_t)(brow_ + t0_ + (tid >> 6)) * 512 + (tid & 63) * 8); \
        wpa = *(const u32x4*)(IKW + (size_t)(brow_ + t0_ + 2 * g) * 128 + 64); wpb = *(const u32x4*)(IKW + (size_t)(brow_ + t0_ + 2 * g + 1) * 128 + 64); \
        const bf16_t* kb_ = IKW + (size_t)(brow_ + fr) * 128 + 8 * g; DSEL_ISSUE(kb0, kb_, w); } while (0)
    if (nun > 0) DSEL_PREFETCH(0);
    for (int u = 0; u < nun; ++u) {
        const int k = DSEL_ITEM(u);
        const int b = k & 3, qt = k >> 2, brow = b * SEQ, t0 = qt * 8, nkt = (t0 + 7) / 16 + 1;
        __syncthreads();
        *(LAS u32x4*)(IQS + (tid >> 6) * 1040 + (tid & 63) * 16) = iqpre;
        __syncthreads();
        {
            bf16x8 aq[4][2];
#pragma unroll
            for (int hp = 0; hp < 4; ++hp)
#pragma unroll
                for (int ks = 0; ks < 2; ++ks) aq[hp][ks] = *(const LAS bf16x8*)(IQS + (fr >> 1) * 1040 + ((2 * hp + (fr & 1)) * 64 + 32 * ks + 8 * g) * 2);
            float wa[8], wb[8];
#pragma unroll
            for (int hh = 0; hh < 8; ++hh) { wa[hh] = (hh & 1) ? __uint_as_float(wpa[hh >> 1] & 0xffff0000u) : __uint_as_float(wpa[hh >> 1] << 16); wb[hh] = (hh & 1) ? __uint_as_float(wpb[hh >> 1] & 0xffff0000u) : __uint_as_float(wpb[hh >> 1] << 16); }
            const int tqa = t0 + 2 * g, tqb = tqa + 1;
            const bf16_t* kbase = IKW + (size_t)(brow + fr) * 128 + 8 * g;
#define DSEL_COMPUTE(buf, base_) do { _Pragma("unroll") for (int j = 0; j < 4; ++j) { const int kt = (base_) + 8 * j; if (kt < nkt) { \
                float sa = 0.f, sb = 0.f; \
                f32x4 ah[4]; \
                _Pragma("unroll") for (int hp = 0; hp < 4; ++hp) { f32x4 acc = {0.f, 0.f, 0.f, 0.f}; \
                    acc = __builtin_amdgcn_mfma_f32_16x16x32_bf16(aq[hp][0], (buf)[j][0], acc, 0, 0, 0); acc = __builtin_amdgcn_mfma_f32_16x16x32_bf16(aq[hp][1], (buf)[j][1], acc, 0, 0, 0); ah[hp] = acc; } \
                mfma_fence(ah[0], ah[1], ah[2], ah[3]); \
                _Pragma("unroll") for (int hp = 0; hp < 4; ++hp) { sa += wa[2 * hp] * fmaxf(ah[hp][0], 0.f) + wa[2 * hp + 1] * fmaxf(ah[hp][1], 0.f); sb += wb[2 * hp] * fmaxf(ah[hp][2], 0.f) + wb[2 * hp + 1] * fmaxf(ah[hp][3], 0.f); } \
                const int spos = 16 * kt + fr; \
                unsigned ua = __float_as_uint(sa + 0.0f); ua = (ua & 0x80000000u) ? ~ua : (ua | 0x80000000u); \
                unsigned ub = __float_as_uint(sb + 0.0f); ub = (ub & 0x80000000u) ? ~ub : (ub | 0x80000000u); \
                *(LAS unsigned*)(KEYS + (2 * g) * 16384 + spos * 4) = (spos <= tqa) ? ((ua & 0xfffff000u) | (unsigned)(4095 - spos)) : 0u; \
                *(LAS unsigned*)(KEYS + (2 * g + 1) * 16384 + spos * 4) = (spos <= tqb) ? ((ub & 0xfffff000u) | (unsigned)(4095 - spos)) : 0u; } } } while (0)
            for (int base = w; base < nkt; base += 64) {
                DSEL_ISSUE(kb1, kbase, base + 32);
                DSEL_COMPUTE(kb0, base);
                DSEL_ISSUE(kb0, kbase, base + 64);
                DSEL_COMPUTE(kb1, base + 32);
            }
#undef DSEL_COMPUTE
        }
        __syncthreads();
        if (u + 1 < nun) DSEL_PREFETCH(u + 1);
        {
            const int t = t0 + w; const int nch = 4 * nkt;
            const int mmax = (nch + 63) >> 6;
            u32x4 kr[16];
#pragma unroll
            for (int m = 0; m < 16; ++m) { const int c = lane + 64 * m; const u32x4 z = {0u, 0u, 0u, 0u};
                kr[m] = (m < mmax && c < nch) ? *(const LAS u32x4*)(KEYS + w * 16384 + c * 16) : z; }
            unsigned thr = 1u;
            if (t + 1 > 256) {
                u32x4 gm = kr[0];
#pragma unroll
                for (int m = 1; m < 16; ++m) if (m < mmax) { gm.x = max(gm.x, kr[m].x); gm.y = max(gm.y, kr[m].y); gm.z = max(gm.z, kr[m].z); gm.w = max(gm.w, kr[m].w); }
                unsigned vlo = min(min(gm.x, gm.y), min(gm.z, gm.w)), vhi = max(max(gm.x, gm.y), max(gm.z, gm.w));
#pragma unroll
                for (int o = 32; o >= 1; o >>= 1) { vlo = min(vlo, (unsigned)__shfl_xor((int)vlo, o)); vhi = max(vhi, (unsigned)__shfl_xor((int)vhi, o)); }
                unsigned lo = (unsigned)__builtin_amdgcn_readfirstlane((int)vlo), hi = (unsigned)__builtin_amdgcn_readfirstlane((int)vhi);
                lo = lo > 1u ? lo : 1u;
                while (lo < hi) {
                    const unsigned cand = lo + ((hi - lo + 1u) >> 1);
                    unsigned c0 = 0u, c1 = 0u, c2 = 0u, c3 = 0u;
#define DSEL_CNT1(m_) do { unsigned long long q0_, q1_, q2_, q3_; asm volatile( \
                        "v_cmp_ge_u32_e64 %[q0], %[kx], %[cd]\n\tv_cmp_ge_u32_e64 %[q1], %[ky], %[cd]\n\tv_cmp_ge_u32_e64 %[q2], %[kz], %[cd]\n\tv_cmp_ge_u32_e64 %[q3], %[kw], %[cd]\n\t" \
                        "v_addc_co_u32_e64 %[a0], %[q0], 0, %[a0], %[q0]\n\tv_addc_co_u32_e64 %[a1], %[q1], 0, %[a1], %[q1]\n\tv_addc_co_u32_e64 %[a2], %[q2], 0, %[a2], %[q2]\n\tv_addc_co_u32_e64 %[a3], %[q3], 0, %[a3], %[q3]" \
                        : [q0] "=&s"(q0_), [q1] "=&s"(q1_), [q2] "=&s"(q2_), [q3] "=&s"(q3_), [a0] "+v"(c0), [a1] "+v"(c1), [a2] "+v"(c2), [a3] "+v"(c3) \
                        : [kx] "v"(kr[m_].x), [ky] "v"(kr[m_].y), [kz] "v"(kr[m_].z), [kw] "v"(kr[m_].w), [cd] "s"(cand)); } while (0)
#define DSEL_CNT4(b_) do { DSEL_CNT1((b_)); DSEL_CNT1((b_) + 1); DSEL_CNT1((b_) + 2); DSEL_CNT1((b_) + 3); } while (0)
                    switch ((mmax + 3) >> 2) { case 4: DSEL_CNT4(12); case 3: DSEL_CNT4(8); case 2: DSEL_CNT4(4); default: DSEL_CNT4(0); }
#undef DSEL_CNT4
#undef DSEL_CNT1
                    const unsigned cn = wave_sum_u32((c0 + c1) + (c2 + c3));
                    if (cn >= 256u) { lo = cand; if (cn == 256u) break; } else hi = cand - 1u;
                }
                thr = lo; }
            unsigned* mrow = MASK + (size_t)(brow + t) * 128;
#pragma unroll
            for (int m = 0; m < 16; ++m) {
                unsigned nib = 0u;
                if (m < mmax) nib = ((kr[m].x >= thr) ? 1u : 0u) | ((kr[m].y >= thr) ? 2u : 0u) | ((kr[m].z >= thr) ? 4u : 0u) | ((kr[m].w >= thr) ? 8u : 0u);
                unsigned v = nib << (4 * (lane & 7));
                v |= (unsigned)__builtin_amdgcn_update_dpp(0, (int)v, 0xB1, 0xf, 0xf, true); v |= (unsigned)__builtin_amdgcn_update_dpp(0, (int)v, 0x4E, 0xf, 0xf, true);
                v |= (unsigned)__builtin_amdgcn_update_dpp(0, (int)v, 0x141, 0xf, 0xf, true);
                if ((lane & 7) == 0) mrow[(lane >> 3) + 8 * m] = v;
            }
        }
    }
#undef DSEL_ISSUE
#undef DSEL_PREFETCH
#undef DSEL_ITEM
}

template <int PROBE = 0> __device__ void phase_datt(const Params& p, LAS unsigned char* lds, int bid, int nb) {
    const int tid = phase_tid(), lane = tid & 63, w = __builtin_amdgcn_readfirstlane(tid >> 6), fr = lane & 15, g = lane >> 4;
    LAS unsigned char* BK = lds;
    LAS float* RL = (LAS float*)(lds + 4096);
    LAS unsigned short* IDX = (LAS unsigned short*)(lds + 5120 + w * 512);
    LAS unsigned char* CT = lds + 9216 + w * (32 * 544);
    const bf16_t* CKV = BF(p, OFF_CKV); bf16_t* Y = BF(p, OFF_Y); const unsigned* MASK = (const unsigned*)(p.ws + OFF_MASK);
    for (int dd = tid; dd < 4096; dd += 512) BK[dd] = (unsigned char)rel_bucket(dd);
    if (tid < 256) RL[tid] = IN(p, I_REL)[tid];
    __syncthreads();
    const float scale = 0.08838834764831845f;
    const int hd = fr & 3;
    for (int it = bid; it < NTOK / 8; it += nb) {
        const int tg = it * 8 + w, brow = (tg >> 12) * SEQ, t = tg & 4095;
        const u32x2 mw = *(const u32x2*)(MASK + (size_t)tg * 128 + 2 * lane);
        const int cnt = __popc(mw.x) + __popc(mw.y);
        int pre = cnt;
#pragma unroll
        for (int o = 1; o < 64; o <<= 1) { const int v = __shfl_up(pre, o); if (lane >= o) pre += v; }
        const int nsel = __shfl(pre, 63);
        int pos = pre - cnt;
        { unsigned m0 = mw.x; while (m0) { const int bpos = __ffs(m0) - 1; m0 &= m0 - 1; IDX[pos++] = (unsigned short)(64 * lane + bpos); }
          unsigned m1 = mw.y; while (m1) { const int bpos = __ffs(m1) - 1; m1 &= m1 - 1; IDX[pos++] = (unsigned short)(64 * lane + 32 + bpos); } }
        for (int e = nsel + lane; e < 256; e += 64) IDX[e] = 0;
        bf16x8 qb[8];
#pragma unroll
        for (int ks = 0; ks < 8; ++ks) { const u32x4 z = {0u, 0u, 0u, 0u}; const u32x4 v = (fr < 4) ? *(const u32x4*)(Y + (size_t)tg * 2048 + 1024 + fr * 256 + 32 * ks + 8 * g) : z; qb[ks] = __builtin_bit_cast(bf16x8, v); }
        f32x4 oacc[16];
#pragma unroll
        for (int rt = 0; rt < 16; ++rt) oacc[rt] = (f32x4){0.f, 0.f, 0.f, 0.f};
        float mrun = -1e30f, lsum = 0.f;
        const int nstep = (nsel + 31) >> 5;
        bf16x8 a0[8], a1[8];
        { const bf16_t* c0 = CKV + (size_t)(brow + IDX[fr]) * 256 + 8 * g; const bf16_t* c1 = CKV + (size_t)(brow + IDX[16 + fr]) * 256 + 8 * g;
#pragma unroll
          for (int ks = 0; ks < 8; ++ks) { a0[ks] = *(const bf16x8*)(c0 + 32 * ks); a1[ks] = *(const bf16x8*)(c1 + 32 * ks); } }
        for (int st = 0; st < nstep; ++st) {
#pragma unroll
            for (int ks = 0; ks < 8; ++ks) { *(LAS bf16x8*)(CT + fr * 544 + (32 * ks + 8 * g) * 2) = a0[ks]; *(LAS bf16x8*)(CT + (16 + fr) * 544 + (32 * ks + 8 * g) * 2) = a1[ks]; }
            f32x4 s0 = {0.f, 0.f, 0.f, 0.f}, s1 = {0.f, 0.f, 0.f, 0.f};
#pragma unroll
            for (int ks = 0; ks < 8; ++ks) { s0 = __builtin_amdgcn_mfma_f32_16x16x32_bf16(a0[ks], qb[ks], s0, 0, 0, 0); s1 = __builtin_amdgcn_mfma_f32_16x16x32_bf16(a1[ks], qb[ks], s1, 0, 0, 0); }
            mfma_fence(s0); mfma_fence(s1);
            if (st + 1 < nstep) {
                const bf16_t* c0 = CKV + (size_t)(brow + IDX[32 * (st + 1) + fr]) * 256 + 8 * g; const bf16_t* c1 = CKV + (size_t)(brow + IDX[32 * (st + 1) + 16 + fr]) * 256 + 8 * g;
#pragma unroll
                for (int ks = 0; ks < 8; ++ks) { a0[ks] = *(const bf16x8*)(c0 + 32 * ks); a1[ks] = *(const bf16x8*)(c1 + 32 * ks); } }
            float mx = -1e30f;
#pragma unroll
            for (int r = 0; r < 4; ++r) {
                { const int slot = 32 * st + 4 * g + r; const int dist = t - (int)IDX[slot]; const float lg = s0[r] * scale + RL[BK[dist < 0 ? 0 : dist] * 8 + 4 + hd]; s0[r] = (slot < nsel) ? lg : -1e30f; mx = fmaxf(mx, s0[r]); }
                { const int slot = 32 * st + 16 + 4 * g + r; const int dist = t - (int)IDX[slot]; const float lg = s1[r] * scale + RL[BK[dist < 0 ? 0 : dist] * 8 + 4 + hd]; s1[r] = (slot < nsel) ? lg : -1e30f; mx = fmaxf(mx, s1[r]); } }
            mx = fmaxf(mx, __shfl_xor(mx, 16)); mx = fmaxf(mx, __shfl_xor(mx, 32));
            const float mnew = fmaxf(mrun, mx), alpha = __expf(mrun - mnew); mrun = mnew;
            float ps = 0.f;
#pragma unroll
            for (int r = 0; r < 4; ++r) { const float p0 = (s0[r] > -1e29f) ? __expf(s0[r] - mnew) : 0.f, p1 = (s1[r] > -1e29f) ? __expf(s1[r] - mnew) : 0.f; s0[r] = p0; s1[r] = p1; ps += p0 + p1; }
            lsum = lsum * alpha + ps;
#pragma unroll
            for (int rt = 0; rt < 16; ++rt) oacc[rt] = oacc[rt] * alpha;
            u32x4 pt; pt.x = cvt_pk_bf16(s0[0], s0[1]); pt.y = cvt_pk_bf16(s0[2], s0[3]); pt.z = cvt_pk_bf16(s1[0], s1[1]); pt.w = cvt_pk_bf16(s1[2], s1[3]);
            const bf16x8 pb = __builtin_bit_cast(bf16x8, pt);
#pragma unroll
            for (int rt = 0; rt < 16; ++rt) {
                const LAS unsigned char* va = CT + (4 * g + (fr >> 2)) * 544 + (16 * rt + 4 * (fr & 3)) * 2;
                const v4i16_t lo = lds_tr16(va), hi = lds_tr16(va + 16 * 544);
                const bf16x8 a = {lo[0], lo[1], lo[2], lo[3], hi[0], hi[1], hi[2], hi[3]};
                oacc[rt] = __builtin_amdgcn_mfma_f32_16x16x32_bf16(a, pb, oacc[rt], 0, 0, 0); }
        }
        lsum += __shfl_xor(lsum, 16); lsum += __shfl_xor(lsum, 32);
        const float inv = 1.f / lsum;
        mfma_fence(oacc[0], oacc[1], oacc[2], oacc[3]); mfma_fence(oacc[4], oacc[5], oacc[6], oacc[7]); mfma_fence(oacc[8], oacc[9], oacc[10], oacc[11]); mfma_fence(oacc[12], oacc[13], oacc[14], oacc[15]);
        if (fr < 4) {
            bf16_t* yo = PROBE ? ((bf16_t*)((unsigned char*)p.x + 32 * MiB) + (size_t)tg * 1024 + fr * 256 + 4 * g) : (Y + (size_t)tg * 2048 + 1024 + fr * 256 + 4 * g);
#pragma unroll
            for (int rt = 0; rt < 16; ++rt) { u32x2 o; o.x = cvt_pk_bf16(oacc[rt][0] * inv, oacc[rt][1] * inv); o.y = cvt_pk_bf16(oacc[rt][2] * inv, oacc[rt][3] * inv); *(u32x2*)(yo + 16 * rt) = o; }
        }
    }
}

__device__ __forceinline__ Params opq(const Params& p) { Params q = p; asm volatile("" : "+s"(q.ws), "+s"(q.x)); return q; }
__device__ __forceinline__ int opqi(int v) { asm volatile("" : "+s"(v)); return v; }
#define GRID_BARRIER() do { XcdBarrier _b; _b.bar = (unsigned*)(opq(p).ws + OFF_CTL); _b.x = xb_xcc_id(); _b.st = (volatile LAS unsigned*)(lds + LDS_PHASE_BYTES); xcd_barrier(_b); } while (0)
#define PP opq(p)
#define BB opqi(bid)
__device__ __forceinline__ void layer_body(const Params& p, LAS unsigned char* lds, const int bid, const int nb, const int l) {
        phase_gemm_in(PP, lds, BB, nb);
        GRID_BARRIER();
        phase_prep(PP, l, lds, BB, nb);
        phase_hg1(PP, l, lds, BB, nb);
        GRID_BARRIER();
        phase_hg2(PP, BB, nb);
        phase_moba(PP, lds, BB, nb);
        phase_dsel(PP, lds, BB, nb);
        GRID_BARRIER();
        phase_hg3(PP, l, lds, BB, nb);
        phase_datt(PP, lds, BB, nb);
        __syncthreads();
        phase_conv_postA(PP, l, lds, BB, nb);
        GRID_BARRIER();
        phase_conv_postB(PP, l, lds, BB, nb);
        phase_gemm_gates(PP, lds, BB, nb);
        GRID_BARRIER();
        phase_gemm_branch(PP, lds, BB, nb);
        GRID_BARRIER();
        phase_gemm_out(PP, lds, BB, nb);
        GRID_BARRIER();
        { const Params q = PP;
          if (l == 0) phase_norm<1, false, true>(IN(q, I_X), BF(q, OFF_XB), BF(q, OFF_OUT), IN(q, I_POSTMIX) + l * 1024, IN(q, I_PREFFN) + l * 1024, BF(q, OFF_H), BB, nb);
          else        phase_norm<1, true, true>((float*)q.x, BF(q, OFF_XB), BF(q, OFF_OUT), IN(q, I_POSTMIX) + l * 1024, IN(q, I_PREFFN) + l * 1024, BF(q, OFF_H), BB, nb); }
        GRID_BARRIER();
        phase_gemm_ffn1(PP, lds, BB, nb);
        GRID_BARRIER();
        phase_gemm_ffn2(PP, lds, BB, nb);
        GRID_BARRIER();
        if (l + 1 < DEPTH) { { const Params q = PP; phase_norm<1, true, true>(BF(q, OFF_XB), (float*)q.x, BF(q, OFF_OUT), IN(q, I_POSTFFN) + l * 1024, IN(q, I_PREMIX) + (l + 1) * 1024, BF(q, OFF_H), BB, nb); } phase_conv_in(PP, l + 1, lds, BB, nb); GRID_BARRIER(); }
        else { const Params q = PP; phase_norm<2, true, false>(BF(q, OFF_XB), (float*)q.x, BF(q, OFF_OUT), IN(q, I_POSTFFN) + l * 1024, nullptr, nullptr, BB, nb); }
}
__global__ __launch_bounds__(512, 2) void mega_fwd(Params p) {
    extern __shared__ __attribute__((aligned(16))) unsigned char shm[];
    LAS unsigned char* lds = (LAS unsigned char*)shm;
    const int bid = blockIdx.x, nb = gridDim.x;
    volatile LAS unsigned* xbw = (volatile LAS unsigned*)(lds + LDS_PHASE_BYTES);
    if (threadIdx.x < 4) xbw[threadIdx.x] = 0u;
    __syncthreads();
    (void)xcd_barrier_post((unsigned*)(p.ws + OFF_CTL), xbw);
    { const Params q = PP; phase_norm<0, false, false>(IN(q, I_X), nullptr, nullptr, nullptr, IN(q, I_PREMIX), BF(q, OFF_H), BB, nb); }
    phase_conv_in(PP, 0, lds, BB, nb);
    GRID_BARRIER();
    for (int l = 0; l < DEPTH; ++l) layer_body(p, lds, bid, nb, l);
}

#define LDS_BYTES (LDS_PHASE_BYTES + 16)
extern "C" void kernel_launch(void* const* d_in, const int* in_sizes, int n_in, void* d_out, int out_size, void* d_ws, size_t ws_size, hipStream_t stream) {
    static int grid = 0;
    if (grid == 0) {
        int dev = 0, cus = 0;
        if (hipGetDevice(&dev) != hipSuccess || hipDeviceGetAttribute(&cus, hipDeviceAttributeMultiprocessorCount, dev) != hipSuccess || cus < 1) { fprintf(stderr, "kernel_launch: no device info\n"); grid = -1; return; }
        if (hipFuncSetAttribute((const void*)mega_fwd, hipFuncAttributeMaxDynamicSharedMemorySize, LDS_BYTES) != hipSuccess) { fprintf(stderr, "kernel_launch: hipFuncSetAttribute failed\n"); grid = -1; return; }
        int per_cu = 0;
        if (hipOccupancyMaxActiveBlocksPerMultiprocessor(&per_cu, (const void*)mega_fwd, 512, LDS_BYTES) != hipSuccess || per_cu < 1) { fprintf(stderr, "kernel_launch: occupancy query says %d blocks per CU\n", per_cu); }
        (void)hipGetLastError();
        grid = cus;
    }
    if (grid < 0) return;
    Params p{};
    for (int i = 0; i < 20; ++i) p.in[i] = (GAS const float*)d_in[i];
    p.x = (GAS float*)d_out; p.ws = (GAS unsigned char*)d_ws;
    if (WS_NEED > ws_size) { fprintf(stderr, "kernel_launch: workspace too small (%zu < %zu)\n", ws_size, (size_t)WS_NEED); return; }
    (void)hipMemsetAsync((unsigned char*)d_ws + OFF_CTL, 0, 16384, stream);
    hipLaunchKernelGGL(mega_fwd, dim3(grid), dim3(512), LDS_BYTES, stream, p);
}
```

```cpp
#include <hip/hip_runtime.h>
#include <stdint.h>
#include <stdio.h>

#define D_MODEL 1024
#define BATCH 4
#define SEQ 4096
#define NTOK 16384
#define DEPTH 2
#define IN_W 8008
#define D_FF 2816
#define NEG_BIG (-1e30f)
#define C_HQ 0
#define C_HF 512
#define C_HI 1024
#define C_HG 1536
#define C_MQ 2048
#define C_MK 2560
#define C_MV 3072
#define C_DQ 3584
#define C_DKV 4096
#define C_IQ 4352
#define C_IK 4864
#define C_IW 4928
#define C_G 4936
#define NP1 5632

#define LAS __attribute__((address_space(3)))
typedef unsigned short bf16_t;
typedef short bf16x8 __attribute__((ext_vector_type(8)));
typedef float f32x4 __attribute__((ext_vector_type(4)));
typedef unsigned u32x4 __attribute__((ext_vector_type(4)));
typedef unsigned u32x2 __attribute__((ext_vector_type(2)));

__device__ __forceinline__ float sigmoidf_(float x) { return 1.f / (1.f + __expf(-x)); }
__device__ __forceinline__ float bf2f(bf16_t b) { return __uint_as_float(((unsigned)b) << 16); }
typedef __bf16 bf16x2_t __attribute__((ext_vector_type(2)));
typedef float f32x2_t __attribute__((ext_vector_type(2)));
__device__ __forceinline__ unsigned cvt_pk_bf16(float lo, float hi) { const f32x2_t f = {lo, hi}; const bf16x2_t v = __builtin_convertvector(f, bf16x2_t); return __builtin_bit_cast(unsigned, v); }
__device__ __forceinline__ bf16_t f2bf(float f) { return (bf16_t)(cvt_pk_bf16(f, 0.f) & 0xffffu); }
__device__ __forceinline__ int phase_tid() { int t = threadIdx.x; asm volatile("" : "+v"(t)); return t; }
__device__ __forceinline__ void mfma_fence(f32x4& a) { asm volatile("s_nop 15\n\ts_nop 3" : "+v"(a)); }
__device__ __forceinline__ void mfma_fence(f32x4& a, f32x4& b, f32x4& c, f32x4& d) { asm volatile("s_nop 15\n\ts_nop 3" : "+v"(a), "+v"(b), "+v"(c), "+v"(d)); }
__device__ __forceinline__ int rel_bucket(int dist) {
    int n = dist > 0 ? dist : 0;
    if (n < 16) return n;
    float nf = (float)n;
    int large = 16 + (int)(logf(nf / 16.f) / 4.852030263919617f * 16.f);
    return large < 31 ? large : 31;
}

enum { I_X = 0, I_WIN, I_PREMIX, I_POSTMIX, I_PREFFN, I_POSTFFN, I_LB, I_HGNW, I_KVN, I_WUK, I_WUV, I_IKNW, I_IKNB, I_REL, I_WA, I_WB, I_WC, I_WOUT, I_WF1, I_WF2 };
#define GAS __attribute__((address_space(1)))
struct Params { GAS const float* in[20]; GAS float* x; GAS unsigned char* ws; };
#define IN(p, i) ((const float*)(p).in[i])
constexpr size_t MiB = 1024 * 1024;
#define LDS_PHASE_BYTES (150 * 1024)
constexpr size_t OFF_CTL = 0, OFF_Y = 65536, OFF_HF = OFF_Y + 64 * MiB, OFF_HI = OFF_HF + 16 * MiB, OFF_HG = OFF_HI + 16 * MiB, OFF_MK = OFF_HG + 16 * MiB,
                 OFF_MV = OFF_MK + 16 * MiB, OFF_IQ = OFF_MV + 16 * MiB, OFF_CKV = OFF_IQ + 16 * MiB, OFF_IKW = OFF_CKV + 8 * MiB, OFF_H = OFF_IKW + 4 * MiB,
                 OFF_WIN = OFF_H + 32 * MiB, OFF_RS = OFF_WIN + 11 * MiB;
constexpr size_t OFF_WG = OFF_WIN, OFF_WBR = OFF_WG + 6 * MiB, OFF_WOUT = OFF_RS, OFF_WF1 = OFF_WOUT + 2 * MiB, OFF_WF2 = OFF_WF1 + 11 * MiB, OFF_WEND = OFF_WF2 + 6 * MiB;
constexpr size_t OFF_ST = OFF_RS, OFF_TMPF = OFF_RS, OFF_DEC = OFF_ST + 32 * MiB, OFF_MASK = OFF_DEC + MiB / 2, OFF_KMEAN = OFF_MASK + 8 * MiB, OFF_MEND = OFF_KMEAN + MiB / 8;
constexpr size_t OFF_OUT = OFF_HG, OFF_ACT = OFF_Y, OFF_XB = OFF_MV;
constexpr size_t WS_NEED = (OFF_WEND > OFF_MEND ? OFF_WEND : OFF_MEND);
#define BF(p, off) ((bf16_t*)((p).ws + (off)))
#define IKT_PTR(p) ((bf16_t*)((unsigned char*)(p).x + 32 * MiB))
#define F32P(p, off) ((float*)((p).ws + (off)))
__device__ const unsigned long long kP1Off[22] = {OFF_Y, OFF_Y, OFF_HF, OFF_HF, OFF_HI, OFF_HI, OFF_HG, OFF_HG, OFF_Y, OFF_Y, OFF_MK, OFF_MK, OFF_MV, OFF_MV, OFF_Y, OFF_Y, OFF_Y, OFF_Y, OFF_CKV, OFF_IQ, OFF_IQ, OFF_IKW};
__device__ const int kP1Ld[22]  = {2048, 2048, 512, 512, 512, 512, 512, 512, 2048, 2048, 512, 512, 512, 512, 2048, 2048, 2048, 2048, 256, 512, 512, 128};
__device__ const int kP1C0[22]  = {0, 256, 0, 256, 0, 256, 0, 256, 512, 768, 0, 256, 0, 256, 1024, 1280, 1536, 1792, 0, 0, 256, 0};
__device__ const int kP1Nc[22]  = {256, 256, 256, 256, 256, 256, 256, 256, 256, 256, 256, 256, 256, 256, 256, 256, 256, 256, 256, 256, 256, 128};

#define XB_TMO      128
#define XB_XCNT(j)  (256  + 64 * (j))
#define XB_XSUB(j)  (1280 + 64 * (j))
#define XB_XGEN(j)  (2304 + 64 * (j))
#define XB_TOP      3328
#define XB_TOPGEN   3392
#define XCD_BAR_WORDS 3456
#define XB_SPIN_CAP (1u << 18)

__device__ __forceinline__ unsigned xb_ld(unsigned* p)              { return __hip_atomic_load(p, __ATOMIC_RELAXED, __HIP_MEMORY_SCOPE_AGENT); }
__device__ __forceinline__ unsigned xb_add(unsigned* p, unsigned v) { return __hip_atomic_fetch_add(p, v, __ATOMIC_RELAXED, __HIP_MEMORY_SCOPE_AGENT); }
__device__ __forceinline__ unsigned xb_xcc_id() { return (unsigned)__builtin_amdgcn_s_getreg((3 << 11) | 20) & 0xFu; }
#define XB_SPIN(cond, bar) do { unsigned _sp = 0; while (cond) { __builtin_amdgcn_s_sleep(1); \
    if ((++_sp & 255u) == 0u) { if (xb_ld(&(bar)[XB_TMO])) break; if (_sp > XB_SPIN_CAP) { atomicAdd(&(bar)[XB_TMO], 1u); break; } } } } while (0)

struct XcdBarrier {
    unsigned* bar; unsigned x;
    volatile LAS unsigned* st;
};

__device__ __forceinline__ XcdBarrier xcd_barrier_post(unsigned* bar, volatile LAS unsigned* st) {
    XcdBarrier b; b.bar = bar; b.x = xb_xcc_id(); b.st = st;
    if (threadIdx.x == 0) (void)xb_add(&bar[XB_XCNT(b.x)], 1u);
    return b;
}
__device__ __forceinline__ void xcd_barrier_complete(unsigned* bar, unsigned x, unsigned& nloc, unsigned& nx) {
    const unsigned G = gridDim.x * gridDim.y * gridDim.z;
    unsigned sum, cnt, mine, sp = 0u;
    for (;;) {
        sum = 0u; cnt = 0u; mine = 0u;
#pragma unroll
        for (unsigned j = 0; j < 16; ++j) { const unsigned c = xb_ld(&bar[XB_XCNT(j)]); sum += c; cnt += (c > 0u) ? 1u : 0u; mine = (j == x) ? c : mine; }
        if (sum == G) break;
        __builtin_amdgcn_s_sleep(1);
        if ((++sp & 255u) == 0u) { if (xb_ld(&bar[XB_TMO])) break; if (sp > XB_SPIN_CAP) { atomicAdd(&bar[XB_TMO], 1u); break; } }
    }
    nloc = mine > 0u ? mine : 1u; nx = cnt > 0u ? cnt : 1u;
}

__device__ __forceinline__ void xcd_barrier(const XcdBarrier& b) {
    asm volatile("s_waitcnt vmcnt(0)" ::: "memory");
    __syncthreads();
    if (threadIdx.x == 0) {
        unsigned* bar = b.bar;
        __builtin_amdgcn_s_waitcnt(0);
        unsigned nloc = b.st[0], nx = b.st[1];
        if (nloc == 0u) { xcd_barrier_complete(bar, b.x, nloc, nx); b.st[0] = nloc; b.st[1] = nx; }
        const unsigned old = xb_add(&bar[XB_XSUB(b.x)], 1u);
        const unsigned gen = old / nloc;
        if (old + 1u == (gen + 1u) * nloc) {
            __builtin_amdgcn_fence(__ATOMIC_RELEASE, "agent");
            asm volatile("s_waitcnt vmcnt(0)" ::: "memory");
            const unsigned og = xb_add(&bar[XB_TOP], 1u);
            const unsigned tg = og / nx;
            if (og + 1u == (tg + 1u) * nx) xb_add(&bar[XB_TOPGEN], 1u);
            else XB_SPIN(xb_ld(&bar[XB_TOPGEN]) == tg, bar);
            __builtin_amdgcn_fence(__ATOMIC_ACQUIRE, "agent");
            xb_add(&bar[XB_XGEN(b.x)], 1u);
            asm volatile("s_waitcnt vmcnt(0)" ::: "memory");
        } else {
            XB_SPIN(xb_ld(&bar[XB_XGEN(b.x)]) == gen, bar);
            __builtin_amdgcn_fence(__ATOMIC_ACQUIRE, "agent");
            asm volatile("s_waitcnt vmcnt(0)" ::: "memory");
        }
    }
    __syncthreads();
}


namespace pg8 {
constexpr int BM = 256, BK = 64, HALF = 128, HTB = HALF * BK * 2, STAGE_BYTES = 8 * HTB, NXCD = 8, WGM = 8;
__host__ __device__ __forceinline__ int lds_byte(int r, int c) { const int st = (r >> 4) * 2 + (c >> 5), rr = r & 15, cc = c & 31, ob = rr * 64 + cc * 2; return st * 1024 + (ob ^ (((ob >> 9) & 1) << 5)); }
__host__ __device__ __forceinline__ void stage_rc(int b, int& R, int& C) { const int st = b / 1024, sb = b % 1024, swz = sb ^ (((sb >> 9) & 1) << 5); R = (st >> 1) * 16 + swz / 64; C = (st & 1) * 32 + (swz % 64) / 2; }
__host__ __device__ __forceinline__ int perm32(int rho) { const int n = rho >> 4, i = rho & 15; return 8 * (i >> 2) + 4 * n + (i & 3); }

struct Unit { int pm, pn, ka, nt, br; };
struct Gemm { const bf16_t* A; const bf16_t* Bt; int lda, ldb; };

__device__ __forceinline__ bool tile_of(long L, int nM, int nN, int& pm, int& pn) {
    const int nwg = nM * nN; if (L >= nwg) return false;
    int wgid = (int)L; { const int q = nwg / NXCD, r = nwg % NXCD, xcd = wgid % NXCD, off = wgid / NXCD; wgid = (xcd < r ? xcd * (q + 1) : r * (q + 1) + (xcd - r) * q) + off; }
    const int nig = WGM * nN, gid = wgid / nig, fm = gid * WGM, gsz = (nM - fm) < WGM ? (nM - fm) : WGM;
    pm = fm + ((wgid % nig) % gsz); pn = (wgid % nig) / gsz; return true;
}
struct StaticOrder {
    int nM, nN, G, c, nt;
    __device__ void init(int M, int N, int K, int G_, int c_) { nM = M / BM; nN = N / BM; G = G_; c = c_; nt = K / BK; }
    __device__ bool next(int i, Unit& u) const { u.ka = 0; u.nt = nt; u.br = 0; return tile_of((long)i * G + c, nM, nN, u.pm, u.pn); }
};
struct BranchOrder {
    int nM, nN, G, c;
    __device__ void init(int M, int N, int G_, int c_) { nM = M / BM; nN = N / BM; G = G_; c = c_; }
    __device__ bool next(int i, Unit& u) const { const int ti = i / 3, br = i - ti * 3; u.br = br; u.ka = br * 512; u.nt = (br == 2) ? 16 : 8; return tile_of((long)ti * G + c, nM, nN, u.pm, u.pn); }
};

template <class Epi, class Sched>
__device__ __forceinline__ void gemm_phase(LAS unsigned char* lds, const Gemm g, const Sched& S, const Epi& E) {
    const int tid = phase_tid(), wid = __builtin_amdgcn_readfirstlane(tid >> 6), lane = tid & 63, wr = wid >> 2, wc = wid & 3, fr = lane & 15, fq = lane >> 4;
    unsigned voffA[2], voffB[2];
#pragma unroll
    for (int i = 0; i < 2; ++i) { int R, C; stage_rc(tid * 16 + i * 8192, R, C); const int Rb = Epi::PERM ? ((R & ~31) + perm32(R & 31)) : R;
        voffA[i] = (unsigned)(R * g.lda + C) * 2u; voffB[i] = (unsigned)(Rb * g.ldb + C) * 2u; }
    const size_t kstep = (size_t)(BK * 2);
    const size_t hsA = (size_t)HALF * g.lda * 2, hsB = (size_t)HALF * g.ldb * 2;
    const size_t tsA = 2 * hsA, tsB = 2 * hsB;
    const unsigned ldsw = (unsigned)wid * 1024u;
    const int aoff = lds_byte(wr * 64 + fr, fq * 8), boff = lds_byte(wc * 32 + fr, fq * 8);
#define PG8_SA(b, h) (((b) * 2 + (h)) * HTB)
#define PG8_SB(b, h) ((4 + (b) * 2 + (h)) * HTB)
#define PG8_STAGE(bufoff, gbase, voff) do { _Pragma("unroll") for (int _i = 0; _i < 2; ++_i) \
        __builtin_amdgcn_global_load_lds((const unsigned*)((const char*)(gbase) + (voff)[_i]), (LAS unsigned*)(lds + (bufoff) + ldsw + _i * 8192), 16, 0, 0); } while (0)
#define PG8_LDA(dst, b, h) do { _Pragma("unroll") for (int m = 0; m < 4; ++m) _Pragma("unroll") for (int k = 0; k < 2; ++k) dst[m][k] = *(const LAS bf16x8*)(lds + PG8_SA(b, h) + aoff + m * 2048 + k * 1024); } while (0)
#define PG8_LDB(dst, b, h) do { _Pragma("unroll") for (int n = 0; n < 2; ++n) _Pragma("unroll") for (int k = 0; k < 2; ++k) dst[n][k] = *(const LAS bf16x8*)(lds + PG8_SB(b, h) + boff + n * 2048 + k * 1024); } while (0)
#define PG8_MMA(ai, bj, At, Bt) do { __builtin_amdgcn_s_setprio(1); _Pragma("unroll") for (int m = 0; m < 4; ++m) _Pragma("unroll") for (int n = 0; n < 2; ++n) _Pragma("unroll") for (int k = 0; k < 2; ++k) \
        acc[ai][bj][m][n] = __builtin_amdgcn_mfma_f32_16x16x32_bf16(Bt[n][k], At[m][k], acc[ai][bj][m][n], 0, 0, 0); __builtin_amdgcn_s_setprio(0); } while (0)
#define PG8_WAIT_V(n) asm volatile("s_waitcnt vmcnt(" #n ")" ::: "memory")
#define PG8_WAIT_L(n) asm volatile("s_waitcnt lgkmcnt(" #n ")" ::: "memory")
#define PG8_BAR __builtin_amdgcn_s_barrier()
#define PG8_SCHED __builtin_amdgcn_sched_barrier(0)
    Unit cur, nxt; int ui = 0;
    if (!S.next(0, cur)) return;
    f32x4 acc[2][2][4][2];
#pragma unroll
    for (int a = 0; a < 2; ++a)
#pragma unroll
        for (int b = 0; b < 2; ++b)
#pragma unroll
            for (int m = 0; m < 4; ++m)
#pragma unroll
                for (int n = 0; n < 2; ++n) acc[a][b][m][n] = (f32x4){0.f, 0.f, 0.f, 0.f};
    bf16x8 At[4][2], B0[2][2], B1[2][2];
    const char* cA = (const char*)g.A + (size_t)cur.pm * tsA + (size_t)cur.ka * 2; const char* cB = (const char*)g.Bt + (size_t)cur.pn * tsB + (size_t)cur.ka * 2;
    PG8_STAGE(PG8_SB(0, 0), cB, voffB); PG8_STAGE(PG8_SA(0, 0), cA, voffA); PG8_STAGE(PG8_SB(0, 1), cB + hsB, voffB); PG8_STAGE(PG8_SA(0, 1), cA + hsA, voffA);
    if (wr == 1) PG8_BAR;
    PG8_WAIT_V(4); PG8_BAR;
    PG8_STAGE(PG8_SB(1, 0), cB + kstep, voffB); PG8_STAGE(PG8_SA(1, 0), cA + kstep, voffA); PG8_STAGE(PG8_SB(1, 1), cB + hsB + kstep, voffB);
    PG8_WAIT_V(6); PG8_BAR;
    for (;;) {
        const bool has_next = S.next(ui + 1, nxt);
        const char* nA = has_next ? (const char*)g.A + (size_t)nxt.pm * tsA + (size_t)nxt.ka * 2 : cA; const char* nB = has_next ? (const char*)g.Bt + (size_t)nxt.pn * tsB + (size_t)nxt.ka * 2 : cB;
        const int nt = cur.nt;
        for (int t = 0; t < nt; t += 2) {
            const bool last = (t == nt - 2);
            const char* a1 = cA + (size_t)(t + 1) * kstep;
            const char* a2 = last ? nA : cA + (size_t)(t + 2) * kstep; const char* b2 = last ? nB : cB + (size_t)(t + 2) * kstep;
            const char* a3 = a2 + kstep; const char* b3 = b2 + kstep;
            PG8_LDB(B0, 0, 0); PG8_SCHED; PG8_LDA(At, 0, 0); PG8_STAGE(PG8_SA(1, 1), a1 + hsA, voffA);
            PG8_WAIT_L(8); PG8_BAR; PG8_WAIT_L(0); PG8_MMA(0, 0, At, B0); PG8_BAR; PG8_SCHED;
            PG8_LDB(B1, 0, 1); PG8_STAGE(PG8_SB(0, 0), b2, voffB);
            PG8_BAR; PG8_WAIT_L(0); PG8_MMA(0, 1, At, B1); PG8_BAR;
            PG8_LDA(At, 0, 1); PG8_STAGE(PG8_SA(0, 0), a2, voffA);
            PG8_BAR; PG8_WAIT_L(0); PG8_MMA(1, 0, At, B0); PG8_BAR; PG8_SCHED;
            PG8_STAGE(PG8_SB(0, 1), b2 + hsB, voffB);
            PG8_WAIT_V(6); PG8_BAR; PG8_MMA(1, 1, At, B1); PG8_BAR;
            PG8_LDB(B0, 1, 0); PG8_SCHED; PG8_LDA(At, 1, 0); PG8_STAGE(PG8_SA(0, 1), a2 + hsA, voffA);
            PG8_WAIT_L(8); PG8_BAR; PG8_WAIT_L(0); PG8_MMA(0, 0, At, B0); PG8_BAR; PG8_SCHED;
            PG8_LDB(B1, 1, 1); PG8_STAGE(PG8_SB(1, 0), b3, voffB);
            PG8_BAR; PG8_WAIT_L(0); PG8_MMA(0, 1, At, B1); PG8_BAR;
            PG8_LDA(At, 1, 1); PG8_STAGE(PG8_SA(1, 0), a3, voffA);
            PG8_BAR; PG8_WAIT_L(0); PG8_MMA(1, 0, At, B0); PG8_BAR; PG8_SCHED;
            PG8_STAGE(PG8_SB(1, 1), b3 + hsB, voffB);
            PG8_WAIT_V(6); PG8_BAR; PG8_MMA(1, 1, At, B1); PG8_BAR;
        }
        E(acc, cur, wr, wc, fr, fq);
        if (!has_next) break;
#pragma unroll
        for (int a = 0; a < 2; ++a)
#pragma unroll
            for (int b = 0; b < 2; ++b)
#pragma unroll
                for (int m = 0; m < 4; ++m)
#pragma unroll
                    for (int n = 0; n < 2; ++n) acc[a][b][m][n] = (f32x4){0.f, 0.f, 0.f, 0.f};
        cur = nxt; cA = nA; cB = nB; ++ui;
    }
    PG8_WAIT_V(0);
    if (wr == 0) PG8_BAR;
    PG8_BAR;
#undef PG8_SA
#undef PG8_SB
#undef PG8_STAGE
#undef PG8_LDA
#undef PG8_LDB
#undef PG8_MMA
#undef PG8_WAIT_V
#undef PG8_WAIT_L
#undef PG8_BAR
#undef PG8_SCHED
}

struct EpiF32 {
    static constexpr bool PERM = false;
    float* C; int ldc;
    __device__ __forceinline__ void operator()(const f32x4 (&acc)[2][2][4][2], const Unit& u, int wr, int wc, int fr, int fq) const {
        const int row0 = u.pm * BM + wr * 64 + fr, col0 = u.pn * BM + wc * 32 + 4 * fq;
#pragma unroll
        for (int ai = 0; ai < 2; ++ai)
#pragma unroll
            for (int m = 0; m < 4; ++m) { float* rowp = C + (size_t)(row0 + ai * HALF + m * 16) * ldc + col0;
#pragma unroll
                for (int bj = 0; bj < 2; ++bj)
#pragma unroll
                    for (int n = 0; n < 2; ++n) *(f32x4*)(rowp + bj * HALF + n * 16) = acc[ai][bj][m][n]; }
    }
};
struct EpiProj {
    static constexpr bool PERM = true;
    unsigned char* ws;
    __device__ __forceinline__ void operator()(const f32x4 (&acc)[2][2][4][2], const Unit& u, int wr, int wc, int fr, int fq) const {
        bf16_t* base = (bf16_t*)(ws + kP1Off[u.pn]); const int ld = kP1Ld[u.pn], ncol = kP1Nc[u.pn];
        const int row0 = u.pm * BM + wr * 64 + fr, col0 = kP1C0[u.pn] + wc * 32 + 8 * fq;
#pragma unroll
        for (int ai = 0; ai < 2; ++ai)
#pragma unroll
            for (int m = 0; m < 4; ++m) { bf16_t* rowp = base + (size_t)(row0 + ai * HALF + m * 16) * ld + col0;
#pragma unroll
                for (int bj = 0; bj < 2; ++bj) { if (bj * HALF >= ncol) continue;
                    const f32x4 v0 = acc[ai][bj][m][0], v1 = acc[ai][bj][m][1];
                    u32x4 w; w.x = cvt_pk_bf16(v0[0], v0[1]); w.y = cvt_pk_bf16(v0[2], v0[3]); w.z = cvt_pk_bf16(v1[0], v1[1]); w.w = cvt_pk_bf16(v1[2], v1[3]);
                    *(u32x4*)(rowp + bj * HALF) = w; } }
    }
};
struct EpiBf16 {
    static constexpr bool PERM = true;
    bf16_t* C; int ldc;
    __device__ __forceinline__ void operator()(const f32x4 (&acc)[2][2][4][2], const Unit& u, int wr, int wc, int fr, int fq) const {
        const int row0 = u.pm * BM + wr * 64 + fr, col0 = u.pn * BM + wc * 32 + 8 * fq;
#pragma unroll
        for (int ai = 0; ai < 2; ++ai)
#pragma unroll
            for (int m = 0; m < 4; ++m) { bf16_t* rowp = C + (size_t)(row0 + ai * HALF + m * 16) * ldc + col0;
#pragma unroll
                for (int bj = 0; bj < 2; ++bj) {
                    const f32x4 v0 = acc[ai][bj][m][0], v1 = acc[ai][bj][m][1];
                    u32x4 w; w.x = cvt_pk_bf16(v0[0], v0[1]); w.y = cvt_pk_bf16(v0[2], v0[3]); w.z = cvt_pk_bf16(v1[0], v1[1]); w.w = cvt_pk_bf16(v1[2], v1[3]);
                    *(u32x4*)(rowp + bj * HALF) = w; } }
    }
};
struct EpiGate {
    static constexpr bool PERM = true;
    bf16_t* G0;
    __device__ __forceinline__ void operator()(const f32x4 (&acc)[2][2][4][2], const Unit& u, int wr, int wc, int fr, int fq) const {
        bf16_t* base = G0 + (size_t)(u.pn >> 1) * ((size_t)NTOK * 512);
        const int row0 = u.pm * BM + wr * 64 + fr, col0 = (u.pn & 1) * 256 + wc * 32 + 8 * fq;
#pragma unroll
        for (int ai = 0; ai < 2; ++ai)
#pragma unroll
            for (int m = 0; m < 4; ++m) { bf16_t* rowp = base + (size_t)(row0 + ai * HALF + m * 16) * 512 + col0;
#pragma unroll
                for (int bj = 0; bj < 2; ++bj) {
                    f32x4 v0 = acc[ai][bj][m][0], v1 = acc[ai][bj][m][1];
#pragma unroll
                    for (int j = 0; j < 4; ++j) { v0[j] = sigmoidf_(v0[j]); v1[j] = sigmoidf_(v1[j]); }
                    u32x4 w; w.x = cvt_pk_bf16(v0[0], v0[1]); w.y = cvt_pk_bf16(v0[2], v0[3]); w.z = cvt_pk_bf16(v1[0], v1[1]); w.w = cvt_pk_bf16(v1[2], v1[3]);
                    *(u32x4*)(rowp + bj * HALF) = w; } }
    }
};
struct EpiSwiglu {
    static constexpr bool PERM = true;
    bf16_t* O; int ldc;
    __device__ __forceinline__ void operator()(const f32x4 (&acc)[2][2][4][2], const Unit& u, int wr, int wc, int fr, int fq) const {
        const int row0 = u.pm * BM + wr * 64 + fr, col0 = u.pn * HALF + wc * 32 + 8 * fq;
#pragma unroll
        for (int ai = 0; ai < 2; ++ai)
#pragma unroll
            for (int m = 0; m < 4; ++m) { bf16_t* rowp = O + (size_t)(row0 + ai * HALF + m * 16) * ldc + col0;
                float r[8];
#pragma unroll
                for (int n = 0; n < 2; ++n)
#pragma unroll
                    for (int j = 0; j < 4; ++j) { const float gv = acc[ai][0][m][n][j], uv = acc[ai][1][m][n][j]; r[n * 4 + j] = gv * sigmoidf_(gv) * uv; }
                u32x4 w; w.x = cvt_pk_bf16(r[0], r[1]); w.y = cvt_pk_bf16(r[2], r[3]); w.z = cvt_pk_bf16(r[4], r[5]); w.w = cvt_pk_bf16(r[6], r[7]);
                *(u32x4*)rowp = w; }
    }
};
struct EpiBranch {
    static constexpr bool PERM = true;
    bf16_t* Mg; const bf16_t* G0;
    __device__ __forceinline__ void operator()(const f32x4 (&acc)[2][2][4][2], const Unit& u, int wr, int wc, int fr, int fq) const {
        const bf16_t* gb = G0 + (size_t)(u.br * 2 + (u.pn >> 1)) * ((size_t)NTOK * 512);
        const int row0 = u.pm * BM + wr * 64 + fr, cl = wc * 32 + 8 * fq;
#pragma unroll
        for (int ai = 0; ai < 2; ++ai)
#pragma unroll
            for (int m = 0; m < 4; ++m) { const size_t row = (size_t)(row0 + ai * HALF + m * 16);
#pragma unroll
                for (int bj = 0; bj < 2; ++bj) {
                    const u32x4 gw = *(const u32x4*)(gb + row * 512 + (u.pn & 1) * 256 + bj * HALF + cl);
                    bf16_t* mp = Mg + row * 1024 + u.pn * 256 + bj * HALF + cl;
                    float r[8];
#pragma unroll
                    for (int q = 0; q < 4; ++q) { const unsigned g2 = gw[q]; const int n = q >> 1, j = (q & 1) * 2;
                        r[q * 2] = __uint_as_float(g2 << 16) * acc[ai][bj][m][n][j]; r[q * 2 + 1] = __uint_as_float(g2 & 0xffff0000u) * acc[ai][bj][m][n][j + 1]; }
                    if (u.br != 0) { u32x4 ow;
#pragma unroll
                        for (int q = 0; q < 4; ++q) ow[q] = __hip_atomic_load((const unsigned*)mp + q, __ATOMIC_RELAXED, __HIP_MEMORY_SCOPE_AGENT);
#pragma unroll
                        for (int q = 0; q < 4; ++q) { r[q * 2] += __uint_as_float(ow[q] << 16); r[q * 2 + 1] += __uint_as_float(ow[q] & 0xffff0000u); } }
                    u32x4 w; w.x = cvt_pk_bf16(r[0], r[1]); w.y = cvt_pk_bf16(r[2], r[3]); w.z = cvt_pk_bf16(r[4], r[5]); w.w = cvt_pk_bf16(r[6], r[7]);
                    *(u32x4*)mp = w; } }
    }
};
}

template <int MAP> __device__ __forceinline__ int colmap(int n, int off) {
    if (MAP == 0) return n + off;
    if (MAP == 1) { if (n < 3584) return n; const int s = n - 512; return s < C_G ? s : -1; }
    const int pn = n >> 8, r = n & 255; return (r < 128) ? 128 * pn + r : D_FF + 128 * pn + (r - 128);
}
template <int MAP>
__device__ void conv_job(LAS unsigned char* lds, bf16_t* dst_, int ld_dst, int koff, const float* src_, int ld_src, int K, int n_lo, int n_hi, int off, int bid, int nb) {
    GAS bf16_t* dst = (GAS bf16_t*)dst_; GAS const float* src = (GAS const float*)src_;
    const int tid = phase_tid(), wid = __builtin_amdgcn_readfirstlane(tid >> 6), lane = tid & 63;
    LAS float* tile = (LAS float*)lds + wid * (64 * 65);
    const int nk = K / 64, nn = (n_hi - n_lo) / 64;
    const int l4 = lane >> 4, c4 = (lane & 15) * 4, l8 = lane >> 3, k8 = (lane & 7) * 8;
    for (int it = bid * 8 + wid; it < nk * nn; it += nb * 8) {
        const int n0 = n_lo + (it % nn) * 64, k0 = (it / nn) * 64;
        const int cfirst = colmap<MAP>(n0 + c4, off), clast = colmap<MAP>(n0 + c4 + 3, off);
        GAS const float* sp = src + (size_t)(k0 + l4) * ld_src;
        f32x4 v[16];
        if (cfirst >= 0 && clast == cfirst + 3 && ((cfirst | ld_src) & 3) == 0) {
#pragma unroll
            for (int j = 0; j < 16; ++j) v[j] = *(GAS const f32x4*)(sp + (size_t)(4 * j) * ld_src + cfirst);
        } else {
            const int q0 = colmap<MAP>(n0 + c4, off), q1 = colmap<MAP>(n0 + c4 + 1, off), q2 = colmap<MAP>(n0 + c4 + 2, off), q3 = colmap<MAP>(n0 + c4 + 3, off);
#pragma unroll
            for (int j = 0; j < 16; ++j) { GAS const float* r = sp + (size_t)(4 * j) * ld_src;
                v[j][0] = (q0 >= 0) ? r[q0] : 0.f; v[j][1] = (q1 >= 0) ? r[q1] : 0.f; v[j][2] = (q2 >= 0) ? r[q2] : 0.f; v[j][3] = (q3 >= 0) ? r[q3] : 0.f; }
        }
#pragma unroll
        for (int j = 0; j < 16; ++j) { LAS float* t = tile + (4 * j + l4) * 65 + c4; t[0] = v[j][0]; t[1] = v[j][1]; t[2] = v[j][2]; t[3] = v[j][3]; }
        asm volatile("s_waitcnt lgkmcnt(0)" ::: "memory");
#pragma unroll
        for (int jj = 0; jj < 8; ++jj) { const int nr = l8 + 8 * jj; float w8[8];
#pragma unroll
            for (int e = 0; e < 8; ++e) w8[e] = tile[(k8 + e) * 65 + nr];
            u32x4 w; w.x = cvt_pk_bf16(w8[0], w8[1]); w.y = cvt_pk_bf16(w8[2], w8[3]); w.z = cvt_pk_bf16(w8[4], w8[5]); w.w = cvt_pk_bf16(w8[6], w8[7]);
            *(GAS u32x4*)(dst + (size_t)(n0 + nr) * ld_dst + koff + k0 + k8) = w; }
        asm volatile("s_waitcnt lgkmcnt(0)" ::: "memory");
    }
}
__device__ void fold_tile(LAS unsigned char* lds, bf16_t* out, long sOi, long sOj, const float* A, long sAi, long sAd, const float* B, long sBj, long sBd) {
    LAS float* As = (LAS float*)lds; LAS float* Bs = As + 64 * 132;
    const int tid = phase_tid();
    for (int e = tid; e < 64 * 128; e += 512) {
        int i, d; if (sAd == 1) { i = e >> 7; d = e & 127; } else { d = e >> 6; i = e & 63; }
        As[i * 132 + d] = A[i * sAi + d * sAd];
        int j, d2; if (sBd == 1) { j = e >> 7; d2 = e & 127; } else { d2 = e >> 6; j = e & 63; }
        Bs[j * 132 + d2] = B[j * sBj + d2 * sBd];
    }
    __syncthreads();
    const int i = tid & 63, jg = tid >> 6;
    float acc[8];
#pragma unroll
    for (int q = 0; q < 8; ++q) acc[q] = 0.f;
    for (int d = 0; d < 128; d += 4) { const f32x4 a = *(const LAS f32x4*)(As + i * 132 + d);
#pragma unroll
        for (int q = 0; q < 8; ++q) { const f32x4 b = *(const LAS f32x4*)(Bs + (jg * 8 + q) * 132 + d); acc[q] += a[0] * b[0] + a[1] * b[1] + a[2] * b[2] + a[3] * b[3]; } }
#pragma unroll
    for (int q = 0; q < 8; ++q) out[i * sOi + (jg * 8 + q) * sOj] = f2bf(acc[q]);
    __syncthreads();
}

__device__ void phase_conv_in(const Params& p, int l, LAS unsigned char* lds, int bid, int nb) {
    const float* Win = IN(p, I_WIN) + (size_t)l * D_MODEL * IN_W;
    __syncthreads();
    conv_job<1>(lds, BF(p, OFF_WIN), 1024, 0, Win, IN_W, 1024, 0, 3584, 0, bid, nb);
    conv_job<1>(lds, BF(p, OFF_WIN), 1024, 0, Win, IN_W, 1024, 4608, NP1, 0, bid, nb);
    __syncthreads();
    const float* wuk = IN(p, I_WUK) + (size_t)l * 256 * 512;
    for (int it = bid; it < 256; it += nb) { const int h = it >> 6, rb = (it >> 4) & 3, kb = it & 15;
        fold_tile(lds, BF(p, OFF_WIN) + (size_t)(3584 + h * 256 + rb * 64) * 1024 + kb * 64, 1, 1024,
                  Win + (size_t)(kb * 64) * IN_W + C_DQ + h * 128, IN_W, 1, wuk + ((size_t)(rb * 64) * 4 + h) * 128, 512, 1); }
}
__device__ void phase_conv_postA(const Params& p, int l, LAS unsigned char* lds, int bid, int nb) {
    const float* Win = IN(p, I_WIN) + (size_t)l * D_MODEL * IN_W;
    __syncthreads();
    conv_job<0>(lds, BF(p, OFF_WG), 1024, 0, Win, IN_W, 1024, 0, 3072, C_G, bid, nb);
    conv_job<0>(lds, BF(p, OFF_WBR), 2048, 0, IN(p, I_WA) + (size_t)l * 512 * 1024, 1024, 512, 0, 1024, 0, bid, nb);
    conv_job<0>(lds, BF(p, OFF_WBR), 2048, 512, IN(p, I_WB) + (size_t)l * 512 * 1024, 1024, 512, 0, 1024, 0, bid, nb);
    __syncthreads();
    const float* wuv = IN(p, I_WUV) + (size_t)l * 256 * 512; const float* wc = IN(p, I_WC) + (size_t)l * 512 * 1024;
    for (int it = bid; it < 256; it += nb) { const int h = it >> 6, rb = (it >> 4) & 3, nbk = it & 15;
        fold_tile(lds, BF(p, OFF_WBR) + (size_t)(nbk * 64) * 2048 + 1024 + h * 256 + rb * 64, 1, 2048,
                  wuv + ((size_t)(rb * 64) * 4 + h) * 128, 512, 1, wc + (size_t)(h * 128) * 1024 + nbk * 64, 1, 1024); }
}
__device__ void phase_conv_postB(const Params& p, int l, LAS unsigned char* lds, int bid, int nb) {
    __syncthreads();
    conv_job<0>(lds, BF(p, OFF_WOUT), 1024, 0, IN(p, I_WOUT) + (size_t)l * 1024 * 1024, 1024, 1024, 0, 1024, 0, bid, nb);
    conv_job<2>(lds, BF(p, OFF_WF1), 1024, 0, IN(p, I_WF1) + (size_t)l * 1024 * 2 * D_FF, 2 * D_FF, 1024, 0, 2 * D_FF, 0, bid, nb);
    conv_job<0>(lds, BF(p, OFF_WF2), D_FF, 0, IN(p, I_WF2) + (size_t)l * D_FF * 1024, 1024, D_FF, 0, 1024, 0, bid, nb);
    __syncthreads();
}

__device__ __forceinline__ unsigned wave_sum_u32(unsigned v) {
    v += (unsigned)__builtin_amdgcn_update_dpp(0, (int)v, 0x111, 0xf, 0xf, true);
    v += (unsigned)__builtin_amdgcn_update_dpp(0, (int)v, 0x112, 0xf, 0xf, true);
    v += (unsigned)__builtin_amdgcn_update_dpp(0, (int)v, 0x114, 0xf, 0xf, true);
    v += (unsigned)__builtin_amdgcn_update_dpp(0, (int)v, 0x118, 0xf, 0xf, true);
    v += (unsigned)__builtin_amdgcn_update_dpp(0, (int)v, 0x142, 0xa, 0xf, false);
    v += (unsigned)__builtin_amdgcn_update_dpp(0, (int)v, 0x143, 0xc, 0xf, false);
    return (unsigned)__builtin_amdgcn_readlane((int)v, 63);
}
__device__ __forceinline__ float wave_sum(float v) {
#pragma unroll
    for (int o = 32; o >= 1; o >>= 1) v += __shfl_xor(v, o);
    return v;
}
template <int MODE, bool XIN_BF, bool XOUT_BF>
__device__ void phase_norm(const void* xin_, void* xout_, const bf16_t* O_, const float* wpost_, const float* w1_, bf16_t* H_, int bid, int nb) {
    GAS const float* xin = (GAS const float*)xin_; GAS float* xout = (GAS float*)xout_; GAS const bf16_t* xinb = (GAS const bf16_t*)xin_; GAS bf16_t* xoutb = (GAS bf16_t*)xout_;
    GAS const bf16_t* O = (GAS const bf16_t*)O_; GAS const float* wpost = (GAS const float*)wpost_; GAS const float* w1 = (GAS const float*)w1_; GAS bf16_t* H = (GAS bf16_t*)H_;
    const int tidn = phase_tid(); const int wv = tidn >> 6, lane = tidn & 63;
    constexpr int NR = 2;
    for (int row0 = bid * 8 + wv; row0 < NTOK; row0 += NR * nb * 8) {
        f32x4 xv[NR][4], ov[NR][4];
#pragma unroll
        for (int q = 0; q < NR; ++q) { const int row = (row0 + q * nb * 8 < NTOK) ? row0 + q * nb * 8 : row0;
#pragma unroll
            for (int j = 0; j < 4; ++j) {
                if (XIN_BF) { const u32x2 xw = *(GAS const u32x2*)(xinb + (size_t)row * 1024 + j * 256 + lane * 4);
                    xv[q][j] = (f32x4){__uint_as_float(xw.x << 16), __uint_as_float(xw.x & 0xffff0000u), __uint_as_float(xw.y << 16), __uint_as_float(xw.y & 0xffff0000u)}; }
                else xv[q][j] = *(GAS const f32x4*)(xin + (size_t)row * 1024 + j * 256 + lane * 4);
                if (MODE >= 1) { const u32x2 ow = *(GAS const u32x2*)(O + (size_t)row * 1024 + j * 256 + lane * 4);
                    ov[q][j] = (f32x4){__uint_as_float(ow.x << 16), __uint_as_float(ow.x & 0xffff0000u), __uint_as_float(ow.y << 16), __uint_as_float(ow.y & 0xffff0000u)}; } } }
        if (MODE >= 1) {
            float ss[NR];
#pragma unroll
            for (int q = 0; q < NR; ++q) { ss[q] = 0.f;
#pragma unroll
                for (int j = 0; j < 4; ++j) ss[q] += ov[q][j][0] * ov[q][j][0] + ov[q][j][1] * ov[q][j][1] + ov[q][j][2] * ov[q][j][2] + ov[q][j][3] * ov[q][j][3]; }
#pragma unroll
            for (int o = 32; o >= 1; o >>= 1)
#pragma unroll
                for (int q = 0; q < NR; ++q) ss[q] += __shfl_xor(ss[q], o);
#pragma unroll
            for (int q = 0; q < NR; ++q) { const int row = row0 + q * nb * 8; const float r = rsqrtf(ss[q] * (1.f / 1024.f) + 1e-6f);
#pragma unroll
                for (int j = 0; j < 4; ++j) { const f32x4 wv4 = *(GAS const f32x4*)(wpost + j * 256 + lane * 4); xv[q][j] = xv[q][j] + ov[q][j] * r * wv4;
                    if (XOUT_BF) { u32x2 xw; xw.x = cvt_pk_bf16(xv[q][j][0], xv[q][j][1]); xw.y = cvt_pk_bf16(xv[q][j][2], xv[q][j][3]); if (row < NTOK) *(GAS u32x2*)(xoutb + (size_t)row * 1024 + j * 256 + lane * 4) = xw;
                        xv[q][j] = (f32x4){__uint_as_float(xw.x << 16), __uint_as_float(xw.x & 0xffff0000u), __uint_as_float(xw.y << 16), __uint_as_float(xw.y & 0xffff0000u)}; }
                    else if (row < NTOK) *(GAS f32x4*)(xout + (size_t)row * 1024 + j * 256 + lane * 4) = xv[q][j]; } }
        }
        if (MODE <= 1) {
            float ss[NR];
#pragma unroll
            for (int q = 0; q < NR; ++q) { ss[q] = 0.f;
#pragma unroll
                for (int j = 0; j < 4; ++j) ss[q] += xv[q][j][0] * xv[q][j][0] + xv[q][j][1] * xv[q][j][1] + xv[q][j][2] * xv[q][j][2] + xv[q][j][3] * xv[q][j][3]; }
#pragma unroll
            for (int o = 32; o >= 1; o >>= 1)
#pragma unroll
                for (int q = 0; q < NR; ++q) ss[q] += __shfl_xor(ss[q], o);
#pragma unroll
            for (int q = 0; q < NR; ++q) { const int row = row0 + q * nb * 8; const float r = rsqrtf(ss[q] * (1.f / 1024.f) + 1e-6f);
#pragma unroll
                for (int j = 0; j < 4; ++j) { const f32x4 wv4 = *(GAS const f32x4*)(w1 + j * 256 + lane * 4); const f32x4 y = xv[q][j] * r * wv4;
                    u32x2 w; w.x = cvt_pk_bf16(y[0], y[1]); w.y = cvt_pk_bf16(y[2], y[3]); if (row < NTOK) *(GAS u32x2*)(H + (size_t)row * 1024 + j * 256 + lane * 4) = w; } }
        }
    }
}

__device__ void phase_gemm_in(const Params& p, LAS unsigned char* lds, int bid, int nb) {
    pg8::EpiProj E{(unsigned char*)p.ws};
    pg8::Gemm g{BF(p, OFF_H), BF(p, OFF_WIN), 1024, 1024};
    pg8::StaticOrder S; S.init(NTOK, NP1, 1024, nb, bid);
    pg8::gemm_phase(lds, g, S, E);
}
__device__ void phase_gemm_gates(const Params& p, LAS unsigned char* lds, int bid, int nb) {
    pg8::EpiGate E{BF(p, OFF_HF)};
    pg8::Gemm g{BF(p, OFF_H), BF(p, OFF_WG), 1024, 1024};
    pg8::StaticOrder S; S.init(NTOK, 3072, 1024, nb, bid);
    pg8::gemm_phase(lds, g, S, E);
}
__device__ void phase_gemm_branch(const Params& p, LAS unsigned char* lds, int bid, int nb) {
    pg8::EpiBranch E; E.Mg = BF(p, OFF_H); E.G0 = BF(p, OFF_HF);
    pg8::Gemm g{BF(p, OFF_Y), BF(p, OFF_WBR), 2048, 2048};
    pg8::BranchOrder S; S.init(NTOK, 1024, nb, bid);
    pg8::gemm_phase(lds, g, S, E);
}
__device__ void phase_gemm_out(const Params& p, LAS unsigned char* lds, int bid, int nb) {
    pg8::EpiBf16 E{BF(p, OFF_OUT), 1024};
    pg8::Gemm g{BF(p, OFF_H), BF(p, OFF_WOUT), 1024, 1024};
    pg8::StaticOrder S; S.init(NTOK, 1024, 1024, nb, bid);
    pg8::gemm_phase(lds, g, S, E);
}
__device__ void phase_gemm_ffn1(const Params& p, LAS unsigned char* lds, int bid, int nb) {
    pg8::EpiSwiglu E{BF(p, OFF_ACT), D_FF};
    pg8::Gemm g{BF(p, OFF_H), BF(p, OFF_WF1), 1024, 1024};
    pg8::StaticOrder S; S.init(NTOK, 2 * D_FF, 1024, nb, bid);
    pg8::gemm_phase(lds, g, S, E);
}
__device__ void phase_gemm_ffn2(const Params& p, LAS unsigned char* lds, int bid, int nb) {
    pg8::EpiBf16 E{BF(p, OFF_OUT), 1024};
    pg8::Gemm g{BF(p, OFF_ACT), BF(p, OFF_WF2), D_FF, D_FF};
    pg8::StaticOrder S; S.init(NTOK, 1024, D_FF, nb, bid);
    pg8::gemm_phase(lds, g, S, E);
}


__device__ __forceinline__ float hg_lower_bound(const float* lbl, int l, int idx) {
    const float l0 = lbl[idx], l1 = lbl[512 + idx]; const float m = fmaxf(l0, l1), e0 = __expf(l0 - m), e1 = __expf(l1 - m), p0 = e0 / (e0 + e1), p1 = e1 / (e0 + e1);
    return ((l == 0) ? p0 : (p0 + p1)) - p0;
}
__device__ __forceinline__ void pack16_store(LAS unsigned char* dst, const float (&v)[16]) {
    u32x4 a, b; a.x = cvt_pk_bf16(v[0], v[1]); a.y = cvt_pk_bf16(v[2], v[3]); a.z = cvt_pk_bf16(v[4], v[5]); a.w = cvt_pk_bf16(v[6], v[7]);
    b.x = cvt_pk_bf16(v[8], v[9]); b.y = cvt_pk_bf16(v[10], v[11]); b.z = cvt_pk_bf16(v[12], v[13]); b.w = cvt_pk_bf16(v[14], v[15]);
    *(LAS u32x4*)dst = a; *(LAS u32x4*)(dst + 16) = b;
}
#define HG_FRONT()                                                                                                   \
    const int d = tid & 127, seg = tid >> 7;                                                                         \
    const float lbd = hg_lower_bound(IN(p, I_LB), l, h * 128 + d);                                                    \
    float kk[16], cs[16];                                                                                            \
    { float run = 0.f;                                                                                               \
      _Pragma("unroll") for (int jj = 0; jj < 16; ++jj) {                                                            \
          const float fp = bf2f(HF[(size_t)(row0 + seg * 16 + jj) * 512 + h * 128 + d]);                            \
          const float sg = sigmoidf_(fp); const float f = fmaxf(lbd + (1.f - lbd) * sg, 1e-20f);                     \
          kk[jj] = (1.f - lbd) * (1.f - sg); run += __logf(f); cs[jj] = run; }                                       \
      SEG[seg * 128 + d] = run; }

__device__ void phase_hg1(const Params& p, int l, LAS unsigned char* lds, int bid, int nb) {
    const int tid = phase_tid(), lane = tid & 63, w = __builtin_amdgcn_readfirstlane(tid >> 6), fr = lane & 15, g = lane >> 4;
    LAS float* SEG = (LAS float*)lds; LAS unsigned char* KT = lds + 2048; LAS unsigned char* VT = KT + 128 * 144;
    const bf16_t* HF = BF(p, OFF_HF); const bf16_t* HI = BF(p, OFF_HI); bf16_t* ST = BF(p, OFF_ST); float* DEC = F32P(p, OFF_DEC);
    for (int unit = bid; unit < 1024; unit += nb) {
        const int bh = unit >> 6, c = unit & 63, h = bh & 3, row0 = (bh >> 2) * SEQ + c * 64;
        HG_FRONT();
        float vv[16];
#pragma unroll
        for (int jj = 0; jj < 16; ++jj) vv[jj] = bf2f(HI[(size_t)(row0 + seg * 16 + jj) * 512 + h * 128 + d]);
        __syncthreads();
        float off = 0.f, bl = 0.f;
#pragma unroll
        for (int s2 = 0; s2 < 4; ++s2) { const float t = SEG[s2 * 128 + d]; off += (s2 < seg) ? t : 0.f; bl += t; }
        float kb[16];
#pragma unroll
        for (int jj = 0; jj < 16; ++jj) kb[jj] = kk[jj] * __expf(bl - (off + cs[jj]));
        pack16_store(KT + d * 144 + seg * 32, kb);
        pack16_store(VT + d * 144 + seg * 32, vv);
        if (seg == 0) DEC[(size_t)unit * 128 + d] = __expf(bl);
        __syncthreads();
        bf16x8 a[2];
#pragma unroll
        for (int ks = 0; ks < 2; ++ks) a[ks] = *(const LAS bf16x8*)(KT + (16 * w + fr) * 144 + (32 * ks + 8 * g) * 2);
#pragma unroll
        for (int et = 0; et < 8; ++et) {
            f32x4 acc = {0.f, 0.f, 0.f, 0.f};
#pragma unroll
            for (int ks = 0; ks < 2; ++ks) { const bf16x8 b = *(const LAS bf16x8*)(VT + (16 * et + fr) * 144 + (32 * ks + 8 * g) * 2); acc = __builtin_amdgcn_mfma_f32_16x16x32_bf16(a[ks], b, acc, 0, 0, 0); }
            mfma_fence(acc);
            u32x2 o; o.x = cvt_pk_bf16(acc[0], acc[1]); o.y = cvt_pk_bf16(acc[2], acc[3]);
            *(u32x2*)(ST + ((size_t)unit * 128 + 16 * et + fr) * 128 + 16 * w + 4 * g) = o;
        }
        __syncthreads();
    }
}
__device__ void phase_hg2(const Params& p, int bid, int nb) {
    bf16_t* ST = BF(p, OFF_ST); const float* DEC = F32P(p, OFF_DEC);
    for (int gid = bid * 512 + phase_tid(); gid < 16 * 8192; gid += nb * 512) {
        const int bh = gid >> 13, within = gid & 8191, e = within >> 6, d = (within & 63) * 2;
        float s0 = 0.f, s1 = 0.f;
        for (int c0 = 0; c0 < 64; c0 += 8) {
            unsigned u[8]; float d0[8], d1[8];
#pragma unroll
            for (int k = 0; k < 8; ++k) { const size_t un = (size_t)(bh * 64 + c0 + k);
                u[k] = *(const unsigned*)(ST + (un * 128 + e) * 128 + d); d0[k] = DEC[un * 128 + d]; d1[k] = DEC[un * 128 + d + 1]; }
            asm volatile("s_waitcnt vmcnt(0)" ::: "memory");
#pragma unroll
            for (int k = 0; k < 8; ++k) { const size_t un = (size_t)(bh * 64 + c0 + k);
                *(unsigned*)(ST + (un * 128 + e) * 128 + d) = cvt_pk_bf16(s0, s1);
                s0 = d0[k] * s0 + __uint_as_float(u[k] << 16); s1 = d1[k] * s1 + __uint_as_float(u[k] & 0xffff0000u); }
        }
    }
}
template <int PROBE = 0> __device__ void phase_hg3(const Params& p, int l, LAS unsigned char* lds, int bid, int nb) {
    const int tid = phase_tid(), lane = tid & 63, w = __builtin_amdgcn_readfirstlane(tid >> 6), fr = lane & 15, g = lane >> 4;
    LAS float* SEG = (LAS float*)lds;
    LAS unsigned char* QH = lds + 2048; LAS unsigned char* QT = QH + 64 * 272; LAS float* OL = (LAS float*)(lds + 2048);
    LAS unsigned char* KB = lds + 36864; LAS unsigned char* VT = lds + 54272; LAS unsigned char* SP = lds + 72704; LAS unsigned char* PL = lds + 107520;
    const bf16_t* HF = BF(p, OFF_HF); const bf16_t* HI = BF(p, OFF_HI); const bf16_t* HG = BF(p, OFF_HG); const bf16_t* ST = BF(p, OFF_ST); bf16_t* Y = BF(p, OFF_Y);
    float nw[16];
#pragma unroll
    for (int k = 0; k < 16; ++k) nw[k] = IN(p, I_HGNW)[l * 128 + (tid & 7) * 16 + k];
    for (int unit = bid; unit < 1024; unit += nb) {
        const int bh = unit >> 6, c = unit & 63, h = bh & 3, row0 = (bh >> 2) * SEQ + c * 64;
        bf16_t qv[16];
#pragma unroll
        for (int jj = 0; jj < 16; ++jj) qv[jj] = Y[(size_t)(row0 + (tid >> 7) * 16 + jj) * 2048 + h * 128 + (tid & 127)];
        const u32x4 g0 = *(const u32x4*)(HG + (size_t)(row0 + (tid >> 3)) * 512 + h * 128 + (tid & 7) * 16), g1 = *(const u32x4*)(HG + (size_t)(row0 + (tid >> 3)) * 512 + h * 128 + (tid & 7) * 16 + 8);
        HG_FRONT();
        {
#pragma unroll
            for (int k = 0; k < 4; ++k) { const int ch = tid + 512 * k, e = ch >> 4, dc = ch & 15;
                *(LAS u32x4*)(SP + e * 272 + dc * 16) = *(const u32x4*)(ST + ((size_t)unit * 128 + e) * 128 + dc * 8); }
            float vv[16];
#pragma unroll
            for (int jj = 0; jj < 16; ++jj) vv[jj] = bf2f(HI[(size_t)(row0 + seg * 16 + jj) * 512 + h * 128 + d]);
            pack16_store(VT + d * 144 + seg * 32, vv);
        }
        __syncthreads();
        float beta[4]; { float run = 0.f;
#pragma unroll
            for (int s2 = 0; s2 < 4; ++s2) { beta[s2] = run; run += SEG[s2 * 128 + d]; } }
        float off = 0.f;
#pragma unroll
        for (int s2 = 0; s2 < 4; ++s2) off = (s2 == seg) ? beta[s2] : off;
#pragma unroll
        for (int jj = 0; jj < 16; ++jj) {
            const float q = bf2f(qv[jj]);
            const int i = seg * 16 + jj;
            *(LAS bf16_t*)(QH + i * 272 + d * 2) = f2bf(q * __expf(off + cs[jj]));
            *(LAS bf16_t*)(QT + i * 272 + d * 2) = f2bf(q * __expf(cs[jj]));
        }
#pragma unroll
        for (int I = 0; I < 4; ++I) {
            if (seg <= I) {
                float bI = 0.f;
#pragma unroll
                for (int s2 = 0; s2 < 4; ++s2) bI = (s2 == I) ? beta[s2] : bI;
#pragma unroll
                for (int jj = 0; jj < 16; ++jj) *(LAS bf16_t*)(KB + (seg * 16 + jj) * 272 + d * 2) = f2bf(kk[jj] * __expf(fminf(bI - (off + cs[jj]), 60.f)));
            }
            __syncthreads();
            if (w < 4) {
                f32x4 acc = {0.f, 0.f, 0.f, 0.f};
                if (w <= I) {
#pragma unroll
                    for (int ks = 0; ks < 4; ++ks) {
                        const bf16x8 a = *(const LAS bf16x8*)(QT + (16 * I + fr) * 272 + (32 * ks + 8 * g) * 2);
                        const bf16x8 b = *(const LAS bf16x8*)(KB + (16 * w + fr) * 272 + (32 * ks + 8 * g) * 2);
                        acc = __builtin_amdgcn_mfma_f32_16x16x32_bf16(a, b, acc, 0, 0, 0); }
                    mfma_fence(acc);
                    const int lim = (w == I) ? (4 * g) : 1000;
#pragma unroll
                    for (int r = 0; r < 4; ++r) acc[r] = (fr <= lim + r) ? acc[r] : 0.f;
                }
#pragma unroll
                for (int r = 0; r < 4; ++r) *(LAS bf16_t*)(PL + (16 * I + 4 * g + r) * 144 + (16 * w + fr) * 2) = f2bf(acc[r]);
            }
            __syncthreads();
        }
        f32x4 oacc[4];
        { const int ib = w >> 1;
          bf16x8 aq[4], ap[2];
#pragma unroll
          for (int ks = 0; ks < 4; ++ks) aq[ks] = *(const LAS bf16x8*)(QH + (16 * ib + fr) * 272 + (32 * ks + 8 * g) * 2);
#pragma unroll
          for (int ks = 0; ks < 2; ++ks) ap[ks] = *(const LAS bf16x8*)(PL + (16 * ib + fr) * 144 + (32 * ks + 8 * g) * 2);
#pragma unroll
          for (int q4 = 0; q4 < 4; ++q4) { const int et = 4 * (w & 1) + q4; f32x4 acc = {0.f, 0.f, 0.f, 0.f};
#pragma unroll
              for (int ks = 0; ks < 4; ++ks) { const bf16x8 b = *(const LAS bf16x8*)(SP + (16 * et + fr) * 272 + (32 * ks + 8 * g) * 2); acc = __builtin_amdgcn_mfma_f32_16x16x32_bf16(aq[ks], b, acc, 0, 0, 0); }
#pragma unroll
              for (int ks = 0; ks < 2; ++ks) { const bf16x8 b = *(const LAS bf16x8*)(VT + (16 * et + fr) * 144 + (32 * ks + 8 * g) * 2); acc = __builtin_amdgcn_mfma_f32_16x16x32_bf16(ap[ks], b, acc, 0, 0, 0); }
              oacc[q4] = acc; } }
        mfma_fence(oacc[0], oacc[1], oacc[2], oacc[3]);
        __syncthreads();
#pragma unroll
        for (int q4 = 0; q4 < 4; ++q4)
#pragma unroll
            for (int r = 0; r < 4; ++r) OL[(16 * (w >> 1) + 4 * g + r) * 132 + 16 * (4 * (w & 1) + q4) + fr] = oacc[q4][r];
        __syncthreads();
        {
            const int i = tid >> 3, es = (tid & 7) * 16;
            float o[16], ss = 0.f;
#pragma unroll
            for (int k = 0; k < 16; ++k) { o[k] = OL[i * 132 + es + k]; ss += o[k] * o[k]; }
            ss += __shfl_xor(ss, 1); ss += __shfl_xor(ss, 2); ss += __shfl_xor(ss, 4);
            const float rstd = rsqrtf(ss * (1.f / 128.f) + 1e-6f);
            float y[16];
#pragma unroll
            for (int k = 0; k < 16; ++k) { const unsigned gw = (k < 8) ? g0[k >> 1] : g1[(k - 8) >> 1]; const float gv = (k & 1) ? __uint_as_float(gw & 0xffff0000u) : __uint_as_float(gw << 16);
                y[k] = o[k] * rstd * nw[k] * (gv * sigmoidf_(gv)); }
            u32x4 a, b; a.x = cvt_pk_bf16(y[0], y[1]); a.y = cvt_pk_bf16(y[2], y[3]); a.z = cvt_pk_bf16(y[4], y[5]); a.w = cvt_pk_bf16(y[6], y[7]);
            b.x = cvt_pk_bf16(y[8], y[9]); b.y = cvt_pk_bf16(y[10], y[11]); b.z = cvt_pk_bf16(y[12], y[13]); b.w = cvt_pk_bf16(y[14], y[15]);
            bf16_t* yo = PROBE ? ((bf16_t*)((unsigned char*)p.x + 16 * MiB) + (size_t)(row0 + i) * 512 + h * 128 + es) : (Y + (size_t)(row0 + i) * 2048 + h * 128 + es);
            *(u32x4*)yo = a; *(u32x4*)(yo + 8) = b;
        }
        __syncthreads();
    }
}


__device__ void phase_prep(const Params& p, int l, LAS unsigned char* lds, int bid, int nb) {
    const int tid = phase_tid(), lane = tid & 63, wv = tid >> 6;
    {
        LAS float* red = (LAS float*)lds; const bf16_t* MK = BF(p, OFF_MK); float* KM = F32P(p, OFF_KMEAN);
        for (int it = bid; it < 256; it += nb) {
            const int bh = it >> 4, n = it & 15, h = bh & 3, d = tid & 127, part = tid >> 7; const size_t row0 = (size_t)(bh >> 2) * SEQ + n * 256 + part * 64;
            float s = 0.f;
            for (int j = 0; j < 64; ++j) s += bf2f(MK[(row0 + j) * 512 + h * 128 + d]);
            red[part * 128 + d] = s; __syncthreads();
            if (part == 0) KM[(size_t)it * 128 + d] = (red[d] + red[128 + d] + red[256 + d] + red[384 + d]) * (1.f / 256.f);
            __syncthreads();
        }
    }
    bf16_t* CKV = BF(p, OFF_CKV); bf16_t* IKW = BF(p, OFF_IKW); bf16_t* IKT = IKT_PTR(p);
    const float* kvw = IN(p, I_KVN) + l * 256; const float* ikw = IN(p, I_IKNW) + l * 64; const float* ikb = IN(p, I_IKNB) + l * 64;
    for (int row = bid * 8 + wv; row < NTOK; row += nb * 8) {
        {   u32x2* cp = (u32x2*)(CKV + (size_t)row * 256 + lane * 4); const u32x2 v = *cp;
            const float a0 = __uint_as_float(v.x << 16), a1 = __uint_as_float(v.x & 0xffff0000u), a2 = __uint_as_float(v.y << 16), a3 = __uint_as_float(v.y & 0xffff0000u);
            const float ss = wave_sum(a0 * a0 + a1 * a1 + a2 * a2 + a3 * a3); const float r = rsqrtf(ss * (1.f / 256.f) + 1e-6f);
            const f32x4 w4 = *(const f32x4*)(kvw + lane * 4);
            u32x2 o; o.x = cvt_pk_bf16(a0 * r * w4[0], a1 * r * w4[1]); o.y = cvt_pk_bf16(a2 * r * w4[2], a3 * r * w4[3]); *cp = o; }
        {   bf16_t* ip = IKW + (size_t)row * 128; const float u = bf2f(ip[lane]);
            const float mu = wave_sum(u) * (1.f / 64.f); const float xc = u - mu; const float var = wave_sum(xc * xc) * (1.f / 64.f);
            const float y = xc * rsqrtf(var + 1e-6f) * ikw[lane] + ikb[lane];
            const float wgt = (lane < 8) ? bf2f(ip[64 + lane]) * (0.35355339059327373f * 0.125f) : 0.f;
            IKT[(size_t)(row >> 4) * 1024 + (((lane >> 5) * 4 + ((lane >> 3) & 3)) * 16 + (row & 15)) * 8 + (lane & 7)] = f2bf(y); if (lane < 8) ip[64 + lane] = f2bf(wgt); }
    }
}

typedef short v4i16_t __attribute__((ext_vector_type(4)));
__device__ __forceinline__ v4i16_t lds_tr16(const LAS unsigned char* pp) { return __builtin_amdgcn_ds_read_tr16_b64_v4i16((LAS v4i16_t*)pp); }
template <int PROBE = 0> __device__ void phase_moba(const Params& p, LAS unsigned char* lds, int bid, int nb) {
    const int tid = phase_tid(), lane = tid & 63, w = __builtin_amdgcn_readfirstlane(tid >> 6), fr = lane & 15, g = lane >> 4;
    LAS float* BL = (LAS float*)lds; LAS float* KM = (LAS float*)(lds + 16384); LAS float* GG = (LAS float*)(lds + 24576);
    LAS unsigned* SM = (LAS unsigned*)(lds + 32768); LAS unsigned* UM = SM + 128; LAS unsigned* TL = SM + 132;
    LAS unsigned char* QS = lds + 33792; LAS unsigned char* KS = lds + 68608; LAS unsigned char* VS = lds + 86016;
    bf16_t* Y = BF(p, OFF_Y); const bf16_t* MK = BF(p, OFF_MK); const bf16_t* MV = BF(p, OFF_MV);
    const float scale = 0.08838834764831845f * 1.4426950408889634f;
    int hprev = -1;
    for (int j = bid; j < 512; j += nb) {
        const int bh = j & 15, qt = (j < 256) ? (j >> 4) : (31 - ((j - 256) >> 4));
        const int h = bh & 3, brow = (bh >> 2) * SEQ, t0 = qt * 128, blk = qt >> 1;
        if (h != hprev) { __syncthreads(); for (int dd = tid; dd < 4096; dd += 512) BL[dd] = IN(p, I_REL)[rel_bucket(dd) * 8 + h] * 1.4426950408889634f; hprev = h; }
        for (int e = tid; e < 2048; e += 512) KM[e] = F32P(p, OFF_KMEAN)[(size_t)bh * 2048 + e];
#pragma unroll
        for (int k = 0; k < 4; ++k) { const int ch = tid + 512 * k, r = ch >> 4, c = ch & 15;
            *(LAS u32x4*)(QS + r * 272 + c * 16) = *(const u32x4*)(Y + (size_t)(brow + t0 + r) * 2048 + 512 + h * 128 + c * 8); }
        if (tid == 0) *UM = 0u;
        __syncthreads();
        bf16x8 qf[4];
#pragma unroll
        for (int ks = 0; ks < 4; ++ks) qf[ks] = *(const LAS bf16x8*)(QS + (16 * w + fr) * 272 + (32 * ks + 8 * g) * 2);
        {
            f32x4 ga = {0.f, 0.f, 0.f, 0.f};
#pragma unroll
            for (int ks = 0; ks < 4; ++ks) { const f32x4 k0 = *(const LAS f32x4*)(KM + fr * 128 + 32 * ks + 8 * g), k1 = *(const LAS f32x4*)(KM + fr * 128 + 32 * ks + 8 * g + 4);
                u32x4 t; t.x = cvt_pk_bf16(k0[0], k0[1]); t.y = cvt_pk_bf16(k0[2], k0[3]); t.z = cvt_pk_bf16(k1[0], k1[1]); t.w = cvt_pk_bf16(k1[2], k1[3]);
                ga = __builtin_amdgcn_mfma_f32_16x16x32_bf16(__builtin_bit_cast(bf16x8, t), qf[ks], ga, 0, 0, 0); }
            mfma_fence(ga);
            *(LAS f32x4*)(GG + (16 * w + fr) * 16 + 4 * g) = ga;
        }
        __syncthreads();
        if (tid < 128) {
            unsigned used = 0u;
            for (int k = 0; k < 3; ++k) { int best = -1; float bv = 0.f;
                for (int n = 0; n < blk; ++n) { const float v = GG[tid * 16 + n]; if (!((used >> n) & 1u) && (best < 0 || v > bv)) { best = n; bv = v; } }
                if (best >= 0) used |= 1u << best; }
            SM[tid] = used; __hip_atomic_fetch_or((unsigned*)UM, used, __ATOMIC_RELAXED, __HIP_MEMORY_SCOPE_WORKGROUP);
        }
        __syncthreads();
        const unsigned mysel = SM[16 * w + fr];
        const int own_tiles = 2 + 2 * (qt & 1);
        if (tid == 0) {
            const unsigned umask = *UM; int c = 0;
            for (int kt = 0; kt < own_tiles; ++kt) TL[c++] = (unsigned)(blk * 4 + kt);
            for (int n = 0; n < blk; ++n) if ((umask >> n) & 1u) { for (int kt = 0; kt < 4; ++kt) TL[c++] = (unsigned)(n * 4 + kt); }
            TL[64] = (unsigned)c; }
        __syncthreads();
        const int ntiles = (int)TL[64];
        const int tq = t0 + 16 * w + fr;
        f32x4 oacc[8];
#pragma unroll
        for (int dt = 0; dt < 8; ++dt) oacc[dt] = (f32x4){0.f, 0.f, 0.f, 0.f};
        float mrun = -1e30f, lsum = 0.f;
        u32x4 kpre[2], vpre[2];
        { const int key0 = (int)TL[0] * 64;
#pragma unroll
          for (int k = 0; k < 2; ++k) { const int ch = tid + 512 * k, r = ch >> 4, c = ch & 15; const size_t go = (size_t)(brow + key0 + r) * 512 + h * 128 + c * 8; kpre[k] = *(const u32x4*)(MK + go); vpre[k] = *(const u32x4*)(MV + go); } }
        for (int ti = 0; ti < ntiles; ++ti) {
            const int ent = (int)TL[ti], n = ent >> 2, key0 = ent * 64;
            const bool qsel = (n == blk) || ((mysel >> n) & 1u);
            __syncthreads();
#pragma unroll
            for (int k = 0; k < 2; ++k) { const int ch = tid + 512 * k, r = ch >> 4, c = ch & 15; *(LAS u32x4*)(KS + r * 272 + c * 16) = kpre[k]; *(LAS u32x4*)(VS + r * 288 + c * 16) = vpre[k]; }
            __syncthreads();
            if (ti + 1 < ntiles) { const int keyn = (int)TL[ti + 1] * 64;
#pragma unroll
                for (int k = 0; k < 2; ++k) { const int ch = tid + 512 * k, r = ch >> 4, c = ch & 15; const size_t go = (size_t)(brow + keyn + r) * 512 + h * 128 + c * 8; kpre[k] = *(const u32x4*)(MK + go); vpre[k] = *(const u32x4*)(MV + go); } }
            {
                f32x4 s[4];
#pragma unroll
                for (int k4 = 0; k4 < 4; ++k4) { f32x4 acc = {0.f, 0.f, 0.f, 0.f};
#pragma unroll
                    for (int ks = 0; ks < 4; ++ks) { const bf16x8 a = *(const LAS bf16x8*)(KS + (16 * k4 + fr) * 272 + (32 * ks + 8 * g) * 2); acc = __builtin_amdgcn_mfma_f32_16x16x32_bf16(a, qf[ks], acc, 0, 0, 0); }
                    s[k4] = acc; }
                mfma_fence(s[0], s[1], s[2], s[3]);
                float mx = -1e30f;
#pragma unroll
                for (int k4 = 0; k4 < 4; ++k4)
#pragma unroll
                    for (int r = 0; r < 4; ++r) { const int dist = tq - (key0 + 16 * k4 + 4 * g + r); const bool ok = qsel && (dist >= 0);
                        const float lg = s[k4][r] * scale + BL[dist < 0 ? 0 : dist]; s[k4][r] = ok ? lg : -1e30f; mx = fmaxf(mx, s[k4][r]); }
                mx = fmaxf(mx, __shfl_xor(mx, 16)); mx = fmaxf(mx, __shfl_xor(mx, 32));
                const float mnew = fmaxf(mrun, mx), alpha = __builtin_amdgcn_exp2f(mrun - mnew); mrun = mnew;
                float ps = 0.f;
#pragma unroll
                for (int k4 = 0; k4 < 4; ++k4)
#pragma unroll
                    for (int r = 0; r < 4; ++r) { const float pv = (s[k4][r] > -1e29f) ? __builtin_amdgcn_exp2f(s[k4][r] - mnew) : 0.f; s[k4][r] = pv; ps += pv; }
                lsum = lsum * alpha + ps;
                if (__any(alpha != 1.0f)) {
#pragma unroll
                    for (int dt = 0; dt < 8; ++dt) oacc[dt] = oacc[dt] * alpha; }
                bf16x8 pb[2];
#pragma unroll
                for (int m2 = 0; m2 < 2; ++m2) { u32x4 t; t.x = cvt_pk_bf16(s[2 * m2][0], s[2 * m2][1]); t.y = cvt_pk_bf16(s[2 * m2][2], s[2 * m2][3]);
                    t.z = cvt_pk_bf16(s[2 * m2 + 1][0], s[2 * m2 + 1][1]); t.w = cvt_pk_bf16(s[2 * m2 + 1][2], s[2 * m2 + 1][3]); pb[m2] = __builtin_bit_cast(bf16x8, t); }
#pragma unroll
                for (int dt = 0; dt < 8; ++dt)
#pragma unroll
                    for (int m2 = 0; m2 < 2; ++m2) {
                        const LAS unsigned char* va = VS + (32 * m2 + 4 * g + (fr >> 2)) * 288 + (16 * dt + 4 * (fr & 3)) * 2;
                        const v4i16_t lo = lds_tr16(va), hi = lds_tr16(va + 16 * 288);
                        const bf16x8 a = {lo[0], lo[1], lo[2], lo[3], hi[0], hi[1], hi[2], hi[3]};
                        oacc[dt] = __builtin_amdgcn_mfma_f32_16x16x32_bf16(a, pb[m2], oacc[dt], 0, 0, 0); }
            }
        }
        lsum += __shfl_xor(lsum, 16); lsum += __shfl_xor(lsum, 32);
        const float inv = 1.f / lsum;
        mfma_fence(oacc[0], oacc[1], oacc[2], oacc[3]); mfma_fence(oacc[4], oacc[5], oacc[6], oacc[7]);
        __syncthreads();
#pragma unroll
        for (int dt = 0; dt < 8; ++dt) { u32x2 o; o.x = cvt_pk_bf16(oacc[dt][0] * inv, oacc[dt][1] * inv); o.y = cvt_pk_bf16(oacc[dt][2] * inv, oacc[dt][3] * inv);
            if (PROBE) *(u32x2*)((bf16_t*)p.x + (size_t)(brow + tq) * 512 + h * 128 + 16 * dt + 4 * g) = o; else *(u32x2*)(Y + (size_t)(brow + tq) * 2048 + 512 + h * 128 + 16 * dt + 4 * g) = o; }
        __syncthreads();
    }
}


template <int PROBE = 0> __device__ void phase_dsel(const Params& p, LAS unsigned char* lds, int bid, int nb) {
    const int tid = phase_tid(), lane = tid & 63, w = __builtin_amdgcn_readfirstlane(tid >> 6), fr = lane & 15, g = lane >> 4;
    LAS unsigned char* KEYS = lds;
    LAS unsigned char* IQS = lds + 131072;
    const bf16_t* IQ = BF(p, OFF_IQ); const bf16_t* IKW = BF(p, OFF_IKW); const bf16_t* IKT = IKT_PTR(p);
    unsigned* MASK = PROBE ? (unsigned*)((unsigned char*)p.x + (size_t)(PROBE - 1) * 8 * MiB) : (unsigned*)(p.ws + OFF_MASK);
    const int nun = (nb == 256) ? 8 : ((2048 - bid + nb - 1) / nb);
#define DSEL_ITEM(u_) ((nb == 256) ? (((u_) & 1) ? (512 * ((u_) >> 1) + 511 - bid) : (512 * ((u_) >> 1) + bid)) : (bid + (u_) * nb))
    u32x4 iqpre, wpa, wpb; bf16x8 kb0[4][2], kb1[4][2];
#define DSEL_ISSUE(buf, kbase_, base_) do { _Pragma("unroll") for (int j = 0; j < 4; ++j) { int ktl = (base_) + 8 * j; ktl = ktl < 256 ? ktl : 255; const bf16_t* kp = (kbase_) + (size_t)ktl * 1024; \
        (buf)[j][0] = *(const bf16x8*)kp; (buf)[j][1] = *(const bf16x8*)(kp + 512); } } while (0)
#define DSEL_PREFETCH(u_) do { const int k_ = DSEL_ITEM(u_); const int brow_ = (k_ & 3) * SEQ, t0_ = (k_ >> 2) * 8; \
        iqpre = *(const u32x4*)(IQ + (size_t)(brow_ + t0_ + (tid >> 6)) * 512 + (tid & 63) * 8); \
        wpa = *(const u32x4*)(IKW + (size_t)(brow_ + t0_ + 2 * g) * 128 + 64); wpb = *(const u32x4*)(IKW + (size_t)(brow_ + t0_ + 2 * g + 1) * 128 + 64); \
        const bf16_t* kb_ = IKT + (size_t)(brow_ >> 4) * 1024 + (tid & 63) * 8; DSEL_ISSUE(kb0, kb_, w); } while (0)
    if (nun > 0) DSEL_PREFETCH(0);
    for (int u = 0; u < nun; ++u) {
        const int k = DSEL_ITEM(u);
        const int b = k & 3, qt = k >> 2, brow = b * SEQ, t0 = qt * 8, nkt = (t0 + 7) / 16 + 1;
        __syncthreads();
        *(LAS u32x4*)(IQS + (tid >> 6) * 1040 + (tid & 63) * 16) = iqpre;
        __syncthreads();
        {
            bf16x8 aq[4][2];
#pragma unroll
            for (int hp = 0; hp < 4; ++hp)
#pragma unroll
                for (int ks = 0; ks < 2; ++ks) aq[hp][ks] = *(const LAS bf16x8*)(IQS + (fr >> 1) * 1040 + ((2 * hp + (fr & 1)) * 64 + 32 * ks + 8 * g) * 2);
            float wa[8], wb[8];
#pragma unroll
            for (int hh = 0; hh < 8; ++hh) { wa[hh] = (hh & 1) ? __uint_as_float(wpa[hh >> 1] & 0xffff0000u) : __uint_as_float(wpa[hh >> 1] << 16); wb[hh] = (hh & 1) ? __uint_as_float(wpb[hh >> 1] & 0xffff0000u) : __uint_as_float(wpb[hh >> 1] << 16); }
            const int tqa = t0 + 2 * g, tqb = tqa + 1;
            const bf16_t* kbase = IKT + (size_t)(brow >> 4) * 1024 + lane * 8;
#define DSEL_COMPUTE(buf, base_) do { _Pragma("unroll") for (int j = 0; j < 4; ++j) { const int kt = (base_) + 8 * j; if (kt < nkt) { \
                float sa = 0.f, sb = 0.f; \
                f32x4 ah[4]; \
                _Pragma("unroll") for (int hp = 0; hp < 4; ++hp) { f32x4 acc = {0.f, 0.f, 0.f, 0.f}; \
                    acc = __builtin_amdgcn_mfma_f32_16x16x32_bf16(aq[hp][0], (buf)[j][0], acc, 0, 0, 0); acc = __builtin_amdgcn_mfma_f32_16x16x32_bf16(aq[hp][1], (buf)[j][1], acc, 0, 0, 0); ah[hp] = acc; } \
                mfma_fence(ah[0], ah[1], ah[2], ah[3]); \
                _Pragma("unroll") for (int hp = 0; hp < 4; ++hp) { sa += wa[2 * hp] * fmaxf(ah[hp][0], 0.f) + wa[2 * hp + 1] * fmaxf(ah[hp][1], 0.f); sb += wb[2 * hp] * fmaxf(ah[hp][2], 0.f) + wb[2 * hp + 1] * fmaxf(ah[hp][3], 0.f); } \
                const int spos = 16 * kt + fr; \
                unsigned ua = __float_as_uint(sa + 0.0f); ua = (ua & 0x80000000u) ? ~ua : (ua | 0x80000000u); \
                unsigned ub = __float_as_uint(sb + 0.0f); ub = (ub & 0x80000000u) ? ~ub : (ub | 0x80000000u); \
                *(LAS unsigned*)(KEYS + (2 * g) * 16384 + spos * 4) = (spos <= tqa) ? ((ua & 0xfffff000u) | (unsigned)(4095 - spos)) : 0u; \
                *(LAS unsigned*)(KEYS + (2 * g + 1) * 16384 + spos * 4) = (spos <= tqb) ? ((ub & 0xfffff000u) | (unsigned)(4095 - spos)) : 0u; } } } while (0)
            for (int base = w; base < nkt; base += 64) {
                DSEL_ISSUE(kb1, kbase, base + 32);
                DSEL_COMPUTE(kb0, base);
                DSEL_ISSUE(kb0, kbase, base + 64);
                DSEL_COMPUTE(kb1, base + 32);
            }
#undef DSEL_COMPUTE
        }
        __syncthreads();
        if (u + 1 < nun) DSEL_PREFETCH(u + 1);
        {
            const int t = t0 + w; const int nch = 4 * nkt;
            const int mmax = (nch + 63) >> 6;
            u32x4 kr[16];
#pragma unroll
            for (int m = 0; m < 16; ++m) { const int c = lane + 64 * m; const u32x4 z = {0u, 0u, 0u, 0u};
                kr[m] = (m < mmax && c < nch) ? *(const LAS u32x4*)(KEYS + w * 16384 + c * 16) : z; }
            unsigned thr = 1u;
            if (t + 1 > 256) {
                u32x4 gm = kr[0];
#pragma unroll
                for (int m = 1; m < 16; ++m) if (m < mmax) { gm.x = max(gm.x, kr[m].x); gm.y = max(gm.y, kr[m].y); gm.z = max(gm.z, kr[m].z); gm.w = max(gm.w, kr[m].w); }
                unsigned vlo = min(min(gm.x, gm.y), min(gm.z, gm.w)), vhi = max(max(gm.x, gm.y), max(gm.z, gm.w));
#pragma unroll
                for (int o = 32; o >= 1; o >>= 1) { vlo = min(vlo, (unsigned)__shfl_xor((int)vlo, o)); vhi = max(vhi, (unsigned)__shfl_xor((int)vhi, o)); }
                unsigned lo = (unsigned)__builtin_amdgcn_readfirstlane((int)vlo), hi = (unsigned)__builtin_amdgcn_readfirstlane((int)vhi);
                lo = lo > 1u ? lo : 1u;
                while (lo < hi) {
                    const unsigned cand = lo + ((hi - lo + 1u) >> 1);
                    unsigned c0 = 0u, c1 = 0u, c2 = 0u, c3 = 0u;
#define DSEL_CNT1(m_) do { unsigned long long q0_, q1_, q2_, q3_; asm volatile( \
                        "v_cmp_ge_u32_e64 %[q0], %[kx], %[cd]\n\tv_cmp_ge_u32_e64 %[q1], %[ky], %[cd]\n\tv_cmp_ge_u32_e64 %[q2], %[kz], %[cd]\n\tv_cmp_ge_u32_e64 %[q3], %[kw], %[cd]\n\t" \
                        "v_addc_co_u32_e64 %[a0], %[q0], 0, %[a0], %[q0]\n\tv_addc_co_u32_e64 %[a1], %[q1], 0, %[a1], %[q1]\n\tv_addc_co_u32_e64 %[a2], %[q2], 0, %[a2], %[q2]\n\tv_addc_co_u32_e64 %[a3], %[q3], 0, %[a3], %[q3]" \
                        : [q0] "=&s"(q0_), [q1] "=&s"(q1_), [q2] "=&s"(q2_), [q3] "=&s"(q3_), [a0] "+v"(c0), [a1] "+v"(c1), [a2] "+v"(c2), [a3] "+v"(c3) \
                        : [kx] "v"(kr[m_].x), [ky] "v"(kr[m_].y), [kz] "v"(kr[m_].z), [kw] "v"(kr[m_].w), [cd] "s"(cand)); } while (0)
#define DSEL_CNT4(b_) do { DSEL_CNT1((b_)); DSEL_CNT1((b_) + 1); DSEL_CNT1((b_) + 2); DSEL_CNT1((b_) + 3); } while (0)
                    switch ((mmax + 3) >> 2) { case 4: DSEL_CNT4(12); case 3: DSEL_CNT4(8); case 2: DSEL_CNT4(4); default: DSEL_CNT4(0); }
#undef DSEL_CNT4
#undef DSEL_CNT1
                    const unsigned cn = wave_sum_u32((c0 + c1) + (c2 + c3));
                    if (cn >= 256u) { lo = cand; if (cn == 256u) break; } else hi = cand - 1u;
                }
                thr = lo; }
            unsigned* mrow = MASK + (size_t)(brow + t) * 128;
#pragma unroll
            for (int m = 0; m < 16; ++m) {
                unsigned nib = 0u;
                if (m < mmax) nib = ((kr[m].x >= thr) ? 1u : 0u) | ((kr[m].y >= thr) ? 2u : 0u) | ((kr[m].z >= thr) ? 4u : 0u) | ((kr[m].w >= thr) ? 8u : 0u);
                unsigned v = nib << (4 * (lane & 7));
                v |= (unsigned)__builtin_amdgcn_update_dpp(0, (int)v, 0xB1, 0xf, 0xf, true); v |= (unsigned)__builtin_amdgcn_update_dpp(0, (int)v, 0x4E, 0xf, 0xf, true);
                v |= (unsigned)__builtin_amdgcn_update_dpp(0, (int)v, 0x141, 0xf, 0xf, true);
                if ((lane & 7) == 0) mrow[(lane >> 3) + 8 * m] = v;
            }
        }
    }
#undef DSEL_ISSUE
#undef DSEL_PREFETCH
#undef DSEL_ITEM
}

template <int PROBE = 0> __device__ void phase_datt(const Params& p, LAS unsigned char* lds, int bid, int nb) {
    const int tid = phase_tid(), lane = tid & 63, w = __builtin_amdgcn_readfirstlane(tid >> 6), fr = lane & 15, g = lane >> 4;
    LAS unsigned char* BK = lds;
    LAS float* RL = (LAS float*)(lds + 4096);
    LAS unsigned short* IDX = (LAS unsigned short*)(lds + 5120 + w * 512);
    LAS unsigned char* CT = lds + 9216 + w * (32 * 544);
    const bf16_t* CKV = BF(p, OFF_CKV); bf16_t* Y = BF(p, OFF_Y); const unsigned* MASK = (const unsigned*)(p.ws + OFF_MASK);
    for (int dd = tid; dd < 4096; dd += 512) BK[dd] = (unsigned char)rel_bucket(dd);
    if (tid < 256) RL[tid] = IN(p, I_REL)[tid] * 1.4426950408889634f;
    __syncthreads();
    const float scale = 0.08838834764831845f * 1.4426950408889634f;
    const int hd = fr & 3;
    for (int it = bid; it < NTOK / 8; it += nb) {
        const int tg = it * 8 + w, brow = (tg >> 12) * SEQ, t = tg & 4095;
        const u32x2 mw = *(const u32x2*)(MASK + (size_t)tg * 128 + 2 * lane);
        const int cnt = __popc(mw.x) + __popc(mw.y);
        int pre = cnt;
#pragma unroll
        for (int o = 1; o < 64; o <<= 1) { const int v = __shfl_up(pre, o); if (lane >= o) pre += v; }
        const int nsel = __shfl(pre, 63);
        int pos = pre - cnt;
        { unsigned m0 = mw.x; while (m0) { const int bpos = __ffs(m0) - 1; m0 &= m0 - 1; IDX[pos++] = (unsigned short)(64 * lane + bpos); }
          unsigned m1 = mw.y; while (m1) { const int bpos = __ffs(m1) - 1; m1 &= m1 - 1; IDX[pos++] = (unsigned short)(64 * lane + 32 + bpos); } }
        for (int e = nsel + lane; e < 256; e += 64) IDX[e] = 0;
        bf16x8 qb[8];
#pragma unroll
        for (int ks = 0; ks < 8; ++ks) { const u32x4 z = {0u, 0u, 0u, 0u}; const u32x4 v = (fr < 4) ? *(const u32x4*)(Y + (size_t)tg * 2048 + 1024 + fr * 256 + 32 * ks + 8 * g) : z; qb[ks] = __builtin_bit_cast(bf16x8, v); }
        f32x4 oacc[16];
#pragma unroll
        for (int rt = 0; rt < 16; ++rt) oacc[rt] = (f32x4){0.f, 0.f, 0.f, 0.f};
        float mrun = -1e30f, lsum = 0.f;
        const int nstep = (nsel + 31) >> 5;
        u32x4 gr[16];
        const int hi32 = lane >> 5, ch16 = (lane & 31) * 8;
#define DATT_GATHER(st_) do { const LAS u32x4* ip_ = (const LAS u32x4*)(IDX + 32 * (st_)); \
            _Pragma("unroll") for (int q4 = 0; q4 < 4; ++q4) { const u32x4 iv_ = ip_[q4]; \
                _Pragma("unroll") for (int e = 0; e < 4; ++e) { const unsigned row_ = hi32 ? (iv_[e] >> 16) : (iv_[e] & 0xffffu); \
                    gr[4 * q4 + e] = *(const u32x4*)(CKV + (size_t)(brow + (int)row_) * 256 + ch16); } } } while (0)
        DATT_GATHER(0);
        for (int st = 0; st < nstep; ++st) {
#pragma unroll
            for (int i = 0; i < 16; ++i) *(LAS u32x4*)(CT + (2 * i + hi32) * 544 + (lane & 31) * 16) = gr[i];
            f32x4 s0 = {0.f, 0.f, 0.f, 0.f}, s1 = {0.f, 0.f, 0.f, 0.f};
#pragma unroll
            for (int ks = 0; ks < 8; ++ks) { const bf16x8 a0 = *(const LAS bf16x8*)(CT + fr * 544 + (32 * ks + 8 * g) * 2), a1 = *(const LAS bf16x8*)(CT + (16 + fr) * 544 + (32 * ks + 8 * g) * 2);
                s0 = __builtin_amdgcn_mfma_f32_16x16x32_bf16(a0, qb[ks], s0, 0, 0, 0); s1 = __builtin_amdgcn_mfma_f32_16x16x32_bf16(a1, qb[ks], s1, 0, 0, 0); }
            mfma_fence(s0); mfma_fence(s1);
            if (st + 1 < nstep) DATT_GATHER(st + 1);
            float mx = -1e30f;
#pragma unroll
            for (int r = 0; r < 4; ++r) {
                { const int slot = 32 * st + 4 * g + r; const int dist = t - (int)IDX[slot]; const float lg = s0[r] * scale + RL[BK[dist < 0 ? 0 : dist] * 8 + 4 + hd]; s0[r] = (slot < nsel) ? lg : -1e30f; mx = fmaxf(mx, s0[r]); }
                { const int slot = 32 * st + 16 + 4 * g + r; const int dist = t - (int)IDX[slot]; const float lg = s1[r] * scale + RL[BK[dist < 0 ? 0 : dist] * 8 + 4 + hd]; s1[r] = (slot < nsel) ? lg : -1e30f; mx = fmaxf(mx, s1[r]); } }
            mx = fmaxf(mx, __shfl_xor(mx, 16)); mx = fmaxf(mx, __shfl_xor(mx, 32));
            const float mnew = fmaxf(mrun, mx), alpha = __builtin_amdgcn_exp2f(mrun - mnew); mrun = mnew;
            float ps = 0.f;
#pragma unroll
            for (int r = 0; r < 4; ++r) { const float p0 = (s0[r] > -1e29f) ? __builtin_amdgcn_exp2f(s0[r] - mnew) : 0.f, p1 = (s1[r] > -1e29f) ? __builtin_amdgcn_exp2f(s1[r] - mnew) : 0.f; s0[r] = p0; s1[r] = p1; ps += p0 + p1; }
            lsum = lsum * alpha + ps;
            if (__any(alpha != 1.0f)) {
#pragma unroll
                for (int rt = 0; rt < 16; ++rt) oacc[rt] = oacc[rt] * alpha; }
            u32x4 pt; pt.x = cvt_pk_bf16(s0[0], s0[1]); pt.y = cvt_pk_bf16(s0[2], s0[3]); pt.z = cvt_pk_bf16(s1[0], s1[1]); pt.w = cvt_pk_bf16(s1[2], s1[3]);
            const bf16x8 pb = __builtin_bit_cast(bf16x8, pt);
#pragma unroll
            for (int rt = 0; rt < 16; ++rt) {
                const LAS unsigned char* va = CT + (4 * g + (fr >> 2)) * 544 + (16 * rt + 4 * (fr & 3)) * 2;
                const v4i16_t lo = lds_tr16(va), hi = lds_tr16(va + 16 * 544);
                const bf16x8 a = {lo[0], lo[1], lo[2], lo[3], hi[0], hi[1], hi[2], hi[3]};
                oacc[rt] = __builtin_amdgcn_mfma_f32_16x16x32_bf16(a, pb, oacc[rt], 0, 0, 0); }
        }
#undef DATT_GATHER
        lsum += __shfl_xor(lsum, 16); lsum += __shfl_xor(lsum, 32);
        const float inv = 1.f / lsum;
        mfma_fence(oacc[0], oacc[1], oacc[2], oacc[3]); mfma_fence(oacc[4], oacc[5], oacc[6], oacc[7]); mfma_fence(oacc[8], oacc[9], oacc[10], oacc[11]); mfma_fence(oacc[12], oacc[13], oacc[14], oacc[15]);
        if (fr < 4) {
            bf16_t* yo = PROBE ? ((bf16_t*)((unsigned char*)p.x + 32 * MiB) + (size_t)tg * 1024 + fr * 256 + 4 * g) : (Y + (size_t)tg * 2048 + 1024 + fr * 256 + 4 * g);
#pragma unroll
            for (int rt = 0; rt < 16; ++rt) { u32x2 o; o.x = cvt_pk_bf16(oacc[rt][0] * inv, oacc[rt][1] * inv); o.y = cvt_pk_bf16(oacc[rt][2] * inv, oacc[rt][3] * inv); *(u32x2*)(yo + 16 * rt) = o; }
        }
    }
}

__device__ __forceinline__ Params opq(const Params& p) { Params q = p; asm volatile("" : "+s"(q.ws), "+s"(q.x)); return q; }
__device__ __forceinline__ int opqi(int v) { asm volatile("" : "+s"(v)); return v; }
#define GRID_BARRIER() do { XcdBarrier _b; _b.bar = (unsigned*)(opq(p).ws + OFF_CTL); _b.x = xb_xcc_id(); _b.st = (volatile LAS unsigned*)(lds + LDS_PHASE_BYTES); xcd_barrier(_b); } while (0)
#define PP opq(p)
#define BB opqi(bid)
__device__ __forceinline__ void layer_body(const Params& p, LAS unsigned char* lds, const int bid, const int nb, const int l) {
        phase_gemm_in(PP, lds, BB, nb);
        GRID_BARRIER();
        phase_prep(PP, l, lds, BB, nb);
        phase_hg1(PP, l, lds, BB, nb);
        GRID_BARRIER();
        phase_hg2(PP, BB, nb);
        phase_moba(PP, lds, BB, nb);
        phase_dsel(PP, lds, BB, nb);
        GRID_BARRIER();
        phase_hg3(PP, l, lds, BB, nb);
        phase_datt(PP, lds, BB, nb);
        __syncthreads();
        phase_conv_postA(PP, l, lds, BB, nb);
        GRID_BARRIER();
        phase_conv_postB(PP, l, lds, BB, nb);
        phase_gemm_gates(PP, lds, BB, nb);
        GRID_BARRIER();
        phase_gemm_branch(PP, lds, BB, nb);
        GRID_BARRIER();
        phase_gemm_out(PP, lds, BB, nb);
        GRID_BARRIER();
        { const Params q = PP;
          if (l == 0) phase_norm<1, false, true>(IN(q, I_X), BF(q, OFF_XB), BF(q, OFF_OUT), IN(q, I_POSTMIX) + l * 1024, IN(q, I_PREFFN) + l * 1024, BF(q, OFF_H), BB, nb);
          else        phase_norm<1, true, true>((float*)q.x, BF(q, OFF_XB), BF(q, OFF_OUT), IN(q, I_POSTMIX) + l * 1024, IN(q, I_PREFFN) + l * 1024, BF(q, OFF_H), BB, nb); }
        GRID_BARRIER();
        phase_gemm_ffn1(PP, lds, BB, nb);
        GRID_BARRIER();
        phase_gemm_ffn2(PP, lds, BB, nb);
        GRID_BARRIER();
        if (l + 1 < DEPTH) { { const Params q = PP; phase_norm<1, true, true>(BF(q, OFF_XB), (float*)q.x, BF(q, OFF_OUT), IN(q, I_POSTFFN) + l * 1024, IN(q, I_PREMIX) + (l + 1) * 1024, BF(q, OFF_H), BB, nb); } phase_conv_in(PP, l + 1, lds, BB, nb); GRID_BARRIER(); }
        else { const Params q = PP; phase_norm<2, true, false>(BF(q, OFF_XB), (float*)q.x, BF(q, OFF_OUT), IN(q, I_POSTFFN) + l * 1024, nullptr, nullptr, BB, nb); }
}
__global__ __launch_bounds__(512, 2) void mega_fwd(Params p) {
    extern __shared__ __attribute__((aligned(16))) unsigned char shm[];
    LAS unsigned char* lds = (LAS unsigned char*)shm;
    const int bid = blockIdx.x, nb = gridDim.x;
    volatile LAS unsigned* xbw = (volatile LAS unsigned*)(lds + LDS_PHASE_BYTES);
    if (threadIdx.x < 4) xbw[threadIdx.x] = 0u;
    __syncthreads();
    (void)xcd_barrier_post((unsigned*)(p.ws + OFF_CTL), xbw);
    { const Params q = PP; phase_norm<0, false, false>(IN(q, I_X), nullptr, nullptr, nullptr, IN(q, I_PREMIX), BF(q, OFF_H), BB, nb); }
    phase_conv_in(PP, 0, lds, BB, nb);
    GRID_BARRIER();
    for (int l = 0; l < DEPTH; ++l) layer_body(p, lds, bid, nb, l);
}

#define LDS_BYTES (LDS_PHASE_BYTES + 16)
extern "C" void kernel_launch(void* const* d_in, const int* in_sizes, int n_in, void* d_out, int out_size, void* d_ws, size_t ws_size, hipStream_t stream) {
    static int grid = 0;
    if (grid == 0) {
        int dev = 0, cus = 0;
        if (hipGetDevice(&dev) != hipSuccess || hipDeviceGetAttribute(&cus, hipDeviceAttributeMultiprocessorCount, dev) != hipSuccess || cus < 1) { fprintf(stderr, "kernel_launch: no device info\n"); grid = -1; return; }
        if (hipFuncSetAttribute((const void*)mega_fwd, hipFuncAttributeMaxDynamicSharedMemorySize, LDS_BYTES) != hipSuccess) { fprintf(stderr, "kernel_launch: hipFuncSetAttribute failed\n"); grid = -1; return; }
        int per_cu = 0;
        if (hipOccupancyMaxActiveBlocksPerMultiprocessor(&per_cu, (const void*)mega_fwd, 512, LDS_BYTES) != hipSuccess || per_cu < 1) { fprintf(stderr, "kernel_launch: occupancy query says %d blocks per CU\n", per_cu); }
        (void)hipGetLastError();
        grid = cus;
    }
    if (grid < 0) return;
    Params p{};
    for (int i = 0; i < 20; ++i) p.in[i] = (GAS const float*)d_in[i];
    p.x = (GAS float*)d_out; p.ws = (GAS unsigned char*)d_ws;
    if (WS_NEED > ws_size) { fprintf(stderr, "kernel_launch: workspace too small (%zu < %zu)\n", ws_size, (size_t)WS_NEED); return; }
    (void)hipMemsetAsync((unsigned char*)d_ws + OFF_CTL, 0, 16384, stream);
    hipLaunchKernelGGL(mega_fwd, dim3(grid), dim3(512), LDS_BYTES, stream, p);
}
```

```cpp
#include <hip/hip_runtime.h>
#include <stdint.h>
#include <stdio.h>

#define D_MODEL 1024
#define BATCH 4
#define SEQ 4096
#define NTOK 16384
#define DEPTH 2
#define IN_W 8008
#define D_FF 2816
#define NEG_BIG (-1e30f)
#define C_HQ 0
#define C_HF 512
#define C_HI 1024
#define C_HG 1536
#define C_MQ 2048
#define C_MK 2560
#define C_MV 3072
#define C_DQ 3584
#define C_DKV 4096
#define C_IQ 4352
#define C_IK 4864
#define C_IW 4928
#define C_G 4936
#define NP1 5632

#define LAS __attribute__((address_space(3)))
typedef unsigned short bf16_t;
typedef short bf16x8 __attribute__((ext_vector_type(8)));
typedef float f32x4 __attribute__((ext_vector_type(4)));
typedef unsigned u32x4 __attribute__((ext_vector_type(4)));
typedef unsigned u32x2 __attribute__((ext_vector_type(2)));

__device__ __forceinline__ float sigmoidf_(float x) { return __builtin_amdgcn_rcpf(1.f + __expf(-x)); }
__device__ __forceinline__ float bf2f(bf16_t b) { return __uint_as_float(((unsigned)b) << 16); }
typedef __bf16 bf16x2_t __attribute__((ext_vector_type(2)));
typedef float f32x2_t __attribute__((ext_vector_type(2)));
__device__ __forceinline__ unsigned cvt_pk_bf16(float lo, float hi) { const f32x2_t f = {lo, hi}; const bf16x2_t v = __builtin_convertvector(f, bf16x2_t); return __builtin_bit_cast(unsigned, v); }
__device__ __forceinline__ bf16_t f2bf(float f) { return (bf16_t)(cvt_pk_bf16(f, 0.f) & 0xffffu); }
__device__ __forceinline__ int phase_tid() { int t = threadIdx.x; asm volatile("" : "+v"(t)); return t; }
__device__ __forceinline__ void mfma_fence(f32x4& a) { asm volatile("s_nop 15\n\ts_nop 3" : "+v"(a)); }
__device__ __forceinline__ void mfma_fence(f32x4& a, f32x4& b, f32x4& c, f32x4& d) { asm volatile("s_nop 15\n\ts_nop 3" : "+v"(a), "+v"(b), "+v"(c), "+v"(d)); }
__device__ __forceinline__ int rel_bucket(int dist) {
    int n = dist > 0 ? dist : 0;
    if (n < 16) return n;
    float nf = (float)n;
    int large = 16 + (int)(logf(nf / 16.f) / 4.852030263919617f * 16.f);
    return large < 31 ? large : 31;
}

enum { I_X = 0, I_WIN, I_PREMIX, I_POSTMIX, I_PREFFN, I_POSTFFN, I_LB, I_HGNW, I_KVN, I_WUK, I_WUV, I_IKNW, I_IKNB, I_REL, I_WA, I_WB, I_WC, I_WOUT, I_WF1, I_WF2 };
#define GAS __attribute__((address_space(1)))
struct Params { GAS const float* in[20]; GAS float* x; GAS unsigned char* ws; };
#define IN(p, i) ((const float*)(p).in[i])
constexpr size_t MiB = 1024 * 1024;
#define LDS_PHASE_BYTES (150 * 1024)
constexpr size_t OFF_CTL = 0, OFF_Y = 65536, OFF_HF = OFF_Y + 64 * MiB, OFF_HI = OFF_HF + 16 * MiB, OFF_HG = OFF_HI + 16 * MiB, OFF_MK = OFF_HG + 16 * MiB,
                 OFF_MV = OFF_MK + 16 * MiB, OFF_IQ = OFF_MV + 16 * MiB, OFF_CKV = OFF_IQ + 16 * MiB, OFF_IKW = OFF_CKV + 8 * MiB, OFF_H = OFF_IKW + 4 * MiB,
                 OFF_WIN = OFF_H + 32 * MiB, OFF_RS = OFF_WIN + 11 * MiB;
constexpr size_t OFF_WG = OFF_WIN, OFF_WBR = OFF_WG + 6 * MiB, OFF_WOUT = OFF_RS, OFF_WF1 = OFF_WOUT + 2 * MiB, OFF_WF2 = OFF_WF1 + 11 * MiB, OFF_WEND = OFF_WF2 + 6 * MiB;
constexpr size_t OFF_ST = OFF_RS, OFF_TMPF = OFF_RS, OFF_DEC = OFF_ST + 32 * MiB, OFF_MASK = OFF_DEC + MiB / 2, OFF_KMEAN = OFF_MASK + 8 * MiB, OFF_MEND = OFF_KMEAN + MiB / 8;
constexpr size_t OFF_OUT = OFF_HG, OFF_ACT = OFF_Y, OFF_XB = OFF_MV;
constexpr size_t WS_NEED = (OFF_WEND > OFF_MEND ? OFF_WEND : OFF_MEND);
#define BF(p, off) ((bf16_t*)((p).ws + (off)))
#define IKT_PTR(p) ((bf16_t*)((unsigned char*)(p).x + 32 * MiB))
#define F32P(p, off) ((float*)((p).ws + (off)))
__device__ const unsigned long long kP1Off[22] = {OFF_Y, OFF_Y, OFF_HF, OFF_HF, OFF_HI, OFF_HI, OFF_HG, OFF_HG, OFF_Y, OFF_Y, OFF_MK, OFF_MK, OFF_MV, OFF_MV, OFF_Y, OFF_Y, OFF_Y, OFF_Y, OFF_CKV, OFF_IQ, OFF_IQ, OFF_IKW};
__device__ const int kP1Ld[22]  = {2048, 2048, 512, 512, 512, 512, 512, 512, 2048, 2048, 512, 512, 512, 512, 2048, 2048, 2048, 2048, 256, 512, 512, 128};
__device__ const int kP1C0[22]  = {0, 256, 0, 256, 0, 256, 0, 256, 512, 768, 0, 256, 0, 256, 1024, 1280, 1536, 1792, 0, 0, 256, 0};
__device__ const int kP1Nc[22]  = {256, 256, 256, 256, 256, 256, 256, 256, 256, 256, 256, 256, 256, 256, 256, 256, 256, 256, 256, 256, 256, 128};

#define XB_TMO      128
#define XB_XCNT(j)  (256  + 64 * (j))
#define XB_XSUB(j)  (1280 + 64 * (j))
#define XB_XGEN(j)  (2304 + 64 * (j))
#define XB_TOP      3328
#define XB_TOPGEN   3392
#define XCD_BAR_WORDS 3456
#define XB_SPIN_CAP (1u << 18)

__device__ __forceinline__ unsigned xb_ld(unsigned* p)              { return __hip_atomic_load(p, __ATOMIC_RELAXED, __HIP_MEMORY_SCOPE_AGENT); }
__device__ __forceinline__ unsigned xb_add(unsigned* p, unsigned v) { return __hip_atomic_fetch_add(p, v, __ATOMIC_RELAXED, __HIP_MEMORY_SCOPE_AGENT); }
__device__ __forceinline__ unsigned xb_xcc_id() { return (unsigned)__builtin_amdgcn_s_getreg((3 << 11) | 20) & 0xFu; }
#define XB_SPIN(cond, bar) do { unsigned _sp = 0; while (cond) { __builtin_amdgcn_s_sleep(1); \
    if ((++_sp & 255u) == 0u) { if (xb_ld(&(bar)[XB_TMO])) break; if (_sp > XB_SPIN_CAP) { atomicAdd(&(bar)[XB_TMO], 1u); break; } } } } while (0)

struct XcdBarrier {
    unsigned* bar; unsigned x;
    volatile LAS unsigned* st;
};

__device__ __forceinline__ XcdBarrier xcd_barrier_post(unsigned* bar, volatile LAS unsigned* st) {
    XcdBarrier b; b.bar = bar; b.x = xb_xcc_id(); b.st = st;
    if (threadIdx.x == 0) (void)xb_add(&bar[XB_XCNT(b.x)], 1u);
    return b;
}
__device__ __forceinline__ void xcd_barrier_complete(unsigned* bar, unsigned x, unsigned& nloc, unsigned& nx) {
    const unsigned G = gridDim.x * gridDim.y * gridDim.z;
    unsigned sum, cnt, mine, sp = 0u;
    for (;;) {
        sum = 0u; cnt = 0u; mine = 0u;
#pragma unroll
        for (unsigned j = 0; j < 16; ++j) { const unsigned c = xb_ld(&bar[XB_XCNT(j)]); sum += c; cnt += (c > 0u) ? 1u : 0u; mine = (j == x) ? c : mine; }
        if (sum == G) break;
        __builtin_amdgcn_s_sleep(1);
        if ((++sp & 255u) == 0u) { if (xb_ld(&bar[XB_TMO])) break; if (sp > XB_SPIN_CAP) { atomicAdd(&bar[XB_TMO], 1u); break; } }
    }
    nloc = mine > 0u ? mine : 1u; nx = cnt > 0u ? cnt : 1u;
}

__device__ __forceinline__ void xcd_barrier(const XcdBarrier& b) {
    asm volatile("s_waitcnt vmcnt(0)" ::: "memory");
    __syncthreads();
    if (threadIdx.x == 0) {
        unsigned* bar = b.bar;
        __builtin_amdgcn_s_waitcnt(0);
        unsigned nloc = b.st[0], nx = b.st[1];
        if (nloc == 0u) { xcd_barrier_complete(bar, b.x, nloc, nx); b.st[0] = nloc; b.st[1] = nx; }
        const unsigned old = xb_add(&bar[XB_XSUB(b.x)], 1u);
        const unsigned gen = old / nloc;
        if (old + 1u == (gen + 1u) * nloc) {
            __builtin_amdgcn_fence(__ATOMIC_RELEASE, "agent");
            asm volatile("s_waitcnt vmcnt(0)" ::: "memory");
            const unsigned og = xb_add(&bar[XB_TOP], 1u);
            const unsigned tg = og / nx;
            if (og + 1u == (tg + 1u) * nx) xb_add(&bar[XB_TOPGEN], 1u);
            else XB_SPIN(xb_ld(&bar[XB_TOPGEN]) == tg, bar);
            __builtin_amdgcn_fence(__ATOMIC_ACQUIRE, "agent");
            xb_add(&bar[XB_XGEN(b.x)], 1u);
            asm volatile("s_waitcnt vmcnt(0)" ::: "memory");
        } else {
            XB_SPIN(xb_ld(&bar[XB_XGEN(b.x)]) == gen, bar);
            __builtin_amdgcn_fence(__ATOMIC_ACQUIRE, "agent");
            asm volatile("s_waitcnt vmcnt(0)" ::: "memory");
        }
    }
    __syncthreads();
}


namespace pg8 {
constexpr int BM = 256, BK = 64, HALF = 128, HTB = HALF * BK * 2, STAGE_BYTES = 8 * HTB, NXCD = 8, WGM = 8;
__host__ __device__ __forceinline__ int lds_byte(int r, int c) { const int st = (r >> 4) * 2 + (c >> 5), rr = r & 15, cc = c & 31, ob = rr * 64 + cc * 2; return st * 1024 + (ob ^ (((ob >> 9) & 1) << 5)); }
__host__ __device__ __forceinline__ void stage_rc(int b, int& R, int& C) { const int st = b / 1024, sb = b % 1024, swz = sb ^ (((sb >> 9) & 1) << 5); R = (st >> 1) * 16 + swz / 64; C = (st & 1) * 32 + (swz % 64) / 2; }
__host__ __device__ __forceinline__ int perm32(int rho) { const int n = rho >> 4, i = rho & 15; return 8 * (i >> 2) + 4 * n + (i & 3); }

struct Unit { int pm, pn, ka, nt, br; };
struct Gemm { const bf16_t* A; const bf16_t* Bt; int lda, ldb; };

__device__ __forceinline__ bool tile_of(long L, int nM, int nN, int& pm, int& pn) {
    const int nwg = nM * nN; if (L >= nwg) return false;
    int wgid = (int)L; { const int q = nwg / NXCD, r = nwg % NXCD, xcd = wgid % NXCD, off = wgid / NXCD; wgid = (xcd < r ? xcd * (q + 1) : r * (q + 1) + (xcd - r) * q) + off; }
    const int nig = WGM * nN, gid = wgid / nig, fm = gid * WGM, gsz = (nM - fm) < WGM ? (nM - fm) : WGM;
    pm = fm + ((wgid % nig) % gsz); pn = (wgid % nig) / gsz; return true;
}
struct StaticOrder {
    int nM, nN, G, c, nt;
    __device__ void init(int M, int N, int K, int G_, int c_) { nM = M / BM; nN = N / BM; G = G_; c = c_; nt = K / BK; }
    __device__ bool next(int i, Unit& u) const { u.ka = 0; u.nt = nt; u.br = 0; return tile_of((long)i * G + c, nM, nN, u.pm, u.pn); }
};
struct BranchOrder {
    int nM, nN, G, c;
    __device__ void init(int M, int N, int G_, int c_) { nM = M / BM; nN = N / BM; G = G_; c = c_; }
    __device__ bool next(int i, Unit& u) const { const int ti = i / 3, br = i - ti * 3; u.br = br; u.ka = br * 512; u.nt = (br == 2) ? 16 : 8; return tile_of((long)ti * G + c, nM, nN, u.pm, u.pn); }
};

template <class Epi, class Sched>
__device__ __forceinline__ void gemm_phase(LAS unsigned char* lds, const Gemm g, const Sched& S, const Epi& E) {
    const int tid = phase_tid(), wid = __builtin_amdgcn_readfirstlane(tid >> 6), lane = tid & 63, wr = wid >> 2, wc = wid & 3, fr = lane & 15, fq = lane >> 4;
    unsigned voffA[2], voffB[2];
#pragma unroll
    for (int i = 0; i < 2; ++i) { int R, C; stage_rc(tid * 16 + i * 8192, R, C); const int Rb = Epi::PERM ? ((R & ~31) + perm32(R & 31)) : R;
        voffA[i] = (unsigned)(R * g.lda + C) * 2u; voffB[i] = (unsigned)(Rb * g.ldb + C) * 2u; }
    const size_t kstep = (size_t)(BK * 2);
    const size_t hsA = (size_t)HALF * g.lda * 2, hsB = (size_t)HALF * g.ldb * 2;
    const size_t tsA = 2 * hsA, tsB = 2 * hsB;
    const unsigned ldsw = (unsigned)wid * 1024u;
    const int aoff = lds_byte(wr * 64 + fr, fq * 8), boff = lds_byte(wc * 32 + fr, fq * 8);
#define PG8_SA(b, h) (((b) * 2 + (h)) * HTB)
#define PG8_SB(b, h) ((4 + (b) * 2 + (h)) * HTB)
#define PG8_STAGE(bufoff, gbase, voff) do { _Pragma("unroll") for (int _i = 0; _i < 2; ++_i) \
        __builtin_amdgcn_global_load_lds((const unsigned*)((const char*)(gbase) + (voff)[_i]), (LAS unsigned*)(lds + (bufoff) + ldsw + _i * 8192), 16, 0, 0); } while (0)
#define PG8_LDA(dst, b, h) do { _Pragma("unroll") for (int m = 0; m < 4; ++m) _Pragma("unroll") for (int k = 0; k < 2; ++k) dst[m][k] = *(const LAS bf16x8*)(lds + PG8_SA(b, h) + aoff + m * 2048 + k * 1024); } while (0)
#define PG8_LDB(dst, b, h) do { _Pragma("unroll") for (int n = 0; n < 2; ++n) _Pragma("unroll") for (int k = 0; k < 2; ++k) dst[n][k] = *(const LAS bf16x8*)(lds + PG8_SB(b, h) + boff + n * 2048 + k * 1024); } while (0)
#define PG8_MMA(ai, bj, At, Bt) do { __builtin_amdgcn_s_setprio(1); _Pragma("unroll") for (int m = 0; m < 4; ++m) _Pragma("unroll") for (int n = 0; n < 2; ++n) _Pragma("unroll") for (int k = 0; k < 2; ++k) \
        acc[ai][bj][m][n] = __builtin_amdgcn_mfma_f32_16x16x32_bf16(Bt[n][k], At[m][k], acc[ai][bj][m][n], 0, 0, 0); __builtin_amdgcn_s_setprio(0); } while (0)
#define PG8_WAIT_V(n) asm volatile("s_waitcnt vmcnt(" #n ")" ::: "memory")
#define PG8_WAIT_L(n) asm volatile("s_waitcnt lgkmcnt(" #n ")" ::: "memory")
#define PG8_BAR __builtin_amdgcn_s_barrier()
#define PG8_SCHED __builtin_amdgcn_sched_barrier(0)
    Unit cur, nxt; int ui = 0;
    if (!S.next(0, cur)) return;
    f32x4 acc[2][2][4][2];
#pragma unroll
    for (int a = 0; a < 2; ++a)
#pragma unroll
        for (int b = 0; b < 2; ++b)
#pragma unroll
            for (int m = 0; m < 4; ++m)
#pragma unroll
                for (int n = 0; n < 2; ++n) acc[a][b][m][n] = (f32x4){0.f, 0.f, 0.f, 0.f};
    bf16x8 At[4][2], B0[2][2], B1[2][2];
    const char* cA = (const char*)g.A + (size_t)cur.pm * tsA + (size_t)cur.ka * 2; const char* cB = (const char*)g.Bt + (size_t)cur.pn * tsB + (size_t)cur.ka * 2;
    PG8_STAGE(PG8_SB(0, 0), cB, voffB); PG8_STAGE(PG8_SA(0, 0), cA, voffA); PG8_STAGE(PG8_SB(0, 1), cB + hsB, voffB); PG8_STAGE(PG8_SA(0, 1), cA + hsA, voffA);
    if (wr == 1) PG8_BAR;
    PG8_WAIT_V(4); PG8_BAR;
    PG8_STAGE(PG8_SB(1, 0), cB + kstep, voffB); PG8_STAGE(PG8_SA(1, 0), cA + kstep, voffA); PG8_STAGE(PG8_SB(1, 1), cB + hsB + kstep, voffB);
    PG8_WAIT_V(6); PG8_BAR;
    for (;;) {
        const bool has_next = S.next(ui + 1, nxt);
        const char* nA = has_next ? (const char*)g.A + (size_t)nxt.pm * tsA + (size_t)nxt.ka * 2 : cA; const char* nB = has_next ? (const char*)g.Bt + (size_t)nxt.pn * tsB + (size_t)nxt.ka * 2 : cB;
        const int nt = cur.nt;
        for (int t = 0; t < nt; t += 2) {
            const bool last = (t == nt - 2);
            const char* a1 = cA + (size_t)(t + 1) * kstep;
            const char* a2 = last ? nA : cA + (size_t)(t + 2) * kstep; const char* b2 = last ? nB : cB + (size_t)(t + 2) * kstep;
            const char* a3 = a2 + kstep; const char* b3 = b2 + kstep;
            PG8_LDB(B0, 0, 0); PG8_SCHED; PG8_LDA(At, 0, 0); PG8_STAGE(PG8_SA(1, 1), a1 + hsA, voffA);
            PG8_WAIT_L(8); PG8_BAR; PG8_WAIT_L(0); PG8_MMA(0, 0, At, B0); PG8_BAR; PG8_SCHED;
            PG8_LDB(B1, 0, 1); PG8_STAGE(PG8_SB(0, 0), b2, voffB);
            PG8_BAR; PG8_WAIT_L(0); PG8_MMA(0, 1, At, B1); PG8_BAR;
            PG8_LDA(At, 0, 1); PG8_STAGE(PG8_SA(0, 0), a2, voffA);
            PG8_BAR; PG8_WAIT_L(0); PG8_MMA(1, 0, At, B0); PG8_BAR; PG8_SCHED;
            PG8_STAGE(PG8_SB(0, 1), b2 + hsB, voffB);
            PG8_WAIT_V(6); PG8_BAR; PG8_MMA(1, 1, At, B1); PG8_BAR;
            PG8_LDB(B0, 1, 0); PG8_SCHED; PG8_LDA(At, 1, 0); PG8_STAGE(PG8_SA(0, 1), a2 + hsA, voffA);
            PG8_WAIT_L(8); PG8_BAR; PG8_WAIT_L(0); PG8_MMA(0, 0, At, B0); PG8_BAR; PG8_SCHED;
            PG8_LDB(B1, 1, 1); PG8_STAGE(PG8_SB(1, 0), b3, voffB);
            PG8_BAR; PG8_WAIT_L(0); PG8_MMA(0, 1, At, B1); PG8_BAR;
            PG8_LDA(At, 1, 1); PG8_STAGE(PG8_SA(1, 0), a3, voffA);
            PG8_BAR; PG8_WAIT_L(0); PG8_MMA(1, 0, At, B0); PG8_BAR; PG8_SCHED;
            PG8_STAGE(PG8_SB(1, 1), b3 + hsB, voffB);
            PG8_WAIT_V(6); PG8_BAR; PG8_MMA(1, 1, At, B1); PG8_BAR;
        }
        E(acc, cur, wr, wc, fr, fq);
        if (!has_next) break;
#pragma unroll
        for (int a = 0; a < 2; ++a)
#pragma unroll
            for (int b = 0; b < 2; ++b)
#pragma unroll
                for (int m = 0; m < 4; ++m)
#pragma unroll
                    for (int n = 0; n < 2; ++n) acc[a][b][m][n] = (f32x4){0.f, 0.f, 0.f, 0.f};
        cur = nxt; cA = nA; cB = nB; ++ui;
    }
    PG8_WAIT_V(0);
    if (wr == 0) PG8_BAR;
    PG8_BAR;
#undef PG8_SA
#undef PG8_SB
#undef PG8_STAGE
#undef PG8_LDA
#undef PG8_LDB
#undef PG8_MMA
#undef PG8_WAIT_V
#undef PG8_WAIT_L
#undef PG8_BAR
#undef PG8_SCHED
}

struct EpiF32 {
    static constexpr bool PERM = false;
    float* C; int ldc;
    __device__ __forceinline__ void operator()(const f32x4 (&acc)[2][2][4][2], const Unit& u, int wr, int wc, int fr, int fq) const {
        const int row0 = u.pm * BM + wr * 64 + fr, col0 = u.pn * BM + wc * 32 + 4 * fq;
#pragma unroll
        for (int ai = 0; ai < 2; ++ai)
#pragma unroll
            for (int m = 0; m < 4; ++m) { float* rowp = C + (size_t)(row0 + ai * HALF + m * 16) * ldc + col0;
#pragma unroll
                for (int bj = 0; bj < 2; ++bj)
#pragma unroll
                    for (int n = 0; n < 2; ++n) *(f32x4*)(rowp + bj * HALF + n * 16) = acc[ai][bj][m][n]; }
    }
};
struct EpiProj {
    static constexpr bool PERM = true;
    unsigned char* ws;
    __device__ __forceinline__ void operator()(const f32x4 (&acc)[2][2][4][2], const Unit& u, int wr, int wc, int fr, int fq) const {
        bf16_t* base = (bf16_t*)(ws + kP1Off[u.pn]); const int ld = kP1Ld[u.pn], ncol = kP1Nc[u.pn];
        const int row0 = u.pm * BM + wr * 64 + fr, col0 = kP1C0[u.pn] + wc * 32 + 8 * fq;
#pragma unroll
        for (int ai = 0; ai < 2; ++ai)
#pragma unroll
            for (int m = 0; m < 4; ++m) { bf16_t* rowp = base + (size_t)(row0 + ai * HALF + m * 16) * ld + col0;
#pragma unroll
                for (int bj = 0; bj < 2; ++bj) { if (bj * HALF >= ncol) continue;
                    const f32x4 v0 = acc[ai][bj][m][0], v1 = acc[ai][bj][m][1];
                    u32x4 w; w.x = cvt_pk_bf16(v0[0], v0[1]); w.y = cvt_pk_bf16(v0[2], v0[3]); w.z = cvt_pk_bf16(v1[0], v1[1]); w.w = cvt_pk_bf16(v1[2], v1[3]);
                    *(u32x4*)(rowp + bj * HALF) = w; } }
    }
};
struct EpiBf16 {
    static constexpr bool PERM = true;
    bf16_t* C; int ldc;
    __device__ __forceinline__ void operator()(const f32x4 (&acc)[2][2][4][2], const Unit& u, int wr, int wc, int fr, int fq) const {
        const int row0 = u.pm * BM + wr * 64 + fr, col0 = u.pn * BM + wc * 32 + 8 * fq;
#pragma unroll
        for (int ai = 0; ai < 2; ++ai)
#pragma unroll
            for (int m = 0; m < 4; ++m) { bf16_t* rowp = C + (size_t)(row0 + ai * HALF + m * 16) * ldc + col0;
#pragma unroll
                for (int bj = 0; bj < 2; ++bj) {
                    const f32x4 v0 = acc[ai][bj][m][0], v1 = acc[ai][bj][m][1];
                    u32x4 w; w.x = cvt_pk_bf16(v0[0], v0[1]); w.y = cvt_pk_bf16(v0[2], v0[3]); w.z = cvt_pk_bf16(v1[0], v1[1]); w.w = cvt_pk_bf16(v1[2], v1[3]);
                    *(u32x4*)(rowp + bj * HALF) = w; } }
    }
};
struct EpiGate {
    static constexpr bool PERM = true;
    bf16_t* G0;
    __device__ __forceinline__ void operator()(const f32x4 (&acc)[2][2][4][2], const Unit& u, int wr, int wc, int fr, int fq) const {
        bf16_t* base = G0 + (size_t)(u.pn >> 1) * ((size_t)NTOK * 512);
        const int row0 = u.pm * BM + wr * 64 + fr, col0 = (u.pn & 1) * 256 + wc * 32 + 8 * fq;
#pragma unroll
        for (int ai = 0; ai < 2; ++ai)
#pragma unroll
            for (int m = 0; m < 4; ++m) { bf16_t* rowp = base + (size_t)(row0 + ai * HALF + m * 16) * 512 + col0;
#pragma unroll
                for (int bj = 0; bj < 2; ++bj) {
                    f32x4 v0 = acc[ai][bj][m][0], v1 = acc[ai][bj][m][1];
#pragma unroll
                    for (int j = 0; j < 4; ++j) { v0[j] = sigmoidf_(v0[j]); v1[j] = sigmoidf_(v1[j]); }
                    u32x4 w; w.x = cvt_pk_bf16(v0[0], v0[1]); w.y = cvt_pk_bf16(v0[2], v0[3]); w.z = cvt_pk_bf16(v1[0], v1[1]); w.w = cvt_pk_bf16(v1[2], v1[3]);
                    *(u32x4*)(rowp + bj * HALF) = w; } }
    }
};
struct EpiSwiglu {
    static constexpr bool PERM = true;
    bf16_t* O; int ldc;
    __device__ __forceinline__ void operator()(const f32x4 (&acc)[2][2][4][2], const Unit& u, int wr, int wc, int fr, int fq) const {
        const int row0 = u.pm * BM + wr * 64 + fr, col0 = u.pn * HALF + wc * 32 + 8 * fq;
#pragma unroll
        for (int ai = 0; ai < 2; ++ai)
#pragma unroll
            for (int m = 0; m < 4; ++m) { bf16_t* rowp = O + (size_t)(row0 + ai * HALF + m * 16) * ldc + col0;
                float r[8];
#pragma unroll
                for (int n = 0; n < 2; ++n)
#pragma unroll
                    for (int j = 0; j < 4; ++j) { const float gv = acc[ai][0][m][n][j], uv = acc[ai][1][m][n][j]; r[n * 4 + j] = gv * sigmoidf_(gv) * uv; }
                u32x4 w; w.x = cvt_pk_bf16(r[0], r[1]); w.y = cvt_pk_bf16(r[2], r[3]); w.z = cvt_pk_bf16(r[4], r[5]); w.w = cvt_pk_bf16(r[6], r[7]);
                *(u32x4*)rowp = w; }
    }
};
struct EpiBranch {
    static constexpr bool PERM = true;
    bf16_t* Mg; const bf16_t* G0;
    __device__ __forceinline__ void operator()(const f32x4 (&acc)[2][2][4][2], const Unit& u, int wr, int wc, int fr, int fq) const {
        const bf16_t* gb = G0 + (size_t)(u.br * 2 + (u.pn >> 1)) * ((size_t)NTOK * 512);
        const int row0 = u.pm * BM + wr * 64 + fr, cl = wc * 32 + 8 * fq;
#pragma unroll
        for (int ai = 0; ai < 2; ++ai)
#pragma unroll
            for (int m = 0; m < 4; ++m) { const size_t row = (size_t)(row0 + ai * HALF + m * 16);
#pragma unroll
                for (int bj = 0; bj < 2; ++bj) {
                    const u32x4 gw = *(const u32x4*)(gb + row * 512 + (u.pn & 1) * 256 + bj * HALF + cl);
                    bf16_t* mp = Mg + row * 1024 + u.pn * 256 + bj * HALF + cl;
                    float r[8];
#pragma unroll
                    for (int q = 0; q < 4; ++q) { const unsigned g2 = gw[q]; const int n = q >> 1, j = (q & 1) * 2;
                        r[q * 2] = __uint_as_float(g2 << 16) * acc[ai][bj][m][n][j]; r[q * 2 + 1] = __uint_as_float(g2 & 0xffff0000u) * acc[ai][bj][m][n][j + 1]; }
                    if (u.br != 0) { u32x4 ow;
#pragma unroll
                        for (int q = 0; q < 4; ++q) ow[q] = __hip_atomic_load((const unsigned*)mp + q, __ATOMIC_RELAXED, __HIP_MEMORY_SCOPE_AGENT);
#pragma unroll
                        for (int q = 0; q < 4; ++q) { r[q * 2] += __uint_as_float(ow[q] << 16); r[q * 2 + 1] += __uint_as_float(ow[q] & 0xffff0000u); } }
                    u32x4 w; w.x = cvt_pk_bf16(r[0], r[1]); w.y = cvt_pk_bf16(r[2], r[3]); w.z = cvt_pk_bf16(r[4], r[5]); w.w = cvt_pk_bf16(r[6], r[7]);
                    *(u32x4*)mp = w; } }
    }
};
}

template <int MAP> __device__ __forceinline__ int colmap(int n, int off) {
    if (MAP == 0) return n + off;
    if (MAP == 1) { if (n < 3584) return n; const int s = n - 512; return s < C_G ? s : -1; }
    const int pn = n >> 8, r = n & 255; return (r < 128) ? 128 * pn + r : D_FF + 128 * pn + (r - 128);
}
template <int MAP>
__device__ void conv_job(LAS unsigned char* lds, bf16_t* dst_, int ld_dst, int koff, const float* src_, int ld_src, int K, int n_lo, int n_hi, int off, int bid, int nb) {
    GAS bf16_t* dst = (GAS bf16_t*)dst_; GAS const float* src = (GAS const float*)src_;
    const int tid = phase_tid(), wid = __builtin_amdgcn_readfirstlane(tid >> 6), lane = tid & 63;
    LAS float* tile = (LAS float*)lds + wid * (64 * 65);
    const int nk = K / 64, nn = (n_hi - n_lo) / 64;
    const int l4 = lane >> 4, c4 = (lane & 15) * 4, l8 = lane >> 3, k8 = (lane & 7) * 8;
    for (int it = bid * 8 + wid; it < nk * nn; it += nb * 8) {
        const int n0 = n_lo + (it % nn) * 64, k0 = (it / nn) * 64;
        const int cfirst = colmap<MAP>(n0 + c4, off), clast = colmap<MAP>(n0 + c4 + 3, off);
        GAS const float* sp = src + (size_t)(k0 + l4) * ld_src;
        f32x4 v[16];
        if (cfirst >= 0 && clast == cfirst + 3 && ((cfirst | ld_src) & 3) == 0) {
#pragma unroll
            for (int j = 0; j < 16; ++j) v[j] = *(GAS const f32x4*)(sp + (size_t)(4 * j) * ld_src + cfirst);
        } else {
            const int q0 = colmap<MAP>(n0 + c4, off), q1 = colmap<MAP>(n0 + c4 + 1, off), q2 = colmap<MAP>(n0 + c4 + 2, off), q3 = colmap<MAP>(n0 + c4 + 3, off);
#pragma unroll
            for (int j = 0; j < 16; ++j) { GAS const float* r = sp + (size_t)(4 * j) * ld_src;
                v[j][0] = (q0 >= 0) ? r[q0] : 0.f; v[j][1] = (q1 >= 0) ? r[q1] : 0.f; v[j][2] = (q2 >= 0) ? r[q2] : 0.f; v[j][3] = (q3 >= 0) ? r[q3] : 0.f; }
        }
#pragma unroll
        for (int j = 0; j < 16; ++j) { LAS float* t = tile + (4 * j + l4) * 65 + c4; t[0] = v[j][0]; t[1] = v[j][1]; t[2] = v[j][2]; t[3] = v[j][3]; }
        asm volatile("s_waitcnt lgkmcnt(0)" ::: "memory");
#pragma unroll
        for (int jj = 0; jj < 8; ++jj) { const int nr = l8 + 8 * jj; float w8[8];
#pragma unroll
            for (int e = 0; e < 8; ++e) w8[e] = tile[(k8 + e) * 65 + nr];
            u32x4 w; w.x = cvt_pk_bf16(w8[0], w8[1]); w.y = cvt_pk_bf16(w8[2], w8[3]); w.z = cvt_pk_bf16(w8[4], w8[5]); w.w = cvt_pk_bf16(w8[6], w8[7]);
            *(GAS u32x4*)(dst + (size_t)(n0 + nr) * ld_dst + koff + k0 + k8) = w; }
        asm volatile("s_waitcnt lgkmcnt(0)" ::: "memory");
    }
}
__device__ void fold_tile(LAS unsigned char* lds, bf16_t* out, long sOi, long sOj, const float* A, long sAi, long sAd, const float* B, long sBj, long sBd) {
    LAS float* As = (LAS float*)lds; LAS float* Bs = As + 64 * 132;
    const int tid = phase_tid();
    for (int e = tid; e < 64 * 128; e += 512) {
        int i, d; if (sAd == 1) { i = e >> 7; d = e & 127; } else { d = e >> 6; i = e & 63; }
        As[i * 132 + d] = A[i * sAi + d * sAd];
        int j, d2; if (sBd == 1) { j = e >> 7; d2 = e & 127; } else { d2 = e >> 6; j = e & 63; }
        Bs[j * 132 + d2] = B[j * sBj + d2 * sBd];
    }
    __syncthreads();
    const int i = tid & 63, jg = tid >> 6;
    float acc[8];
#pragma unroll
    for (int q = 0; q < 8; ++q) acc[q] = 0.f;
    for (int d = 0; d < 128; d += 4) { const f32x4 a = *(const LAS f32x4*)(As + i * 132 + d);
#pragma unroll
        for (int q = 0; q < 8; ++q) { const f32x4 b = *(const LAS f32x4*)(Bs + (jg * 8 + q) * 132 + d); acc[q] += a[0] * b[0] + a[1] * b[1] + a[2] * b[2] + a[3] * b[3]; } }
#pragma unroll
    for (int q = 0; q < 8; ++q) out[i * sOi + (jg * 8 + q) * sOj] = f2bf(acc[q]);
    __syncthreads();
}

__device__ void phase_conv_in(const Params& p, int l, LAS unsigned char* lds, int bid, int nb) {
    const float* Win = IN(p, I_WIN) + (size_t)l * D_MODEL * IN_W;
    __syncthreads();
    conv_job<1>(lds, BF(p, OFF_WIN), 1024, 0, Win, IN_W, 1024, 0, 3584, 0, bid, nb);
    conv_job<1>(lds, BF(p, OFF_WIN), 1024, 0, Win, IN_W, 1024, 4608, NP1, 0, bid, nb);
    __syncthreads();
    const float* wuk = IN(p, I_WUK) + (size_t)l * 256 * 512;
    for (int it = bid; it < 256; it += nb) { const int h = it >> 6, rb = (it >> 4) & 3, kb = it & 15;
        fold_tile(lds, BF(p, OFF_WIN) + (size_t)(3584 + h * 256 + rb * 64) * 1024 + kb * 64, 1, 1024,
                  Win + (size_t)(kb * 64) * IN_W + C_DQ + h * 128, IN_W, 1, wuk + ((size_t)(rb * 64) * 4 + h) * 128, 512, 1); }
}
__device__ void phase_conv_postA(const Params& p, int l, LAS unsigned char* lds, int bid, int nb) {
    const float* Win = IN(p, I_WIN) + (size_t)l * D_MODEL * IN_W;
    __syncthreads();
    conv_job<0>(lds, BF(p, OFF_WG), 1024, 0, Win, IN_W, 1024, 0, 3072, C_G, bid, nb);
    conv_job<0>(lds, BF(p, OFF_WBR), 2048, 0, IN(p, I_WA) + (size_t)l * 512 * 1024, 1024, 512, 0, 1024, 0, bid, nb);
    conv_job<0>(lds, BF(p, OFF_WBR), 2048, 512, IN(p, I_WB) + (size_t)l * 512 * 1024, 1024, 512, 0, 1024, 0, bid, nb);
    __syncthreads();
    const float* wuv = IN(p, I_WUV) + (size_t)l * 256 * 512; const float* wc = IN(p, I_WC) + (size_t)l * 512 * 1024;
    for (int it = bid; it < 256; it += nb) { const int h = it >> 6, rb = (it >> 4) & 3, nbk = it & 15;
        fold_tile(lds, BF(p, OFF_WBR) + (size_t)(nbk * 64) * 2048 + 1024 + h * 256 + rb * 64, 1, 2048,
                  wuv + ((size_t)(rb * 64) * 4 + h) * 128, 512, 1, wc + (size_t)(h * 128) * 1024 + nbk * 64, 1, 1024); }
}
__device__ void phase_conv_postB(const Params& p, int l, LAS unsigned char* lds, int bid, int nb) {
    __syncthreads();
    conv_job<0>(lds, BF(p, OFF_WOUT), 1024, 0, IN(p, I_WOUT) + (size_t)l * 1024 * 1024, 1024, 1024, 0, 1024, 0, bid, nb);
    conv_job<2>(lds, BF(p, OFF_WF1), 1024, 0, IN(p, I_WF1) + (size_t)l * 1024 * 2 * D_FF, 2 * D_FF, 1024, 0, 2 * D_FF, 0, bid, nb);
    conv_job<0>(lds, BF(p, OFF_WF2), D_FF, 0, IN(p, I_WF2) + (size_t)l * D_FF * 1024, 1024, D_FF, 0, 1024, 0, bid, nb);
    __syncthreads();
}

__device__ __forceinline__ unsigned wave_sum_u32(unsigned v) {
    v += (unsigned)__builtin_amdgcn_update_dpp(0, (int)v, 0x111, 0xf, 0xf, true);
    v += (unsigned)__builtin_amdgcn_update_dpp(0, (int)v, 0x112, 0xf, 0xf, true);
    v += (unsigned)__builtin_amdgcn_update_dpp(0, (int)v, 0x114, 0xf, 0xf, true);
    v += (unsigned)__builtin_amdgcn_update_dpp(0, (int)v, 0x118, 0xf, 0xf, true);
    v += (unsigned)__builtin_amdgcn_update_dpp(0, (int)v, 0x142, 0xa, 0xf, false);
    v += (unsigned)__builtin_amdgcn_update_dpp(0, (int)v, 0x143, 0xc, 0xf, false);
    return (unsigned)__builtin_amdgcn_readlane((int)v, 63);
}
__device__ __forceinline__ float wave_sum(float v) {
#pragma unroll
    for (int o = 32; o >= 1; o >>= 1) v += __shfl_xor(v, o);
    return v;
}
template <int MODE, bool XIN_BF, bool XOUT_BF>
__device__ void phase_norm(const void* xin_, void* xout_, const bf16_t* O_, const float* wpost_, const float* w1_, bf16_t* H_, int bid, int nb) {
    GAS const float* xin = (GAS const float*)xin_; GAS float* xout = (GAS float*)xout_; GAS const bf16_t* xinb = (GAS const bf16_t*)xin_; GAS bf16_t* xoutb = (GAS bf16_t*)xout_;
    GAS const bf16_t* O = (GAS const bf16_t*)O_; GAS const float* wpost = (GAS const float*)wpost_; GAS const float* w1 = (GAS const float*)w1_; GAS bf16_t* H = (GAS bf16_t*)H_;
    const int tidn = phase_tid(); const int wv = tidn >> 6, lane = tidn & 63;
    constexpr int NR = 2;
    for (int row0 = bid * 8 + wv; row0 < NTOK; row0 += NR * nb * 8) {
        f32x4 xv[NR][4], ov[NR][4];
#pragma unroll
        for (int q = 0; q < NR; ++q) { const int row = (row0 + q * nb * 8 < NTOK) ? row0 + q * nb * 8 : row0;
#pragma unroll
            for (int j = 0; j < 4; ++j) {
                if (XIN_BF) { const u32x2 xw = *(GAS const u32x2*)(xinb + (size_t)row * 1024 + j * 256 + lane * 4);
                    xv[q][j] = (f32x4){__uint_as_float(xw.x << 16), __uint_as_float(xw.x & 0xffff0000u), __uint_as_float(xw.y << 16), __uint_as_float(xw.y & 0xffff0000u)}; }
                else xv[q][j] = *(GAS const f32x4*)(xin + (size_t)row * 1024 + j * 256 + lane * 4);
                if (MODE >= 1) { const u32x2 ow = *(GAS const u32x2*)(O + (size_t)row * 1024 + j * 256 + lane * 4);
                    ov[q][j] = (f32x4){__uint_as_float(ow.x << 16), __uint_as_float(ow.x & 0xffff0000u), __uint_as_float(ow.y << 16), __uint_as_float(ow.y & 0xffff0000u)}; } } }
        if (MODE >= 1) {
            float ss[NR];
#pragma unroll
            for (int q = 0; q < NR; ++q) { ss[q] = 0.f;
#pragma unroll
                for (int j = 0; j < 4; ++j) ss[q] += ov[q][j][0] * ov[q][j][0] + ov[q][j][1] * ov[q][j][1] + ov[q][j][2] * ov[q][j][2] + ov[q][j][3] * ov[q][j][3]; }
#pragma unroll
            for (int o = 32; o >= 1; o >>= 1)
#pragma unroll
                for (int q = 0; q < NR; ++q) ss[q] += __shfl_xor(ss[q], o);
#pragma unroll
            for (int q = 0; q < NR; ++q) { const int row = row0 + q * nb * 8; const float r = rsqrtf(ss[q] * (1.f / 1024.f) + 1e-6f);
#pragma unroll
                for (int j = 0; j < 4; ++j) { const f32x4 wv4 = *(GAS const f32x4*)(wpost + j * 256 + lane * 4); xv[q][j] = xv[q][j] + ov[q][j] * r * wv4;
                    if (XOUT_BF) { u32x2 xw; xw.x = cvt_pk_bf16(xv[q][j][0], xv[q][j][1]); xw.y = cvt_pk_bf16(xv[q][j][2], xv[q][j][3]); if (row < NTOK) *(GAS u32x2*)(xoutb + (size_t)row * 1024 + j * 256 + lane * 4) = xw;
                        xv[q][j] = (f32x4){__uint_as_float(xw.x << 16), __uint_as_float(xw.x & 0xffff0000u), __uint_as_float(xw.y << 16), __uint_as_float(xw.y & 0xffff0000u)}; }
                    else if (row < NTOK) *(GAS f32x4*)(xout + (size_t)row * 1024 + j * 256 + lane * 4) = xv[q][j]; } }
        }
        if (MODE <= 1) {
            float ss[NR];
#pragma unroll
            for (int q = 0; q < NR; ++q) { ss[q] = 0.f;
#pragma unroll
                for (int j = 0; j < 4; ++j) ss[q] += xv[q][j][0] * xv[q][j][0] + xv[q][j][1] * xv[q][j][1] + xv[q][j][2] * xv[q][j][2] + xv[q][j][3] * xv[q][j][3]; }
#pragma unroll
            for (int o = 32; o >= 1; o >>= 1)
#pragma unroll
                for (int q = 0; q < NR; ++q) ss[q] += __shfl_xor(ss[q], o);
#pragma unroll
            for (int q = 0; q < NR; ++q) { const int row = row0 + q * nb * 8; const float r = rsqrtf(ss[q] * (1.f / 1024.f) + 1e-6f);
#pragma unroll
                for (int j = 0; j < 4; ++j) { const f32x4 wv4 = *(GAS const f32x4*)(w1 + j * 256 + lane * 4); const f32x4 y = xv[q][j] * r * wv4;
                    u32x2 w; w.x = cvt_pk_bf16(y[0], y[1]); w.y = cvt_pk_bf16(y[2], y[3]); if (row < NTOK) *(GAS u32x2*)(H + (size_t)row * 1024 + j * 256 + lane * 4) = w; } }
        }
    }
}

__device__ void phase_gemm_in(const Params& p, LAS unsigned char* lds, int bid, int nb) {
    pg8::EpiProj E{(unsigned char*)p.ws};
    pg8::Gemm g{BF(p, OFF_H), BF(p, OFF_WIN), 1024, 1024};
    pg8::StaticOrder S; S.init(NTOK, NP1, 1024, nb, bid);
    pg8::gemm_phase(lds, g, S, E);
}
__device__ void phase_gemm_gates(const Params& p, LAS unsigned char* lds, int bid, int nb) {
    pg8::EpiGate E{BF(p, OFF_HF)};
    pg8::Gemm g{BF(p, OFF_H), BF(p, OFF_WG), 1024, 1024};
    pg8::StaticOrder S; S.init(NTOK, 3072, 1024, nb, bid);
    pg8::gemm_phase(lds, g, S, E);
}
__device__ void phase_gemm_branch(const Params& p, LAS unsigned char* lds, int bid, int nb) {
    pg8::EpiBranch E; E.Mg = BF(p, OFF_H); E.G0 = BF(p, OFF_HF);
    pg8::Gemm g{BF(p, OFF_Y), BF(p, OFF_WBR), 2048, 2048};
    pg8::BranchOrder S; S.init(NTOK, 1024, nb, bid);
    pg8::gemm_phase(lds, g, S, E);
}
__device__ void phase_gemm_out(const Params& p, LAS unsigned char* lds, int bid, int nb) {
    pg8::EpiBf16 E{BF(p, OFF_OUT), 1024};
    pg8::Gemm g{BF(p, OFF_H), BF(p, OFF_WOUT), 1024, 1024};
    pg8::StaticOrder S; S.init(NTOK, 1024, 1024, nb, bid);
    pg8::gemm_phase(lds, g, S, E);
}
__device__ void phase_gemm_ffn1(const Params& p, LAS unsigned char* lds, int bid, int nb) {
    pg8::EpiSwiglu E{BF(p, OFF_ACT), D_FF};
    pg8::Gemm g{BF(p, OFF_H), BF(p, OFF_WF1), 1024, 1024};
    pg8::StaticOrder S; S.init(NTOK, 2 * D_FF, 1024, nb, bid);
    pg8::gemm_phase(lds, g, S, E);
}
__device__ void phase_gemm_ffn2(const Params& p, LAS unsigned char* lds, int bid, int nb) {
    pg8::EpiBf16 E{BF(p, OFF_OUT), 1024};
    pg8::Gemm g{BF(p, OFF_ACT), BF(p, OFF_WF2), D_FF, D_FF};
    pg8::StaticOrder S; S.init(NTOK, 1024, D_FF, nb, bid);
    pg8::gemm_phase(lds, g, S, E);
}


__device__ __forceinline__ float hg_lower_bound(const float* lbl, int l, int idx) {
    const float l0 = lbl[idx], l1 = lbl[512 + idx]; const float m = fmaxf(l0, l1), e0 = __expf(l0 - m), e1 = __expf(l1 - m), p0 = e0 / (e0 + e1), p1 = e1 / (e0 + e1);
    return ((l == 0) ? p0 : (p0 + p1)) - p0;
}
__device__ __forceinline__ void pack16_store(LAS unsigned char* dst, const float (&v)[16]) {
    u32x4 a, b; a.x = cvt_pk_bf16(v[0], v[1]); a.y = cvt_pk_bf16(v[2], v[3]); a.z = cvt_pk_bf16(v[4], v[5]); a.w = cvt_pk_bf16(v[6], v[7]);
    b.x = cvt_pk_bf16(v[8], v[9]); b.y = cvt_pk_bf16(v[10], v[11]); b.z = cvt_pk_bf16(v[12], v[13]); b.w = cvt_pk_bf16(v[14], v[15]);
    *(LAS u32x4*)dst = a; *(LAS u32x4*)(dst + 16) = b;
}
#define HG_FRONT()                                                                                                   \
    const int d = tid & 127, seg = tid >> 7;                                                                         \
    const float lbd = hg_lower_bound(IN(p, I_LB), l, h * 128 + d);                                                    \
    float kk[16], cs[16];                                                                                            \
    { float run = 0.f;                                                                                               \
      _Pragma("unroll") for (int jj = 0; jj < 16; ++jj) {                                                            \
          const float fp = bf2f(HF[(size_t)(row0 + seg * 16 + jj) * 512 + h * 128 + d]);                            \
          const float sg = sigmoidf_(fp); const float f = fmaxf(lbd + (1.f - lbd) * sg, 1e-20f);                     \
          kk[jj] = (1.f - lbd) * (1.f - sg); run += __builtin_amdgcn_logf(f) * 0.6931471805599453f; cs[jj] = run; }                                              \
      SEG[seg * 128 + d] = run; }

__device__ void phase_hg1(const Params& p, int l, LAS unsigned char* lds, int bid, int nb) {
    const int tid = phase_tid(), lane = tid & 63, w = __builtin_amdgcn_readfirstlane(tid >> 6), fr = lane & 15, g = lane >> 4;
    LAS float* SEG = (LAS float*)lds; LAS unsigned char* KT = lds + 2048; LAS unsigned char* VT = KT + 128 * 144;
    const bf16_t* HF = BF(p, OFF_HF); const bf16_t* HI = BF(p, OFF_HI); bf16_t* ST = BF(p, OFF_ST); float* DEC = F32P(p, OFF_DEC);
    for (int unit = bid; unit < 1024; unit += nb) {
        const int bh = unit >> 6, c = unit & 63, h = bh & 3, row0 = (bh >> 2) * SEQ + c * 64;
        HG_FRONT();
        float vv[16];
#pragma unroll
        for (int jj = 0; jj < 16; ++jj) vv[jj] = bf2f(HI[(size_t)(row0 + seg * 16 + jj) * 512 + h * 128 + d]);
        __syncthreads();
        float off = 0.f, bl = 0.f;
#pragma unroll
        for (int s2 = 0; s2 < 4; ++s2) { const float t = SEG[s2 * 128 + d]; off += (s2 < seg) ? t : 0.f; bl += t; }
        float kb[16];
#pragma unroll
        for (int jj = 0; jj < 16; ++jj) kb[jj] = kk[jj] * __expf(bl - (off + cs[jj]));
        pack16_store(KT + d * 144 + seg * 32, kb);
        pack16_store(VT + d * 144 + seg * 32, vv);
        if (seg == 0) DEC[(size_t)unit * 128 + d] = __expf(bl);
        __syncthreads();
        bf16x8 a[2];
#pragma unroll
        for (int ks = 0; ks < 2; ++ks) a[ks] = *(const LAS bf16x8*)(KT + (16 * w + fr) * 144 + (32 * ks + 8 * g) * 2);
#pragma unroll
        for (int et = 0; et < 8; ++et) {
            f32x4 acc = {0.f, 0.f, 0.f, 0.f};
#pragma unroll
            for (int ks = 0; ks < 2; ++ks) { const bf16x8 b = *(const LAS bf16x8*)(VT + (16 * et + fr) * 144 + (32 * ks + 8 * g) * 2); acc = __builtin_amdgcn_mfma_f32_16x16x32_bf16(a[ks], b, acc, 0, 0, 0); }
            mfma_fence(acc);
            u32x2 o; o.x = cvt_pk_bf16(acc[0], acc[1]); o.y = cvt_pk_bf16(acc[2], acc[3]);
            *(u32x2*)(ST + ((size_t)unit * 128 + 16 * et + fr) * 128 + 16 * w + 4 * g) = o;
        }
        __syncthreads();
    }
}
__device__ void phase_hg2(const Params& p, int bid, int nb) {
    bf16_t* ST = BF(p, OFF_ST); const float* DEC = F32P(p, OFF_DEC);
    for (int gid = bid * 512 + phase_tid(); gid < 16 * 8192; gid += nb * 512) {
        const int bh = gid >> 13, within = gid & 8191, e = within >> 6, d = (within & 63) * 2;
        float s0 = 0.f, s1 = 0.f;
        for (int c0 = 0; c0 < 64; c0 += 8) {
            unsigned u[8]; float d0[8], d1[8];
#pragma unroll
            for (int k = 0; k < 8; ++k) { const size_t un = (size_t)(bh * 64 + c0 + k);
                u[k] = *(const unsigned*)(ST + (un * 128 + e) * 128 + d); d0[k] = DEC[un * 128 + d]; d1[k] = DEC[un * 128 + d + 1]; }
            asm volatile("s_waitcnt vmcnt(0)" ::: "memory");
#pragma unroll
            for (int k = 0; k < 8; ++k) { const size_t un = (size_t)(bh * 64 + c0 + k);
                *(unsigned*)(ST + (un * 128 + e) * 128 + d) = cvt_pk_bf16(s0, s1);
                s0 = d0[k] * s0 + __uint_as_float(u[k] << 16); s1 = d1[k] * s1 + __uint_as_float(u[k] & 0xffff0000u); }
        }
    }
}
template <int PROBE = 0> __device__ void phase_hg3(const Params& p, int l, LAS unsigned char* lds, int bid, int nb) {
    const int tid = phase_tid(), lane = tid & 63, w = __builtin_amdgcn_readfirstlane(tid >> 6), fr = lane & 15, g = lane >> 4;
    LAS float* SEG = (LAS float*)lds;
    LAS unsigned char* QH = lds + 2048; LAS unsigned char* QT = QH + 64 * 272; LAS float* OL = (LAS float*)(lds + 2048);
    LAS unsigned char* KB = lds + 36864; LAS unsigned char* VT = lds + 54272; LAS unsigned char* SP = lds + 72704; LAS unsigned char* PL = lds + 107520;
    const bf16_t* HF = BF(p, OFF_HF); const bf16_t* HI = BF(p, OFF_HI); const bf16_t* HG = BF(p, OFF_HG); const bf16_t* ST = BF(p, OFF_ST); bf16_t* Y = BF(p, OFF_Y);
    float nw[16];
#pragma unroll
    for (int k = 0; k < 16; ++k) nw[k] = IN(p, I_HGNW)[l * 128 + (tid & 7) * 16 + k];
    for (int unit = bid; unit < 1024; unit += nb) {
        const int bh = unit >> 6, c = unit & 63, h = bh & 3, row0 = (bh >> 2) * SEQ + c * 64;
        bf16_t qv[16];
#pragma unroll
        for (int jj = 0; jj < 16; ++jj) qv[jj] = Y[(size_t)(row0 + (tid >> 7) * 16 + jj) * 2048 + h * 128 + (tid & 127)];
        const u32x4 g0 = *(const u32x4*)(HG + (size_t)(row0 + (tid >> 3)) * 512 + h * 128 + (tid & 7) * 16), g1 = *(const u32x4*)(HG + (size_t)(row0 + (tid >> 3)) * 512 + h * 128 + (tid & 7) * 16 + 8);
        HG_FRONT();
        {
#pragma unroll
            for (int k = 0; k < 4; ++k) { const int ch = tid + 512 * k, e = ch >> 4, dc = ch & 15;
                *(LAS u32x4*)(SP + e * 272 + dc * 16) = *(const u32x4*)(ST + ((size_t)unit * 128 + e) * 128 + dc * 8); }
            float vv[16];
#pragma unroll
            for (int jj = 0; jj < 16; ++jj) vv[jj] = bf2f(HI[(size_t)(row0 + seg * 16 + jj) * 512 + h * 128 + d]);
            pack16_store(VT + d * 144 + seg * 32, vv);
        }
        __syncthreads();
        float beta[4]; { float run = 0.f;
#pragma unroll
            for (int s2 = 0; s2 < 4; ++s2) { beta[s2] = run; run += SEG[s2 * 128 + d]; } }
        float off = 0.f;
#pragma unroll
        for (int s2 = 0; s2 < 4; ++s2) off = (s2 == seg) ? beta[s2] : off;
#pragma unroll
        for (int jj = 0; jj < 16; ++jj) {
            const float q = bf2f(qv[jj]);
            const int i = seg * 16 + jj;
            *(LAS bf16_t*)(QH + i * 272 + d * 2) = f2bf(q * __expf(off + cs[jj]));
            *(LAS bf16_t*)(QT + i * 272 + d * 2) = f2bf(q * __expf(cs[jj]));
        }
#pragma unroll
        for (int I = 0; I < 4; ++I) {
            if (seg <= I) {
                float bI = 0.f;
#pragma unroll
                for (int s2 = 0; s2 < 4; ++s2) bI = (s2 == I) ? beta[s2] : bI;
#pragma unroll
                for (int jj = 0; jj < 16; ++jj) *(LAS bf16_t*)(KB + (seg * 16 + jj) * 272 + d * 2) = f2bf(kk[jj] * __expf(fminf(bI - (off + cs[jj]), 60.f)));
            }
            __syncthreads();
            if (w < 4) {
                f32x4 acc = {0.f, 0.f, 0.f, 0.f};
                if (w <= I) {
#pragma unroll
                    for (int ks = 0; ks < 4; ++ks) {
                        const bf16x8 a = *(const LAS bf16x8*)(QT + (16 * I + fr) * 272 + (32 * ks + 8 * g) * 2);
                        const bf16x8 b = *(const LAS bf16x8*)(KB + (16 * w + fr) * 272 + (32 * ks + 8 * g) * 2);
                        acc = __builtin_amdgcn_mfma_f32_16x16x32_bf16(a, b, acc, 0, 0, 0); }
                    mfma_fence(acc);
                    const int lim = (w == I) ? (4 * g) : 1000;
#pragma unroll
                    for (int r = 0; r < 4; ++r) acc[r] = (fr <= lim + r) ? acc[r] : 0.f;
                }
#pragma unroll
                for (int r = 0; r < 4; ++r) *(LAS bf16_t*)(PL + (16 * I + 4 * g + r) * 144 + (16 * w + fr) * 2) = f2bf(acc[r]);
            }
            __syncthreads();
        }
        f32x4 oacc[4];
        { const int ib = w >> 1;
          bf16x8 aq[4], ap[2];
#pragma unroll
          for (int ks = 0; ks < 4; ++ks) aq[ks] = *(const LAS bf16x8*)(QH + (16 * ib + fr) * 272 + (32 * ks + 8 * g) * 2);
#pragma unroll
          for (int ks = 0; ks < 2; ++ks) ap[ks] = *(const LAS bf16x8*)(PL + (16 * ib + fr) * 144 + (32 * ks + 8 * g) * 2);
#pragma unroll
          for (int q4 = 0; q4 < 4; ++q4) { const int et = 4 * (w & 1) + q4; f32x4 acc = {0.f, 0.f, 0.f, 0.f};
#pragma unroll
              for (int ks = 0; ks < 4; ++ks) { const bf16x8 b = *(const LAS bf16x8*)(SP + (16 * et + fr) * 272 + (32 * ks + 8 * g) * 2); acc = __builtin_amdgcn_mfma_f32_16x16x32_bf16(aq[ks], b, acc, 0, 0, 0); }
#pragma unroll
              for (int ks = 0; ks < 2; ++ks) { const bf16x8 b = *(const LAS bf16x8*)(VT + (16 * et + fr) * 144 + (32 * ks + 8 * g) * 2); acc = __builtin_amdgcn_mfma_f32_16x16x32_bf16(ap[ks], b, acc, 0, 0, 0); }
              oacc[q4] = acc; } }
        mfma_fence(oacc[0], oacc[1], oacc[2], oacc[3]);
        __syncthreads();
#pragma unroll
        for (int q4 = 0; q4 < 4; ++q4)
#pragma unroll
            for (int r = 0; r < 4; ++r) OL[(16 * (w >> 1) + 4 * g + r) * 132 + 16 * (4 * (w & 1) + q4) + fr] = oacc[q4][r];
        __syncthreads();
        {
            const int i = tid >> 3, es = (tid & 7) * 16;
            float o[16], ss = 0.f;
#pragma unroll
            for (int k = 0; k < 16; ++k) { o[k] = OL[i * 132 + es + k]; ss += o[k] * o[k]; }
            ss += __shfl_xor(ss, 1); ss += __shfl_xor(ss, 2); ss += __shfl_xor(ss, 4);
            const float rstd = rsqrtf(ss * (1.f / 128.f) + 1e-6f);
            float y[16];
#pragma unroll
            for (int k = 0; k < 16; ++k) { const unsigned gw = (k < 8) ? g0[k >> 1] : g1[(k - 8) >> 1]; const float gv = (k & 1) ? __uint_as_float(gw & 0xffff0000u) : __uint_as_float(gw << 16);
                y[k] = o[k] * rstd * nw[k] * (gv * sigmoidf_(gv)); }
            u32x4 a, b; a.x = cvt_pk_bf16(y[0], y[1]); a.y = cvt_pk_bf16(y[2], y[3]); a.z = cvt_pk_bf16(y[4], y[5]); a.w = cvt_pk_bf16(y[6], y[7]);
            b.x = cvt_pk_bf16(y[8], y[9]); b.y = cvt_pk_bf16(y[10], y[11]); b.z = cvt_pk_bf16(y[12], y[13]); b.w = cvt_pk_bf16(y[14], y[15]);
            bf16_t* yo = PROBE ? ((bf16_t*)((unsigned char*)p.x + 16 * MiB) + (size_t)(row0 + i) * 512 + h * 128 + es) : (Y + (size_t)(row0 + i) * 2048 + h * 128 + es);
            *(u32x4*)yo = a; *(u32x4*)(yo + 8) = b;
        }
        __syncthreads();
    }
}


__device__ void phase_prep(const Params& p, int l, LAS unsigned char* lds, int bid, int nb) {
    const int tid = phase_tid(), lane = tid & 63, wv = tid >> 6;
    {
        LAS float* red = (LAS float*)lds; const bf16_t* MK = BF(p, OFF_MK); float* KM = F32P(p, OFF_KMEAN);
        for (int it = bid; it < 256; it += nb) {
            const int bh = it >> 4, n = it & 15, h = bh & 3, d = tid & 127, part = tid >> 7; const size_t row0 = (size_t)(bh >> 2) * SEQ + n * 256 + part * 64;
            float s = 0.f;
            for (int j = 0; j < 64; ++j) s += bf2f(MK[(row0 + j) * 512 + h * 128 + d]);
            red[part * 128 + d] = s; __syncthreads();
            if (part == 0) KM[(size_t)it * 128 + d] = (red[d] + red[128 + d] + red[256 + d] + red[384 + d]) * (1.f / 256.f);
            __syncthreads();
        }
    }
    bf16_t* CKV = BF(p, OFF_CKV); bf16_t* IKW = BF(p, OFF_IKW); bf16_t* IKT = IKT_PTR(p);
    const float* kvw = IN(p, I_KVN) + l * 256; const float* ikw = IN(p, I_IKNW) + l * 64; const float* ikb = IN(p, I_IKNB) + l * 64;
    for (int row = bid * 8 + wv; row < NTOK; row += nb * 8) {
        {   u32x2* cp = (u32x2*)(CKV + (size_t)row * 256 + lane * 4); const u32x2 v = *cp;
            const float a0 = __uint_as_float(v.x << 16), a1 = __uint_as_float(v.x & 0xffff0000u), a2 = __uint_as_float(v.y << 16), a3 = __uint_as_float(v.y & 0xffff0000u);
            const float ss = wave_sum(a0 * a0 + a1 * a1 + a2 * a2 + a3 * a3); const float r = rsqrtf(ss * (1.f / 256.f) + 1e-6f);
            const f32x4 w4 = *(const f32x4*)(kvw + lane * 4);
            u32x2 o; o.x = cvt_pk_bf16(a0 * r * w4[0], a1 * r * w4[1]); o.y = cvt_pk_bf16(a2 * r * w4[2], a3 * r * w4[3]); *cp = o; }
        {   bf16_t* ip = IKW + (size_t)row * 128; const float u = bf2f(ip[lane]);
            const float mu = wave_sum(u) * (1.f / 64.f); const float xc = u - mu; const float var = wave_sum(xc * xc) * (1.f / 64.f);
            const float y = xc * rsqrtf(var + 1e-6f) * ikw[lane] + ikb[lane];
            const float wgt = (lane < 8) ? bf2f(ip[64 + lane]) * (0.35355339059327373f * 0.125f) : 0.f;
            IKT[(size_t)(row >> 4) * 1024 + (((lane >> 5) * 4 + ((lane >> 3) & 3)) * 16 + (row & 15)) * 8 + (lane & 7)] = f2bf(y); if (lane < 8) ip[64 + lane] = f2bf(wgt); }
    }
}

typedef short v4i16_t __attribute__((ext_vector_type(4)));
__device__ __forceinline__ v4i16_t lds_tr16(const LAS unsigned char* pp) { return __builtin_amdgcn_ds_read_tr16_b64_v4i16((LAS v4i16_t*)pp); }
template <int PROBE = 0> __device__ void phase_moba(const Params& p, LAS unsigned char* lds, int bid, int nb) {
    const int tid = phase_tid(), lane = tid & 63, w = __builtin_amdgcn_readfirstlane(tid >> 6), fr = lane & 15, g = lane >> 4;
    LAS float* BL = (LAS float*)lds; LAS float* KM = (LAS float*)(lds + 16400); LAS float* GG = (LAS float*)(lds + 24592);
    LAS unsigned* SM = (LAS unsigned*)(lds + 32784); LAS unsigned* UM = SM + 128; LAS unsigned* TL = SM + 132;
    LAS unsigned char* QS = lds + 33808; LAS unsigned char* KS = lds + 68624; LAS unsigned char* VS = lds + 86032;
    bf16_t* Y = BF(p, OFF_Y); const bf16_t* MK = BF(p, OFF_MK); const bf16_t* MV = BF(p, OFF_MV);
    const float scale = 0.08838834764831845f * 1.4426950408889634f;
    int hprev = -1;
    for (int j = bid; j < 512; j += nb) {
        const int bh = j & 15, qt = (j < 256) ? (j >> 4) : (31 - ((j - 256) >> 4));
        const int h = bh & 3, brow = (bh >> 2) * SEQ, t0 = qt * 128, blk = qt >> 1;
        if (h != hprev) { __syncthreads(); for (int dd = tid; dd < 4096; dd += 512) BL[dd] = IN(p, I_REL)[rel_bucket(dd) * 8 + h] * 1.4426950408889634f; if (tid == 0) BL[4096] = -1e30f; hprev = h; }
        for (int e = tid; e < 2048; e += 512) KM[e] = F32P(p, OFF_KMEAN)[(size_t)bh * 2048 + e];
#pragma unroll
        for (int k = 0; k < 4; ++k) { const int ch = tid + 512 * k, r = ch >> 4, c = ch & 15;
            *(LAS u32x4*)(QS + r * 272 + c * 16) = *(const u32x4*)(Y + (size_t)(brow + t0 + r) * 2048 + 512 + h * 128 + c * 8); }
        if (tid == 0) *UM = 0u;
        __syncthreads();
        bf16x8 qf[4];
#pragma unroll
        for (int ks = 0; ks < 4; ++ks) qf[ks] = *(const LAS bf16x8*)(QS + (16 * w + fr) * 272 + (32 * ks + 8 * g) * 2);
        {
            f32x4 ga = {0.f, 0.f, 0.f, 0.f};
#pragma unroll
            for (int ks = 0; ks < 4; ++ks) { const f32x4 k0 = *(const LAS f32x4*)(KM + fr * 128 + 32 * ks + 8 * g), k1 = *(const LAS f32x4*)(KM + fr * 128 + 32 * ks + 8 * g + 4);
                u32x4 t; t.x = cvt_pk_bf16(k0[0], k0[1]); t.y = cvt_pk_bf16(k0[2], k0[3]); t.z = cvt_pk_bf16(k1[0], k1[1]); t.w = cvt_pk_bf16(k1[2], k1[3]);
                ga = __builtin_amdgcn_mfma_f32_16x16x32_bf16(__builtin_bit_cast(bf16x8, t), qf[ks], ga, 0, 0, 0); }
            mfma_fence(ga);
            *(LAS f32x4*)(GG + (16 * w + fr) * 16 + 4 * g) = ga;
        }
        __syncthreads();
        if (tid < 128) {
            unsigned used = 0u;
            for (int k = 0; k < 3; ++k) { int best = -1; float bv = 0.f;
                for (int n = 0; n < blk; ++n) { const float v = GG[tid * 16 + n]; if (!((used >> n) & 1u) && (best < 0 || v > bv)) { best = n; bv = v; } }
                if (best >= 0) used |= 1u << best; }
            SM[tid] = used; __hip_atomic_fetch_or((unsigned*)UM, used, __ATOMIC_RELAXED, __HIP_MEMORY_SCOPE_WORKGROUP);
        }
        __syncthreads();
        const unsigned mysel = SM[16 * w + fr];
        const int own_tiles = 2 + 2 * (qt & 1);
        if (tid == 0) {
            const unsigned umask = *UM; int c = 0;
            for (int kt = 0; kt < own_tiles; ++kt) TL[c++] = (unsigned)(blk * 4 + kt);
            for (int n = 0; n < blk; ++n) if ((umask >> n) & 1u) { for (int kt = 0; kt < 4; ++kt) TL[c++] = (unsigned)(n * 4 + kt); }
            TL[64] = (unsigned)c; }
        __syncthreads();
        const int ntiles = (int)TL[64];
        const int tq = t0 + 16 * w + fr;
        f32x4 oacc[8];
#pragma unroll
        for (int dt = 0; dt < 8; ++dt) oacc[dt] = (f32x4){0.f, 0.f, 0.f, 0.f};
        float mrun = -1e30f, lsum = 0.f;
        u32x4 kpre[2], vpre[2];
        { const int key0 = (int)TL[0] * 64;
#pragma unroll
          for (int k = 0; k < 2; ++k) { const int ch = tid + 512 * k, r = ch >> 4, c = ch & 15; const size_t go = (size_t)(brow + key0 + r) * 512 + h * 128 + c * 8; kpre[k] = *(const u32x4*)(MK + go); vpre[k] = *(const u32x4*)(MV + go); } }
        for (int ti = 0; ti < ntiles; ++ti) {
            const int ent = (int)TL[ti], n = ent >> 2, key0 = ent * 64;
            const bool qsel = (n == blk) || ((mysel >> n) & 1u);
            __syncthreads();
#pragma unroll
            for (int k = 0; k < 2; ++k) { const int ch = tid + 512 * k, r = ch >> 4, c = ch & 15; *(LAS u32x4*)(KS + r * 272 + c * 16) = kpre[k]; *(LAS u32x4*)(VS + r * 288 + c * 16) = vpre[k]; }
            __syncthreads();
            if (ti + 1 < ntiles) { const int keyn = (int)TL[ti + 1] * 64;
#pragma unroll
                for (int k = 0; k < 2; ++k) { const int ch = tid + 512 * k, r = ch >> 4, c = ch & 15; const size_t go = (size_t)(brow + keyn + r) * 512 + h * 128 + c * 8; kpre[k] = *(const u32x4*)(MK + go); vpre[k] = *(const u32x4*)(MV + go); } }
            {
                f32x4 s[4];
#pragma unroll
                for (int k4 = 0; k4 < 4; ++k4) { f32x4 acc = {0.f, 0.f, 0.f, 0.f};
#pragma unroll
                    for (int ks = 0; ks < 4; ++ks) { const bf16x8 a = *(const LAS bf16x8*)(KS + (16 * k4 + fr) * 272 + (32 * ks + 8 * g) * 2); acc = __builtin_amdgcn_mfma_f32_16x16x32_bf16(a, qf[ks], acc, 0, 0, 0); }
                    s[k4] = acc; }
                mfma_fence(s[0], s[1], s[2], s[3]);
                float mx = -1e30f;
#pragma unroll
                for (int k4 = 0; k4 < 4; ++k4)
#pragma unroll
                    for (int r = 0; r < 4; ++r) { const unsigned di = min((unsigned)(tq - (key0 + 16 * k4 + 4 * g + r)), 4096u);
                        s[k4][r] = s[k4][r] * scale + BL[di]; mx = fmaxf(mx, s[k4][r]); }
                mx = qsel ? mx : -1e30f;
                mx = fmaxf(mx, __shfl_xor(mx, 16)); mx = fmaxf(mx, __shfl_xor(mx, 32));
                const float mnew = fmaxf(mrun, mx), alpha = __builtin_amdgcn_exp2f(mrun - mnew); mrun = mnew;
                const float meff = qsel ? fmaxf(mnew, -1e20f) : 1e30f;
                float ps = 0.f;
#pragma unroll
                for (int k4 = 0; k4 < 4; ++k4)
#pragma unroll
                    for (int r = 0; r < 4; ++r) { const float pv = __builtin_amdgcn_exp2f(s[k4][r] - meff); s[k4][r] = pv; ps += pv; }
                lsum = lsum * alpha + ps;
                if (__any(alpha != 1.0f)) {
#pragma unroll
                    for (int dt = 0; dt < 8; ++dt) oacc[dt] = oacc[dt] * alpha; }
                bf16x8 pb[2];
#pragma unroll
                for (int m2 = 0; m2 < 2; ++m2) { u32x4 t; t.x = cvt_pk_bf16(s[2 * m2][0], s[2 * m2][1]); t.y = cvt_pk_bf16(s[2 * m2][2], s[2 * m2][3]);
                    t.z = cvt_pk_bf16(s[2 * m2 + 1][0], s[2 * m2 + 1][1]); t.w = cvt_pk_bf16(s[2 * m2 + 1][2], s[2 * m2 + 1][3]); pb[m2] = __builtin_bit_cast(bf16x8, t); }
#pragma unroll
                for (int dt = 0; dt < 8; ++dt)
#pragma unroll
                    for (int m2 = 0; m2 < 2; ++m2) {
                        const LAS unsigned char* va = VS + (32 * m2 + 4 * g + (fr >> 2)) * 288 + (16 * dt + 4 * (fr & 3)) * 2;
                        const v4i16_t lo = lds_tr16(va), hi = lds_tr16(va + 16 * 288);
                        const bf16x8 a = {lo[0], lo[1], lo[2], lo[3], hi[0], hi[1], hi[2], hi[3]};
                        oacc[dt] = __builtin_amdgcn_mfma_f32_16x16x32_bf16(a, pb[m2], oacc[dt], 0, 0, 0); }
            }
        }
        lsum += __shfl_xor(lsum, 16); lsum += __shfl_xor(lsum, 32);
        const float inv = 1.f / lsum;
        mfma_fence(oacc[0], oacc[1], oacc[2], oacc[3]); mfma_fence(oacc[4], oacc[5], oacc[6], oacc[7]);
        __syncthreads();
#pragma unroll
        for (int dt = 0; dt < 8; ++dt) { u32x2 o; o.x = cvt_pk_bf16(oacc[dt][0] * inv, oacc[dt][1] * inv); o.y = cvt_pk_bf16(oacc[dt][2] * inv, oacc[dt][3] * inv);
            if (PROBE) *(u32x2*)((bf16_t*)p.x + (size_t)(brow + tq) * 512 + h * 128 + 16 * dt + 4 * g) = o; else *(u32x2*)(Y + (size_t)(brow + tq) * 2048 + 512 + h * 128 + 16 * dt + 4 * g) = o; }
        __syncthreads();
    }
}


template <int PROBE = 0> __device__ void phase_dsel(const Params& p, LAS unsigned char* lds, int bid, int nb) {
    const int tid = phase_tid(), lane = tid & 63, w = __builtin_amdgcn_readfirstlane(tid >> 6), fr = lane & 15, g = lane >> 4;
    LAS unsigned char* KEYS = lds;
    LAS unsigned char* IQS = lds + 131072;
    const bf16_t* IQ = BF(p, OFF_IQ); const bf16_t* IKW = BF(p, OFF_IKW); const bf16_t* IKT = IKT_PTR(p);
    unsigned* MASK = PROBE ? (unsigned*)((unsigned char*)p.x + (size_t)(PROBE - 1) * 8 * MiB) : (unsigned*)(p.ws + OFF_MASK);
    const int nun = (nb == 256) ? 8 : ((2048 - bid + nb - 1) / nb);
#define DSEL_ITEM(u_) ((nb == 256) ? (((u_) & 1) ? (512 * ((u_) >> 1) + 511 - bid) : (512 * ((u_) >> 1) + bid)) : (bid + (u_) * nb))
    u32x4 iqpre, wpa, wpb; bf16x8 kb0[4][2], kb1[4][2];
#define DSEL_ISSUE(buf, kbase_, base_) do { _Pragma("unroll") for (int j = 0; j < 4; ++j) { int ktl = (base_) + 8 * j; ktl = ktl < 256 ? ktl : 255; const bf16_t* kp = (kbase_) + (size_t)ktl * 1024; \
        (buf)[j][0] = *(const bf16x8*)kp; (buf)[j][1] = *(const bf16x8*)(kp + 512); } } while (0)
#define DSEL_PREFETCH(u_) do { const int k_ = DSEL_ITEM(u_); const int brow_ = (k_ & 3) * SEQ, t0_ = (k_ >> 2) * 8; \
        iqpre = *(const u32x4*)(IQ + (size_t)(brow_ + t0_ + (tid >> 6)) * 512 + (tid & 63) * 8); \
        wpa = *(const u32x4*)(IKW + (size_t)(brow_ + t0_ + 2 * g) * 128 + 64); wpb = *(const u32x4*)(IKW + (size_t)(brow_ + t0_ + 2 * g + 1) * 128 + 64); \
        const bf16_t* kb_ = IKT + (size_t)(brow_ >> 4) * 1024 + (tid & 63) * 8; DSEL_ISSUE(kb0, kb_, w); } while (0)
    if (nun > 0) DSEL_PREFETCH(0);
    for (int u = 0; u < nun; ++u) {
        const int k = DSEL_ITEM(u);
        const int b = k & 3, qt = k >> 2, brow = b * SEQ, t0 = qt * 8, nkt = (t0 + 7) / 16 + 1;
        __syncthreads();
        *(LAS u32x4*)(IQS + (tid >> 6) * 1040 + (tid & 63) * 16) = iqpre;
        __syncthreads();
        {
            bf16x8 aq[4][2];
#pragma unroll
            for (int hp = 0; hp < 4; ++hp)
#pragma unroll
                for (int ks = 0; ks < 2; ++ks) aq[hp][ks] = *(const LAS bf16x8*)(IQS + (fr >> 1) * 1040 + ((2 * hp + (fr & 1)) * 64 + 32 * ks + 8 * g) * 2);
            float wa[8], wb[8];
#pragma unroll
            for (int hh = 0; hh < 8; ++hh) { wa[hh] = (hh & 1) ? __uint_as_float(wpa[hh >> 1] & 0xffff0000u) : __uint_as_float(wpa[hh >> 1] << 16); wb[hh] = (hh & 1) ? __uint_as_float(wpb[hh >> 1] & 0xffff0000u) : __uint_as_float(wpb[hh >> 1] << 16); }
            const int tqa = t0 + 2 * g, tqb = tqa + 1;
            const bf16_t* kbase = IKT + (size_t)(brow >> 4) * 1024 + lane * 8;
#define DSEL_COMPUTE(buf, base_) do { _Pragma("unroll") for (int j = 0; j < 4; ++j) { const int kt = (base_) + 8 * j; if (kt < nkt) { \
                float sa = 0.f, sb = 0.f; \
                f32x4 ah[4]; \
                _Pragma("unroll") for (int hp = 0; hp < 4; ++hp) { f32x4 acc = {0.f, 0.f, 0.f, 0.f}; \
                    acc = __builtin_amdgcn_mfma_f32_16x16x32_bf16(aq[hp][0], (buf)[j][0], acc, 0, 0, 0); acc = __builtin_amdgcn_mfma_f32_16x16x32_bf16(aq[hp][1], (buf)[j][1], acc, 0, 0, 0); ah[hp] = acc; } \
                mfma_fence(ah[0], ah[1], ah[2], ah[3]); \
                _Pragma("unroll") for (int hp = 0; hp < 4; ++hp) { sa += wa[2 * hp] * fmaxf(ah[hp][0], 0.f) + wa[2 * hp + 1] * fmaxf(ah[hp][1], 0.f); sb += wb[2 * hp] * fmaxf(ah[hp][2], 0.f) + wb[2 * hp + 1] * fmaxf(ah[hp][3], 0.f); } \
                const int spos = 16 * kt + fr; \
                unsigned ua = __float_as_uint(sa + 0.0f); ua = (ua & 0x80000000u) ? ~ua : (ua | 0x80000000u); \
                unsigned ub = __float_as_uint(sb + 0.0f); ub = (ub & 0x80000000u) ? ~ub : (ub | 0x80000000u); \
                *(LAS unsigned*)(KEYS + (2 * g) * 16384 + spos * 4) = (spos <= tqa) ? ((ua & 0xfffff000u) | (unsigned)(4095 - spos)) : 0u; \
                *(LAS unsigned*)(KEYS + (2 * g + 1) * 16384 + spos * 4) = (spos <= tqb) ? ((ub & 0xfffff000u) | (unsigned)(4095 - spos)) : 0u; } } } while (0)
            for (int base = w; base < nkt; base += 64) {
                DSEL_ISSUE(kb1, kbase, base + 32);
                DSEL_COMPUTE(kb0, base);
                DSEL_ISSUE(kb0, kbase, base + 64);
                DSEL_COMPUTE(kb1, base + 32);
            }
#undef DSEL_COMPUTE
        }
        __syncthreads();
        if (u + 1 < nun) DSEL_PREFETCH(u + 1);
        {
            const int t = t0 + w; const int nch = 4 * nkt;
            const int mmax = (nch + 63) >> 6;
            u32x4 kr[16];
#pragma unroll
            for (int m = 0; m < 16; ++m) { const int c = lane + 64 * m; const u32x4 z = {0u, 0u, 0u, 0u};
                kr[m] = (m < mmax && c < nch) ? *(const LAS u32x4*)(KEYS + w * 16384 + c * 16) : z; }
            unsigned thr = 1u;
            if (t + 1 > 256) {
                u32x4 gm = kr[0];
#pragma unroll
                for (int m = 1; m < 16; ++m) if (m < mmax) { gm.x = max(gm.x, kr[m].x); gm.y = max(gm.y, kr[m].y); gm.z = max(gm.z, kr[m].z); gm.w = max(gm.w, kr[m].w); }
                unsigned vlo = min(min(gm.x, gm.y), min(gm.z, gm.w)), vhi = max(max(gm.x, gm.y), max(gm.z, gm.w));
#pragma unroll
                for (int o = 32; o >= 1; o >>= 1) { vlo = min(vlo, (unsigned)__shfl_xor((int)vlo, o)); vhi = max(vhi, (unsigned)__shfl_xor((int)vhi, o)); }
                unsigned lo = (unsigned)__builtin_amdgcn_readfirstlane((int)vlo), hi = (unsigned)__builtin_amdgcn_readfirstlane((int)vhi);
                lo = lo > 1u ? lo : 1u;
                while (lo < hi) {
                    const unsigned cand = lo + ((hi - lo + 1u) >> 1);
                    unsigned c0 = 0u, c1 = 0u, c2 = 0u, c3 = 0u;
#define DSEL_CNT1(m_) do { unsigned long long q0_, q1_, q2_, q3_; asm volatile( \
                        "v_cmp_ge_u32_e64 %[q0], %[kx], %[cd]\n\tv_cmp_ge_u32_e64 %[q1], %[ky], %[cd]\n\tv_cmp_ge_u32_e64 %[q2], %[kz], %[cd]\n\tv_cmp_ge_u32_e64 %[q3], %[kw], %[cd]\n\t" \
                        "v_addc_co_u32_e64 %[a0], %[q0], 0, %[a0], %[q0]\n\tv_addc_co_u32_e64 %[a1], %[q1], 0, %[a1], %[q1]\n\tv_addc_co_u32_e64 %[a2], %[q2], 0, %[a2], %[q2]\n\tv_addc_co_u32_e64 %[a3], %[q3], 0, %[a3], %[q3]" \
                        : [q0] "=&s"(q0_), [q1] "=&s"(q1_), [q2] "=&s"(q2_), [q3] "=&s"(q3_), [a0] "+v"(c0), [a1] "+v"(c1), [a2] "+v"(c2), [a3] "+v"(c3) \
                        : [kx] "v"(kr[m_].x), [ky] "v"(kr[m_].y), [kz] "v"(kr[m_].z), [kw] "v"(kr[m_].w), [cd] "s"(cand)); } while (0)
#define DSEL_CNT4(b_) do { DSEL_CNT1((b_)); DSEL_CNT1((b_) + 1); DSEL_CNT1((b_) + 2); DSEL_CNT1((b_) + 3); } while (0)
                    switch ((mmax + 3) >> 2) { case 4: DSEL_CNT4(12); case 3: DSEL_CNT4(8); case 2: DSEL_CNT4(4); default: DSEL_CNT4(0); }
#undef DSEL_CNT4
#undef DSEL_CNT1
                    const unsigned cn = wave_sum_u32((c0 + c1) + (c2 + c3));
                    if (cn >= 256u) { lo = cand; if (cn == 256u) break; } else hi = cand - 1u;
                }
                thr = lo; }
            unsigned* mrow = MASK + (size_t)(brow + t) * 128;
#pragma unroll
            for (int m = 0; m < 16; ++m) {
                unsigned nib = 0u;
                if (m < mmax) nib = ((kr[m].x >= thr) ? 1u : 0u) | ((kr[m].y >= thr) ? 2u : 0u) | ((kr[m].z >= thr) ? 4u : 0u) | ((kr[m].w >= thr) ? 8u : 0u);
                unsigned v = nib << (4 * (lane & 7));
                v |= (unsigned)__builtin_amdgcn_update_dpp(0, (int)v, 0xB1, 0xf, 0xf, true); v |= (unsigned)__builtin_amdgcn_update_dpp(0, (int)v, 0x4E, 0xf, 0xf, true);
                v |= (unsigned)__builtin_amdgcn_update_dpp(0, (int)v, 0x141, 0xf, 0xf, true);
                if ((lane & 7) == 0) mrow[(lane >> 3) + 8 * m] = v;
            }
        }
    }
#undef DSEL_ISSUE
#undef DSEL_PREFETCH
#undef DSEL_ITEM
}

template <int PROBE = 0> __device__ void phase_datt(const Params& p, LAS unsigned char* lds, int bid, int nb) {
    const int tid = phase_tid(), lane = tid & 63, w = __builtin_amdgcn_readfirstlane(tid >> 6), fr = lane & 15, g = lane >> 4;
    LAS unsigned char* BK = lds;
    LAS float* RL = (LAS float*)(lds + 4096);
    LAS unsigned short* IDX = (LAS unsigned short*)(lds + 5120 + w * 512);
    LAS unsigned char* CT = lds + 9216 + w * (32 * 544);
    const bf16_t* CKV = BF(p, OFF_CKV); bf16_t* Y = BF(p, OFF_Y); const unsigned* MASK = (const unsigned*)(p.ws + OFF_MASK);
    for (int dd = tid; dd < 4096; dd += 512) BK[dd] = (unsigned char)rel_bucket(dd);
    if (tid < 256) RL[tid] = IN(p, I_REL)[tid] * 1.4426950408889634f;
    __syncthreads();
    const float scale = 0.08838834764831845f * 1.4426950408889634f;
    const int hd = fr & 3;
    for (int it = bid; it < NTOK / 8; it += nb) {
        const int tg = it * 8 + w, brow = (tg >> 12) * SEQ, t = tg & 4095;
        const u32x2 mw = *(const u32x2*)(MASK + (size_t)tg * 128 + 2 * lane);
        const int cnt = __popc(mw.x) + __popc(mw.y);
        int pre = cnt;
#pragma unroll
        for (int o = 1; o < 64; o <<= 1) { const int v = __shfl_up(pre, o); if (lane >= o) pre += v; }
        const int nsel = __shfl(pre, 63);
        int pos = pre - cnt;
        { unsigned m0 = mw.x; while (m0) { const int bpos = __ffs(m0) - 1; m0 &= m0 - 1; IDX[pos++] = (unsigned short)(64 * lane + bpos); }
          unsigned m1 = mw.y; while (m1) { const int bpos = __ffs(m1) - 1; m1 &= m1 - 1; IDX[pos++] = (unsigned short)(64 * lane + 32 + bpos); } }
        for (int e = nsel + lane; e < 256; e += 64) IDX[e] = 0;
        bf16x8 qb[8];
#pragma unroll
        for (int ks = 0; ks < 8; ++ks) { const u32x4 z = {0u, 0u, 0u, 0u}; const u32x4 v = (fr < 4) ? *(const u32x4*)(Y + (size_t)tg * 2048 + 1024 + fr * 256 + 32 * ks + 8 * g) : z; qb[ks] = __builtin_bit_cast(bf16x8, v); }
        f32x4 oacc[16];
#pragma unroll
        for (int rt = 0; rt < 16; ++rt) oacc[rt] = (f32x4){0.f, 0.f, 0.f, 0.f};
        float mrun = -1e30f, lsum = 0.f;
        const int nstep = (nsel + 31) >> 5;
        u32x4 gr[16];
        const int hi32 = lane >> 5, ch16 = (lane & 31) * 8;
#define DATT_GATHER(st_) do { const LAS u32x4* ip_ = (const LAS u32x4*)(IDX + 32 * (st_)); \
            _Pragma("unroll") for (int q4 = 0; q4 < 4; ++q4) { const u32x4 iv_ = ip_[q4]; \
                _Pragma("unroll") for (int e = 0; e < 4; ++e) { const unsigned row_ = hi32 ? (iv_[e] >> 16) : (iv_[e] & 0xffffu); \
                    gr[4 * q4 + e] = *(const u32x4*)(CKV + (size_t)(brow + (int)row_) * 256 + ch16); } } } while (0)
        DATT_GATHER(0);
        for (int st = 0; st < nstep; ++st) {
#pragma unroll
            for (int i = 0; i < 16; ++i) *(LAS u32x4*)(CT + (2 * i + hi32) * 544 + (lane & 31) * 16) = gr[i];
            f32x4 s0 = {0.f, 0.f, 0.f, 0.f}, s1 = {0.f, 0.f, 0.f, 0.f};
#pragma unroll
            for (int ks = 0; ks < 8; ++ks) { const bf16x8 a0 = *(const LAS bf16x8*)(CT + fr * 544 + (32 * ks + 8 * g) * 2), a1 = *(const LAS bf16x8*)(CT + (16 + fr) * 544 + (32 * ks + 8 * g) * 2);
                s0 = __builtin_amdgcn_mfma_f32_16x16x32_bf16(a0, qb[ks], s0, 0, 0, 0); s1 = __builtin_amdgcn_mfma_f32_16x16x32_bf16(a1, qb[ks], s1, 0, 0, 0); }
            mfma_fence(s0); mfma_fence(s1);
            if (st + 1 < nstep) DATT_GATHER(st + 1);
            float mx = -1e30f;
#pragma unroll
            for (int r = 0; r < 4; ++r) {
                { const int slot = 32 * st + 4 * g + r; const int dist = t - (int)IDX[slot]; const float lg = s0[r] * scale + RL[BK[dist < 0 ? 0 : dist] * 8 + 4 + hd]; s0[r] = (slot < nsel) ? lg : -1e30f; mx = fmaxf(mx, s0[r]); }
                { const int slot = 32 * st + 16 + 4 * g + r; const int dist = t - (int)IDX[slot]; const float lg = s1[r] * scale + RL[BK[dist < 0 ? 0 : dist] * 8 + 4 + hd]; s1[r] = (slot < nsel) ? lg : -1e30f; mx = fmaxf(mx, s1[r]); } }
            mx = fmaxf(mx, __shfl_xor(mx, 16)); mx = fmaxf(mx, __shfl_xor(mx, 32));
            const float mnew = fmaxf(mrun, mx), alpha = __builtin_amdgcn_exp2f(mrun - mnew); mrun = mnew;
            float ps = 0.f;
#pragma unroll
            for (int r = 0; r < 4; ++r) { const float p0 = __builtin_amdgcn_exp2f(s0[r] - mnew), p1 = __builtin_amdgcn_exp2f(s1[r] - mnew);        s0[r] = p0; s1[r] = p1; ps += p0 + p1; }
            lsum = lsum * alpha + ps;
            if (__any(alpha != 1.0f)) {
#pragma unroll
                for (int rt = 0; rt < 16; ++rt) oacc[rt] = oacc[rt] * alpha; }
            u32x4 pt; pt.x = cvt_pk_bf16(s0[0], s0[1]); pt.y = cvt_pk_bf16(s0[2], s0[3]); pt.z = cvt_pk_bf16(s1[0], s1[1]); pt.w = cvt_pk_bf16(s1[2], s1[3]);
            const bf16x8 pb = __builtin_bit_cast(bf16x8, pt);
#pragma unroll
            for (int rt = 0; rt < 16; ++rt) {
                const LAS unsigned char* va = CT + (4 * g + (fr >> 2)) * 544 + (16 * rt + 4 * (fr & 3)) * 2;
                const v4i16_t lo = lds_tr16(va), hi = lds_tr16(va + 16 * 544);
                const bf16x8 a = {lo[0], lo[1], lo[2], lo[3], hi[0], hi[1], hi[2], hi[3]};
                oacc[rt] = __builtin_amdgcn_mfma_f32_16x16x32_bf16(a, pb, oacc[rt], 0, 0, 0); }
        }
#undef DATT_GATHER
        lsum += __shfl_xor(lsum, 16); lsum += __shfl_xor(lsum, 32);
        const float inv = 1.f / lsum;
        mfma_fence(oacc[0], oacc[1], oacc[2], oacc[3]); mfma_fence(oacc[4], oacc[5], oacc[6], oacc[7]); mfma_fence(oacc[8], oacc[9], oacc[10], oacc[11]); mfma_fence(oacc[12], oacc[13], oacc[14], oacc[15]);
        if (fr < 4) {
            bf16_t* yo = PROBE ? ((bf16_t*)((unsigned char*)p.x + 32 * MiB) + (size_t)tg * 1024 + fr * 256 + 4 * g) : (Y + (size_t)tg * 2048 + 1024 + fr * 256 + 4 * g);
#pragma unroll
            for (int rt = 0; rt < 16; ++rt) { u32x2 o; o.x = cvt_pk_bf16(oacc[rt][0] * inv, oacc[rt][1] * inv); o.y = cvt_pk_bf16(oacc[rt][2] * inv, oacc[rt][3] * inv); *(u32x2*)(yo + 16 * rt) = o; }
        }
    }
}

__device__ __forceinline__ Params opq(const Params& p) { Params q = p; asm volatile("" : "+s"(q.ws), "+s"(q.x)); return q; }
__device__ __forceinline__ int opqi(int v) { asm volatile("" : "+s"(v)); return v; }
#define GRID_BARRIER() do { XcdBarrier _b; _b.bar = (unsigned*)(opq(p).ws + OFF_CTL); _b.x = xb_xcc_id(); _b.st = (volatile LAS unsigned*)(lds + LDS_PHASE_BYTES); xcd_barrier(_b); } while (0)
#define PP opq(p)
#define BB opqi(bid)
__device__ __forceinline__ void layer_body(const Params& p, LAS unsigned char* lds, const int bid, const int nb, const int l) {
        phase_gemm_in(PP, lds, BB, nb);
        GRID_BARRIER();
        phase_prep(PP, l, lds, BB, nb);
        phase_hg1(PP, l, lds, BB, nb);
        GRID_BARRIER();
        phase_hg2(PP, BB, nb);
        phase_moba(PP, lds, BB, nb);
        phase_dsel(PP, lds, BB, nb);
        GRID_BARRIER();
        phase_hg3(PP, l, lds, BB, nb);
        phase_datt(PP, lds, BB, nb);
        __syncthreads();
        phase_conv_postA(PP, l, lds, BB, nb);
        GRID_BARRIER();
        phase_conv_postB(PP, l, lds, BB, nb);
        phase_gemm_gates(PP, lds, BB, nb);
        GRID_BARRIER();
        phase_gemm_branch(PP, lds, BB, nb);
        GRID_BARRIER();
        phase_gemm_out(PP, lds, BB, nb);
        GRID_BARRIER();
        { const Params q = PP;
          if (l == 0) phase_norm<1, false, true>(IN(q, I_X), BF(q, OFF_XB), BF(q, OFF_OUT), IN(q, I_POSTMIX) + l * 1024, IN(q, I_PREFFN) + l * 1024, BF(q, OFF_H), BB, nb);
          else        phase_norm<1, true, true>((float*)q.x, BF(q, OFF_XB), BF(q, OFF_OUT), IN(q, I_POSTMIX) + l * 1024, IN(q, I_PREFFN) + l * 1024, BF(q, OFF_H), BB, nb); }
        GRID_BARRIER();
        phase_gemm_ffn1(PP, lds, BB, nb);
        GRID_BARRIER();
        phase_gemm_ffn2(PP, lds, BB, nb);
        GRID_BARRIER();
        if (l + 1 < DEPTH) { { const Params q = PP; phase_norm<1, true, true>(BF(q, OFF_XB), (float*)q.x, BF(q, OFF_OUT), IN(q, I_POSTFFN) + l * 1024, IN(q, I_PREMIX) + (l + 1) * 1024, BF(q, OFF_H), BB, nb); } phase_conv_in(PP, l + 1, lds, BB, nb); GRID_BARRIER(); }
        else { const Params q = PP; phase_norm<2, true, false>(BF(q, OFF_XB), (float*)q.x, BF(q, OFF_OUT), IN(q, I_POSTFFN) + l * 1024, nullptr, nullptr, BB, nb); }
}
__global__ __launch_bounds__(512, 2) void mega_fwd(Params p) {
    extern __shared__ __attribute__((aligned(16))) unsigned char shm[];
    LAS unsigned char* lds = (LAS unsigned char*)shm;
    const int bid = blockIdx.x, nb = gridDim.x;
    volatile LAS unsigned* xbw = (volatile LAS unsigned*)(lds + LDS_PHASE_BYTES);
    if (threadIdx.x < 4) xbw[threadIdx.x] = 0u;
    __syncthreads();
    (void)xcd_barrier_post((unsigned*)(p.ws + OFF_CTL), xbw);
    { const Params q = PP; phase_norm<0, false, false>(IN(q, I_X), nullptr, nullptr, nullptr, IN(q, I_PREMIX), BF(q, OFF_H), BB, nb); }
    phase_conv_in(PP, 0, lds, BB, nb);
    GRID_BARRIER();
    for (int l = 0; l < DEPTH; ++l) layer_body(p, lds, bid, nb, l);
}

#define LDS_BYTES (LDS_PHASE_BYTES + 16)
extern "C" void kernel_launch(void* const* d_in, const int* in_sizes, int n_in, void* d_out, int out_size, void* d_ws, size_t ws_size, hipStream_t stream) {
    static int grid = 0;
    if (grid == 0) {
        int dev = 0, cus = 0;
        if (hipGetDevice(&dev) != hipSuccess || hipDeviceGetAttribute(&cus, hipDeviceAttributeMultiprocessorCount, dev) != hipSuccess || cus < 1) { fprintf(stderr, "kernel_launch: no device info\n"); grid = -1; return; }
        if (hipFuncSetAttribute((const void*)mega_fwd, hipFuncAttributeMaxDynamicSharedMemorySize, LDS_BYTES) != hipSuccess) { fprintf(stderr, "kernel_launch: hipFuncSetAttribute failed\n"); grid = -1; return; }
        int per_cu = 0;
        if (hipOccupancyMaxActiveBlocksPerMultiprocessor(&per_cu, (const void*)mega_fwd, 512, LDS_BYTES) != hipSuccess || per_cu < 1) { fprintf(stderr, "kernel_launch: occupancy query says %d blocks per CU\n", per_cu); }
        (void)hipGetLastError();
        grid = cus;
    }
    if (grid < 0) return;
    Params p{};
    for (int i = 0; i < 20; ++i) p.in[i] = (GAS const float*)d_in[i];
    p.x = (GAS float*)d_out; p.ws = (GAS unsigned char*)d_ws;
    if (WS_NEED > ws_size) { fprintf(stderr, "kernel_launch: workspace too small (%zu < %zu)\n", ws_size, (size_t)WS_NEED); return; }
    (void)hipMemsetAsync((unsigned char*)d_ws + OFF_CTL, 0, 16384, stream);
    hipLaunchKernelGGL(mega_fwd, dim3(grid), dim3(512), LDS_BYTES, stream, p);
}
```

```cpp
#include <hip/hip_runtime.h>
#include <stdint.h>
#include <stdio.h>

#define D_MODEL 1024
#define BATCH 4
#define SEQ 4096
#define NTOK 16384
#define DEPTH 2
#define IN_W 8008
#define D_FF 2816
#define NEG_BIG (-1e30f)
#define C_HQ 0
#define C_HF 512
#define C_HI 1024
#define C_HG 1536
#define C_MQ 2048
#define C_MK 2560
#define C_MV 3072
#define C_DQ 3584
#define C_DKV 4096
#define C_IQ 4352
#define C_IK 4864
#define C_IW 4928
#define C_G 4936
#define NP1 5632

#define LAS __attribute__((address_space(3)))
typedef unsigned short bf16_t;
typedef short bf16x8 __attribute__((ext_vector_type(8)));
typedef float f32x4 __attribute__((ext_vector_type(4)));
typedef unsigned u32x4 __attribute__((ext_vector_type(4)));
typedef unsigned u32x2 __attribute__((ext_vector_type(2)));

__device__ __forceinline__ float sigmoidf_(float x) { return __builtin_amdgcn_rcpf(1.f + __expf(-x)); }
__device__ __forceinline__ float bf2f(bf16_t b) { return __uint_as_float(((unsigned)b) << 16); }
typedef __bf16 bf16x2_t __attribute__((ext_vector_type(2)));
typedef float f32x2_t __attribute__((ext_vector_type(2)));
__device__ __forceinline__ unsigned cvt_pk_bf16(float lo, float hi) { const f32x2_t f = {lo, hi}; const bf16x2_t v = __builtin_convertvector(f, bf16x2_t); return __builtin_bit_cast(unsigned, v); }
__device__ __forceinline__ bf16_t f2bf(float f) { return (bf16_t)(cvt_pk_bf16(f, 0.f) & 0xffffu); }
__device__ __forceinline__ int phase_tid() { int t = threadIdx.x; asm volatile("" : "+v"(t)); return t; }
__device__ __forceinline__ void mfma_fence(f32x4& a) { asm volatile("s_nop 15\n\ts_nop 3" : "+v"(a)); }
__device__ __forceinline__ void mfma_fence(f32x4& a, f32x4& b, f32x4& c, f32x4& d) { asm volatile("s_nop 15\n\ts_nop 3" : "+v"(a), "+v"(b), "+v"(c), "+v"(d)); }
__device__ __forceinline__ float relu_(float x) { float r; asm("v_max_f32_e32 %0, 0, %1" : "=v"(r) : "v"(x)); return r; }
__device__ __forceinline__ int rel_bucket(int dist) {
    int n = dist > 0 ? dist : 0;
    if (n < 16) return n;
    float nf = (float)n;
    int large = 16 + (int)(logf(nf / 16.f) / 4.852030263919617f * 16.f);
    return large < 31 ? large : 31;
}

enum { I_X = 0, I_WIN, I_PREMIX, I_POSTMIX, I_PREFFN, I_POSTFFN, I_LB, I_HGNW, I_KVN, I_WUK, I_WUV, I_IKNW, I_IKNB, I_REL, I_WA, I_WB, I_WC, I_WOUT, I_WF1, I_WF2 };
#define GAS __attribute__((address_space(1)))
struct Params { GAS const float* in[20]; GAS float* x; GAS unsigned char* ws; };
#define IN(p, i) ((const float*)(p).in[i])
constexpr size_t MiB = 1024 * 1024;
#define LDS_PHASE_BYTES (150 * 1024)
constexpr size_t OFF_CTL = 0, OFF_Y = 65536, OFF_HF = OFF_Y + 64 * MiB, OFF_HI = OFF_HF + 16 * MiB, OFF_HG = OFF_HI + 16 * MiB, OFF_MK = OFF_HG + 16 * MiB,
                 OFF_MV = OFF_MK + 16 * MiB, OFF_IQ = OFF_MV + 16 * MiB, OFF_CKV = OFF_IQ + 16 * MiB, OFF_IKW = OFF_CKV + 8 * MiB, OFF_H = OFF_IKW + 4 * MiB,
                 OFF_WIN = OFF_H + 32 * MiB, OFF_RS = OFF_WIN + 11 * MiB;
constexpr size_t OFF_WG = OFF_WIN, OFF_WBR = OFF_WG + 6 * MiB, OFF_WOUT = OFF_RS, OFF_WF1 = OFF_WOUT + 2 * MiB, OFF_WF2 = OFF_WF1 + 11 * MiB, OFF_WEND = OFF_WF2 + 6 * MiB;
constexpr size_t OFF_ST = OFF_RS, OFF_TMPF = OFF_RS, OFF_DEC = OFF_ST + 32 * MiB, OFF_MASK = OFF_DEC + MiB / 2, OFF_KMEAN = OFF_MASK + 8 * MiB, OFF_MEND = OFF_KMEAN + MiB / 8;
constexpr size_t OFF_OUT = OFF_HG, OFF_ACT = OFF_Y, OFF_XB = OFF_MV;
constexpr size_t WS_NEED = (OFF_WEND > OFF_MEND ? OFF_WEND : OFF_MEND);
#define BF(p, off) ((bf16_t*)((p).ws + (off)))
#define IKT_PTR(p) ((bf16_t*)((unsigned char*)(p).x + 32 * MiB))
#define F32P(p, off) ((float*)((p).ws + (off)))
__device__ const unsigned long long kP1Off[22] = {OFF_Y, OFF_Y, OFF_HF, OFF_HF, OFF_HI, OFF_HI, OFF_HG, OFF_HG, OFF_Y, OFF_Y, OFF_MK, OFF_MK, OFF_MV, OFF_MV, OFF_Y, OFF_Y, OFF_Y, OFF_Y, OFF_CKV, OFF_IQ, OFF_IQ, OFF_IKW};
__device__ const int kP1Ld[22]  = {2048, 2048, 512, 512, 512, 512, 512, 512, 2048, 2048, 512, 512, 512, 512, 2048, 2048, 2048, 2048, 256, 512, 512, 128};
__device__ const int kP1C0[22]  = {0, 256, 0, 256, 0, 256, 0, 256, 512, 768, 0, 256, 0, 256, 1024, 1280, 1536, 1792, 0, 0, 256, 0};
__device__ const int kP1Nc[22]  = {256, 256, 256, 256, 256, 256, 256, 256, 256, 256, 256, 256, 256, 256, 256, 256, 256, 256, 256, 256, 256, 128};

#define XB_TMO      128
#define XB_XCNT(j)  (256  + 64 * (j))
#define XB_XSUB(j)  (1280 + 64 * (j))
#define XB_XGEN(j)  (2304 + 64 * (j))
#define XB_TOP      3328
#define XB_TOPGEN   3392
#define XCD_BAR_WORDS 3456
#define XB_SPIN_CAP (1u << 18)

__device__ __forceinline__ unsigned xb_ld(unsigned* p)              { return __hip_atomic_load(p, __ATOMIC_RELAXED, __HIP_MEMORY_SCOPE_AGENT); }
__device__ __forceinline__ unsigned xb_add(unsigned* p, unsigned v) { return __hip_atomic_fetch_add(p, v, __ATOMIC_RELAXED, __HIP_MEMORY_SCOPE_AGENT); }
__device__ __forceinline__ unsigned xb_xcc_id() { return (unsigned)__builtin_amdgcn_s_getreg((3 << 11) | 20) & 0xFu; }
#define XB_SPIN(cond, bar) do { unsigned _sp = 0; while (cond) { __builtin_amdgcn_s_sleep(1); \
    if ((++_sp & 255u) == 0u) { if (xb_ld(&(bar)[XB_TMO])) break; if (_sp > XB_SPIN_CAP) { atomicAdd(&(bar)[XB_TMO], 1u); break; } } } } while (0)

struct XcdBarrier {
    unsigned* bar; unsigned x;
    volatile LAS unsigned* st;
};

__device__ __forceinline__ XcdBarrier xcd_barrier_post(unsigned* bar, volatile LAS unsigned* st) {
    XcdBarrier b; b.bar = bar; b.x = xb_xcc_id(); b.st = st;
    if (threadIdx.x == 0) (void)xb_add(&bar[XB_XCNT(b.x)], 1u);
    return b;
}
__device__ __forceinline__ void xcd_barrier_complete(unsigned* bar, unsigned x, unsigned& nloc, unsigned& nx) {
    const unsigned G = gridDim.x * gridDim.y * gridDim.z;
    unsigned sum, cnt, mine, sp = 0u;
    for (;;) {
        sum = 0u; cnt = 0u; mine = 0u;
#pragma unroll
        for (unsigned j = 0; j < 16; ++j) { const unsigned c = xb_ld(&bar[XB_XCNT(j)]); sum += c; cnt += (c > 0u) ? 1u : 0u; mine = (j == x) ? c : mine; }
        if (sum == G) break;
        __builtin_amdgcn_s_sleep(1);
        if ((++sp & 255u) == 0u) { if (xb_ld(&bar[XB_TMO])) break; if (sp > XB_SPIN_CAP) { atomicAdd(&bar[XB_TMO], 1u); break; } }
    }
    nloc = mine > 0u ? mine : 1u; nx = cnt > 0u ? cnt : 1u;
}

__device__ __forceinline__ void xcd_barrier(const XcdBarrier& b) {
    asm volatile("s_waitcnt vmcnt(0)" ::: "memory");
    __syncthreads();
    if (threadIdx.x == 0) {
        unsigned* bar = b.bar;
        __builtin_amdgcn_s_waitcnt(0);
        unsigned nloc = b.st[0], nx = b.st[1];
        if (nloc == 0u) { xcd_barrier_complete(bar, b.x, nloc, nx); b.st[0] = nloc; b.st[1] = nx; }
        const unsigned old = xb_add(&bar[XB_XSUB(b.x)], 1u);
        const unsigned gen = old / nloc;
        if (old + 1u == (gen + 1u) * nloc) {
            __builtin_amdgcn_fence(__ATOMIC_RELEASE, "agent");
            asm volatile("s_waitcnt vmcnt(0)" ::: "memory");
            const unsigned og = xb_add(&bar[XB_TOP], 1u);
            const unsigned tg = og / nx;
            if (og + 1u == (tg + 1u) * nx) xb_add(&bar[XB_TOPGEN], 1u);
            else XB_SPIN(xb_ld(&bar[XB_TOPGEN]) == tg, bar);
            __builtin_amdgcn_fence(__ATOMIC_ACQUIRE, "agent");
            xb_add(&bar[XB_XGEN(b.x)], 1u);
            asm volatile("s_waitcnt vmcnt(0)" ::: "memory");
        } else {
            XB_SPIN(xb_ld(&bar[XB_XGEN(b.x)]) == gen, bar);
            __builtin_amdgcn_fence(__ATOMIC_ACQUIRE, "agent");
            asm volatile("s_waitcnt vmcnt(0)" ::: "memory");
        }
    }
    __syncthreads();
}


namespace pg8 {
constexpr int BM = 256, BK = 64, HALF = 128, HTB = HALF * BK * 2, STAGE_BYTES = 8 * HTB, NXCD = 8, WGM = 8;
__host__ __device__ __forceinline__ int lds_byte(int r, int c) { const int st = (r >> 4) * 2 + (c >> 5), rr = r & 15, cc = c & 31, ob = rr * 64 + cc * 2; return st * 1024 + (ob ^ (((ob >> 9) & 1) << 5)); }
__host__ __device__ __forceinline__ void stage_rc(int b, int& R, int& C) { const int st = b / 1024, sb = b % 1024, swz = sb ^ (((sb >> 9) & 1) << 5); R = (st >> 1) * 16 + swz / 64; C = (st & 1) * 32 + (swz % 64) / 2; }
__host__ __device__ __forceinline__ int perm32(int rho) { const int n = rho >> 4, i = rho & 15; return 8 * (i >> 2) + 4 * n + (i & 3); }

struct Unit { int pm, pn, ka, nt, br; };
struct Gemm { const bf16_t* A; const bf16_t* Bt; int lda, ldb; };

__device__ __forceinline__ bool tile_of(long L, int nM, int nN, int& pm, int& pn) {
    const int nwg = nM * nN; if (L >= nwg) return false;
    int wgid = (int)L; { const int q = nwg / NXCD, r = nwg % NXCD, xcd = wgid % NXCD, off = wgid / NXCD; wgid = (xcd < r ? xcd * (q + 1) : r * (q + 1) + (xcd - r) * q) + off; }
    const int nig = WGM * nN, gid = wgid / nig, fm = gid * WGM, gsz = (nM - fm) < WGM ? (nM - fm) : WGM;
    pm = fm + ((wgid % nig) % gsz); pn = (wgid % nig) / gsz; return true;
}
struct StaticOrder {
    int nM, nN, G, c, nt;
    __device__ void init(int M, int N, int K, int G_, int c_) { nM = M / BM; nN = N / BM; G = G_; c = c_; nt = K / BK; }
    __device__ bool next(int i, Unit& u) const { u.ka = 0; u.nt = nt; u.br = 0; return tile_of((long)i * G + c, nM, nN, u.pm, u.pn); }
};
struct BranchOrder {
    int nM, nN, G, c;
    __device__ void init(int M, int N, int G_, int c_) { nM = M / BM; nN = N / BM; G = G_; c = c_; }
    __device__ bool next(int i, Unit& u) const { const int ti = i / 3, br = i - ti * 3; u.br = br; u.ka = br * 512; u.nt = (br == 2) ? 16 : 8; return tile_of((long)ti * G + c, nM, nN, u.pm, u.pn); }
};

template <class Epi, class Sched>
__device__ __forceinline__ void gemm_phase(LAS unsigned char* lds, const Gemm g, const Sched& S, const Epi& E) {
    const int tid = phase_tid(), wid = __builtin_amdgcn_readfirstlane(tid >> 6), lane = tid & 63, wr = wid >> 2, wc = wid & 3, fr = lane & 15, fq = lane >> 4;
    unsigned voffA[2], voffB[2];
#pragma unroll
    for (int i = 0; i < 2; ++i) { int R, C; stage_rc(tid * 16 + i * 8192, R, C); const int Rb = Epi::PERM ? ((R & ~31) + perm32(R & 31)) : R;
        voffA[i] = (unsigned)(R * g.lda + C) * 2u; voffB[i] = (unsigned)(Rb * g.ldb + C) * 2u; }
    const size_t kstep = (size_t)(BK * 2);
    const size_t hsA = (size_t)HALF * g.lda * 2, hsB = (size_t)HALF * g.ldb * 2;
    const size_t tsA = 2 * hsA, tsB = 2 * hsB;
    const unsigned ldsw = (unsigned)wid * 1024u;
    const int aoff = lds_byte(wr * 64 + fr, fq * 8), boff = lds_byte(wc * 32 + fr, fq * 8);
#define PG8_SA(b, h) (((b) * 2 + (h)) * HTB)
#define PG8_SB(b, h) ((4 + (b) * 2 + (h)) * HTB)
#define PG8_STAGE(bufoff, gbase, voff) do { _Pragma("unroll") for (int _i = 0; _i < 2; ++_i) \
        __builtin_amdgcn_global_load_lds((const unsigned*)((const char*)(gbase) + (voff)[_i]), (LAS unsigned*)(lds + (bufoff) + ldsw + _i * 8192), 16, 0, 0); } while (0)
#define PG8_LDA(dst, b, h) do { _Pragma("unroll") for (int m = 0; m < 4; ++m) _Pragma("unroll") for (int k = 0; k < 2; ++k) dst[m][k] = *(const LAS bf16x8*)(lds + PG8_SA(b, h) + aoff + m * 2048 + k * 1024); } while (0)
#define PG8_LDB(dst, b, h) do { _Pragma("unroll") for (int n = 0; n < 2; ++n) _Pragma("unroll") for (int k = 0; k < 2; ++k) dst[n][k] = *(const LAS bf16x8*)(lds + PG8_SB(b, h) + boff + n * 2048 + k * 1024); } while (0)
#define PG8_MMA(ai, bj, At, Bt) do { __builtin_amdgcn_s_setprio(1); _Pragma("unroll") for (int m = 0; m < 4; ++m) _Pragma("unroll") for (int n = 0; n < 2; ++n) _Pragma("unroll") for (int k = 0; k < 2; ++k) \
        acc[ai][bj][m][n] = __builtin_amdgcn_mfma_f32_16x16x32_bf16(Bt[n][k], At[m][k], acc[ai][bj][m][n], 0, 0, 0); __builtin_amdgcn_s_setprio(0); } while (0)
#define PG8_WAIT_V(n) asm volatile("s_waitcnt vmcnt(" #n ")" ::: "memory")
#define PG8_WAIT_L(n) asm volatile("s_waitcnt lgkmcnt(" #n ")" ::: "memory")
#define PG8_BAR __builtin_amdgcn_s_barrier()
#define PG8_SCHED __builtin_amdgcn_sched_barrier(0)
    Unit cur, nxt; int ui = 0;
    if (!S.next(0, cur)) return;
    f32x4 acc[2][2][4][2];
#pragma unroll
    for (int a = 0; a < 2; ++a)
#pragma unroll
        for (int b = 0; b < 2; ++b)
#pragma unroll
            for (int m = 0; m < 4; ++m)
#pragma unroll
                for (int n = 0; n < 2; ++n) acc[a][b][m][n] = (f32x4){0.f, 0.f, 0.f, 0.f};
    bf16x8 At[4][2], B0[2][2], B1[2][2];
    const char* cA = (const char*)g.A + (size_t)cur.pm * tsA + (size_t)cur.ka * 2; const char* cB = (const char*)g.Bt + (size_t)cur.pn * tsB + (size_t)cur.ka * 2;
    PG8_STAGE(PG8_SB(0, 0), cB, voffB); PG8_STAGE(PG8_SA(0, 0), cA, voffA); PG8_STAGE(PG8_SB(0, 1), cB + hsB, voffB); PG8_STAGE(PG8_SA(0, 1), cA + hsA, voffA);
    if (wr == 1) PG8_BAR;
    PG8_WAIT_V(4); PG8_BAR;
    PG8_STAGE(PG8_SB(1, 0), cB + kstep, voffB); PG8_STAGE(PG8_SA(1, 0), cA + kstep, voffA); PG8_STAGE(PG8_SB(1, 1), cB + hsB + kstep, voffB);
    PG8_WAIT_V(6); PG8_BAR;
    for (;;) {
        const bool has_next = S.next(ui + 1, nxt);
        const char* nA = has_next ? (const char*)g.A + (size_t)nxt.pm * tsA + (size_t)nxt.ka * 2 : cA; const char* nB = has_next ? (const char*)g.Bt + (size_t)nxt.pn * tsB + (size_t)nxt.ka * 2 : cB;
        const int nt = cur.nt;
        for (int t = 0; t < nt; t += 2) {
            const bool last = (t == nt - 2);
            const char* a1 = cA + (size_t)(t + 1) * kstep;
            const char* a2 = last ? nA : cA + (size_t)(t + 2) * kstep; const char* b2 = last ? nB : cB + (size_t)(t + 2) * kstep;
            const char* a3 = a2 + kstep; const char* b3 = b2 + kstep;
            PG8_LDB(B0, 0, 0); PG8_SCHED; PG8_LDA(At, 0, 0); PG8_STAGE(PG8_SA(1, 1), a1 + hsA, voffA);
            PG8_WAIT_L(8); PG8_BAR; PG8_WAIT_L(0); PG8_MMA(0, 0, At, B0); PG8_BAR; PG8_SCHED;
            PG8_LDB(B1, 0, 1); PG8_STAGE(PG8_SB(0, 0), b2, voffB);
            PG8_BAR; PG8_WAIT_L(0); PG8_MMA(0, 1, At, B1); PG8_BAR;
            PG8_LDA(At, 0, 1); PG8_STAGE(PG8_SA(0, 0), a2, voffA);
            PG8_BAR; PG8_WAIT_L(0); PG8_MMA(1, 0, At, B0); PG8_BAR; PG8_SCHED;
            PG8_STAGE(PG8_SB(0, 1), b2 + hsB, voffB);
            PG8_WAIT_V(6); PG8_BAR; PG8_MMA(1, 1, At, B1); PG8_BAR;
            PG8_LDB(B0, 1, 0); PG8_SCHED; PG8_LDA(At, 1, 0); PG8_STAGE(PG8_SA(0, 1), a2 + hsA, voffA);
            PG8_WAIT_L(8); PG8_BAR; PG8_WAIT_L(0); PG8_MMA(0, 0, At, B0); PG8_BAR; PG8_SCHED;
            PG8_LDB(B1, 1, 1); PG8_STAGE(PG8_SB(1, 0), b3, voffB);
            PG8_BAR; PG8_WAIT_L(0); PG8_MMA(0, 1, At, B1); PG8_BAR;
            PG8_LDA(At, 1, 1); PG8_STAGE(PG8_SA(1, 0), a3, voffA);
            PG8_BAR; PG8_WAIT_L(0); PG8_MMA(1, 0, At, B0); PG8_BAR; PG8_SCHED;
            PG8_STAGE(PG8_SB(1, 1), b3 + hsB, voffB);
            PG8_WAIT_V(6); PG8_BAR; PG8_MMA(1, 1, At, B1); PG8_BAR;
        }
        E(acc, cur, wr, wc, fr, fq);
        if (!has_next) break;
#pragma unroll
        for (int a = 0; a < 2; ++a)
#pragma unroll
            for (int b = 0; b < 2; ++b)
#pragma unroll
                for (int m = 0; m < 4; ++m)
#pragma unroll
                    for (int n = 0; n < 2; ++n) acc[a][b][m][n] = (f32x4){0.f, 0.f, 0.f, 0.f};
        cur = nxt; cA = nA; cB = nB; ++ui;
    }
    PG8_WAIT_V(0);
    if (wr == 0) PG8_BAR;
    PG8_BAR;
#undef PG8_SA
#undef PG8_SB
#undef PG8_STAGE
#undef PG8_LDA
#undef PG8_LDB
#undef PG8_MMA
#undef PG8_WAIT_V
#undef PG8_WAIT_L
#undef PG8_BAR
#undef PG8_SCHED
}

struct EpiF32 {
    static constexpr bool PERM = false;
    float* C; int ldc;
    __device__ __forceinline__ void operator()(const f32x4 (&acc)[2][2][4][2], const Unit& u, int wr, int wc, int fr, int fq) const {
        const int row0 = u.pm * BM + wr * 64 + fr, col0 = u.pn * BM + wc * 32 + 4 * fq;
#pragma unroll
        for (int ai = 0; ai < 2; ++ai)
#pragma unroll
            for (int m = 0; m < 4; ++m) { float* rowp = C + (size_t)(row0 + ai * HALF + m * 16) * ldc + col0;
#pragma unroll
                for (int bj = 0; bj < 2; ++bj)
#pragma unroll
                    for (int n = 0; n < 2; ++n) *(f32x4*)(rowp + bj * HALF + n * 16) = acc[ai][bj][m][n]; }
    }
};
struct EpiProj {
    static constexpr bool PERM = true;
    unsigned char* ws;
    __device__ __forceinline__ void operator()(const f32x4 (&acc)[2][2][4][2], const Unit& u, int wr, int wc, int fr, int fq) const {
        bf16_t* base = (bf16_t*)(ws + kP1Off[u.pn]); const int ld = kP1Ld[u.pn], ncol = kP1Nc[u.pn];
        const int row0 = u.pm * BM + wr * 64 + fr, col0 = kP1C0[u.pn] + wc * 32 + 8 * fq;
#pragma unroll
        for (int ai = 0; ai < 2; ++ai)
#pragma unroll
            for (int m = 0; m < 4; ++m) { bf16_t* rowp = base + (size_t)(row0 + ai * HALF + m * 16) * ld + col0;
#pragma unroll
                for (int bj = 0; bj < 2; ++bj) { if (bj * HALF >= ncol) continue;
                    const f32x4 v0 = acc[ai][bj][m][0], v1 = acc[ai][bj][m][1];
                    u32x4 w; w.x = cvt_pk_bf16(v0[0], v0[1]); w.y = cvt_pk_bf16(v0[2], v0[3]); w.z = cvt_pk_bf16(v1[0], v1[1]); w.w = cvt_pk_bf16(v1[2], v1[3]);
                    *(u32x4*)(rowp + bj * HALF) = w; } }
    }
};
struct EpiBf16 {
    static constexpr bool PERM = true;
    bf16_t* C; int ldc;
    __device__ __forceinline__ void operator()(const f32x4 (&acc)[2][2][4][2], const Unit& u, int wr, int wc, int fr, int fq) const {
        const int row0 = u.pm * BM + wr * 64 + fr, col0 = u.pn * BM + wc * 32 + 8 * fq;
#pragma unroll
        for (int ai = 0; ai < 2; ++ai)
#pragma unroll
            for (int m = 0; m < 4; ++m) { bf16_t* rowp = C + (size_t)(row0 + ai * HALF + m * 16) * ldc + col0;
#pragma unroll
                for (int bj = 0; bj < 2; ++bj) {
                    const f32x4 v0 = acc[ai][bj][m][0], v1 = acc[ai][bj][m][1];
                    u32x4 w; w.x = cvt_pk_bf16(v0[0], v0[1]); w.y = cvt_pk_bf16(v0[2], v0[3]); w.z = cvt_pk_bf16(v1[0], v1[1]); w.w = cvt_pk_bf16(v1[2], v1[3]);
                    *(u32x4*)(rowp + bj * HALF) = w; } }
    }
};
struct EpiGate {
    static constexpr bool PERM = true;
    bf16_t* G0;
    __device__ __forceinline__ void operator()(const f32x4 (&acc)[2][2][4][2], const Unit& u, int wr, int wc, int fr, int fq) const {
        bf16_t* base = G0 + (size_t)(u.pn >> 1) * ((size_t)NTOK * 512);
        const int row0 = u.pm * BM + wr * 64 + fr, col0 = (u.pn & 1) * 256 + wc * 32 + 8 * fq;
#pragma unroll
        for (int ai = 0; ai < 2; ++ai)
#pragma unroll
            for (int m = 0; m < 4; ++m) { bf16_t* rowp = base + (size_t)(row0 + ai * HALF + m * 16) * 512 + col0;
#pragma unroll
                for (int bj = 0; bj < 2; ++bj) {
                    f32x4 v0 = acc[ai][bj][m][0], v1 = acc[ai][bj][m][1];
#pragma unroll
                    for (int j = 0; j < 4; ++j) { v0[j] = sigmoidf_(v0[j]); v1[j] = sigmoidf_(v1[j]); }
                    u32x4 w; w.x = cvt_pk_bf16(v0[0], v0[1]); w.y = cvt_pk_bf16(v0[2], v0[3]); w.z = cvt_pk_bf16(v1[0], v1[1]); w.w = cvt_pk_bf16(v1[2], v1[3]);
                    *(u32x4*)(rowp + bj * HALF) = w; } }
    }
};
struct EpiSwiglu {
    static constexpr bool PERM = true;
    bf16_t* O; int ldc;
    __device__ __forceinline__ void operator()(const f32x4 (&acc)[2][2][4][2], const Unit& u, int wr, int wc, int fr, int fq) const {
        const int row0 = u.pm * BM + wr * 64 + fr, col0 = u.pn * HALF + wc * 32 + 8 * fq;
#pragma unroll
        for (int ai = 0; ai < 2; ++ai)
#pragma unroll
            for (int m = 0; m < 4; ++m) { bf16_t* rowp = O + (size_t)(row0 + ai * HALF + m * 16) * ldc + col0;
                float r[8];
#pragma unroll
                for (int n = 0; n < 2; ++n)
#pragma unroll
                    for (int j = 0; j < 4; ++j) { const float gv = acc[ai][0][m][n][j], uv = acc[ai][1][m][n][j]; r[n * 4 + j] = gv * sigmoidf_(gv) * uv; }
                u32x4 w; w.x = cvt_pk_bf16(r[0], r[1]); w.y = cvt_pk_bf16(r[2], r[3]); w.z = cvt_pk_bf16(r[4], r[5]); w.w = cvt_pk_bf16(r[6], r[7]);
                *(u32x4*)rowp = w; }
    }
};
struct EpiBranch {
    static constexpr bool PERM = true;
    bf16_t* Mg; const bf16_t* G0;
    __device__ __forceinline__ void operator()(const f32x4 (&acc)[2][2][4][2], const Unit& u, int wr, int wc, int fr, int fq) const {
        const bf16_t* gb = G0 + (size_t)(u.br * 2 + (u.pn >> 1)) * ((size_t)NTOK * 512);
        const int row0 = u.pm * BM + wr * 64 + fr, cl = wc * 32 + 8 * fq;
#pragma unroll
        for (int ai = 0; ai < 2; ++ai) {
            u32x4 gw[4][2], ow[4][2];
#pragma unroll
            for (int m = 0; m < 4; ++m) { const size_t row = (size_t)(row0 + ai * HALF + m * 16);
#pragma unroll
                for (int bj = 0; bj < 2; ++bj) {
                    gw[m][bj] = *(const u32x4*)(gb + row * 512 + (u.pn & 1) * 256 + bj * HALF + cl);
                    if (u.br != 0) ow[m][bj] = *(const u32x4*)(Mg + row * 1024 + u.pn * 256 + bj * HALF + cl); } }
#pragma unroll
            for (int m = 0; m < 4; ++m) { const size_t row = (size_t)(row0 + ai * HALF + m * 16);
#pragma unroll
                for (int bj = 0; bj < 2; ++bj) {
                    bf16_t* mp = Mg + row * 1024 + u.pn * 256 + bj * HALF + cl;
                    float r[8];
#pragma unroll
                    for (int q = 0; q < 4; ++q) { const unsigned g2 = gw[m][bj][q]; const int n = q >> 1, j = (q & 1) * 2;
                        r[q * 2] = __uint_as_float(g2 << 16) * acc[ai][bj][m][n][j]; r[q * 2 + 1] = __uint_as_float(g2 & 0xffff0000u) * acc[ai][bj][m][n][j + 1]; }
                    if (u.br != 0) {
#pragma unroll
                        for (int q = 0; q < 4; ++q) { r[q * 2] += __uint_as_float(ow[m][bj][q] << 16); r[q * 2 + 1] += __uint_as_float(ow[m][bj][q] & 0xffff0000u); } }
                    u32x4 w; w.x = cvt_pk_bf16(r[0], r[1]); w.y = cvt_pk_bf16(r[2], r[3]); w.z = cvt_pk_bf16(r[4], r[5]); w.w = cvt_pk_bf16(r[6], r[7]);
                    *(u32x4*)mp = w; } }
        }
    }
};
}

template <int MAP> __device__ __forceinline__ int colmap(int n, int off) {
    if (MAP == 0) return n + off;
    if (MAP == 1) { if (n < 3584) return n; const int s = n - 512; return s < C_G ? s : -1; }
    const int pn = n >> 8, r = n & 255; return (r < 128) ? 128 * pn + r : D_FF + 128 * pn + (r - 128);
}
template <int MAP>
__device__ void conv_job(LAS unsigned char* lds, bf16_t* dst_, int ld_dst, int koff, const float* src_, int ld_src, int K, int n_lo, int n_hi, int off, int bid, int nb, int fbase = 0) {
    GAS bf16_t* dst = (GAS bf16_t*)dst_; GAS const float* src = (GAS const float*)src_;
    const int tid = phase_tid(), wid = __builtin_amdgcn_readfirstlane(tid >> 6), lane = tid & 63;
    LAS float* tile = (LAS float*)lds + wid * (64 * 65);
    const int nk = K / 64, nn = (n_hi - n_lo) / 64;
    const int l4 = lane >> 4, c4 = (lane & 15) * 4, l8 = lane >> 3, k8 = (lane & 7) * 8;
    for (int f = bid * 8 + wid; f < fbase + nk * nn; f += nb * 8) {
        if (f < fbase) continue;
        const int it = f - fbase;
        const int n0 = n_lo + (it % nn) * 64, k0 = (it / nn) * 64;
        const int cfirst = colmap<MAP>(n0 + c4, off), clast = colmap<MAP>(n0 + c4 + 3, off);
        GAS const float* sp = src + (size_t)(k0 + l4) * ld_src;
        f32x4 v[16];
        if (cfirst >= 0 && clast == cfirst + 3 && ((cfirst | ld_src) & 3) == 0) {
#pragma unroll
            for (int j = 0; j < 16; ++j) v[j] = __builtin_nontemporal_load((GAS const f32x4*)(sp + (size_t)(4 * j) * ld_src + cfirst));
        } else {
            const int q0 = colmap<MAP>(n0 + c4, off), q1 = colmap<MAP>(n0 + c4 + 1, off), q2 = colmap<MAP>(n0 + c4 + 2, off), q3 = colmap<MAP>(n0 + c4 + 3, off);
#pragma unroll
            for (int j = 0; j < 16; ++j) { GAS const float* r = sp + (size_t)(4 * j) * ld_src;
                v[j][0] = (q0 >= 0) ? r[q0] : 0.f; v[j][1] = (q1 >= 0) ? r[q1] : 0.f; v[j][2] = (q2 >= 0) ? r[q2] : 0.f; v[j][3] = (q3 >= 0) ? r[q3] : 0.f; }
        }
#pragma unroll
        for (int j = 0; j < 16; ++j) { LAS float* t = tile + (4 * j + l4) * 65 + c4; t[0] = v[j][0]; t[1] = v[j][1]; t[2] = v[j][2]; t[3] = v[j][3]; }
        asm volatile("s_waitcnt lgkmcnt(0)" ::: "memory");
#pragma unroll
        for (int jj = 0; jj < 8; ++jj) { const int nr = l8 + 8 * jj; float w8[8];
#pragma unroll
            for (int e = 0; e < 8; ++e) w8[e] = tile[(k8 + e) * 65 + nr];
            u32x4 w; w.x = cvt_pk_bf16(w8[0], w8[1]); w.y = cvt_pk_bf16(w8[2], w8[3]); w.z = cvt_pk_bf16(w8[4], w8[5]); w.w = cvt_pk_bf16(w8[6], w8[7]);
            *(GAS u32x4*)(dst + (size_t)(n0 + nr) * ld_dst + koff + k0 + k8) = w; }
        asm volatile("s_waitcnt lgkmcnt(0)" ::: "memory");
    }
}
__device__ void fold_tile(LAS unsigned char* lds, bf16_t* out, long sOi, long sOj, const float* A, long sAi, long sAd, const float* B, long sBj, long sBd) {
    LAS float* As = (LAS float*)lds; LAS float* Bs = As + 64 * 132;
    const int tid = phase_tid();
    {
        float av[16], bv[16];
#pragma unroll
        for (int k = 0; k < 16; ++k) { const int e = tid + 512 * k;
            int i, d; if (sAd == 1) { i = e >> 7; d = e & 127; } else { d = e >> 6; i = e & 63; }
            av[k] = A[i * sAi + d * sAd];
            int j, d2; if (sBd == 1) { j = e >> 7; d2 = e & 127; } else { d2 = e >> 6; j = e & 63; }
            bv[k] = B[j * sBj + d2 * sBd]; }
#pragma unroll
        for (int k = 0; k < 16; ++k) { const int e = tid + 512 * k;
            int i, d; if (sAd == 1) { i = e >> 7; d = e & 127; } else { d = e >> 6; i = e & 63; }
            As[i * 132 + d] = av[k];
            int j, d2; if (sBd == 1) { j = e >> 7; d2 = e & 127; } else { d2 = e >> 6; j = e & 63; }
            Bs[j * 132 + d2] = bv[k]; }
    }
    __syncthreads();
    const int lane = tid & 63, w = tid >> 6, fr = lane & 15, g = lane >> 4, i0 = (w & 3) * 16, j0 = (w >> 2) * 32;
    f32x4 acc[2]; acc[0] = (f32x4){0.f, 0.f, 0.f, 0.f}; acc[1] = (f32x4){0.f, 0.f, 0.f, 0.f};
#define FOLD_SPLIT(hi, lo, x0, x1) { u32x4 h_, l_;                                                                              \
        h_.x = cvt_pk_bf16(x0[0], x0[1]); h_.y = cvt_pk_bf16(x0[2], x0[3]); h_.z = cvt_pk_bf16(x1[0], x1[1]); h_.w = cvt_pk_bf16(x1[2], x1[3]);  \
        l_.x = cvt_pk_bf16(x0[0] - __uint_as_float(h_.x << 16), x0[1] - __uint_as_float(h_.x & 0xffff0000u));                      \
        l_.y = cvt_pk_bf16(x0[2] - __uint_as_float(h_.y << 16), x0[3] - __uint_as_float(h_.y & 0xffff0000u));                      \
        l_.z = cvt_pk_bf16(x1[0] - __uint_as_float(h_.z << 16), x1[1] - __uint_as_float(h_.z & 0xffff0000u));                      \
        l_.w = cvt_pk_bf16(x1[2] - __uint_as_float(h_.w << 16), x1[3] - __uint_as_float(h_.w & 0xffff0000u));                      \
        hi = __builtin_bit_cast(bf16x8, h_); lo = __builtin_bit_cast(bf16x8, l_); }
#pragma unroll
    for (int ks = 0; ks < 4; ++ks) {
        const f32x4 a0 = *(const LAS f32x4*)(As + (i0 + fr) * 132 + 32 * ks + 8 * g), a1 = *(const LAS f32x4*)(As + (i0 + fr) * 132 + 32 * ks + 8 * g + 4);
        const f32x4 b0 = *(const LAS f32x4*)(Bs + (j0 + fr) * 132 + 32 * ks + 8 * g), b1 = *(const LAS f32x4*)(Bs + (j0 + fr) * 132 + 32 * ks + 8 * g + 4);
        const f32x4 c0 = *(const LAS f32x4*)(Bs + (j0 + 16 + fr) * 132 + 32 * ks + 8 * g), c1 = *(const LAS f32x4*)(Bs + (j0 + 16 + fr) * 132 + 32 * ks + 8 * g + 4);
        bf16x8 ah, al, bh, bl, ch, cl;
        FOLD_SPLIT(ah, al, a0, a1) FOLD_SPLIT(bh, bl, b0, b1) FOLD_SPLIT(ch, cl, c0, c1)
        acc[0] = __builtin_amdgcn_mfma_f32_16x16x32_bf16(al, bh, acc[0], 0, 0, 0); acc[1] = __builtin_amdgcn_mfma_f32_16x16x32_bf16(al, ch, acc[1], 0, 0, 0);
        acc[0] = __builtin_amdgcn_mfma_f32_16x16x32_bf16(ah, bl, acc[0], 0, 0, 0); acc[1] = __builtin_amdgcn_mfma_f32_16x16x32_bf16(ah, cl, acc[1], 0, 0, 0);
        acc[0] = __builtin_amdgcn_mfma_f32_16x16x32_bf16(ah, bh, acc[0], 0, 0, 0); acc[1] = __builtin_amdgcn_mfma_f32_16x16x32_bf16(ah, ch, acc[1], 0, 0, 0);
    }
#undef FOLD_SPLIT
    mfma_fence(acc[0]); mfma_fence(acc[1]);
#pragma unroll
    for (int jt = 0; jt < 2; ++jt) { const int j = j0 + 16 * jt + fr;
        if (sOi == 1) { u32x2 o; o.x = cvt_pk_bf16(acc[jt][0], acc[jt][1]); o.y = cvt_pk_bf16(acc[jt][2], acc[jt][3]); *(u32x2*)(out + (i0 + 4 * g) + j * sOj) = o; }
        else {
#pragma unroll
            for (int r = 0; r < 4; ++r) out[(i0 + 4 * g + r) * sOi + j * sOj] = f2bf(acc[jt][r]); } }
    __syncthreads();
}

__device__ void phase_conv_in(const Params& p, int l, LAS unsigned char* lds, int bid, int nb) {
    const float* Win = IN(p, I_WIN) + (size_t)l * D_MODEL * IN_W;
    __syncthreads();
    conv_job<1>(lds, BF(p, OFF_WIN), 1024, 0, Win, IN_W, 1024, 0, 3584, 0, bid, nb);
    conv_job<1>(lds, BF(p, OFF_WIN), 1024, 0, Win, IN_W, 1024, 4608, NP1, 0, bid, nb, 16 * 56);
    __syncthreads();
    const float* wuk = IN(p, I_WUK) + (size_t)l * 256 * 512;
    for (int it = bid; it < 256; it += nb) { const int h = it >> 6, rb = (it >> 4) & 3, kb = it & 15;
        fold_tile(lds, BF(p, OFF_WIN) + (size_t)(3584 + h * 256 + rb * 64) * 1024 + kb * 64, 1, 1024,
                  Win + (size_t)(kb * 64) * IN_W + C_DQ + h * 128, IN_W, 1, wuk + ((size_t)(rb * 64) * 4 + h) * 128, 512, 1); }
}
__device__ void phase_conv_postA(const Params& p, int l, LAS unsigned char* lds, int bid, int nb) {
    const float* Win = IN(p, I_WIN) + (size_t)l * D_MODEL * IN_W;
    __syncthreads();
    conv_job<0>(lds, BF(p, OFF_WG), 1024, 0, Win, IN_W, 1024, 0, 3072, C_G, bid, nb);
    conv_job<0>(lds, BF(p, OFF_WBR), 2048, 0, IN(p, I_WA) + (size_t)l * 512 * 1024, 1024, 512, 0, 1024, 0, bid, nb, 768);
    conv_job<0>(lds, BF(p, OFF_WBR), 2048, 512, IN(p, I_WB) + (size_t)l * 512 * 1024, 1024, 512, 0, 1024, 0, bid, nb, 768 + 128);
    __syncthreads();
    const float* wuv = IN(p, I_WUV) + (size_t)l * 256 * 512; const float* wc = IN(p, I_WC) + (size_t)l * 512 * 1024;
    for (int it = bid; it < 256; it += nb) { const int h = it >> 6, rb = (it >> 4) & 3, nbk = it & 15;
        fold_tile(lds, BF(p, OFF_WBR) + (size_t)(nbk * 64) * 2048 + 1024 + h * 256 + rb * 64, 1, 2048,
                  wuv + ((size_t)(rb * 64) * 4 + h) * 128, 512, 1, wc + (size_t)(h * 128) * 1024 + nbk * 64, 1, 1024); }
}
__device__ void phase_conv_postB(const Params& p, int l, LAS unsigned char* lds, int bid, int nb) {
    __syncthreads();
    conv_job<0>(lds, BF(p, OFF_WOUT), 1024, 0, IN(p, I_WOUT) + (size_t)l * 1024 * 1024, 1024, 1024, 0, 1024, 0, bid, nb);
    conv_job<2>(lds, BF(p, OFF_WF1), 1024, 0, IN(p, I_WF1) + (size_t)l * 1024 * 2 * D_FF, 2 * D_FF, 1024, 0, 2 * D_FF, 0, bid, nb, 256);
    conv_job<0>(lds, BF(p, OFF_WF2), D_FF, 0, IN(p, I_WF2) + (size_t)l * D_FF * 1024, 1024, D_FF, 0, 1024, 0, bid, nb, 256 + 16 * (2 * D_FF / 64));
    __syncthreads();
}

__device__ __forceinline__ unsigned wave_sum_u32(unsigned v) {
    v += (unsigned)__builtin_amdgcn_update_dpp(0, (int)v, 0x111, 0xf, 0xf, true);
    v += (unsigned)__builtin_amdgcn_update_dpp(0, (int)v, 0x112, 0xf, 0xf, true);
    v += (unsigned)__builtin_amdgcn_update_dpp(0, (int)v, 0x114, 0xf, 0xf, true);
    v += (unsigned)__builtin_amdgcn_update_dpp(0, (int)v, 0x118, 0xf, 0xf, true);
    v += (unsigned)__builtin_amdgcn_update_dpp(0, (int)v, 0x142, 0xa, 0xf, false);
    v += (unsigned)__builtin_amdgcn_update_dpp(0, (int)v, 0x143, 0xc, 0xf, false);
    return (unsigned)__builtin_amdgcn_readlane((int)v, 63);
}
__device__ __forceinline__ float max_x16_x32(float v) {
    const unsigned u = __float_as_uint(v);
    const auto a = __builtin_amdgcn_permlane16_swap(u, u, false, false);
    const float m = fmaxf(__uint_as_float(a[0]), __uint_as_float(a[1]));
    const unsigned um = __float_as_uint(m);
    const auto b = __builtin_amdgcn_permlane32_swap(um, um, false, false);
    return fmaxf(__uint_as_float(b[0]), __uint_as_float(b[1]));
}
__device__ __forceinline__ float sum_x16_x32(float v) {
    const unsigned u = __float_as_uint(v);
    const auto a = __builtin_amdgcn_permlane16_swap(u, u, false, false);
    const float m = __uint_as_float(a[0]) + __uint_as_float(a[1]);
    const unsigned um = __float_as_uint(m);
    const auto b = __builtin_amdgcn_permlane32_swap(um, um, false, false);
    return __uint_as_float(b[0]) + __uint_as_float(b[1]);
}
__device__ __forceinline__ float wave_allsum_f32(float v) {
    v += __int_as_float(__builtin_amdgcn_update_dpp(0, __float_as_int(v), 0xB1, 0xf, 0xf, true));
    v += __int_as_float(__builtin_amdgcn_update_dpp(0, __float_as_int(v), 0x4E, 0xf, 0xf, true));
    v += __int_as_float(__builtin_amdgcn_update_dpp(0, __float_as_int(v), 0x141, 0xf, 0xf, true));
    v += __int_as_float(__builtin_amdgcn_update_dpp(0, __float_as_int(v), 0x140, 0xf, 0xf, true));
    const unsigned u = __float_as_uint(v);
    const auto a = __builtin_amdgcn_permlane16_swap(u, u, false, false);
    const float m = __uint_as_float(a[0]) + __uint_as_float(a[1]);
    const unsigned um = __float_as_uint(m);
    const auto b = __builtin_amdgcn_permlane32_swap(um, um, false, false);
    return __uint_as_float(b[0]) + __uint_as_float(b[1]);
}
#define DPP_STEP_(v, op, ctrl, rmask) (v) = op((v), (decltype(v))__builtin_amdgcn_update_dpp((int)(v), (int)(v), (ctrl), (rmask), 0xf, false))
__device__ __forceinline__ unsigned umin_(unsigned a, unsigned b) { return a < b ? a : b; }
__device__ __forceinline__ unsigned umax_(unsigned a, unsigned b) { return a > b ? a : b; }
__device__ __forceinline__ unsigned wave_min_u32(unsigned v) {
    DPP_STEP_(v, umin_, 0x111, 0xf); DPP_STEP_(v, umin_, 0x112, 0xf); DPP_STEP_(v, umin_, 0x114, 0xf); DPP_STEP_(v, umin_, 0x118, 0xf); DPP_STEP_(v, umin_, 0x142, 0xa); DPP_STEP_(v, umin_, 0x143, 0xc);
    return (unsigned)__builtin_amdgcn_readlane((int)v, 63); }
__device__ __forceinline__ unsigned wave_max_u32(unsigned v) {
    DPP_STEP_(v, umax_, 0x111, 0xf); DPP_STEP_(v, umax_, 0x112, 0xf); DPP_STEP_(v, umax_, 0x114, 0xf); DPP_STEP_(v, umax_, 0x118, 0xf); DPP_STEP_(v, umax_, 0x142, 0xa); DPP_STEP_(v, umax_, 0x143, 0xc);
    return (unsigned)__builtin_amdgcn_readlane((int)v, 63); }
__device__ __forceinline__ int wave_scan_incl(int v) {
    v += __builtin_amdgcn_update_dpp(0, v, 0x111, 0xf, 0xf, true); v += __builtin_amdgcn_update_dpp(0, v, 0x112, 0xf, 0xf, true);
    v += __builtin_amdgcn_update_dpp(0, v, 0x114, 0xf, 0xf, true); v += __builtin_amdgcn_update_dpp(0, v, 0x118, 0xf, 0xf, true);
    v += __builtin_amdgcn_update_dpp(0, v, 0x142, 0xa, 0xf, false); v += __builtin_amdgcn_update_dpp(0, v, 0x143, 0xc, 0xf, false);
    return v; }
__device__ __forceinline__ float wave_sum(float v) {
#pragma unroll
    for (int o = 32; o >= 1; o >>= 1) v += __shfl_xor(v, o);
    return v;
}
template <int MODE, bool XIN_BF, bool XOUT_BF>
__device__ void phase_norm(const void* xin_, void* xout_, const bf16_t* O_, const float* wpost_, const float* w1_, bf16_t* H_, int bid, int nb) {
    GAS const float* xin = (GAS const float*)xin_; GAS float* xout = (GAS float*)xout_; GAS const bf16_t* xinb = (GAS const bf16_t*)xin_; GAS bf16_t* xoutb = (GAS bf16_t*)xout_;
    GAS const bf16_t* O = (GAS const bf16_t*)O_; GAS const float* wpost = (GAS const float*)wpost_; GAS const float* w1 = (GAS const float*)w1_; GAS bf16_t* H = (GAS bf16_t*)H_;
    const int tidn = phase_tid(); const int wv = tidn >> 6, lane = tidn & 63;
    f32x4 wpv[4], w1v[4];
#pragma unroll
    for (int j = 0; j < 4; ++j) { const f32x4 z4 = {0.f, 0.f, 0.f, 0.f}; wpv[j] = (MODE >= 1) ? *(GAS const f32x4*)(wpost + j * 256 + lane * 4) : z4; w1v[j] = (MODE <= 1) ? *(GAS const f32x4*)(w1 + j * 256 + lane * 4) : z4; }
    constexpr int NR = 2;
    for (int row0 = bid * 8 + wv; row0 < NTOK; row0 += NR * nb * 8) {
        f32x4 xv[NR][4], ov[NR][4];
#pragma unroll
        for (int q = 0; q < NR; ++q) { const int row = (row0 + q * nb * 8 < NTOK) ? row0 + q * nb * 8 : row0;
#pragma unroll
            for (int j = 0; j < 4; ++j) {
                if (XIN_BF) { const u32x2 xw = __builtin_nontemporal_load((GAS const u32x2*)(xinb + (size_t)row * 1024 + j * 256 + lane * 4));
                    xv[q][j] = (f32x4){__uint_as_float(xw.x << 16), __uint_as_float(xw.x & 0xffff0000u), __uint_as_float(xw.y << 16), __uint_as_float(xw.y & 0xffff0000u)}; }
                else xv[q][j] = __builtin_nontemporal_load((GAS const f32x4*)(xin + (size_t)row * 1024 + j * 256 + lane * 4));
                if (MODE >= 1) { const u32x2 ow = __builtin_nontemporal_load((GAS const u32x2*)(O + (size_t)row * 1024 + j * 256 + lane * 4));
                    ov[q][j] = (f32x4){__uint_as_float(ow.x << 16), __uint_as_float(ow.x & 0xffff0000u), __uint_as_float(ow.y << 16), __uint_as_float(ow.y & 0xffff0000u)}; } } }
        if (MODE >= 1) {
            float ss[NR];
#pragma unroll
            for (int q = 0; q < NR; ++q) { ss[q] = 0.f;
#pragma unroll
                for (int j = 0; j < 4; ++j) ss[q] += ov[q][j][0] * ov[q][j][0] + ov[q][j][1] * ov[q][j][1] + ov[q][j][2] * ov[q][j][2] + ov[q][j][3] * ov[q][j][3]; }
#pragma unroll
            for (int q = 0; q < NR; ++q) ss[q] = wave_allsum_f32(ss[q]);
#pragma unroll
            for (int q = 0; q < NR; ++q) { const int row = row0 + q * nb * 8; const float r = rsqrtf(ss[q] * (1.f / 1024.f) + 1e-6f);
#pragma unroll
                for (int j = 0; j < 4; ++j) { const f32x4 wv4 = wpv[j]; xv[q][j] = xv[q][j] + ov[q][j] * r * wv4;
                    if (XOUT_BF) { u32x2 xw; xw.x = cvt_pk_bf16(xv[q][j][0], xv[q][j][1]); xw.y = cvt_pk_bf16(xv[q][j][2], xv[q][j][3]); if (row < NTOK) *(GAS u32x2*)(xoutb + (size_t)row * 1024 + j * 256 + lane * 4) = xw;
                        xv[q][j] = (f32x4){__uint_as_float(xw.x << 16), __uint_as_float(xw.x & 0xffff0000u), __uint_as_float(xw.y << 16), __uint_as_float(xw.y & 0xffff0000u)}; }
                    else if (row < NTOK) *(GAS f32x4*)(xout + (size_t)row * 1024 + j * 256 + lane * 4) = xv[q][j]; } }
        }
        if (MODE <= 1) {
            float ss[NR];
#pragma unroll
            for (int q = 0; q < NR; ++q) { ss[q] = 0.f;
#pragma unroll
                for (int j = 0; j < 4; ++j) ss[q] += xv[q][j][0] * xv[q][j][0] + xv[q][j][1] * xv[q][j][1] + xv[q][j][2] * xv[q][j][2] + xv[q][j][3] * xv[q][j][3]; }
#pragma unroll
            for (int q = 0; q < NR; ++q) ss[q] = wave_allsum_f32(ss[q]);
#pragma unroll
            for (int q = 0; q < NR; ++q) { const int row = row0 + q * nb * 8; const float r = rsqrtf(ss[q] * (1.f / 1024.f) + 1e-6f);
#pragma unroll
                for (int j = 0; j < 4; ++j) { const f32x4 wv4 = w1v[j]; const f32x4 y = xv[q][j] * r * wv4;
                    u32x2 w; w.x = cvt_pk_bf16(y[0], y[1]); w.y = cvt_pk_bf16(y[2], y[3]); if (row < NTOK) *(GAS u32x2*)(H + (size_t)row * 1024 + j * 256 + lane * 4) = w; } }
        }
    }
}

__device__ void phase_gemm_in(const Params& p, LAS unsigned char* lds, int bid, int nb) {
    pg8::EpiProj E{(unsigned char*)p.ws};
    pg8::Gemm g{BF(p, OFF_H), BF(p, OFF_WIN), 1024, 1024};
    pg8::StaticOrder S; S.init(NTOK, NP1, 1024, nb, bid);
    pg8::gemm_phase(lds, g, S, E);
}
__device__ void phase_gemm_gates(const Params& p, LAS unsigned char* lds, int bid, int nb) {
    pg8::EpiGate E{BF(p, OFF_HF)};
    pg8::Gemm g{BF(p, OFF_H), BF(p, OFF_WG), 1024, 1024};
    pg8::StaticOrder S; S.init(NTOK, 3072, 1024, nb, bid);
    pg8::gemm_phase(lds, g, S, E);
}
__device__ void phase_gemm_branch(const Params& p, LAS unsigned char* lds, int bid, int nb) {
    pg8::EpiBranch E; E.Mg = BF(p, OFF_H); E.G0 = BF(p, OFF_HF);
    pg8::Gemm g{BF(p, OFF_Y), BF(p, OFF_WBR), 2048, 2048};
    pg8::BranchOrder S; S.init(NTOK, 1024, nb, bid);
    pg8::gemm_phase(lds, g, S, E);
}
__device__ void phase_gemm_out(const Params& p, LAS unsigned char* lds, int bid, int nb) {
    pg8::EpiBf16 E{BF(p, OFF_OUT), 1024};
    pg8::Gemm g{BF(p, OFF_H), BF(p, OFF_WOUT), 1024, 1024};
    pg8::StaticOrder S; S.init(NTOK, 1024, 1024, nb, bid);
    pg8::gemm_phase(lds, g, S, E);
}
__device__ void phase_gemm_ffn1(const Params& p, LAS unsigned char* lds, int bid, int nb) {
    pg8::EpiSwiglu E{BF(p, OFF_ACT), D_FF};
    pg8::Gemm g{BF(p, OFF_H), BF(p, OFF_WF1), 1024, 1024};
    pg8::StaticOrder S; S.init(NTOK, 2 * D_FF, 1024, nb, bid);
    pg8::gemm_phase(lds, g, S, E);
}
__device__ void phase_gemm_ffn2(const Params& p, LAS unsigned char* lds, int bid, int nb) {
    pg8::EpiBf16 E{BF(p, OFF_OUT), 1024};
    pg8::Gemm g{BF(p, OFF_ACT), BF(p, OFF_WF2), D_FF, D_FF};
    pg8::StaticOrder S; S.init(NTOK, 1024, D_FF, nb, bid);
    pg8::gemm_phase(lds, g, S, E);
}


__device__ __forceinline__ float hg_lower_bound(float l0, float l1, int l) {
    const float m = fmaxf(l0, l1), e0 = __expf(l0 - m), e1 = __expf(l1 - m), p0 = e0 / (e0 + e1), p1 = e1 / (e0 + e1);
    return ((l == 0) ? p0 : (p0 + p1)) - p0;
}
__device__ __forceinline__ void pack16_store(LAS unsigned char* dst, const float (&v)[16]) {
    u32x4 a, b; a.x = cvt_pk_bf16(v[0], v[1]); a.y = cvt_pk_bf16(v[2], v[3]); a.z = cvt_pk_bf16(v[4], v[5]); a.w = cvt_pk_bf16(v[6], v[7]);
    b.x = cvt_pk_bf16(v[8], v[9]); b.y = cvt_pk_bf16(v[10], v[11]); b.z = cvt_pk_bf16(v[12], v[13]); b.w = cvt_pk_bf16(v[14], v[15]);
    *(LAS u32x4*)dst = a; *(LAS u32x4*)(dst + 16) = b;
}
#define HG_FRONT()                                                                                                   \
    const int d = tid & 127, seg = tid >> 7;                                                                         \
    const float lbd = (h == 0) ? lbdv[0] : (h == 1) ? lbdv[1] : (h == 2) ? lbdv[2] : lbdv[3];                          \
    float kk[16], cs[16];                                                                                            \
    { float run = 0.f;                                                                                               \
      _Pragma("unroll") for (int jj = 0; jj < 16; ++jj) {                                                            \
          const float fp = bf2f(HF[(size_t)(row0 + seg * 16 + jj) * 512 + h * 128 + d]);                            \
          const float sg = sigmoidf_(fp); const float f = fmaxf(lbd + (1.f - lbd) * sg, 1e-20f);                     \
          kk[jj] = (1.f - lbd) * (1.f - sg); run += __builtin_amdgcn_logf(f) * 0.6931471805599453f; cs[jj] = run; }                                              \
      SEG[seg * 128 + d] = run; }
#define HG_FRONT_V(hfv_)                                                                                                   \
    const int d = tid & 127, seg = tid >> 7;                                                                         \
    const float lbd = (h == 0) ? lbdv[0] : (h == 1) ? lbdv[1] : (h == 2) ? lbdv[2] : lbdv[3];                          \
    float kk[16], cs[16];                                                                                            \
    { float run = 0.f;                                                                                               \
      _Pragma("unroll") for (int jj = 0; jj < 16; ++jj) {                                                            \
          const float fp = bf2f((hfv_)[jj]);                                                                                                \
          const float sg = sigmoidf_(fp); const float f = fmaxf(lbd + (1.f - lbd) * sg, 1e-20f);                     \
          kk[jj] = (1.f - lbd) * (1.f - sg); run += __builtin_amdgcn_logf(f) * 0.6931471805599453f; cs[jj] = run; }                                              \
      SEG[seg * 128 + d] = run; }

__device__ void phase_hg1(const Params& p, int l, LAS unsigned char* lds, int bid, int nb) {
    const int tid = phase_tid(), lane = tid & 63, w = __builtin_amdgcn_readfirstlane(tid >> 6), fr = lane & 15, g = lane >> 4;
    LAS float* SEG = (LAS float*)lds; LAS unsigned char* KT = lds + 2048; LAS unsigned char* VT = KT + 128 * 144;
    const bf16_t* HF = BF(p, OFF_HF); const bf16_t* HI = BF(p, OFF_HI); bf16_t* ST = BF(p, OFF_ST); float* DEC = F32P(p, OFF_DEC);
    float lb0[4], lb1[4];
    float lbdv[4];
#pragma unroll
    for (int hh = 0; hh < 4; ++hh) { lb0[hh] = IN(p, I_LB)[hh * 128 + (tid & 127)]; lb1[hh] = IN(p, I_LB)[512 + hh * 128 + (tid & 127)]; }
#pragma unroll
    for (int hh = 0; hh < 4; ++hh) lbdv[hh] = hg_lower_bound(lb0[hh], lb1[hh], l);
    bf16_t hfv[16], hiv[16];
#define HG1_LOAD(unit_) do { const int bh_ = (unit_) >> 6, c_ = (unit_) & 63, h_ = bh_ & 3, row0_ = (bh_ >> 2) * SEQ + c_ * 64; \
        const unsigned o5_ = (unsigned)(row0_ + (tid >> 7) * 16) * 512u + (unsigned)(h_ * 128 + (tid & 127)); \
        _Pragma("unroll") for (int jj = 0; jj < 16; ++jj) { hfv[jj] = HF[o5_ + 512u * jj]; hiv[jj] = HI[o5_ + 512u * jj]; } } while (0)
    if (bid < 1024) HG1_LOAD(bid);
    for (int unit = bid; unit < 1024; unit += nb) {
        const int bh = unit >> 6, c = unit & 63, h = bh & 3, row0 = (bh >> 2) * SEQ + c * 64;
        HG_FRONT_V(hfv);
        float vv[16];
#pragma unroll
        for (int jj = 0; jj < 16; ++jj) vv[jj] = bf2f(hiv[jj]);
        if (unit + nb < 1024) HG1_LOAD(unit + nb);
        __syncthreads();
        float off = 0.f, bl = 0.f;
#pragma unroll
        for (int s2 = 0; s2 < 4; ++s2) { const float t = SEG[s2 * 128 + d]; off += (s2 < seg) ? t : 0.f; bl += t; }
        float kb[16];
#pragma unroll
        for (int jj = 0; jj < 16; ++jj) kb[jj] = kk[jj] * __expf(bl - (off + cs[jj]));
        pack16_store(KT + d * 144 + seg * 32, kb);
        pack16_store(VT + d * 144 + seg * 32, vv);
        if (seg == 0) DEC[(size_t)unit * 128 + d] = __expf(bl);
        __syncthreads();
        bf16x8 a[2];
#pragma unroll
        for (int ks = 0; ks < 2; ++ks) a[ks] = *(const LAS bf16x8*)(KT + (16 * w + fr) * 144 + (32 * ks + 8 * g) * 2);
        {
            bf16x8 vb[8][2]; f32x4 accs[8];
#pragma unroll
            for (int et = 0; et < 8; ++et)
#pragma unroll
                for (int ks = 0; ks < 2; ++ks) vb[et][ks] = *(const LAS bf16x8*)(VT + (16 * et + fr) * 144 + (32 * ks + 8 * g) * 2);
            __builtin_amdgcn_sched_group_barrier(0x100, 18, 0);
#pragma unroll
            for (int et = 0; et < 8; ++et) accs[et] = (f32x4){0.f, 0.f, 0.f, 0.f};
#pragma unroll
            for (int ks = 0; ks < 2; ++ks)
#pragma unroll
                for (int et = 0; et < 8; ++et) accs[et] = __builtin_amdgcn_mfma_f32_16x16x32_bf16(a[ks], vb[et][ks], accs[et], 0, 0, 0);
            __builtin_amdgcn_sched_group_barrier(0x008, 16, 0);
            mfma_fence(accs[0], accs[1], accs[2], accs[3]); mfma_fence(accs[4], accs[5], accs[6], accs[7]);
#pragma unroll
            for (int et = 0; et < 8; ++et) { u32x2 o; o.x = cvt_pk_bf16(accs[et][0], accs[et][1]); o.y = cvt_pk_bf16(accs[et][2], accs[et][3]);
                *(u32x2*)(ST + ((size_t)unit * 128 + 16 * et + fr) * 128 + 16 * w + 4 * g) = o; }
        }
        __syncthreads();
    }
}
__device__ void phase_hg2(const Params& p, int bid, int nb) {
    bf16_t* ST = BF(p, OFF_ST); const float* DEC = F32P(p, OFF_DEC);
    for (int gid = bid * 512 + phase_tid(); gid < 16 * 8192; gid += nb * 512) {
        const int bh = gid >> 13, within = gid & 8191, e = within >> 6, d = (within & 63) * 2;
        float s0 = 0.f, s1 = 0.f;
        for (int c0 = 0; c0 < 64; c0 += 16) {
            unsigned u[16]; f32x2_t dd[16];
#pragma unroll
            for (int k = 0; k < 16; ++k) { const size_t un = (size_t)(bh * 64 + c0 + k);
                u[k] = *(const unsigned*)(ST + (un * 128 + e) * 128 + d); dd[k] = *(const f32x2_t*)(DEC + un * 128 + d); }
            asm volatile("s_waitcnt vmcnt(0)" ::: "memory");
#pragma unroll
            for (int k = 0; k < 16; ++k) { const size_t un = (size_t)(bh * 64 + c0 + k);
                *(unsigned*)(ST + (un * 128 + e) * 128 + d) = cvt_pk_bf16(s0, s1);
                s0 = dd[k][0] * s0 + __uint_as_float(u[k] << 16); s1 = dd[k][1] * s1 + __uint_as_float(u[k] & 0xffff0000u); }
        }
    }
}
template <int PROBE = 0> __device__ void phase_hg3(const Params& p, int l, LAS unsigned char* lds, int bid, int nb) {
    const int tid = phase_tid(), lane = tid & 63, w = __builtin_amdgcn_readfirstlane(tid >> 6), fr = lane & 15, g = lane >> 4;
    LAS float* SEG = (LAS float*)lds;
    LAS unsigned char* QH = lds + 2048; LAS unsigned char* QT = QH + 64 * 272; LAS float* OL = (LAS float*)(lds + 2048);
    LAS unsigned char* KB = lds + 36864; LAS unsigned char* VT = lds + 54272; LAS unsigned char* SP = lds + 72704; LAS unsigned char* PL = lds + 107520;
    const bf16_t* HF = BF(p, OFF_HF); const bf16_t* HI = BF(p, OFF_HI); const bf16_t* HG = BF(p, OFF_HG); const bf16_t* ST = BF(p, OFF_ST); bf16_t* Y = BF(p, OFF_Y);
    float lbdv[4], lb0[4], lb1[4];
#pragma unroll
    for (int hh = 0; hh < 4; ++hh) { lb0[hh] = IN(p, I_LB)[hh * 128 + (tid & 127)]; lb1[hh] = IN(p, I_LB)[512 + hh * 128 + (tid & 127)]; }
#pragma unroll
    for (int hh = 0; hh < 4; ++hh) lbdv[hh] = hg_lower_bound(lb0[hh], lb1[hh], l);
    float nw[16];
#pragma unroll
    for (int k = 0; k < 16; ++k) nw[k] = IN(p, I_HGNW)[l * 128 + (tid & 7) * 16 + k];
    bf16_t hfv[16], hiv[16], qv[16]; u32x4 spv[4], g0n, g1n;
#define HG3_LOAD(unit_) do { const int bh_ = (unit_) >> 6, c_ = (unit_) & 63, h_ = bh_ & 3, row0_ = (bh_ >> 2) * SEQ + c_ * 64; \
        const unsigned o5_ = (unsigned)(row0_ + (tid >> 7) * 16) * 512u + (unsigned)(h_ * 128 + (tid & 127)), o2_ = (unsigned)(row0_ + (tid >> 7) * 16) * 2048u + (unsigned)(h_ * 128 + (tid & 127)); \
        _Pragma("unroll") for (int jj = 0; jj < 16; ++jj) { hfv[jj] = HF[o5_ + 512u * jj]; hiv[jj] = HI[o5_ + 512u * jj]; qv[jj] = Y[o2_ + 2048u * jj]; } \
        _Pragma("unroll") for (int k = 0; k < 4; ++k) { const int ch = tid + 512 * k, e = ch >> 4, dc = ch & 15; spv[k] = *(const u32x4*)(ST + ((size_t)(unit_) * 128 + e) * 128 + dc * 8); } \
        g0n = *(const u32x4*)(HG + (size_t)(row0_ + (tid >> 3)) * 512 + h_ * 128 + (tid & 7) * 16); g1n = *(const u32x4*)(HG + (size_t)(row0_ + (tid >> 3)) * 512 + h_ * 128 + (tid & 7) * 16 + 8); } while (0)
    if (bid < 1024) HG3_LOAD(bid);
    for (int unit = bid; unit < 1024; unit += nb) {
        const int bh = unit >> 6, c = unit & 63, h = bh & 3, row0 = (bh >> 2) * SEQ + c * 64;
        const u32x4 g0 = g0n, g1 = g1n;
        HG_FRONT_V(hfv);
        {
#pragma unroll
            for (int k = 0; k < 4; ++k) { const int ch = tid + 512 * k, e = ch >> 4, dc = ch & 15; *(LAS u32x4*)(SP + e * 272 + dc * 16) = spv[k]; }
            float vv[16];
#pragma unroll
            for (int jj = 0; jj < 16; ++jj) vv[jj] = bf2f(hiv[jj]);
            pack16_store(VT + d * 144 + seg * 32, vv);
        }
        float qf_[16];
#pragma unroll
        for (int jj = 0; jj < 16; ++jj) qf_[jj] = bf2f(qv[jj]);
        if (unit + nb < 1024) HG3_LOAD(unit + nb);
        __syncthreads();
        float beta[4]; { float run = 0.f;
#pragma unroll
            for (int s2 = 0; s2 < 4; ++s2) { beta[s2] = run; run += SEG[s2 * 128 + d]; } }
        float off = 0.f;
#pragma unroll
        for (int s2 = 0; s2 < 4; ++s2) off = (s2 == seg) ? beta[s2] : off;
#pragma unroll
        for (int jj = 0; jj < 16; ++jj) {
            const float q = qf_[jj];
            const int i = seg * 16 + jj;
            *(LAS bf16_t*)(QH + i * 272 + d * 2) = f2bf(q * __expf(off + cs[jj]));
            *(LAS bf16_t*)(QT + i * 272 + d * 2) = f2bf(q * __expf(cs[jj]));
        }
#pragma unroll
        for (int I = 0; I < 4; ++I) {
            if (seg <= I) {
                float bI = 0.f;
#pragma unroll
                for (int s2 = 0; s2 < 4; ++s2) bI = (s2 == I) ? beta[s2] : bI;
#pragma unroll
                for (int jj = 0; jj < 16; ++jj) *(LAS bf16_t*)(KB + (seg * 16 + jj) * 272 + d * 2) = f2bf(kk[jj] * __expf(fminf(bI - (off + cs[jj]), 60.f)));
            }
            __syncthreads();
            if (w < 4) {
                f32x4 acc = {0.f, 0.f, 0.f, 0.f};
                if (w <= I) { bf16x8 qa[4], kbf[4];
#pragma unroll
                    for (int ks = 0; ks < 4; ++ks) { qa[ks] = *(const LAS bf16x8*)(QT + (16 * I + fr) * 272 + (32 * ks + 8 * g) * 2); kbf[ks] = *(const LAS bf16x8*)(KB + (16 * w + fr) * 272 + (32 * ks + 8 * g) * 2); }
                    __builtin_amdgcn_sched_group_barrier(0x100, 8, 0);
#pragma unroll
                    for (int ks = 0; ks < 4; ++ks) acc = __builtin_amdgcn_mfma_f32_16x16x32_bf16(qa[ks], kbf[ks], acc, 0, 0, 0);
                    __builtin_amdgcn_sched_group_barrier(0x008, 4, 0);
                    mfma_fence(acc);
                    const int lim = (w == I) ? (4 * g) : 1000;
#pragma unroll
                    for (int r = 0; r < 4; ++r) acc[r] = (fr <= lim + r) ? acc[r] : 0.f;
                }
#pragma unroll
                for (int r = 0; r < 4; ++r) *(LAS bf16_t*)(PL + (16 * I + 4 * g + r) * 144 + (16 * w + fr) * 2) = f2bf(acc[r]);
            }
            __syncthreads();
        }
        f32x4 oacc[4];
        { const int ib = w >> 1;
          bf16x8 aq[4], ap[2], bs[4][4], bv[4][2];
#pragma unroll
          for (int ks = 0; ks < 4; ++ks) aq[ks] = *(const LAS bf16x8*)(QH + (16 * ib + fr) * 272 + (32 * ks + 8 * g) * 2);
#pragma unroll
          for (int q4 = 0; q4 < 4; ++q4) { const int et = 4 * (w & 1) + q4;
#pragma unroll
              for (int ks = 0; ks < 4; ++ks) bs[q4][ks] = *(const LAS bf16x8*)(SP + (16 * et + fr) * 272 + (32 * ks + 8 * g) * 2); }
          __builtin_amdgcn_sched_group_barrier(0x100, 20, 0);
#pragma unroll
          for (int q4 = 0; q4 < 4; ++q4) oacc[q4] = (f32x4){0.f, 0.f, 0.f, 0.f};
#pragma unroll
          for (int ks = 0; ks < 2; ++ks)
#pragma unroll
              for (int q4 = 0; q4 < 4; ++q4) oacc[q4] = __builtin_amdgcn_mfma_f32_16x16x32_bf16(aq[ks], bs[q4][ks], oacc[q4], 0, 0, 0);
          __builtin_amdgcn_sched_group_barrier(0x008, 8, 0);
#pragma unroll
          for (int ks = 0; ks < 2; ++ks) ap[ks] = *(const LAS bf16x8*)(PL + (16 * ib + fr) * 144 + (32 * ks + 8 * g) * 2);
#pragma unroll
          for (int q4 = 0; q4 < 4; ++q4) { const int et = 4 * (w & 1) + q4;
#pragma unroll
              for (int ks = 0; ks < 2; ++ks) bv[q4][ks] = *(const LAS bf16x8*)(VT + (16 * et + fr) * 144 + (32 * ks + 8 * g) * 2); }
          __builtin_amdgcn_sched_group_barrier(0x100, 10, 0);
#pragma unroll
          for (int ks = 2; ks < 4; ++ks)
#pragma unroll
              for (int q4 = 0; q4 < 4; ++q4) oacc[q4] = __builtin_amdgcn_mfma_f32_16x16x32_bf16(aq[ks], bs[q4][ks], oacc[q4], 0, 0, 0);
#pragma unroll
          for (int ks = 0; ks < 2; ++ks)
#pragma unroll
              for (int q4 = 0; q4 < 4; ++q4) oacc[q4] = __builtin_amdgcn_mfma_f32_16x16x32_bf16(ap[ks], bv[q4][ks], oacc[q4], 0, 0, 0);
          __builtin_amdgcn_sched_group_barrier(0x008, 16, 0); }
        mfma_fence(oacc[0], oacc[1], oacc[2], oacc[3]);
        __syncthreads();
#pragma unroll
        for (int q4 = 0; q4 < 4; ++q4)
#pragma unroll
            for (int r = 0; r < 4; ++r) OL[(16 * (w >> 1) + 4 * g + r) * 132 + 16 * (4 * (w & 1) + q4) + fr] = oacc[q4][r];
        __syncthreads();
        {
            const int i = tid >> 3, es = (tid & 7) * 16;
            float o[16], ss = 0.f;
#pragma unroll
            for (int k = 0; k < 16; ++k) { o[k] = OL[i * 132 + es + k]; ss += o[k] * o[k]; }
            ss += __int_as_float(__builtin_amdgcn_update_dpp(0, __float_as_int(ss), 0xB1, 0xf, 0xf, true)); ss += __int_as_float(__builtin_amdgcn_update_dpp(0, __float_as_int(ss), 0x4E, 0xf, 0xf, true));
            ss += __int_as_float(__builtin_amdgcn_update_dpp(0, __float_as_int(ss), 0x141, 0xf, 0xf, true));
            const float rstd = rsqrtf(ss * (1.f / 128.f) + 1e-6f);
            float y[16];
#pragma unroll
            for (int k = 0; k < 16; ++k) { const unsigned gw = (k < 8) ? g0[k >> 1] : g1[(k - 8) >> 1]; const float gv = (k & 1) ? __uint_as_float(gw & 0xffff0000u) : __uint_as_float(gw << 16);
                y[k] = o[k] * rstd * nw[k] * (gv * sigmoidf_(gv)); }
            u32x4 a, b; a.x = cvt_pk_bf16(y[0], y[1]); a.y = cvt_pk_bf16(y[2], y[3]); a.z = cvt_pk_bf16(y[4], y[5]); a.w = cvt_pk_bf16(y[6], y[7]);
            b.x = cvt_pk_bf16(y[8], y[9]); b.y = cvt_pk_bf16(y[10], y[11]); b.z = cvt_pk_bf16(y[12], y[13]); b.w = cvt_pk_bf16(y[14], y[15]);
            bf16_t* yo = PROBE ? ((bf16_t*)((unsigned char*)p.x + 16 * MiB) + (size_t)(row0 + i) * 512 + h * 128 + es) : (Y + (size_t)(row0 + i) * 2048 + h * 128 + es);
            *(u32x4*)yo = a; *(u32x4*)(yo + 8) = b;
        }
        __syncthreads();
    }
}


__device__ void phase_prep(const Params& p, int l, LAS unsigned char* lds, int bid, int nb) {
    const int tid = phase_tid(), lane = tid & 63, wv = tid >> 6;
    {
        LAS float* red = (LAS float*)lds; const bf16_t* MK = BF(p, OFF_MK); float* KM = F32P(p, OFF_KMEAN);
        for (int it = bid; it < 256; it += nb) {
            const int bh = it >> 4, n = it & 15, h = bh & 3, d = tid & 127, part = tid >> 7; const size_t row0 = (size_t)(bh >> 2) * SEQ + n * 256 + part * 64;
            float s = 0.f;
#pragma unroll
            for (int jb = 0; jb < 64; jb += 32) { bf16_t v[32];
#pragma unroll
                for (int k = 0; k < 32; ++k) v[k] = MK[(row0 + jb + k) * 512 + h * 128 + d];
                __builtin_amdgcn_sched_group_barrier(0x020, 32, 0);
#pragma unroll
                for (int k = 0; k < 32; ++k) s += bf2f(v[k]); }
            red[part * 128 + d] = s; __syncthreads();
            if (part == 0) KM[(size_t)it * 128 + d] = (red[d] + red[128 + d] + red[256 + d] + red[384 + d]) * (1.f / 256.f);
            __syncthreads();
        }
    }
    bf16_t* CKV = BF(p, OFF_CKV); bf16_t* IKW = BF(p, OFF_IKW); bf16_t* IKT = IKT_PTR(p);
    const float* kvw = IN(p, I_KVN) + l * 256; const float* ikw = IN(p, I_IKNW) + l * 64; const float* ikb = IN(p, I_IKNB) + l * 64;
    constexpr int NR = 4;
    const f32x4 w4 = *(const f32x4*)(kvw + lane * 4); const float lw = ikw[lane], lb = ikb[lane];
    for (int rowb = bid * 8 + wv; rowb < NTOK; rowb += NR * nb * 8) {
        u32x2 cv[NR]; float iu[NR], iwv[NR];
#pragma unroll
        for (int q = 0; q < NR; ++q) { const int row = (rowb + q * nb * 8 < NTOK) ? rowb + q * nb * 8 : rowb;
            cv[q] = *(const u32x2*)(CKV + (size_t)row * 256 + lane * 4);
            const bf16_t* ip = IKW + (size_t)row * 128; iu[q] = bf2f(ip[lane]); iwv[q] = bf2f(ip[64 + (lane & 7)]); }
        float a0[NR], a1[NR], a2[NR], a3[NR], ss[NR], mu[NR];
#pragma unroll
        for (int q = 0; q < NR; ++q) { a0[q] = __uint_as_float(cv[q].x << 16); a1[q] = __uint_as_float(cv[q].x & 0xffff0000u); a2[q] = __uint_as_float(cv[q].y << 16); a3[q] = __uint_as_float(cv[q].y & 0xffff0000u);
            ss[q] = a0[q] * a0[q] + a1[q] * a1[q] + a2[q] * a2[q] + a3[q] * a3[q]; mu[q] = iu[q]; }
#pragma unroll
        for (int q = 0; q < NR; ++q) { ss[q] = wave_allsum_f32(ss[q]); mu[q] = wave_allsum_f32(mu[q]); }
        float xc[NR], var[NR];
#pragma unroll
        for (int q = 0; q < NR; ++q) { mu[q] *= (1.f / 64.f); xc[q] = iu[q] - mu[q]; var[q] = xc[q] * xc[q]; }
#pragma unroll
        for (int q = 0; q < NR; ++q) var[q] = wave_allsum_f32(var[q]);
#pragma unroll
        for (int q = 0; q < NR; ++q) { const int row = rowb + q * nb * 8;
            if (row < NTOK) {
                const float r = rsqrtf(ss[q] * (1.f / 256.f) + 1e-6f);
                u32x2 o; o.x = cvt_pk_bf16(a0[q] * r * w4[0], a1[q] * r * w4[1]); o.y = cvt_pk_bf16(a2[q] * r * w4[2], a3[q] * r * w4[3]); *(u32x2*)(CKV + (size_t)row * 256 + lane * 4) = o;
                const float y = xc[q] * rsqrtf(var[q] * (1.f / 64.f) + 1e-6f) * lw + lb;
                IKT[(size_t)(row >> 4) * 1024 + (((lane >> 5) * 4 + ((lane >> 3) & 3)) * 16 + (row & 15)) * 8 + (lane & 7)] = f2bf(y);
                if (lane < 8) IKW[(size_t)row * 128 + 64 + lane] = f2bf(iwv[q] * (0.35355339059327373f * 0.125f)); } }
    }
}

typedef short v4i16_t __attribute__((ext_vector_type(4)));
__device__ __forceinline__ v4i16_t lds_tr16(const LAS unsigned char* pp) { return __builtin_amdgcn_ds_read_tr16_b64_v4i16((LAS v4i16_t*)pp); }
template <int PROBE = 0> __device__ void phase_moba(const Params& p, LAS unsigned char* lds, int bid, int nb) {
    const int tid = phase_tid(), lane = tid & 63, w = __builtin_amdgcn_readfirstlane(tid >> 6), fr = lane & 15, g = lane >> 4;
    LAS float* BL = (LAS float*)(lds + 1024); LAS float* KM = (LAS float*)(lds + 17408); LAS float* GG = (LAS float*)(lds + 25600);
    LAS unsigned* SM = (LAS unsigned*)(lds + 33792); LAS unsigned* UM = SM + 128; LAS unsigned* TL = SM + 132;
    LAS unsigned char* QS = lds + 34816; LAS unsigned char* KS = lds + 69632; LAS unsigned char* VS = lds + 87040;
    bf16_t* Y = BF(p, OFF_Y); const bf16_t* MK = BF(p, OFF_MK); const bf16_t* MV = BF(p, OFF_MV);
    const float scale = 0.08838834764831845f * 1.4426950408889634f;
    int hprev = -1;
    for (int j = bid; j < 512; j += nb) {
        const int bh = j & 15, qt = (j < 256) ? (j >> 4) : (31 - ((j - 256) >> 4));
        const int h = bh & 3, brow = (bh >> 2) * SEQ, t0 = qt * 128, blk = qt >> 1;
        u32x4 kpre[2], vpre[2];
#pragma unroll
        for (int k = 0; k < 2; ++k) { const int ch = tid + 512 * k, r = ch >> 4, c = ch & 15; const size_t go = (size_t)(brow + blk * 256 + r) * 512 + h * 128 + c * 8; kpre[k] = *(const u32x4*)(MK + go); vpre[k] = *(const u32x4*)(MV + go); }
        u32x4 qpre[4];
#pragma unroll
        for (int k = 0; k < 4; ++k) { const int ch = tid + 512 * k, r = ch >> 4, c = ch & 15; qpre[k] = *(const u32x4*)(Y + (size_t)(brow + t0 + r) * 2048 + 512 + h * 128 + c * 8); }
        if (h != hprev) { __syncthreads(); float blt[8];
#pragma unroll
            for (int k = 0; k < 8; ++k) blt[k] = IN(p, I_REL)[rel_bucket(tid + 512 * k) * 8 + h];
#pragma unroll
            for (int k = 0; k < 8; ++k) BL[tid + 512 * k] = blt[k] * 1.4426950408889634f;
            if (tid < 256) BL[-1 - tid] = -1e30f; hprev = h; }
        { float kmt[4];
#pragma unroll
          for (int k = 0; k < 4; ++k) kmt[k] = F32P(p, OFF_KMEAN)[(size_t)bh * 2048 + tid + 512 * k];
#pragma unroll
          for (int k = 0; k < 4; ++k) KM[tid + 512 * k] = kmt[k]; }
#pragma unroll
        for (int k = 0; k < 4; ++k) { const int ch = tid + 512 * k, r = ch >> 4, c = ch & 15; *(LAS u32x4*)(QS + r * 272 + c * 16) = qpre[k]; }
        if (tid == 0) *UM = 0u;
        __syncthreads();
        bf16x8 qf[4];
#pragma unroll
        for (int ks = 0; ks < 4; ++ks) qf[ks] = *(const LAS bf16x8*)(QS + (16 * w + fr) * 272 + (32 * ks + 8 * g) * 2);
        {
            f32x4 ga = {0.f, 0.f, 0.f, 0.f};
#pragma unroll
            for (int ks = 0; ks < 4; ++ks) { const f32x4 k0 = *(const LAS f32x4*)(KM + fr * 128 + 32 * ks + 8 * g), k1 = *(const LAS f32x4*)(KM + fr * 128 + 32 * ks + 8 * g + 4);
                u32x4 t; t.x = cvt_pk_bf16(k0[0], k0[1]); t.y = cvt_pk_bf16(k0[2], k0[3]); t.z = cvt_pk_bf16(k1[0], k1[1]); t.w = cvt_pk_bf16(k1[2], k1[3]);
                ga = __builtin_amdgcn_mfma_f32_16x16x32_bf16(__builtin_bit_cast(bf16x8, t), qf[ks], ga, 0, 0, 0); }
            mfma_fence(ga);
            *(LAS f32x4*)(GG + (16 * w + fr) * 16 + 4 * g) = ga;
        }
        __syncthreads();
        if (tid < 128) {
            float gv[16];
#pragma unroll
            for (int q4 = 0; q4 < 4; ++q4) { const f32x4 t4 = *(const LAS f32x4*)(GG + tid * 16 + 4 * q4); gv[4 * q4] = t4[0]; gv[4 * q4 + 1] = t4[1]; gv[4 * q4 + 2] = t4[2]; gv[4 * q4 + 3] = t4[3]; }
            unsigned used = 0u;
#pragma unroll
            for (int k = 0; k < 3; ++k) { int best = -1; float bv = 0.f;
#pragma unroll
                for (int n = 0; n < 16; ++n) { const bool cand = (n < blk) && !((used >> n) & 1u) && (best < 0 || gv[n] > bv); best = cand ? n : best; bv = cand ? gv[n] : bv; }
                used |= (best >= 0) ? (1u << best) : 0u; }
            SM[tid] = used; __hip_atomic_fetch_or((unsigned*)UM, used, __ATOMIC_RELAXED, __HIP_MEMORY_SCOPE_WORKGROUP);
        }
        __syncthreads();
        const unsigned mysel = SM[16 * w + fr];
        const int own_tiles = 2 + 2 * (qt & 1);
        {
            const unsigned umask = *UM;
            if (tid < own_tiles) TL[tid] = (unsigned)(blk * 4 + tid);
            if (tid < blk && ((umask >> tid) & 1u)) { const int c0 = own_tiles + 4 * __popc(umask & ((1u << tid) - 1u));
#pragma unroll
                for (int kt = 0; kt < 4; ++kt) TL[c0 + kt] = (unsigned)(tid * 4 + kt); }
            if (tid == 0) TL[64] = (unsigned)(own_tiles + 4 * __popc(umask & ((1u << blk) - 1u))); }
        __syncthreads();
        const int ntiles = (int)TL[64];
        const int tlv = (int)TL[lane];
        const int tq = t0 + 16 * w + fr;
        f32x4 oacc[8];
#pragma unroll
        for (int dt = 0; dt < 8; ++dt) oacc[dt] = (f32x4){0.f, 0.f, 0.f, 0.f};
        float mrun = -1e30f, lsum = 0.f;
        for (int ti = 0; ti < ntiles; ++ti) {
            const int ent = __builtin_amdgcn_readlane(tlv, ti), n = ent >> 2, key0 = ent * 64;
            const bool qsel = (n == blk) || ((mysel >> n) & 1u);
            __syncthreads();
#pragma unroll
            for (int k = 0; k < 2; ++k) { const int ch = tid + 512 * k, r = ch >> 4, c = ch & 15; *(LAS u32x4*)(KS + r * 272 + c * 16) = kpre[k]; *(LAS u32x4*)(VS + r * 288 + c * 16) = vpre[k]; }
            __syncthreads();
            if (ti + 1 < ntiles) { const int keyn = __builtin_amdgcn_readlane(tlv, ti + 1) * 64;
#pragma unroll
                for (int k = 0; k < 2; ++k) { const int ch = tid + 512 * k, r = ch >> 4, c = ch & 15; const size_t go = (size_t)(brow + keyn + r) * 512 + h * 128 + c * 8; kpre[k] = *(const u32x4*)(MK + go); vpre[k] = *(const u32x4*)(MV + go); } }
            {
                f32x4 s[4];
                {
                    bf16x8 ka[4][4];
#pragma unroll
                    for (int k4 = 0; k4 < 4; ++k4)
#pragma unroll
                        for (int ks = 0; ks < 4; ++ks) ka[k4][ks] = *(const LAS bf16x8*)(KS + (16 * k4 + fr) * 272 + (32 * ks + 8 * g) * 2);
                    __builtin_amdgcn_sched_group_barrier(0x100, 16, 0);
#pragma unroll
                    for (int k4 = 0; k4 < 4; ++k4) s[k4] = (f32x4){0.f, 0.f, 0.f, 0.f};
#pragma unroll
                    for (int ks = 0; ks < 4; ++ks)
#pragma unroll
                        for (int k4 = 0; k4 < 4; ++k4) s[k4] = __builtin_amdgcn_mfma_f32_16x16x32_bf16(ka[k4][ks], qf[ks], s[k4], 0, 0, 0);
                    __builtin_amdgcn_sched_group_barrier(0x008, 16, 0);
                }
                mfma_fence(s[0], s[1], s[2], s[3]);
                float mx = -1e30f;
                const LAS float* blp = BL + (tq - key0 - 4 * g - 51);
#pragma unroll
                for (int k4 = 0; k4 < 4; ++k4)
#pragma unroll
                    for (int r = 0; r < 4; ++r) { s[k4][r] = s[k4][r] * scale + blp[51 - (16 * k4 + r)]; mx = fmaxf(mx, s[k4][r]); }
                mx = qsel ? mx : -1e30f;
                mx = max_x16_x32(mx);
                const bool grow = mx > mrun + 8.0f;
                const float mnew = grow ? mx : mrun, alpha = grow ? __builtin_amdgcn_exp2f(mrun - mnew) : 1.0f; mrun = mnew;
                const float meff = qsel ? fmaxf(mnew, -1e20f) : 1e30f;
                float ps = 0.f;
#pragma unroll
                for (int k4 = 0; k4 < 4; ++k4)
#pragma unroll
                    for (int r = 0; r < 4; ++r) { const float pv = __builtin_amdgcn_exp2f(s[k4][r] - meff); s[k4][r] = pv; ps += pv; }
                lsum = lsum * alpha + ps;
                if (__any(alpha != 1.0f)) {
#pragma unroll
                    for (int dt = 0; dt < 8; ++dt) oacc[dt] = oacc[dt] * alpha; }
                bf16x8 pb[2];
#pragma unroll
                for (int m2 = 0; m2 < 2; ++m2) { u32x4 t; t.x = cvt_pk_bf16(s[2 * m2][0], s[2 * m2][1]); t.y = cvt_pk_bf16(s[2 * m2][2], s[2 * m2][3]);
                    t.z = cvt_pk_bf16(s[2 * m2 + 1][0], s[2 * m2 + 1][1]); t.w = cvt_pk_bf16(s[2 * m2 + 1][2], s[2 * m2 + 1][3]); pb[m2] = __builtin_bit_cast(bf16x8, t); }
                v4i16_t flo[2][4], fhi[2][4];
#define MOBA_PVLOAD(buf_, q_) do { _Pragma("unroll") for (int i_ = 0; i_ < 4; ++i_) { const int dt_ = 2 * (q_) + (i_ & 1), m2_ = i_ >> 1; \
                    const LAS unsigned char* va_ = VS + (32 * m2_ + 4 * g + (fr >> 2)) * 288 + (16 * dt_ + 4 * (fr & 3)) * 2; flo[buf_][i_] = lds_tr16(va_); fhi[buf_][i_] = lds_tr16(va_ + 16 * 288); } } while (0)
#define MOBA_PVMMA(buf_, q_) do { _Pragma("unroll") for (int i_ = 0; i_ < 4; ++i_) { const int dt_ = 2 * (q_) + (i_ & 1), m2_ = i_ >> 1; \
                    const bf16x8 a_ = {flo[buf_][i_][0], flo[buf_][i_][1], flo[buf_][i_][2], flo[buf_][i_][3], fhi[buf_][i_][0], fhi[buf_][i_][1], fhi[buf_][i_][2], fhi[buf_][i_][3]}; \
                    oacc[dt_] = __builtin_amdgcn_mfma_f32_16x16x32_bf16(a_, pb[m2_], oacc[dt_], 0, 0, 0); } } while (0)
                MOBA_PVLOAD(0, 0);
                MOBA_PVLOAD(1, 1); __builtin_amdgcn_sched_group_barrier(0x100, 16, 0);
                MOBA_PVMMA(0, 0);  __builtin_amdgcn_sched_group_barrier(0x008, 4, 0);
                MOBA_PVLOAD(0, 2); __builtin_amdgcn_sched_group_barrier(0x100, 8, 0);
                MOBA_PVMMA(1, 1);  __builtin_amdgcn_sched_group_barrier(0x008, 4, 0);
                MOBA_PVLOAD(1, 3); __builtin_amdgcn_sched_group_barrier(0x100, 8, 0);
                MOBA_PVMMA(0, 2);  __builtin_amdgcn_sched_group_barrier(0x008, 4, 0);
                MOBA_PVMMA(1, 3);  __builtin_amdgcn_sched_group_barrier(0x008, 4, 0);
#undef MOBA_PVLOAD
#undef MOBA_PVMMA
            }
        }
        lsum = sum_x16_x32(lsum);
        const float inv = 1.f / lsum;
        mfma_fence(oacc[0], oacc[1], oacc[2], oacc[3]); mfma_fence(oacc[4], oacc[5], oacc[6], oacc[7]);
        __syncthreads();
#pragma unroll
        for (int dt = 0; dt < 8; ++dt) { u32x2 o; o.x = cvt_pk_bf16(oacc[dt][0] * inv, oacc[dt][1] * inv); o.y = cvt_pk_bf16(oacc[dt][2] * inv, oacc[dt][3] * inv);
            if (PROBE) *(u32x2*)((bf16_t*)p.x + (size_t)(brow + tq) * 512 + h * 128 + 16 * dt + 4 * g) = o; else *(u32x2*)(Y + (size_t)(brow + tq) * 2048 + 512 + h * 128 + 16 * dt + 4 * g) = o; }
        __syncthreads();
    }
}


template <int PROBE = 0> __device__ void phase_dsel(const Params& p, LAS unsigned char* lds, int bid, int nb) {
    const int tid = phase_tid(), lane = tid & 63, w = __builtin_amdgcn_readfirstlane(tid >> 6), fr = lane & 15, g = lane >> 4;
    LAS unsigned char* KEYS = lds;
    LAS unsigned char* IQS = lds + 131072;
    const bf16_t* IQ = BF(p, OFF_IQ); const bf16_t* IKW = BF(p, OFF_IKW); const bf16_t* IKT = IKT_PTR(p);
    unsigned* MASK = PROBE ? (unsigned*)((unsigned char*)p.x + (size_t)(PROBE - 1) * 8 * MiB) : (unsigned*)(p.ws + OFF_MASK);
    const int nun = (nb == 256) ? 8 : ((2048 - bid + nb - 1) / nb);
#define DSEL_ITEM(u_) ((nb == 256) ? (((u_) & 1) ? (512 * ((u_) >> 1) + 511 - bid) : (512 * ((u_) >> 1) + bid)) : (bid + (u_) * nb))
    u32x4 iqpre, wpa, wpb; bf16x8 kb0[4][2], kb1[4][2];
#define DSEL_ISSUE(buf, kbase_, base_) do { _Pragma("unroll") for (int j = 0; j < 4; ++j) { int ktl = (base_) + 8 * j; ktl = ktl < 256 ? ktl : 255; const bf16_t* kp = (kbase_) + (size_t)ktl * 1024; \
        (buf)[j][0] = *(const bf16x8*)kp; (buf)[j][1] = *(const bf16x8*)(kp + 512); } } while (0)
#define DSEL_PREFETCH(u_) do { const int k_ = DSEL_ITEM(u_); const int brow_ = (k_ & 3) * SEQ, t0_ = (k_ >> 2) * 8; \
        iqpre = *(const u32x4*)(IQ + (size_t)(brow_ + t0_ + (tid >> 6)) * 512 + (tid & 63) * 8); \
        wpa = *(const u32x4*)(IKW + (size_t)(brow_ + t0_ + 2 * g) * 128 + 64); wpb = *(const u32x4*)(IKW + (size_t)(brow_ + t0_ + 2 * g + 1) * 128 + 64); \
        const bf16_t* kb_ = IKT + (size_t)(brow_ >> 4) * 1024 + (tid & 63) * 8; DSEL_ISSUE(kb0, kb_, w); } while (0)
    if (nun > 0) DSEL_PREFETCH(0);
    for (int u = 0; u < nun; ++u) {
        const int k = DSEL_ITEM(u);
        const int b = k & 3, qt = k >> 2, brow = b * SEQ, t0 = qt * 8, nkt = (t0 + 7) / 16 + 1;
        __syncthreads();
        *(LAS u32x4*)(IQS + (tid >> 6) * 1040 + (tid & 63) * 16) = iqpre;
        __syncthreads();
        {
            bf16x8 aq[4][2];
#pragma unroll
            for (int hp = 0; hp < 4; ++hp)
#pragma unroll
                for (int ks = 0; ks < 2; ++ks) aq[hp][ks] = *(const LAS bf16x8*)(IQS + (fr >> 1) * 1040 + ((2 * hp + (fr & 1)) * 64 + 32 * ks + 8 * g) * 2);
            float wa[8], wb[8];
#pragma unroll
            for (int hh = 0; hh < 8; ++hh) { wa[hh] = (hh & 1) ? __uint_as_float(wpa[hh >> 1] & 0xffff0000u) : __uint_as_float(wpa[hh >> 1] << 16); wb[hh] = (hh & 1) ? __uint_as_float(wpb[hh >> 1] & 0xffff0000u) : __uint_as_float(wpb[hh >> 1] << 16); }
            const int tqa = t0 + 2 * g, tqb = tqa + 1;
            const bf16_t* kbase = IKT + (size_t)(brow >> 4) * 1024 + lane * 8;
#define DSEL_COMPUTE(buf, base_) do { _Pragma("unroll") for (int j = 0; j < 4; ++j) { const int kt = (base_) + 8 * j; if (kt < nkt) { \
                float sa = 0.f, sb = 0.f; \
                f32x4 ah[4]; \
                _Pragma("unroll") for (int hp = 0; hp < 4; ++hp) { f32x4 acc = {0.f, 0.f, 0.f, 0.f}; \
                    acc = __builtin_amdgcn_mfma_f32_16x16x32_bf16(aq[hp][0], (buf)[j][0], acc, 0, 0, 0); acc = __builtin_amdgcn_mfma_f32_16x16x32_bf16(aq[hp][1], (buf)[j][1], acc, 0, 0, 0); ah[hp] = acc; } \
                mfma_fence(ah[0], ah[1], ah[2], ah[3]); \
                _Pragma("unroll") for (int hp = 0; hp < 4; ++hp) { sa += wa[2 * hp] * relu_(ah[hp][0]) + wa[2 * hp + 1] * relu_(ah[hp][1]); sb += wb[2 * hp] * relu_(ah[hp][2]) + wb[2 * hp + 1] * relu_(ah[hp][3]); } \
                const int spos = 16 * kt + fr; \
                unsigned ua = __float_as_uint(sa + 0.0f); ua ^= (unsigned)((int)ua >> 31) | 0x80000000u;        \
                unsigned ub = __float_as_uint(sb + 0.0f); ub ^= (unsigned)((int)ub >> 31) | 0x80000000u; \
                unsigned ka_ = (ua & 0xfffff000u) | (unsigned)(4095 - spos), kb_ = (ub & 0xfffff000u) | (unsigned)(4095 - spos); \
                if (16 * kt + 15 > t0) { ka_ = (spos <= tqa) ? ka_ : 0u; kb_ = (spos <= tqb) ? kb_ : 0u; }        \
                *(LAS unsigned*)(KEYS + (2 * g) * 16384 + spos * 4) = ka_; \
                *(LAS unsigned*)(KEYS + (2 * g + 1) * 16384 + spos * 4) = kb_; } } } while (0)
            for (int base = w; base < nkt; base += 64) {
                DSEL_ISSUE(kb1, kbase, base + 32);
                DSEL_COMPUTE(kb0, base);
                DSEL_ISSUE(kb0, kbase, base + 64);
                DSEL_COMPUTE(kb1, base + 32);
            }
#undef DSEL_COMPUTE
        }
        __syncthreads();
        if (u + 1 < nun) DSEL_PREFETCH(u + 1);
        {
            const int t = t0 + w; const int nch = 4 * nkt;
            const int mmax = (nch + 63) >> 6;
            u32x4 kr[16];
#pragma unroll
            for (int m = 0; m < 16; ++m) { const int c = lane + 64 * m; const u32x4 z = {0u, 0u, 0u, 0u};
                kr[m] = (m < mmax && c < nch) ? *(const LAS u32x4*)(KEYS + w * 16384 + c * 16) : z; }
            unsigned thr = 1u;
            if (t + 1 > 256) {
                u32x4 gm = kr[0];
#pragma unroll
                for (int m = 1; m < 16; ++m) { gm.x = max(gm.x, kr[m].x); gm.y = max(gm.y, kr[m].y); gm.z = max(gm.z, kr[m].z); gm.w = max(gm.w, kr[m].w); }
                unsigned vlo = min(min(gm.x, gm.y), min(gm.z, gm.w)), vhi = max(max(gm.x, gm.y), max(gm.z, gm.w));
                unsigned lo = wave_min_u32(vlo), hi = wave_max_u32(vhi);
                lo = lo > 1u ? lo : 1u;
                while (lo < hi) {
                    const unsigned cand = lo + ((hi - lo + 1u) >> 1);
                    unsigned c0 = 0u, c1 = 0u, c2 = 0u, c3 = 0u;
#define DSEL_CNT1(m_) do { unsigned long long q0_, q1_, q2_, q3_; asm volatile( \
                        "v_cmp_ge_u32_e64 %[q0], %[kx], %[cd]\n\tv_cmp_ge_u32_e64 %[q1], %[ky], %[cd]\n\tv_cmp_ge_u32_e64 %[q2], %[kz], %[cd]\n\tv_cmp_ge_u32_e64 %[q3], %[kw], %[cd]\n\t" \
                        "v_addc_co_u32_e64 %[a0], %[q0], 0, %[a0], %[q0]\n\tv_addc_co_u32_e64 %[a1], %[q1], 0, %[a1], %[q1]\n\tv_addc_co_u32_e64 %[a2], %[q2], 0, %[a2], %[q2]\n\tv_addc_co_u32_e64 %[a3], %[q3], 0, %[a3], %[q3]" \
                        : [q0] "=&s"(q0_), [q1] "=&s"(q1_), [q2] "=&s"(q2_), [q3] "=&s"(q3_), [a0] "+v"(c0), [a1] "+v"(c1), [a2] "+v"(c2), [a3] "+v"(c3) \
                        : [kx] "v"(kr[m_].x), [ky] "v"(kr[m_].y), [kz] "v"(kr[m_].z), [kw] "v"(kr[m_].w), [cd] "s"(cand)); } while (0)
#define DSEL_CNT4(b_) do { DSEL_CNT1((b_)); DSEL_CNT1((b_) + 1); DSEL_CNT1((b_) + 2); DSEL_CNT1((b_) + 3); } while (0)
                    switch ((mmax + 3) >> 2) { case 4: DSEL_CNT4(12); case 3: DSEL_CNT4(8); case 2: DSEL_CNT4(4); default: DSEL_CNT4(0); }
#undef DSEL_CNT4
#undef DSEL_CNT1
                    const unsigned cn = wave_sum_u32((c0 + c1) + (c2 + c3));
                    if (cn >= 256u) { lo = cand; if (cn == 256u) break; } else hi = cand - 1u;
                }
                thr = lo; }
            unsigned* mrow = MASK + (size_t)(brow + t) * 128;
#pragma unroll
            for (int m = 0; m < 16; ++m) {
                unsigned nib = 0u;
                if (m < mmax) nib = ((kr[m].x >= thr) ? 1u : 0u) | ((kr[m].y >= thr) ? 2u : 0u) | ((kr[m].z >= thr) ? 4u : 0u) | ((kr[m].w >= thr) ? 8u : 0u);
                unsigned v = nib << (4 * (lane & 7));
                v |= (unsigned)__builtin_amdgcn_update_dpp(0, (int)v, 0xB1, 0xf, 0xf, true); v |= (unsigned)__builtin_amdgcn_update_dpp(0, (int)v, 0x4E, 0xf, 0xf, true);
                v |= (unsigned)__builtin_amdgcn_update_dpp(0, (int)v, 0x141, 0xf, 0xf, true);
                if ((lane & 7) == 0) mrow[(lane >> 3) + 8 * m] = v;
            }
        }
    }
#undef DSEL_ISSUE
#undef DSEL_PREFETCH
#undef DSEL_ITEM
}

template <int PROBE = 0> __device__ void phase_datt(const Params& p, LAS unsigned char* lds, int bid, int nb) {
    const int tid = phase_tid(), lane = tid & 63, w = __builtin_amdgcn_readfirstlane(tid >> 6), fr = lane & 15, g = lane >> 4;
    LAS unsigned char* BK = lds;
    LAS float* RL = (LAS float*)(lds + 4112);
    LAS unsigned short* IDX = (LAS unsigned short*)(lds + 5184 + w * 512);
    LAS unsigned char* CT = lds + 9280 + w * (32 * 544);
    const bf16_t* CKV = BF(p, OFF_CKV); bf16_t* Y = BF(p, OFF_Y); const unsigned* MASK = (const unsigned*)(p.ws + OFF_MASK);
    for (int dd = tid; dd < 4096; dd += 512) BK[dd] = (unsigned char)rel_bucket(dd);
    if (tid == 0) BK[4096] = 32;
    if (tid < 256) RL[tid] = IN(p, I_REL)[tid] * 1.4426950408889634f;
    if (tid < 8) RL[256 + tid] = -1e30f;
    __syncthreads();
    const float scale = 0.08838834764831845f * 1.4426950408889634f;
    const int hd = fr & 3;
    for (int it = bid; it < NTOK / 8; it += nb) {
        const int tg = it * 8 + w, brow = (tg >> 12) * SEQ, t = tg & 4095;
        const u32x2 mw = *(const u32x2*)(MASK + (size_t)tg * 128 + 2 * lane);
        const int cnt = __popc(mw.x) + __popc(mw.y);
        const int pre = wave_scan_incl(cnt);
        const int nsel = __builtin_amdgcn_readlane(pre, 63);
        int pos = pre - cnt;
        { unsigned m0 = mw.x; while (m0) { const int bpos = __ffs(m0) - 1; m0 &= m0 - 1; IDX[pos++] = (unsigned short)(64 * lane + bpos); }
          unsigned m1 = mw.y; while (m1) { const int bpos = __ffs(m1) - 1; m1 &= m1 - 1; IDX[pos++] = (unsigned short)(64 * lane + 32 + bpos); } }
        for (int e = nsel + lane; e < 256; e += 64) IDX[e] = (unsigned short)(t + 1);
        bf16x8 qb[8];
#pragma unroll
        for (int ks = 0; ks < 8; ++ks) { const u32x4 z = {0u, 0u, 0u, 0u}; const u32x4 v = (fr < 4) ? *(const u32x4*)(Y + (size_t)tg * 2048 + 1024 + fr * 256 + 32 * ks + 8 * g) : z; qb[ks] = __builtin_bit_cast(bf16x8, v); }
        f32x4 oacc[16];
#pragma unroll
        for (int rt = 0; rt < 16; ++rt) oacc[rt] = (f32x4){0.f, 0.f, 0.f, 0.f};
        float mrun = -1e30f, lsum = 0.f;
        const int nstep = (nsel + 31) >> 5;
        u32x4 gr[16];
        const int hi32 = lane >> 5, ch16 = (lane & 31) * 8; const unsigned cko = (unsigned)brow * 256u + (unsigned)ch16;
#define DATT_GATHER(st_) do { const LAS u32x4* ip_ = (const LAS u32x4*)(IDX + 32 * (st_)); \
            _Pragma("unroll") for (int q4 = 0; q4 < 4; ++q4) { const u32x4 iv_ = ip_[q4]; \
                _Pragma("unroll") for (int e = 0; e < 4; ++e) { const unsigned row_ = hi32 ? (iv_[e] >> 16) : (iv_[e] & 0xffffu); \
                    gr[4 * q4 + e] = *(const u32x4*)(CKV + (cko + row_ * 256u)); } } } while (0)
        DATT_GATHER(0);
        for (int st = 0; st < nstep; ++st) {
#pragma unroll
            for (int i = 0; i < 16; ++i) *(LAS u32x4*)(CT + (2 * i + hi32) * 544 + (lane & 31) * 16) = gr[i];
            f32x4 s0 = {0.f, 0.f, 0.f, 0.f}, s1 = {0.f, 0.f, 0.f, 0.f};
            {
                bf16x8 fa[2][2];
#define DATT_SLOAD(buf_, ks_) do { fa[buf_][0] = *(const LAS bf16x8*)(CT + fr * 544 + (32 * (ks_) + 8 * g) * 2); fa[buf_][1] = *(const LAS bf16x8*)(CT + (16 + fr) * 544 + (32 * (ks_) + 8 * g) * 2); } while (0)
#define DATT_SMMA(buf_, ks_) do { s0 = __builtin_amdgcn_mfma_f32_16x16x32_bf16(fa[buf_][0], qb[ks_], s0, 0, 0, 0); s1 = __builtin_amdgcn_mfma_f32_16x16x32_bf16(fa[buf_][1], qb[ks_], s1, 0, 0, 0); } while (0)
                DATT_SLOAD(0, 0); DATT_SLOAD(1, 1); __builtin_amdgcn_sched_group_barrier(0x100, 4, 0);
#pragma unroll
                for (int ks = 0; ks < 8; ks += 2) {
                    DATT_SMMA(0, ks);     __builtin_amdgcn_sched_group_barrier(0x008, 2, 0);
                    if (ks + 2 < 8) { DATT_SLOAD(0, ks + 2); __builtin_amdgcn_sched_group_barrier(0x100, 2, 0); }
                    DATT_SMMA(1, ks + 1); __builtin_amdgcn_sched_group_barrier(0x008, 2, 0);
                    if (ks + 3 < 8) { DATT_SLOAD(1, ks + 3); __builtin_amdgcn_sched_group_barrier(0x100, 2, 0); }
                }
#undef DATT_SLOAD
#undef DATT_SMMA
            }
            mfma_fence(s0); mfma_fence(s1);
            if (st + 1 < nstep) DATT_GATHER(st + 1);
            float mx = -1e30f;
#pragma unroll
            for (int r = 0; r < 4; ++r) {
                { const int slot = 32 * st + 4 * g + r; const unsigned di = min((unsigned)(t - (int)IDX[slot]), 4096u); s0[r] = s0[r] * scale + RL[BK[di] * 8 + 4 + hd]; mx = fmaxf(mx, s0[r]); }
                { const int slot = 32 * st + 16 + 4 * g + r; const unsigned di = min((unsigned)(t - (int)IDX[slot]), 4096u); s1[r] = s1[r] * scale + RL[BK[di] * 8 + 4 + hd]; mx = fmaxf(mx, s1[r]); } }
            mx = max_x16_x32(mx);
            const bool grow = mx > mrun + 8.0f;
            const float mnew = grow ? mx : mrun, alpha = grow ? __builtin_amdgcn_exp2f(mrun - mnew) : 1.0f; mrun = mnew;
            float ps = 0.f;
#pragma unroll
            for (int r = 0; r < 4; ++r) { const float p0 = __builtin_amdgcn_exp2f(s0[r] - mnew), p1 = __builtin_amdgcn_exp2f(s1[r] - mnew);        s0[r] = p0; s1[r] = p1; ps += p0 + p1; }
            lsum = lsum * alpha + ps;
            if (__any(alpha != 1.0f)) {
#pragma unroll
                for (int rt = 0; rt < 16; ++rt) oacc[rt] = oacc[rt] * alpha; }
            u32x4 pt; pt.x = cvt_pk_bf16(s0[0], s0[1]); pt.y = cvt_pk_bf16(s0[2], s0[3]); pt.z = cvt_pk_bf16(s1[0], s1[1]); pt.w = cvt_pk_bf16(s1[2], s1[3]);
            const bf16x8 pb = __builtin_bit_cast(bf16x8, pt);
            {
                v4i16_t flo[2][2], fhi[2][2];
#define DATT_PVLOAD(buf_, q_) do { _Pragma("unroll") for (int i_ = 0; i_ < 2; ++i_) { const int rt_ = 2 * (q_) + i_; \
                    const LAS unsigned char* va_ = CT + (4 * g + (fr >> 2)) * 544 + (16 * rt_ + 4 * (fr & 3)) * 2; flo[buf_][i_] = lds_tr16(va_); fhi[buf_][i_] = lds_tr16(va_ + 16 * 544); } } while (0)
#define DATT_PVMMA(buf_, q_) do { _Pragma("unroll") for (int i_ = 0; i_ < 2; ++i_) { const int rt_ = 2 * (q_) + i_; \
                    const bf16x8 a_ = {flo[buf_][i_][0], flo[buf_][i_][1], flo[buf_][i_][2], flo[buf_][i_][3], fhi[buf_][i_][0], fhi[buf_][i_][1], fhi[buf_][i_][2], fhi[buf_][i_][3]}; \
                    oacc[rt_] = __builtin_amdgcn_mfma_f32_16x16x32_bf16(a_, pb, oacc[rt_], 0, 0, 0); } } while (0)
                DATT_PVLOAD(0, 0);
                DATT_PVLOAD(1, 1); __builtin_amdgcn_sched_group_barrier(0x100, 8, 0);
#pragma unroll
                for (int q = 0; q < 8; q += 2) {
                    DATT_PVMMA(0, q);     __builtin_amdgcn_sched_group_barrier(0x008, 2, 0);
                    if (q + 2 < 8) { DATT_PVLOAD(0, q + 2); __builtin_amdgcn_sched_group_barrier(0x100, 4, 0); }
                    DATT_PVMMA(1, q + 1); __builtin_amdgcn_sched_group_barrier(0x008, 2, 0);
                    if (q + 3 < 8) { DATT_PVLOAD(1, q + 3); __builtin_amdgcn_sched_group_barrier(0x100, 4, 0); }
                }
#undef DATT_PVLOAD
#undef DATT_PVMMA
            }
        }
#undef DATT_GATHER
        lsum = sum_x16_x32(lsum);
        const float inv = 1.f / lsum;
        mfma_fence(oacc[0], oacc[1], oacc[2], oacc[3]); mfma_fence(oacc[4], oacc[5], oacc[6], oacc[7]); mfma_fence(oacc[8], oacc[9], oacc[10], oacc[11]); mfma_fence(oacc[12], oacc[13], oacc[14], oacc[15]);
        if (fr < 4) {
            bf16_t* yo = PROBE ? ((bf16_t*)((unsigned char*)p.x + 32 * MiB) + (size_t)tg * 1024 + fr * 256 + 4 * g) : (Y + (size_t)tg * 2048 + 1024 + fr * 256 + 4 * g);
#pragma unroll
            for (int rt = 0; rt < 16; ++rt) { u32x2 o; o.x = cvt_pk_bf16(oacc[rt][0] * inv, oacc[rt][1] * inv); o.y = cvt_pk_bf16(oacc[rt][2] * inv, oacc[rt][3] * inv); *(u32x2*)(yo + 16 * rt) = o; }
        }
    }
}

__device__ __forceinline__ Params opq(const Params& p) { Params q = p; asm volatile("" : "+s"(q.ws), "+s"(q.x)); return q; }
__device__ __forceinline__ int opqi(int v) { asm volatile("" : "+s"(v)); return v; }
#define GRID_BARRIER() do { XcdBarrier _b; _b.bar = (unsigned*)(opq(p).ws + OFF_CTL); _b.x = xb_xcc_id(); _b.st = (volatile LAS unsigned*)(lds + LDS_PHASE_BYTES); xcd_barrier(_b); } while (0)
#define PP opq(p)
#define BB opqi(bid)
__device__ __forceinline__ void layer_body(const Params& p, LAS unsigned char* lds, const int bid, const int nb, const int l) {
        phase_gemm_in(PP, lds, BB, nb);
        GRID_BARRIER();
#pragma unroll 1
        for (int stp = 0; stp < 2; ++stp) { if ((stp == 0) != ((BB & 1) != 0)) phase_prep(PP, l, lds, BB, nb); else phase_hg1(PP, l, lds, BB, nb); }
        GRID_BARRIER();
#pragma unroll 1
        for (int stp = 0; stp < 2; ++stp) { if ((stp == 0) != ((BB & 1) != 0)) phase_hg2(PP, BB, nb); else phase_moba(PP, lds, BB, nb); }
        phase_dsel(PP, lds, BB, nb);
        GRID_BARRIER();
        phase_hg3(PP, l, lds, BB, nb);
        phase_datt(PP, lds, BB, nb);
        __syncthreads();
        phase_conv_postA(PP, l, lds, BB, nb);
        GRID_BARRIER();
        phase_conv_postB(PP, l, lds, BB, nb);
        phase_gemm_gates(PP, lds, BB, nb);
        GRID_BARRIER();
        phase_gemm_branch(PP, lds, BB, nb);
        GRID_BARRIER();
        phase_gemm_out(PP, lds, BB, nb);
        GRID_BARRIER();
        { const Params q = PP;
          if (l == 0) phase_norm<1, false, true>(IN(q, I_X), BF(q, OFF_XB), BF(q, OFF_OUT), IN(q, I_POSTMIX) + l * 1024, IN(q, I_PREFFN) + l * 1024, BF(q, OFF_H), BB, nb);
          else        phase_norm<1, true, true>((float*)q.x, BF(q, OFF_XB), BF(q, OFF_OUT), IN(q, I_POSTMIX) + l * 1024, IN(q, I_PREFFN) + l * 1024, BF(q, OFF_H), BB, nb); }
        GRID_BARRIER();
        phase_gemm_ffn1(PP, lds, BB, nb);
        GRID_BARRIER();
        phase_gemm_ffn2(PP, lds, BB, nb);
        GRID_BARRIER();
        if (l + 1 < DEPTH) { { const Params q = PP; phase_norm<1, true, true>(BF(q, OFF_XB), (float*)q.x, BF(q, OFF_OUT), IN(q, I_POSTFFN) + l * 1024, IN(q, I_PREMIX) + (l + 1) * 1024, BF(q, OFF_H), BB, nb); } phase_conv_in(PP, l + 1, lds, BB, nb); GRID_BARRIER(); }
        else { const Params q = PP; phase_norm<2, true, false>(BF(q, OFF_XB), (float*)q.x, BF(q, OFF_OUT), IN(q, I_POSTFFN) + l * 1024, nullptr, nullptr, BB, nb); }
}
__global__ __launch_bounds__(512, 2) void mega_fwd(Params p) {
    extern __shared__ __attribute__((aligned(16))) unsigned char shm[];
    LAS unsigned char* lds = (LAS unsigned char*)shm;
    const int bid = blockIdx.x, nb = gridDim.x;
    volatile LAS unsigned* xbw = (volatile LAS unsigned*)(lds + LDS_PHASE_BYTES);
    if (threadIdx.x < 4) xbw[threadIdx.x] = 0u;
    __syncthreads();
    (void)xcd_barrier_post((unsigned*)(p.ws + OFF_CTL), xbw);
    { const Params q = PP; phase_norm<0, false, false>(IN(q, I_X), nullptr, nullptr, nullptr, IN(q, I_PREMIX), BF(q, OFF_H), BB, nb); }
    phase_conv_in(PP, 0, lds, BB, nb);
    GRID_BARRIER();
    for (int l = 0; l < DEPTH; ++l) layer_body(p, lds, bid, nb, l);
}

#define LDS_BYTES (LDS_PHASE_BYTES + 16)
extern "C" void kernel_launch(void* const* d_in, const int* in_sizes, int n_in, void* d_out, int out_size, void* d_ws, size_t ws_size, hipStream_t stream) {
    static int grid = 0;
    if (grid == 0) {
        int dev = 0, cus = 0;
        if (hipGetDevice(&dev) != hipSuccess || hipDeviceGetAttribute(&cus, hipDeviceAttributeMultiprocessorCount, dev) != hipSuccess || cus < 1) { fprintf(stderr, "kernel_launch: no device info\n"); grid = -1; return; }
        if (hipFuncSetAttribute((const void*)mega_fwd, hipFuncAttributeMaxDynamicSharedMemorySize, LDS_BYTES) != hipSuccess) { fprintf(stderr, "kernel_launch: hipFuncSetAttribute failed\n"); grid = -1; return; }
        int per_cu = 0;
        if (hipOccupancyMaxActiveBlocksPerMultiprocessor(&per_cu, (const void*)mega_fwd, 512, LDS_BYTES) != hipSuccess || per_cu < 1) { fprintf(stderr, "kernel_launch: occupancy query says %d blocks per CU\n", per_cu); }
        (void)hipGetLastError();
        grid = cus;
    }
    if (grid < 0) return;
    Params p{};
    for (int i = 0; i < 20; ++i) p.in[i] = (GAS const float*)d_in[i];
    p.x = (GAS float*)d_out; p.ws = (GAS unsigned char*)d_ws;
    if (WS_NEED > ws_size) { fprintf(stderr, "kernel_launch: workspace too small (%zu < %zu)\n", ws_size, (size_t)WS_NEED); return; }
    (void)hipMemsetAsync((unsigned char*)d_ws + OFF_CTL, 0, 16384, stream);
    hipLaunchKernelGGL(mega_fwd, dim3(grid), dim3(512), LDS_BYTES, stream, p);
}
```
